# Optimizing an MI355X kernel written in HIP

```python
import jax, jax.numpy as jnp
from jax import lax
import numpy as np

D_MODEL = 1024
BATCH = 8
SEQ = 2048
DEPTH = 2
DEC_BATCH = 128
DEC_SEQ = 1
PAST_LEN = 16384
PAGE_SIZE = 128

N_MIXERS = 2
N_POOL_LAYERS = (DEPTH + N_MIXERS - 1) // N_MIXERS
N_CONV_LAYERS = DEPTH // N_MIXERS
POOL_WINDOWS = (2, 4, 8, 16)
N_POOL_GROUPS = len(POOL_WINDOWS)
POOL_GROUP = D_MODEL // N_POOL_GROUPS
POOL_STATE = max(POOL_WINDOWS) - 1
CONV_WIDTH = 3
CONV_STATE = CONV_WIDTH - 1
D_CONV = D_MODEL
D_FF = 4 * D_MODEL
N_MEM = 256
MEM_HEADS = 4
MEM_HEAD_DIM = D_MODEL // MEM_HEADS
EPS = 1e-6

kernel_name = "hybrid_pool_shortconv_memxattn_step"


def rmsnorm(x, g):
    xf = x.astype(jnp.float32)
    y = xf * lax.rsqrt(jnp.mean(xf * xf, axis=-1, keepdims=True) + EPS)
    return (y * g.astype(jnp.float32)).astype(x.dtype)


def pool_mixer(u, prev, start_pos, w_pool, scale):
    b, t, d = u.shape
    ext = jnp.concatenate([prev, u], axis=1)
    c = jnp.cumsum(ext.astype(jnp.float32), axis=1)
    c = jnp.pad(c, ((0, 0), (1, 0), (0, 0)))
    end = c[:, POOL_STATE + 1:POOL_STATE + 1 + t]
    pos = start_pos + jnp.arange(t)
    means = []
    for g, w in enumerate(POOL_WINDOWS):
        sl = slice(g * POOL_GROUP, (g + 1) * POOL_GROUP)
        begin = c[:, POOL_STATE + 1 - w:POOL_STATE + 1 - w + t, sl]
        cnt = jnp.minimum(pos + 1, w).astype(jnp.float32)[None, :, None]
        means.append((end[..., sl] - begin) / cnt)
    pooled = jnp.concatenate(means, axis=-1) - u.astype(jnp.float32)
    pooled = pooled.reshape(b, t, N_POOL_GROUPS, POOL_GROUP).astype(u.dtype)
    y = jnp.einsum('btgc,gce->btge', pooled, w_pool).reshape(b, t, d)
    return y * scale, ext[:, -POOL_STATE:]


def conv_mixer(u, prev, w_in, w_conv, w_out):
    t = u.shape[1]
    bch = jnp.einsum('btd,de->bte', u, w_in)
    gate_b, gate_c, h = jnp.split(bch, 3, axis=-1)
    ext = jnp.concatenate([prev, gate_c * h], axis=1)
    conv = ext[:, 0:t] * w_conv[0]
    for k in range(1, CONV_WIDTH):
        conv = conv + ext[:, k:k + t] * w_conv[k]
    y = jnp.einsum('bte,ed->btd', gate_b * conv, w_out)
    return y, ext[:, -CONV_STATE:]


def mem_kv(mem, g_mem, w_kv):
    b, n, _ = mem.shape
    kv = jnp.einsum('bnd,de->bne', rmsnorm(mem, g_mem), w_kv)
    k, v = jnp.split(kv, 2, axis=-1)
    return (k.reshape(b, n, MEM_HEADS, MEM_HEAD_DIM), v.reshape(b, n, MEM_HEADS, MEM_HEAD_DIM))


def mem_attend(u, k, v, w_q, w_o):
    b, t, d = u.shape
    q = jnp.einsum('btd,de->bte', u, w_q).reshape(b, t, MEM_HEADS, MEM_HEAD_DIM)
    s = jnp.einsum('bthd,bnhd->bhtn', q, k).astype(jnp.float32) * (MEM_HEAD_DIM ** -0.5)
    p = jax.nn.softmax(s, axis=-1).astype(v.dtype)
    o = jnp.einsum('bhtn,bnhd->bthd', p, v).reshape(b, t, d)
    return jnp.einsum('btd,de->bte', o, w_o)


def sq_relu_mlp(u, w_up, w_down):
    h = jax.nn.relu(jnp.einsum('btd,df->btf', u, w_up))
    return jnp.einsum('btf,fd->btd', h * h, w_down)


def trunk(x, pool_prev, conv_prev, mem_k, mem_v, start_pos,
          g_mix, g_attn, g_ffn, g_final, w_pool, pool_scale,
          w_conv_in, w_conv, w_conv_out, w_q, w_o, w_up, w_down):
    new_pool, new_conv = [], []
    for i in range(DEPTH):
        j = i // N_MIXERS
        u = rmsnorm(x, g_mix[i])
        if i % N_MIXERS == 0:
            y, st = pool_mixer(u, pool_prev[j], start_pos, w_pool[j], pool_scale[j])
            new_pool.append(st)
        else:
            y, st = conv_mixer(u, conv_prev[j], w_conv_in[j], w_conv[j], w_conv_out[j])
            new_conv.append(st)
        x = x + y
        x = x + mem_attend(rmsnorm(x, g_attn[i]), mem_k[i], mem_v[i], w_q[i], w_o[i])
        x = x + sq_relu_mlp(rmsnorm(x, g_ffn[i]), w_up[i], w_down[i])
    return rmsnorm(x, g_final), jnp.stack(new_pool), jnp.stack(new_conv)


def setup_inputs(seed: int = 0) -> dict:
    key = jax.random.key(seed)
    ks = jax.random.split(key, 24)
    f32 = jnp.float32
    nrm = lambda k, shape, s: jax.random.normal(k, shape, f32) * s
    gain = lambda k, shape: 1.0 + 0.05 * jax.random.normal(k, shape, f32)
    mem_shape = (DEPTH, DEC_BATCH, N_MEM, MEM_HEADS, MEM_HEAD_DIM)
    return {
        "x_prompt": nrm(ks[0], (BATCH, SEQ, D_MODEL), 1.0),
        "x_sample": nrm(ks[1], (DEC_BATCH, DEC_SEQ, D_MODEL), 1.0),
        "state_pool": nrm(ks[2], (N_POOL_LAYERS, DEC_BATCH, POOL_STATE, D_MODEL), 1.0),
        "state_conv": nrm(ks[3], (N_CONV_LAYERS, DEC_BATCH, CONV_STATE, D_CONV), 1.0),
        "cache_mem_k": nrm(ks[4], mem_shape, 1.0),
        "cache_mem_v": nrm(ks[5], mem_shape, 1.0),
        "mem_prompt": nrm(ks[6], (BATCH, N_MEM, D_MODEL), 1.0),
        "g_mix": gain(ks[7], (DEPTH, D_MODEL)),
        "g_attn": gain(ks[8], (DEPTH, D_MODEL)),
        "g_mem": gain(ks[9], (DEPTH, D_MODEL)),
        "g_ffn": gain(ks[10], (DEPTH, D_MODEL)),
        "g_final": gain(ks[11], (D_MODEL,)),
        "w_pool": nrm(ks[12], (N_POOL_LAYERS, N_POOL_GROUPS, POOL_GROUP, POOL_GROUP), POOL_GROUP ** -0.5),
        "pool_scale": 0.5 + 0.1 * jax.random.normal(ks[13], (N_POOL_LAYERS, D_MODEL), f32),
        "w_conv_in": nrm(ks[14], (N_CONV_LAYERS, D_MODEL, 3 * D_CONV), D_MODEL ** -0.5),
        "w_conv": nrm(ks[15], (N_CONV_LAYERS, CONV_WIDTH, D_CONV), CONV_WIDTH ** -0.5),
        "w_conv_out": nrm(ks[16], (N_CONV_LAYERS, D_CONV, D_MODEL), D_CONV ** -0.5),
        "w_q": nrm(ks[17], (DEPTH, D_MODEL, D_MODEL), D_MODEL ** -0.5),
        "w_kv": nrm(ks[18], (DEPTH, D_MODEL, 2 * D_MODEL), D_MODEL ** -0.5),
        "w_o": nrm(ks[19], (DEPTH, D_MODEL, D_MODEL), D_MODEL ** -0.5),
        "w_up": nrm(ks[20], (DEPTH, D_MODEL, D_FF), D_MODEL ** -0.5),
        "w_down": nrm(ks[21], (DEPTH, D_FF, D_MODEL), D_FF ** -0.5),
    }


def reference(x_prompt, x_sample, state_pool, state_conv, cache_mem_k, cache_mem_v, mem_prompt,
              g_mix, g_attn, g_mem, g_ffn, g_final, w_pool, pool_scale,
              w_conv_in, w_conv, w_conv_out, w_q, w_kv, w_o, w_up, w_down):
    kvs = [mem_kv(mem_prompt, g_mem[i], w_kv[i]) for i in range(DEPTH)]
    mem_k_prompt = jnp.stack([kv[0] for kv in kvs])
    mem_v_prompt = jnp.stack([kv[1] for kv in kvs])
    b = x_prompt.shape[0]
    pool0 = jnp.zeros((N_POOL_LAYERS, b, POOL_STATE, D_MODEL), x_prompt.dtype)
    conv0 = jnp.zeros((N_CONV_LAYERS, b, CONV_STATE, D_CONV), x_prompt.dtype)
    y_prompt, new_pool_prompt, new_conv_prompt = trunk(
        x_prompt, pool0, conv0, mem_k_prompt, mem_v_prompt, 0,
        g_mix, g_attn, g_ffn, g_final, w_pool, pool_scale,
        w_conv_in, w_conv, w_conv_out, w_q, w_o, w_up, w_down)
    y_sample, new_pool_sample, new_conv_sample = trunk(
        x_sample, state_pool, state_conv, cache_mem_k, cache_mem_v, PAST_LEN,
        g_mix, g_attn, g_ffn, g_final, w_pool, pool_scale,
        w_conv_in, w_conv, w_conv_out, w_q, w_o, w_up, w_down)
    return (y_prompt, y_sample, new_pool_prompt, new_conv_prompt, mem_k_prompt, mem_v_prompt,
            new_pool_sample, new_conv_sample)
```

```cpp
#include <hip/hip_runtime.h>
#include <cstdio>
#include <cstdint>

#define DBG_SCALE_MASK 0x00
#define DBGF(k) (((DBG_SCALE_MASK >> (k)) & 1) ? 0.8f : 1.0f)
#ifndef MK_PER_PHASE
#define MK_PER_PHASE 0
#endif

constexpr int D = 1024, BATCH = 8, SEQ = 2048, MP = BATCH * SEQ  , MS = 128  ;
constexpr int NMEM = 256, NH = 4, HD = 256, FF = 4096, MEMROWS = BATCH * NMEM  ;
constexpr float EPS = 1e-6f;
constexpr float QSCALE = 0.0625f * 1.4426950408889634f;

constexpr size_t OY = 0, OYS = 16777216, OPP = 16908288, OCP = 17031168, OMK = 17047552, OMV = 21241856, OPS = 25436160, OCS = 27402240;

#define SWZ_XOR(v, m) __builtin_bit_cast(float, __builtin_amdgcn_ds_swizzle(__builtin_bit_cast(int, (float)(v)), (((m) << 10) | 0x1f)))
__device__ __forceinline__ void swap32(float& a, float& b) { asm volatile("s_nop 1\n\tv_permlane32_swap_b32 %0, %1\n\ts_nop 1" : "+v"(a), "+v"(b)); }
__device__ __forceinline__ float add_x32(float v) { float a = v, b = v; swap32(a, b); return a + b; }
__device__ __forceinline__ float max_x32(float v) { float a = v, b = v; swap32(a, b); return fmaxf(a, b); }
__device__ __forceinline__ float add_x16_x32(float v) { v += SWZ_XOR(v, 16); return add_x32(v); }
__device__ __forceinline__ float max_x16_x32(float v) { v = fmaxf(v, SWZ_XOR(v, 16)); return max_x32(v); }
__device__ __forceinline__ float wave_sum(float v) { v += SWZ_XOR(v, 1); v += SWZ_XOR(v, 2); v += SWZ_XOR(v, 4); v += SWZ_XOR(v, 8); v += SWZ_XOR(v, 16); return add_x32(v); }
__device__ __forceinline__ float wave_max(float v) { v = fmaxf(v, SWZ_XOR(v, 1)); v = fmaxf(v, SWZ_XOR(v, 2)); v = fmaxf(v, SWZ_XOR(v, 4)); v = fmaxf(v, SWZ_XOR(v, 8)); v = fmaxf(v, SWZ_XOR(v, 16)); return max_x32(v); }

namespace pg8 {
#define PG8_LAS __attribute__((address_space(3)))
typedef unsigned short bf16_t;
typedef short bf16x8 __attribute__((ext_vector_type(8)));
typedef float f32x4 __attribute__((ext_vector_type(4)));
typedef float f32x2 __attribute__((ext_vector_type(2)));
typedef unsigned u32x4 __attribute__((ext_vector_type(4)));
typedef unsigned u32x2 __attribute__((ext_vector_type(2)));
constexpr int BM = 256, BK = 64, HALF = 128, HTB = HALF * BK * 2, STAGE_BYTES = 8 * HTB, NXCD = 8, WGM = 8;

__host__ __device__ __forceinline__ int lds_byte(int r, int c) { const int st = (r >> 4) * 2 + (c >> 5), rr = r & 15, cc = c & 31, ob = rr * 64 + cc * 2; return st * 1024 + (ob ^ (((ob >> 9) & 1) << 5)); }
__host__ __device__ __forceinline__ void stage_rc(int b, int& R, int& C) { const int st = b / 1024, sb = b % 1024, swz = sb ^ (((sb >> 9) & 1) << 5); R = (st >> 1) * 16 + swz / 64; C = (st & 1) * 32 + (swz % 64) / 2; }
__host__ __device__ __forceinline__ int perm32(int rho) { const int n = rho >> 4, i = rho & 15; return 8 * (i >> 2) + 4 * n + (i & 3); }

struct Unit { int pm, pn; };
struct Gemm { int lda, ldb, K; };

__device__ __forceinline__ unsigned cvt_pk_bf16(float lo, float hi) { unsigned r; asm volatile("v_cvt_pk_bf16_f32 %0, %1, %2" : "=v"(r) : "v"(lo), "v"(hi)); return r; }

struct StaticOrder {
    int nM, nN, nwg, G, c;
    const char* A; const char* B; size_t astep, bstep, apn;
    __device__ void init(int nM_, int nN_, int G_, int c_, const void* A_, size_t astep_, const void* B_, size_t bstep_, size_t apn_ = 0) {
        nM = nM_; nN = nN_; nwg = nM * nN; G = G_; c = c_; A = (const char*)A_; B = (const char*)B_; astep = astep_; bstep = bstep_; apn = apn_; }
    __device__ bool next(int i, Unit& u) const {
        const long L = (long)i * G + c; if (L >= nwg) return false;
        int wgid = (int)L; { const int q = nwg / NXCD, r = nwg % NXCD, xcd = wgid % NXCD, off = wgid / NXCD; wgid = (xcd < r ? xcd * (q + 1) : r * (q + 1) + (xcd - r) * q) + off; }
        const int nig = WGM * nN, gid = wgid / nig, fm = gid * WGM, gsz = (nM - fm) < WGM ? (nM - fm) : WGM;
        u.pm = fm + ((wgid % nig) % gsz); u.pn = (wgid % nig) / gsz; return true;
    }
    __device__ __forceinline__ const char* aptr(const Unit& u) const { return A + (size_t)u.pm * astep + (size_t)u.pn * apn; }
    __device__ __forceinline__ const char* bptr(const Unit& u) const { return B + (size_t)u.pn * bstep; }
};
struct KvOrder {
    int G, c; const char* A; const char* B;
    __device__ bool next(int i, Unit& u) const { const int L = i * G + c; if (L >= 128) return false; u.pm = L >> 3; u.pn = L & 7; return true; }
    __device__ __forceinline__ const char* aptr(const Unit& u) const { return A + (size_t)u.pm * (256 * 1024 * 2); }
    __device__ __forceinline__ const char* bptr(const Unit& u) const { return B + (size_t)((u.pm >> 3) * 2048 + u.pn * 256) * (1024 * 2); }
};
struct SingleOrder {
    Unit u0; const char* A; const char* B;
    __device__ bool next(int i, Unit& u) const { if (i) return false; u = u0; return true; }
    __device__ __forceinline__ const char* aptr(const Unit&) const { return A; }
    __device__ __forceinline__ const char* bptr(const Unit&) const { return B; }
};


struct EpiRes {
    static constexpr bool PERM = false, AFTER_DRAIN = false;
    const float* base; float* out; bf16_t* xg; const float* gnext; float* ssq; const float* cscale;
    __device__ __forceinline__ void operator()(const f32x4 (&acc)[2][2][4][2], const Unit& u, int wr, int wc, int fr, int fq) const {
        const int col0 = u.pn * BM + wc * 32 + 4 * fq;
        f32x4 gv[2][2], cs[2][2];
#pragma unroll
        for (int bj = 0; bj < 2; ++bj)
#pragma unroll
            for (int n = 0; n < 2; ++n) { gv[bj][n] = *(const f32x4*)(gnext + col0 + bj * HALF + n * 16);
                cs[bj][n] = cscale ? *(const f32x4*)(cscale + col0 + bj * HALF + n * 16) : (f32x4){1.f, 1.f, 1.f, 1.f}; }
#pragma unroll
        for (int ai = 0; ai < 2; ++ai)
#pragma unroll
            for (int m = 0; m < 4; ++m) { const int row = u.pm * BM + ai * HALF + wr * 64 + m * 16 + fr; const size_t off = (size_t)row * D + col0; float ss = 0.f;
#pragma unroll
                for (int bj = 0; bj < 2; ++bj)
#pragma unroll
                    for (int n = 0; n < 2; ++n) { const f32x4 b = *(const f32x4*)(base + off + bj * HALF + n * 16); const f32x4 v = b + acc[ai][bj][m][n] * cs[bj][n];
                        *(f32x4*)(out + off + bj * HALF + n * 16) = v; ss += (v[0] * v[0] + v[1] * v[1]) + (v[2] * v[2] + v[3] * v[3]);
                        const f32x4 w = v * gv[bj][n]; u32x2 p; p.x = cvt_pk_bf16(w[0], w[1]); p.y = cvt_pk_bf16(w[2], w[3]); *(u32x2*)(xg + off + bj * HALF + n * 16) = p; }
                ss = add_x16_x32(ss);
                if (fq == 0) ssq[(size_t)row * 16 + u.pn * 4 + wc] = ss; }
    }
};
__device__ __forceinline__ float rstd_from_ssq16(const float* ssq, int row) {
    const f32x4* sp = (const f32x4*)(ssq + (size_t)row * 16); const f32x4 s = (sp[0] + sp[1]) + (sp[2] + sp[3]);
    return __builtin_amdgcn_rsqf(((s[0] + s[1]) + (s[2] + s[3])) * (1.0f / D) + EPS);
}
template <int MODE> struct EpiRow {
    static constexpr bool PERM = true, AFTER_DRAIN = false;
    bf16_t* O; int ldc; const float* ssq; float scale; bf16_t* O2; float* convout;
    __device__ __forceinline__ void operator()(const f32x4 (&acc)[2][2][4][2], const Unit& u, int wr, int wc, int fr, int fq) const {
        const int colw = wc * 32 + 8 * fq;
#pragma unroll
        for (int ai = 0; ai < 2; ++ai)
#pragma unroll
            for (int m = 0; m < 4; ++m) { const int row = u.pm * BM + ai * HALF + wr * 64 + m * 16 + fr; const float rs = rstd_from_ssq16(ssq, row);
                if (MODE == 2 && u.pn >= 4) {
                    const float r2 = rs * rs; const f32x4 v0 = acc[ai][0][m][0] * acc[ai][1][m][0] * r2, v1 = acc[ai][0][m][1] * acc[ai][1][m][1] * r2;
                    const int ch = (u.pn - 4) * 128 + colw;
                    u32x4 w; w.x = cvt_pk_bf16(v0[0], v0[1]); w.y = cvt_pk_bf16(v0[2], v0[3]); w.z = cvt_pk_bf16(v1[0], v1[1]); w.w = cvt_pk_bf16(v1[2], v1[3]);
                    *(u32x4*)(O2 + (size_t)row * D + ch) = w;
                    const int t = row & (SEQ - 1);
                    if (t >= SEQ - 2) { float* cp = convout + ((size_t)(row >> 11) * 2 + (t - (SEQ - 2))) * D + ch; *(f32x4*)cp = v0; *(f32x4*)(cp + 4) = v1; }
                } else {
                    const float sc = (MODE == 0) ? rs * scale : rs;
#pragma unroll
                    for (int bj = 0; bj < 2; ++bj) { f32x4 v0 = acc[ai][bj][m][0] * sc, v1 = acc[ai][bj][m][1] * sc;
                        if (MODE == 1) {
#pragma unroll
                            for (int j = 0; j < 4; ++j) { const float a = fmaxf(v0[j], 0.f), b = fmaxf(v1[j], 0.f); v0[j] = a * a; v1[j] = b * b; } }
                        u32x4 w; w.x = cvt_pk_bf16(v0[0], v0[1]); w.y = cvt_pk_bf16(v0[2], v0[3]); w.z = cvt_pk_bf16(v1[0], v1[1]); w.w = cvt_pk_bf16(v1[2], v1[3]);
                        *(u32x4*)(O + (size_t)row * ldc + u.pn * BM + bj * HALF + colw) = w; }
                } }
    }
};
struct EpiBf16 {
    static constexpr bool PERM = true, AFTER_DRAIN = false;
    bf16_t* O; int ldc;
    __device__ __forceinline__ void operator()(const f32x4 (&acc)[2][2][4][2], const Unit& u, int wr, int wc, int fr, int fq) const {
        const int colw = u.pn * BM + wc * 32 + 8 * fq;
#pragma unroll
        for (int ai = 0; ai < 2; ++ai)
#pragma unroll
            for (int m = 0; m < 4; ++m) { const int row = u.pm * BM + ai * HALF + wr * 64 + m * 16 + fr;
#pragma unroll
                for (int bj = 0; bj < 2; ++bj) { const f32x4 v0 = acc[ai][bj][m][0], v1 = acc[ai][bj][m][1];
                    u32x4 w; w.x = cvt_pk_bf16(v0[0], v0[1]); w.y = cvt_pk_bf16(v0[2], v0[3]); w.z = cvt_pk_bf16(v1[0], v1[1]); w.w = cvt_pk_bf16(v1[2], v1[3]);
                    *(u32x4*)(O + (size_t)row * ldc + colw + bj * HALF) = w; } }
    }
};
struct EpiKV {
    static constexpr bool PERM = false, AFTER_DRAIN = false;
    float* outk; float* outv; bf16_t* Kb; bf16_t* Vt;
    __device__ __forceinline__ void operator()(const f32x4 (&acc)[2][2][4][2], const Unit& u, int wr, int wc, int fr, int fq) const {
        const int layer = u.pm >> 3; const bool isV = u.pn >= 4; const int col0 = (u.pn & 3) * BM + wc * 32 + 4 * fq;
        float* outp = isV ? outv : outk;
#pragma unroll
        for (int ai = 0; ai < 2; ++ai)
#pragma unroll
            for (int m = 0; m < 4; ++m) { const int rowl = (u.pm & 7) * BM + ai * HALF + wr * 64 + m * 16 + fr; const size_t off = ((size_t)layer * MEMROWS + rowl) * D + col0;
#pragma unroll
                for (int bj = 0; bj < 2; ++bj)
#pragma unroll
                    for (int n = 0; n < 2; ++n) { const f32x4 v = acc[ai][bj][m][n]; *(f32x4*)(outp + off + bj * HALF + n * 16) = v;
                        if (!isV) { u32x2 p; p.x = cvt_pk_bf16(v[0], v[1]); p.y = cvt_pk_bf16(v[2], v[3]); *(u32x2*)(Kb + off + bj * HALF + n * 16) = p; }
                        else { const int b = rowl >> 8, nn = rowl & 255; bf16_t* vp = Vt + ((size_t)(layer * BATCH + b) * D + col0 + bj * HALF + n * 16) * NMEM + nn;
                            const unsigned p0 = cvt_pk_bf16(v[0], v[1]), p1 = cvt_pk_bf16(v[2], v[3]);
                            vp[0] = (bf16_t)(p0 & 0xffffu); vp[NMEM] = (bf16_t)(p0 >> 16); vp[2 * NMEM] = (bf16_t)(p1 & 0xffffu); vp[3 * NMEM] = (bf16_t)(p1 >> 16); } } }
    }
};
struct EpiSoftmax {
    static constexpr bool PERM = true, AFTER_DRAIN = true;
    bf16_t* P;
    __device__ __forceinline__ void operator()(const f32x4 (&)[2][2][4][2], const Unit&, int, int, int, int) const {}
    __device__ __forceinline__ void fused(f32x4 (&acc)[2][2][4][2], const Unit& u, int wr, int wc, int fr, int fq, PG8_LAS unsigned char* lds, int wid, int lane) const {
        PG8_LAS float* Pm = (PG8_LAS float*)lds;
        PG8_LAS float* Ps = (PG8_LAS float*)(lds + 4096);
#pragma unroll
        for (int ai = 0; ai < 2; ++ai)
#pragma unroll
            for (int m = 0; m < 4; ++m) { float mx = -3.0e38f;
#pragma unroll
                for (int bj = 0; bj < 2; ++bj)
#pragma unroll
                    for (int n = 0; n < 2; ++n) { const f32x4 x = acc[ai][bj][m][n]; mx = fmaxf(mx, fmaxf(fmaxf(x[0], x[1]), fmaxf(x[2], x[3]))); }
                mx = max_x16_x32(mx);
                if (fq == 0) Pm[(ai * HALF + wr * 64 + m * 16 + fr) * 4 + wc] = mx; }
        asm volatile("s_waitcnt lgkmcnt(0)" ::: "memory"); __builtin_amdgcn_s_barrier(); asm volatile("" ::: "memory");
#pragma unroll
        for (int ai = 0; ai < 2; ++ai)
#pragma unroll
            for (int m = 0; m < 4; ++m) { const int r = ai * HALF + wr * 64 + m * 16 + fr; const f32x4 q = *(const PG8_LAS f32x4*)(Pm + r * 4);
                const float mx = fmaxf(fmaxf(q[0], q[1]), fmaxf(q[2], q[3])); float s = 0.f;
#pragma unroll
                for (int bj = 0; bj < 2; ++bj)
#pragma unroll
                    for (int n = 0; n < 2; ++n) { f32x4 x = acc[ai][bj][m][n];
#pragma unroll
                        for (int j = 0; j < 4; ++j) { x[j] = __builtin_amdgcn_exp2f(x[j] - mx); s += x[j]; }
                        acc[ai][bj][m][n] = x; }
                s = add_x16_x32(s);
                if (fq == 0) Ps[r * 4 + wc] = s; }
        asm volatile("s_waitcnt lgkmcnt(0)" ::: "memory"); __builtin_amdgcn_s_barrier(); asm volatile("" ::: "memory");
        const int colw = wc * 32 + 8 * fq;
#pragma unroll
        for (int ai = 0; ai < 2; ++ai)
#pragma unroll
            for (int m = 0; m < 4; ++m) { const int r = ai * HALF + wr * 64 + m * 16 + fr; const f32x4 q = *(const PG8_LAS f32x4*)(Ps + r * 4);
                const float inv = __builtin_amdgcn_rcpf((q[0] + q[1]) + (q[2] + q[3]));
#pragma unroll
                for (int bj = 0; bj < 2; ++bj) { const f32x4 v0 = acc[ai][bj][m][0] * inv, v1 = acc[ai][bj][m][1] * inv;
                    u32x4 w; w.x = cvt_pk_bf16(v0[0], v0[1]); w.y = cvt_pk_bf16(v0[2], v0[3]); w.z = cvt_pk_bf16(v1[0], v1[1]); w.w = cvt_pk_bf16(v1[2], v1[3]);
                    *(u32x4*)(P + (size_t)r * 256 + bj * HALF + colw) = w; } }
    }
};

template <class Epi, class Sched, bool ALIGN_EPI>
__device__ __forceinline__ void gemm_phase(PG8_LAS unsigned char* lds, const Gemm g, const Sched& S, const Epi& E, int tid) {
    asm volatile("" : "+v"(tid));
    const int wid = __builtin_amdgcn_readfirstlane(tid >> 6), lane = tid & 63, wr = wid >> 2, wc = wid & 3, fr = lane & 15, fq = lane >> 4;
    const int nt = g.K / BK;
    unsigned voffA[2], voffB[2];
#pragma unroll
    for (int i = 0; i < 2; ++i) { int R, C; stage_rc(tid * 16 + i * 8192, R, C); const int Rb = Epi::PERM ? ((R & ~31) + perm32(R & 31)) : R;
        voffA[i] = (unsigned)(R * g.lda + C) * 2u; voffB[i] = (unsigned)(Rb * g.ldb + C) * 2u; }
    const size_t kstep = (size_t)(BK * 2);
    const size_t hstepA = (size_t)HALF * g.lda * 2, hstepB = (size_t)HALF * g.ldb * 2;
    const unsigned ldsw = (unsigned)wid * 1024u;
    const int aoff = lds_byte(wr * 64 + fr, fq * 8), boff = lds_byte(wc * 32 + fr, fq * 8);
#define PG8_SA(b, h) (((b) * 2 + (h)) * HTB)
#define PG8_SB(b, h) ((4 + (b) * 2 + (h)) * HTB)
#define PG8_STAGE(bufoff, gbase, voff) do { _Pragma("unroll") for (int _i = 0; _i < 2; ++_i) \
        __builtin_amdgcn_global_load_lds((const unsigned*)((const char*)(gbase) + (voff)[_i]), (PG8_LAS unsigned*)(lds + (bufoff) + ldsw + _i * 8192), 16, 0, 0); } while (0)
#define PG8_LDA(dst, b, h) do { _Pragma("unroll") for (int m = 0; m < 4; ++m) _Pragma("unroll") for (int k = 0; k < 2; ++k) dst[m][k] = *(const PG8_LAS bf16x8*)(lds + PG8_SA(b, h) + aoff + m * 2048 + k * 1024); } while (0)
#define PG8_LDB(dst, b, h) do { _Pragma("unroll") for (int n = 0; n < 2; ++n) _Pragma("unroll") for (int k = 0; k < 2; ++k) dst[n][k] = *(const PG8_LAS bf16x8*)(lds + PG8_SB(b, h) + boff + n * 2048 + k * 1024); } while (0)
#define PG8_MMA(ai, bj, At, Bt) do { __builtin_amdgcn_s_setprio(1); _Pragma("unroll") for (int m = 0; m < 4; ++m) _Pragma("unroll") for (int n = 0; n < 2; ++n) _Pragma("unroll") for (int k = 0; k < 2; ++k) \
        acc[ai][bj][m][n] = __builtin_amdgcn_mfma_f32_16x16x32_bf16(Bt[n][k], At[m][k], acc[ai][bj][m][n], 0, 0, 0); __builtin_amdgcn_s_setprio(0); } while (0)
#define PG8_WAIT_V(n) asm volatile("s_waitcnt vmcnt(" #n ")" ::: "memory")
#define PG8_WAIT_L(n) asm volatile("s_waitcnt lgkmcnt(" #n ")" ::: "memory")
#define PG8_BAR __builtin_amdgcn_s_barrier()
#define PG8_SCHED __builtin_amdgcn_sched_barrier(0)
    Unit cur, nxt; int ui = 0;
    if (!S.next(0, cur)) return;
    f32x4 acc[2][2][4][2];
#pragma unroll
    for (int a = 0; a < 2; ++a)
#pragma unroll
        for (int b = 0; b < 2; ++b)
#pragma unroll
            for (int m = 0; m < 4; ++m)
#pragma unroll
                for (int n = 0; n < 2; ++n) acc[a][b][m][n] = (f32x4){0.f, 0.f, 0.f, 0.f};
    bf16x8 At[4][2], B0[2][2], B1[2][2];
    const char* cA = S.aptr(cur); const char* cB = S.bptr(cur);
    PG8_STAGE(PG8_SB(0, 0), cB, voffB); PG8_STAGE(PG8_SB(0, 1), cB + hstepB, voffB); PG8_STAGE(PG8_SA(0, 0), cA, voffA); PG8_STAGE(PG8_SA(0, 1), cA + hstepA, voffA);
    if (wr == 1) PG8_BAR;
    PG8_WAIT_V(2); PG8_BAR;
    PG8_STAGE(PG8_SB(1, 0), cB + kstep, voffB); PG8_STAGE(PG8_SA(1, 0), cA + kstep, voffA); PG8_STAGE(PG8_SB(1, 1), cB + hstepB + kstep, voffB);
    PG8_WAIT_V(6); PG8_BAR;
    for (;;) {
        const bool has_next = S.next(ui + 1, nxt);
        const char* nA = has_next ? S.aptr(nxt) : cA; const char* nB = has_next ? S.bptr(nxt) : cB;
        for (int t = 0; t < nt; t += 2) {
            const bool last = (t == nt - 2);
            const char* a1 = cA + (size_t)(t + 1) * kstep;
            const char* a2 = last ? nA : cA + (size_t)(t + 2) * kstep; const char* b2 = last ? nB : cB + (size_t)(t + 2) * kstep;
            const char* a3 = a2 + kstep; const char* b3 = b2 + kstep;
            PG8_LDB(B0, 0, 0); PG8_LDB(B1, 0, 1); PG8_SCHED; PG8_LDA(At, 0, 0); PG8_STAGE(PG8_SA(1, 1), a1 + hstepA, voffA);
            PG8_WAIT_V(8); PG8_WAIT_L(0); PG8_BAR; PG8_MMA(0, 0, At, B0); PG8_MMA(0, 1, At, B1); PG8_BAR; PG8_SCHED;
            PG8_LDA(At, 0, 1); PG8_STAGE(PG8_SB(0, 0), b2, voffB); PG8_STAGE(PG8_SB(0, 1), b2 + hstepB, voffB); PG8_STAGE(PG8_SA(0, 0), a2, voffA);
            PG8_WAIT_V(8); PG8_WAIT_L(0); PG8_BAR; PG8_MMA(1, 0, At, B0); PG8_MMA(1, 1, At, B1); PG8_BAR; PG8_SCHED;
            PG8_LDB(B0, 1, 0); PG8_LDB(B1, 1, 1); PG8_SCHED; PG8_LDA(At, 1, 0); PG8_STAGE(PG8_SA(0, 1), a2 + hstepA, voffA);
            PG8_WAIT_V(8); PG8_WAIT_L(0); PG8_BAR; PG8_MMA(0, 0, At, B0); PG8_MMA(0, 1, At, B1); PG8_BAR; PG8_SCHED;
            PG8_LDA(At, 1, 1); PG8_STAGE(PG8_SB(1, 0), b3, voffB); PG8_STAGE(PG8_SB(1, 1), b3 + hstepB, voffB); PG8_STAGE(PG8_SA(1, 0), a3, voffA);
            PG8_WAIT_V(8); PG8_WAIT_L(0); PG8_BAR; PG8_MMA(1, 0, At, B0); PG8_MMA(1, 1, At, B1); PG8_BAR; PG8_SCHED;
        }
        if constexpr (ALIGN_EPI) { if (wr == 0) PG8_BAR; }
        if constexpr (!Epi::AFTER_DRAIN) { E(acc, cur, wr, wc, fr, fq); }
        if (!has_next) break;
#pragma unroll
        for (int a = 0; a < 2; ++a)
#pragma unroll
            for (int b = 0; b < 2; ++b)
#pragma unroll
                for (int m = 0; m < 4; ++m)
#pragma unroll
                    for (int n = 0; n < 2; ++n) acc[a][b][m][n] = (f32x4){0.f, 0.f, 0.f, 0.f};
        cur = nxt; cA = nA; cB = nB; ++ui;
        if constexpr (ALIGN_EPI) { if (wr == 1) PG8_BAR; }
    }
    PG8_WAIT_V(0);
    if constexpr (!ALIGN_EPI) { if (wr == 0) PG8_BAR; }
    PG8_BAR;
    if constexpr (Epi::AFTER_DRAIN) { E.fused(acc, cur, wr, wc, fr, fq, lds, wid, lane); }
#undef PG8_SA
#undef PG8_SB
#undef PG8_STAGE
#undef PG8_LDA
#undef PG8_LDB
#undef PG8_MMA
#undef PG8_WAIT_V
#undef PG8_WAIT_L
#undef PG8_BAR
#undef PG8_SCHED
}
}

constexpr int NWAVES = 8, NTHREADS = 512;
constexpr size_t MiB = 1u << 20;
constexpr size_t WS_CTL = 0, CTL_ZERO_BYTES = 64 * 1024;
constexpr size_t WS_WPOOL = 1 * MiB;
constexpr size_t WS_WQ = 2 * MiB;
constexpr size_t WS_WO = 6 * MiB;
constexpr size_t WS_WKV = 10 * MiB;
constexpr size_t WS_WUP = 18 * MiB;
constexpr size_t WS_WDN = 34 * MiB;
constexpr size_t WS_WIN = 50 * MiB;
constexpr size_t WS_WOUT = 56 * MiB;
constexpr size_t WS_MN = 58 * MiB;
constexpr size_t WS_KB = 66 * MiB;
constexpr size_t WS_VT = 74 * MiB;
constexpr size_t WS_SSQ = 82 * MiB;
constexpr size_t WS_SMALL = 84 * MiB;
constexpr size_t WS_X = 96 * MiB;
constexpr size_t WS_XG = 160 * MiB;
constexpr size_t WS_P0 = 192 * MiB;
constexpr size_t WS_O = 224 * MiB;
constexpr size_t WS_CH = 256 * MiB;
constexpr size_t WS_PS = 288 * MiB;
constexpr size_t WS_H = 320 * MiB;
constexpr size_t WS_END = 448 * MiB;
constexpr size_t SS_X = WS_SMALL;
constexpr size_t SS_XG = SS_X + 512 * 1024;
constexpr size_t SS_SSQ = SS_XG + 256 * 1024;
constexpr size_t SS_P0 = SS_SSQ + 16 * 1024;
constexpr size_t SS_O = SS_P0 + 256 * 1024;
constexpr size_t SS_CH = SS_O + 256 * 1024;
constexpr size_t SS_H = SS_CH + 512 * 1024;
static_assert(SS_H + 1024 * 1024 <= WS_X, "sample buffers");
constexpr int CW_BAR = 4096;

constexpr int RING_OFF = 0, RING_BYTES = 131072;
constexpr int LDSCTL_OFF = RING_BYTES, MISC_OFF = LDSCTL_OFF + 320;
constexpr int LDS_BYTES = 147456;

#define GAS __attribute__((address_space(1)))
#define LAS __attribute__((address_space(3)))
typedef unsigned short bf16;
typedef unsigned v4u __attribute__((ext_vector_type(4)));
typedef unsigned v2u __attribute__((ext_vector_type(2)));
typedef float f32x4 __attribute__((ext_vector_type(4)));
typedef short bf16x8 __attribute__((ext_vector_type(8)));
#define LDS_WAIT() asm volatile("s_waitcnt lgkmcnt(0)" ::: "memory")
#define VM_WAIT() asm volatile("s_waitcnt vmcnt(0)" ::: "memory")
__device__ __forceinline__ unsigned f2bf(float f) { unsigned u = __builtin_bit_cast(unsigned, f); return (u + 0x7fffu + ((u >> 16) & 1u)) >> 16; }
__device__ __forceinline__ unsigned pk2(float lo, float hi) { return f2bf(lo) | (f2bf(hi) << 16); }
__device__ __forceinline__ float bf2f(unsigned short h) { return __builtin_bit_cast(float, (unsigned)h << 16); }
__device__ __forceinline__ float bflo(unsigned w) { return __builtin_bit_cast(float, w << 16); }
__device__ __forceinline__ float bfhi(unsigned w) { return __builtin_bit_cast(float, w & 0xffff0000u); }

#define XB_TMO      128
#define XB_XCNT(j)  (256  + 64 * (j))
#define XB_XSUB(j)  (1280 + 64 * (j))
#define XB_XGEN(j)  (2304 + 64 * (j))
#define XB_TOP      3328
#define XB_TOPGEN   3392
#define XCD_BAR_WORDS 3456
#define XB_SPIN_CAP (1u << 18)
__device__ __forceinline__ unsigned xb_ld(unsigned* p)              { return __hip_atomic_load(p, __ATOMIC_RELAXED, __HIP_MEMORY_SCOPE_AGENT); }
__device__ __forceinline__ unsigned xb_add(unsigned* p, unsigned v) { return __hip_atomic_fetch_add(p, v, __ATOMIC_RELAXED, __HIP_MEMORY_SCOPE_AGENT); }
__device__ __forceinline__ unsigned xb_xcc_id() { return (unsigned)__builtin_amdgcn_s_getreg((3 << 11) | 20) & 0xFu; }
#define XB_SPIN(cond, bar) do { unsigned _sp = 0; while (cond) { __builtin_amdgcn_s_sleep(1); \
    if ((++_sp & 255u) == 0u) { if (xb_ld(&(bar)[XB_TMO])) break; if (_sp > XB_SPIN_CAP) { atomicAdd(&(bar)[XB_TMO], 1u); break; } } } } while (0)
struct XcdBarrier { unsigned* bar; unsigned x; volatile LAS unsigned* st; };
__device__ __forceinline__ XcdBarrier xcd_barrier_post(unsigned* bar, volatile LAS unsigned* st) {
    XcdBarrier b; b.bar = bar; b.x = xb_xcc_id(); b.st = st;
    if (threadIdx.x == 0) (void)xb_add(&bar[XB_XCNT(b.x)], 1u);
    return b;
}
__device__ __forceinline__ void xcd_barrier_complete(unsigned* bar, unsigned x, unsigned& nloc, unsigned& nx) {
    const unsigned G = gridDim.x * gridDim.y * gridDim.z;
    unsigned sum, cnt, mine, sp = 0u;
    for (;;) {
        sum = 0u; cnt = 0u; mine = 0u;
#pragma unroll
        for (unsigned j = 0; j < 16; ++j) { const unsigned c = xb_ld(&bar[XB_XCNT(j)]); sum += c; cnt += (c > 0u) ? 1u : 0u; mine = (j == x) ? c : mine; }
        if (sum == G) break;
        __builtin_amdgcn_s_sleep(1);
        if ((++sp & 255u) == 0u) { if (xb_ld(&bar[XB_TMO])) break; if (sp > XB_SPIN_CAP) { atomicAdd(&bar[XB_TMO], 1u); break; } }
    }
    nloc = mine > 0u ? mine : 1u; nx = cnt > 0u ? cnt : 1u;
}
__device__ __forceinline__ void xcd_barrier(const XcdBarrier& b, const int tid) {
    asm volatile("s_waitcnt vmcnt(0)" ::: "memory");
    __syncthreads();
    if (tid == 0) {
        unsigned* bar = b.bar; asm volatile("" : "+s"(bar));
        __builtin_amdgcn_s_waitcnt(0);
        unsigned nloc = b.st[0], nx = b.st[1];
        if (nloc == 0u) { xcd_barrier_complete(bar, b.x, nloc, nx); b.st[0] = nloc; b.st[1] = nx; }
        const unsigned old = xb_add(&bar[XB_XSUB(b.x)], 1u);
        const unsigned gen = old / nloc;
        if (old + 1u == (gen + 1u) * nloc) {
            __builtin_amdgcn_fence(__ATOMIC_RELEASE, "agent");
            asm volatile("s_waitcnt vmcnt(0)" ::: "memory");
            const unsigned og = xb_add(&bar[XB_TOP], 1u);
            const unsigned tg = og / nx;
            if (og + 1u == (tg + 1u) * nx) xb_add(&bar[XB_TOPGEN], 1u);
            else XB_SPIN(xb_ld(&bar[XB_TOPGEN]) == tg, bar);
            __builtin_amdgcn_fence(__ATOMIC_ACQUIRE, "agent");
            xb_add(&bar[XB_XGEN(b.x)], 1u);
            asm volatile("s_waitcnt vmcnt(0)" ::: "memory");
        } else {
            XB_SPIN(xb_ld(&bar[XB_XGEN(b.x)]) == gen, bar);
            __builtin_amdgcn_fence(__ATOMIC_ACQUIRE, "agent");
            asm volatile("s_waitcnt vmcnt(0)" ::: "memory");
        }
    }
    __syncthreads();
}

__device__ __forceinline__ int opq_v(int x) { asm volatile("" : "+v"(x)); return x; }
__device__ __forceinline__ int lane_id_opaque() { int l; asm volatile("v_mbcnt_lo_u32_b32 %0, -1, 0\n\tv_mbcnt_hi_u32_b32 %0, -1, %0" : "=v"(l)); return l; }
struct Args { const float* in[22]; float* out; unsigned char* ws; int ph_lo, ph_hi; };


__device__ __forceinline__ void p0_transpose_item(const float* W, int K, int N, bf16* WT, int k0, int n0, int drow0, LAS float* scr, int lane) {
#pragma unroll 8
    for (int i = 0; i < 32; ++i) { const int kk = 2 * i + (lane >> 5); scr[kk * 33 + (lane & 31)] = W[(size_t)(k0 + kk) * N + n0 + (lane & 31)]; }
    LDS_WAIT(); asm volatile("" ::: "memory");
    const int c = lane & 7;
#pragma unroll
    for (int j = 0; j < 4; ++j) { const int n = (lane >> 3) + 8 * j; const LAS float* s = scr + (8 * c) * 33 + n;
        v4u o; o.x = pk2(s[0 * 33], s[1 * 33]); o.y = pk2(s[2 * 33], s[3 * 33]); o.z = pk2(s[4 * 33], s[5 * 33]); o.w = pk2(s[6 * 33], s[7 * 33]);
        *(GAS v4u*)(WT + (size_t)(drow0 + n) * K + k0 + 8 * c) = o; }
    LDS_WAIT(); asm volatile("" ::: "memory");
}
__device__ __forceinline__ int win_dest_row(int n) {
    if (n < 1024) return n;
    if (n < 2048) { const int ch = n - 1024; return 1024 + (ch >> 7) * 256 + (ch & 127); }
    const int ch = n - 2048; return 1024 + (ch >> 7) * 256 + 128 + (ch & 127);
}

template <int W>
__device__ __forceinline__ void pool_wave(const float* xb  , const LAS float* rs, f32x4 g4, int tA, bf16* pout  , float* poolout  ) {
    f32x4 ring[16]; f32x4 S = {0.f, 0.f, 0.f, 0.f};
#pragma unroll
    for (int i = 16 - W; i < 31; ++i) {
        const int t = tA - 15 + i;
        f32x4 u = {0.f, 0.f, 0.f, 0.f};
        if (t >= 0) { const f32x4 xv = *(const f32x4*)(xb + (size_t)t * D); u = xv * rs[i] * g4; }
        S += u; if (i - W >= 16 - W) S -= ring[(i - W) & 15];
        ring[i & 15] = u;
        if (i >= 15) {
            const int cnt = (t + 1 < W) ? (t + 1) : W; const float ic = 1.0f / (float)cnt;
            const f32x4 p = S * ic - u; v2u o; o.x = pk2(p[0], p[1]); o.y = pk2(p[2], p[3]);
            *(v2u*)(pout + (size_t)t * D) = o;
            if (t >= SEQ - 15) *(f32x4*)(poolout + (size_t)(t - (SEQ - 15)) * D) = u;
        }
    }
}

template <class F>
__device__ __forceinline__ void sgemm_unit(const bf16* A, int lda, const bf16* Bt, int ldb, int K, int b0row, int b1row, int wave, int lane, const F& f) {
    const int fr = lane & 15, fq = lane >> 4;
    const bf16* ap = A + (size_t)(16 * wave + fr) * lda + fq * 8;
    const bf16* bp0 = Bt + (size_t)(b0row + fr) * ldb + fq * 8;
    const bf16* bp1 = Bt + (size_t)(b1row + fr) * ldb + fq * 8;
    f32x4 acc0 = {0.f, 0.f, 0.f, 0.f}, acc1 = {0.f, 0.f, 0.f, 0.f};
#pragma unroll 8
    for (int k0 = 0; k0 < K; k0 += 32) {
        const bf16x8 a = *(const bf16x8*)(ap + k0), b0 = *(const bf16x8*)(bp0 + k0), b1 = *(const bf16x8*)(bp1 + k0);
        acc0 = __builtin_amdgcn_mfma_f32_16x16x32_bf16(b0, a, acc0, 0, 0, 0);
        acc1 = __builtin_amdgcn_mfma_f32_16x16x32_bf16(b1, a, acc1, 0, 0, 0);
    }
    f(acc0, acc1, 16 * wave + fr, fq);
}
__device__ __forceinline__ float srstd(const float* ssq, int row, int fq) {
    const f32x4* sp = (const f32x4*)(ssq + row * 32 + fq * 8); const f32x4 s = sp[0] + sp[1]; float t = (s[0] + s[1]) + (s[2] + s[3]);
    t = add_x16_x32(t);
    return __builtin_amdgcn_rsqf(t * (1.0f / D) + EPS);
}
__device__ __forceinline__ void s_res_unit(const bf16* A, int lda, const bf16* Bt, int ldb, int K, int mu, const float* base, float* xs, bf16* xg, float* ssq, const float* gnext, const float* cscale, int wave, int lane) {
    sgemm_unit(A, lda, Bt, ldb, K, 32 * mu, 32 * mu + 16, wave, lane, [&](f32x4 a0, f32x4 a1, int row, int fq) {
        const int c0 = 32 * mu + 4 * fq; const size_t off = (size_t)row * D + c0;
        f32x4 cs0 = {1.f, 1.f, 1.f, 1.f}, cs1 = cs0; if (cscale) { cs0 = *(const f32x4*)(cscale + c0); cs1 = *(const f32x4*)(cscale + c0 + 16); }
        const f32x4 v0 = *(const f32x4*)(base + off) + a0 * cs0, v1 = *(const f32x4*)(base + off + 16) + a1 * cs1;
        *(f32x4*)(xs + off) = v0; *(f32x4*)(xs + off + 16) = v1;
        float ss = ((v0[0] * v0[0] + v0[1] * v0[1]) + (v0[2] * v0[2] + v0[3] * v0[3])) + ((v1[0] * v1[0] + v1[1] * v1[1]) + (v1[2] * v1[2] + v1[3] * v1[3]));
        ss = add_x16_x32(ss);
        if (fq == 0) ssq[row * 32 + mu] = ss;
        const f32x4 g0 = *(const f32x4*)(gnext + c0), g1 = *(const f32x4*)(gnext + c0 + 16); const f32x4 w0 = v0 * g0, w1 = v1 * g1;
        v2u p0, p1; p0.x = pk2(w0[0], w0[1]); p0.y = pk2(w0[2], w0[3]); p1.x = pk2(w1[0], w1[1]); p1.y = pk2(w1[2], w1[3]);
        *(v2u*)(xg + off) = p0; *(v2u*)(xg + off + 16) = p1; });
}
template <int MODE>
__device__ __forceinline__ void s_row_unit(const bf16* A, int lda, const bf16* Bt, int ldb, int K, int mu, bf16* O, int ldc, const float* ssq, float scale, int wave, int lane) {
    sgemm_unit(A, lda, Bt, ldb, K, 32 * mu, 32 * mu + 16, wave, lane, [&](f32x4 a0, f32x4 a1, int row, int fq) {
        const float rs = srstd(ssq, row, fq); const float sc = (MODE == 0) ? rs * scale : rs;
        f32x4 v0 = a0 * sc, v1 = a1 * sc;
        if (MODE == 1) {
#pragma unroll
            for (int j = 0; j < 4; ++j) { const float a = fmaxf(v0[j], 0.f), b = fmaxf(v1[j], 0.f); v0[j] = a * a; v1[j] = b * b; } }
        v2u p0, p1; p0.x = pk2(v0[0], v0[1]); p0.y = pk2(v0[2], v0[3]); p1.x = pk2(v1[0], v1[1]); p1.y = pk2(v1[2], v1[3]);
        bf16* op = O + (size_t)row * ldc + 32 * mu + 4 * fq; *(v2u*)op = p0; *(v2u*)(op + 16) = p1; });
}

constexpr int NPHASES = 16;
__global__ void __launch_bounds__(NTHREADS, 2) mk_fwd(Args args) {
    extern __shared__ __attribute__((aligned(16))) unsigned char lds[];
    LAS unsigned char* L = (LAS unsigned char*)lds;
    volatile LAS unsigned* MISC = (volatile LAS unsigned*)(L + MISC_OFF);
    const int wave0 = __builtin_amdgcn_readfirstlane((int)threadIdx.x >> 6);
    const int G = gridDim.x; const int bx = blockIdx.x; const int vcu = (G % 8 == 0) ? (bx % 8) * (G / 8) + bx / 8 : bx;
    for (int u = threadIdx.x; u < (LDS_BYTES - LDSCTL_OFF) / 4; u += NTHREADS) ((LAS unsigned*)(L + LDSCTL_OFF))[u] = 0u;
    __syncthreads();
#if MK_PER_PHASE
    XcdBarrier bar; bar.bar = nullptr; bar.x = 0; bar.st = nullptr;
#define GRID_BAR() do { } while (0)
#else
    XcdBarrier bar = xcd_barrier_post((unsigned*)(args.ws + WS_CTL) + CW_BAR, MISC + 8);
#define GRID_BAR() xcd_barrier(bar, wave0 * 64 + lane_id_opaque())
#endif
    const int lo = args.ph_lo, hi = args.ph_hi;
#define IN(k) (ph == (k))
#define SEAM(k) do { } while (0)
    const int NGW = G * NWAVES;
#define RELANE const int tid = wave0 * 64 + lane_id_opaque(), lane = tid & 63; (void)tid; (void)lane;
#define KA_PTR(T, off) (*(T const __attribute__((address_space(4)))*)(ka + (off)))
#define PH_BEGIN const int tid = wave0 * 64 + lane_id_opaque(), lane = tid & 63, wave = wave0, gw = vcu * NWAVES + wave; (void)lane; (void)gw; \
    const __attribute__((address_space(4))) char* ka = (const __attribute__((address_space(4))) char*)__builtin_amdgcn_kernarg_segment_ptr(); asm volatile("" : "+s"(ka)); \
    unsigned char* const ws = KA_PTR(unsigned char*, 184); float* const out = KA_PTR(float*, 176); (void)ws; (void)out; \
    const float* const x_prompt = KA_PTR(const float*, 0); const float* const x_sample = KA_PTR(const float*, 8); const float* const state_pool = KA_PTR(const float*, 16); const float* const state_conv = KA_PTR(const float*, 24); \
    const float* const cache_k = KA_PTR(const float*, 32); const float* const cache_v = KA_PTR(const float*, 40); const float* const mem_prompt = KA_PTR(const float*, 48); \
    const float* const g_mix = KA_PTR(const float*, 56); const float* const g_attn = KA_PTR(const float*, 64); const float* const g_mem = KA_PTR(const float*, 72); const float* const g_ffn = KA_PTR(const float*, 80); const float* const g_final = KA_PTR(const float*, 88); \
    const float* const w_pool = KA_PTR(const float*, 96); const float* const pool_scale = KA_PTR(const float*, 104); const float* const w_conv_in = KA_PTR(const float*, 112); const float* const w_conv = KA_PTR(const float*, 120); const float* const w_conv_out = KA_PTR(const float*, 128); \
    const float* const w_q = KA_PTR(const float*, 136); const float* const w_kv = KA_PTR(const float*, 144); const float* const w_o = KA_PTR(const float*, 152); const float* const w_up = KA_PTR(const float*, 160); const float* const w_down = KA_PTR(const float*, 168); \
    (void)x_prompt; (void)x_sample; (void)state_pool; (void)state_conv; (void)cache_k; (void)cache_v; (void)mem_prompt; (void)g_mix; (void)g_attn; (void)g_mem; (void)g_ffn; (void)g_final; (void)w_pool; (void)pool_scale; (void)w_conv_in; (void)w_conv; (void)w_conv_out; (void)w_q; (void)w_kv; (void)w_o; (void)w_up; (void)w_down; \
    bf16* const WPOOL = (bf16*)(ws + WS_WPOOL); bf16* const WQ = (bf16*)(ws + WS_WQ); bf16* const WO = (bf16*)(ws + WS_WO); bf16* const WKV = (bf16*)(ws + WS_WKV); \
    bf16* const WUP = (bf16*)(ws + WS_WUP); bf16* const WDN = (bf16*)(ws + WS_WDN); bf16* const WIN = (bf16*)(ws + WS_WIN); bf16* const WOUT = (bf16*)(ws + WS_WOUT); \
    bf16* const MN = (bf16*)(ws + WS_MN); bf16* const KB = (bf16*)(ws + WS_KB); bf16* const VT = (bf16*)(ws + WS_VT); float* const SSQ = (float*)(ws + WS_SSQ); \
    float* const X = (float*)(ws + WS_X); bf16* const XG = (bf16*)(ws + WS_XG); bf16* const P0 = (bf16*)(ws + WS_P0); bf16* const OB = (bf16*)(ws + WS_O); bf16* const CH = (bf16*)(ws + WS_CH); \
    bf16* const PS = (bf16*)(ws + WS_PS); bf16* const HB = (bf16*)(ws + WS_H); \
    float* const XS = (float*)(ws + SS_X); bf16* const XGS = (bf16*)(ws + SS_XG); float* const SSQS = (float*)(ws + SS_SSQ); bf16* const P0S = (bf16*)(ws + SS_P0); bf16* const OS = (bf16*)(ws + SS_O); \
    float* const CHS = (float*)(ws + SS_CH); bf16* const HS = (bf16*)(ws + SS_H); \
    (void)WPOOL; (void)WQ; (void)WO; (void)WKV; (void)WUP; (void)WDN; (void)WIN; (void)WOUT; (void)MN; (void)KB; (void)VT; (void)SSQ; (void)X; (void)XG; (void)P0; (void)OB; (void)CH; (void)PS; (void)HB; (void)XS; (void)XGS; (void)SSQS; (void)P0S; (void)OS; (void)CHS; (void)HS;

#pragma unroll 1
    for (int ph = lo; ph < hi; ++ph) {
    if (IN(0)) { PH_BEGIN
        LAS float* scr = (LAS float*)(L + RING_OFF + wave * 16384);
        {
            constexpr int I_POOL = 4 * 4 * 8, I_Q = 16 * 32, I_KV = 16 * 64, I_UP = 16 * 128, I_DN = 64 * 32, I_IN = 16 * 96;
            constexpr int NITEMS = I_POOL + 2 * (I_Q + I_KV + I_Q + I_UP + I_DN) + I_IN + I_Q;
            for (int it = gw; it < NITEMS; it += NGW) {
                int r = it;
                if (r < I_POOL) { const int g = r >> 5, rr = r & 31, kb = rr >> 3, nb = rr & 7; p0_transpose_item(w_pool + g * 65536, 256, 256, WPOOL + g * 65536, 64 * kb, 32 * nb, 32 * nb, scr, lane); continue; } r -= I_POOL;
                bool done = false;
#pragma unroll 1
                for (int l = 0; l < 2 && !done; ++l) {
                    if (r < I_Q) { const int kb = r >> 5, nb = r & 31; p0_transpose_item(w_q + (size_t)l * D * D, D, D, WQ + (size_t)l * D * D, 64 * kb, 32 * nb, 32 * nb, scr, lane); done = true; break; } r -= I_Q;
                    if (r < I_KV) { const int kb = r >> 6, nb = r & 63; p0_transpose_item(w_kv + (size_t)l * D * 2048, D, 2048, WKV + (size_t)l * 2048 * D, 64 * kb, 32 * nb, 32 * nb, scr, lane); done = true; break; } r -= I_KV;
                    if (r < I_Q) { const int kb = r >> 5, nb = r & 31; p0_transpose_item(w_o + (size_t)l * D * D, D, D, WO + (size_t)l * D * D, 64 * kb, 32 * nb, 32 * nb, scr, lane); done = true; break; } r -= I_Q;
                    if (r < I_UP) { const int kb = r >> 7, nb = r & 127; p0_transpose_item(w_up + (size_t)l * D * FF, D, FF, WUP + (size_t)l * FF * D, 64 * kb, 32 * nb, 32 * nb, scr, lane); done = true; break; } r -= I_UP;
                    if (r < I_DN) { const int kb = r >> 5, nb = r & 31; p0_transpose_item(w_down + (size_t)l * FF * D, FF, D, WDN + (size_t)l * D * FF, 64 * kb, 32 * nb, 32 * nb, scr, lane); done = true; break; } r -= I_DN;
                }
                if (done) continue;
                if (r < I_IN) { const int kb = r / 96, nb = r % 96; p0_transpose_item(w_conv_in, D, 3072, WIN, 64 * kb, 32 * nb, win_dest_row(32 * nb), scr, lane); continue; } r -= I_IN;
                { const int kb = r >> 5, nb = r & 31; p0_transpose_item(w_conv_out, D, D, WOUT, 64 * kb, 32 * nb, 32 * nb, scr, lane); }
            }
        }
        for (int m = gw; m < MEMROWS; m += NGW) {
            const f32x4* xr = (const f32x4*)(mem_prompt + (size_t)m * D) + lane; f32x4 v[4]; float s = 0.f;
#pragma unroll
            for (int j = 0; j < 4; ++j) { v[j] = xr[64 * j]; s += (v[j][0] * v[j][0] + v[j][1] * v[j][1]) + (v[j][2] * v[j][2] + v[j][3] * v[j][3]); }
            const float rstd = __builtin_amdgcn_rsqf(wave_sum(s) * (1.f / D) + EPS);
#pragma unroll
            for (int l = 0; l < 2; ++l) { v2u* o8 = (v2u*)(MN + ((size_t)l * MEMROWS + m) * D) + lane;
#pragma unroll
                for (int j = 0; j < 4; ++j) { const f32x4 gg = *((const f32x4*)(g_mem + l * D) + lane + 64 * j); const f32x4 w = v[j] * rstd * gg; v2u o; o.x = pk2(w[0], w[1]); o.y = pk2(w[2], w[3]); o8[64 * j] = o; } }
        }
        for (int it = gw; it < MS * 4; it += NGW) {
            const int b = it >> 2, g = it & 3, c4 = g * 256 + lane * 4;
            const f32x4* xr = (const f32x4*)(x_sample + (size_t)b * D) + lane; float s = 0.f;
#pragma unroll
            for (int j = 0; j < 4; ++j) { const f32x4 v = xr[64 * j]; s += (v[0] * v[0] + v[1] * v[1]) + (v[2] * v[2] + v[3] * v[3]); }
            const float rstd = __builtin_amdgcn_rsqf(wave_sum(s) * (1.f / D) + EPS);
            const f32x4 u = *(const f32x4*)(x_sample + (size_t)b * D + c4) * rstd * *(const f32x4*)(g_mix + c4);
            const int W = 2 << g; f32x4 S = u;
            const float* sp = state_pool + (size_t)b * 15 * D + c4;
            float* po = out + OPS + (size_t)b * 15 * D + c4;
            for (int r = 0; r < 15; ++r) { const f32x4 sv = *(const f32x4*)(sp + (size_t)r * D); if (r >= 16 - W) S += sv; if (r >= 1) *(f32x4*)(po + (size_t)(r - 1) * D) = sv; }
            *(f32x4*)(po + (size_t)14 * D) = u;
            const f32x4 p = S * (1.0f / (float)W) - u; v2u o; o.x = pk2(p[0], p[1]); o.y = pk2(p[2], p[3]); *(v2u*)(P0S + (size_t)b * D + c4) = o;
        }
        __syncthreads();
        {
            LAS float* rs = (LAS float*)(L + RING_OFF);
            for (int it = vcu; it < BATCH * (SEQ / 32); it += G) {
                const int b = it >> 6, t0 = (it & 63) * 32;
                for (int r = wave; r < 47; r += NWAVES) { const int t = t0 - 15 + r; float rv = 0.f;
                    if (t >= 0) { const f32x4* xr = (const f32x4*)(x_prompt + ((size_t)b * SEQ + t) * D) + lane; float s = 0.f;
#pragma unroll
                        for (int j = 0; j < 4; ++j) { const f32x4 v = xr[64 * j]; s += (v[0] * v[0] + v[1] * v[1]) + (v[2] * v[2] + v[3] * v[3]); }
                        rv = __builtin_amdgcn_rsqf(wave_sum(s) * (1.f / D) + EPS); }
                    if (lane == 0) rs[r] = rv; }
                LDS_WAIT(); __syncthreads();
                const int g = wave & 3, tA = t0 + (wave >> 2) * 16, c4 = g * 256 + lane * 4;
                const float* xb = x_prompt + (size_t)b * SEQ * D + c4; const f32x4 g4 = *(const f32x4*)(g_mix + c4);
                bf16* pout = P0 + (size_t)b * SEQ * D + c4; float* poolout = out + OPP + (size_t)b * 15 * D + c4;
                const LAS float* rsw = rs + (wave >> 2) * 16;
                if (g == 0) pool_wave<2>(xb, rsw, g4, tA, pout, poolout); else if (g == 1) pool_wave<4>(xb, rsw, g4, tA, pout, poolout);
                else if (g == 2) pool_wave<8>(xb, rsw, g4, tA, pout, poolout); else pool_wave<16>(xb, rsw, g4, tA, pout, poolout);
                __syncthreads();
            }
        }
    }
    SEAM(0);

    if (IN(1)) { PH_BEGIN
        { pg8::Gemm g{D, D, D}; pg8::KvOrder S{G, bx, (const char*)MN, (const char*)WKV};
          pg8::EpiKV E{out + OMK, out + OMV, KB, VT};
          pg8::gemm_phase<pg8::EpiKV, pg8::KvOrder, true>(L + RING_OFF, g, S, E, tid); }
        { pg8::Gemm g{D, 256, 256}; pg8::StaticOrder S; S.init(MP / 256, 4, G, bx, P0, (size_t)256 * D * 2, WPOOL, (size_t)65536 * 2, (size_t)256 * 2);
          pg8::EpiRes E{x_prompt, X, XG, g_attn, SSQ, pool_scale};
          pg8::gemm_phase<pg8::EpiRes, pg8::StaticOrder, true>(L + RING_OFF, g, S, E, tid); }
        for (int mu = vcu; mu < 32; mu += G) s_res_unit(P0S + (mu >> 3) * 256, D, WPOOL, 256, 256, mu, x_sample, XS, XGS, SSQS, g_attn, pool_scale, wave, lane);
    }
    SEAM(1);

    {
        const int l = (ph >= 7) ? 1 : 0, pb = l ? 10 : 2;
        {
            if (IN(7)) { PH_BEGIN
                { pg8::Gemm g{D, D, D}; pg8::StaticOrder S; S.init(MP / 256, 12, G, bx, XG, (size_t)256 * D * 2, WIN, (size_t)256 * D * 2);
                  pg8::EpiRow<2> E{OB, D, SSQ, 1.f, CH, out + OCP};
                  pg8::gemm_phase<pg8::EpiRow<2>, pg8::StaticOrder, true>(L + RING_OFF, g, S, E, tid); }
                { RELANE
                for (int mu = vcu; mu < 96; mu += G) {
                    if (mu < 32) s_row_unit<0>(XGS, D, WIN, D, D, mu, OS, D, SSQS, 1.f, wave, lane);
                    else { const int c0 = (mu - 32) * 16; const int r0 = 1024 + (c0 >> 7) * 256 + (c0 & 127);
                        sgemm_unit(XGS, D, WIN, D, D, r0, r0 + 128, wave, lane, [&](f32x4 a0, f32x4 a1, int row, int fq) {
                            const float rs = srstd(SSQS, row, fq); const f32x4 v = a0 * a1 * (rs * rs);
                            *(f32x4*)(CHS + (size_t)row * D + c0 + 4 * fq) = v; *(f32x4*)(out + OCS + ((size_t)row * 2 + 1) * D + c0 + 4 * fq) = v; }); }
                }
                }
            }
            SEAM(7);
            if (IN(8)) { PH_BEGIN
                const int gt = vcu * NTHREADS + tid, NT = G * NTHREADS;
                for (int idx = gt; idx < MP * 128; idx += NT) {
                    const int row = idx >> 7, c8 = (idx & 127) * 8, t = row & (SEQ - 1);
                    const v4u gb = *(const v4u*)(OB + (size_t)row * D + c8); const v4u c2 = *(const v4u*)(CH + (size_t)row * D + c8);
                    v4u c1 = {0u, 0u, 0u, 0u}, c0 = {0u, 0u, 0u, 0u};
                    if (t >= 1) c1 = *(const v4u*)(CH + (size_t)(row - 1) * D + c8);
                    if (t >= 2) c0 = *(const v4u*)(CH + (size_t)(row - 2) * D + c8);
                    const f32x4 w0a = *(const f32x4*)(w_conv + c8), w0b = *(const f32x4*)(w_conv + c8 + 4), w1a = *(const f32x4*)(w_conv + D + c8), w1b = *(const f32x4*)(w_conv + D + c8 + 4),
                                w2a = *(const f32x4*)(w_conv + 2 * D + c8), w2b = *(const f32x4*)(w_conv + 2 * D + c8 + 4);
                    v4u o;
#pragma unroll
                    for (int j = 0; j < 4; ++j) { const float wl0 = (j < 2) ? w0a[2 * j] : w0b[2 * j - 4], wh0 = (j < 2) ? w0a[2 * j + 1] : w0b[2 * j - 3];
                        const float wl1 = (j < 2) ? w1a[2 * j] : w1b[2 * j - 4], wh1 = (j < 2) ? w1a[2 * j + 1] : w1b[2 * j - 3];
                        const float wl2 = (j < 2) ? w2a[2 * j] : w2b[2 * j - 4], wh2 = (j < 2) ? w2a[2 * j + 1] : w2b[2 * j - 3];
                        const float lo_ = bflo(gb[j]) * (bflo(c0[j]) * wl0 + bflo(c1[j]) * wl1 + bflo(c2[j]) * wl2);
                        const float hi_ = bfhi(gb[j]) * (bfhi(c0[j]) * wh0 + bfhi(c1[j]) * wh1 + bfhi(c2[j]) * wh2);
                        o[j] = pk2(lo_, hi_); }
                    *(v4u*)(P0 + (size_t)row * D + c8) = o;
                }
                for (int idx = gt; idx < MS * 256; idx += NT) {
                    const int b = idx >> 8, c4 = (idx & 255) * 4;
                    const f32x4 s0 = *(const f32x4*)(state_conv + ((size_t)b * 2 + 0) * D + c4), s1 = *(const f32x4*)(state_conv + ((size_t)b * 2 + 1) * D + c4), chv = *(const f32x4*)(CHS + (size_t)b * D + c4);
                    const f32x4 cv = s0 * *(const f32x4*)(w_conv + c4) + s1 * *(const f32x4*)(w_conv + D + c4) + chv * *(const f32x4*)(w_conv + 2 * D + c4);
                    const v2u gbw = *(const v2u*)(OS + (size_t)b * D + c4);
                    v2u o; o.x = pk2(bflo(gbw.x) * cv[0], bfhi(gbw.x) * cv[1]); o.y = pk2(bflo(gbw.y) * cv[2], bfhi(gbw.y) * cv[3]);
                    *(v2u*)(P0S + (size_t)b * D + c4) = o;
                    *(f32x4*)(out + OCS + ((size_t)b * 2 + 0) * D + c4) = s1;
                }
            }
            SEAM(8);
            if (IN(9)) { PH_BEGIN
                { pg8::Gemm g{D, D, D}; pg8::StaticOrder S; S.init(MP / 256, 4, G, bx, P0, (size_t)256 * D * 2, WOUT, (size_t)256 * D * 2);
                  pg8::EpiRes E{X, X, XG, g_attn + D, SSQ, nullptr};
                  pg8::gemm_phase<pg8::EpiRes, pg8::StaticOrder, true>(L + RING_OFF, g, S, E, tid); }
                { RELANE for (int mu = vcu; mu < 32; mu += G) s_res_unit(P0S, D, WOUT, D, D, mu, XS, XS, XGS, SSQS, g_attn + D, nullptr, wave, lane); }
            }
            SEAM(9);
        }
#define LAYER_W const bf16* WQl = WQ + (size_t)l * D * D; const bf16* WOl = WO + (size_t)l * D * D; const bf16* WUPl = WUP + (size_t)l * FF * D; const bf16* WDNl = WDN + (size_t)l * D * FF; (void)WQl; (void)WOl; (void)WUPl; (void)WDNl;
        if (IN(pb)) { PH_BEGIN LAYER_W
            { pg8::Gemm g{D, D, D}; pg8::StaticOrder S; S.init(MP / 256, 4, G, bx, XG, (size_t)256 * D * 2, WQl, (size_t)256 * D * 2);
              pg8::EpiRow<0> E{P0, D, SSQ, QSCALE, nullptr, nullptr};
              pg8::gemm_phase<pg8::EpiRow<0>, pg8::StaticOrder, true>(L + RING_OFF, g, S, E, tid); }
            { RELANE for (int mu = vcu; mu < 32; mu += G) s_row_unit<0>(XGS, D, WQl, D, D, mu, P0S, D, SSQS, QSCALE, wave, lane); }
        }
        SEAM(pb);
        if (IN(pb + 1)) { PH_BEGIN LAYER_W
            for (int it = bx; it < 256; it += G) {
                const int pm = it >> 2, h = it & 3, b = pm >> 3;
                bf16* Pu = PS + (size_t)it * 65536;
                { pg8::Gemm g{D, D, 256}; pg8::SingleOrder S{{pm, h}, (const char*)(P0 + (size_t)pm * 256 * D + h * 256), (const char*)(KB + ((size_t)l * MEMROWS + b * 256) * D + h * 256)};
                  pg8::EpiSoftmax E{Pu};
                  pg8::gemm_phase<pg8::EpiSoftmax, pg8::SingleOrder, false>(L + RING_OFF, g, S, E, tid); }
                VM_WAIT(); __syncthreads();
                { pg8::Gemm g{256, 256, 256}; pg8::SingleOrder S{{pm, h}, (const char*)Pu, (const char*)(VT + ((size_t)(l * BATCH + b) * D + h * 256) * NMEM)};
                  pg8::EpiBf16 E{OB, D};
                  pg8::gemm_phase<pg8::EpiBf16, pg8::SingleOrder, true>(L + RING_OFF, g, S, E, tid); }
                __syncthreads();
            }
            { RELANE
                LAS float* sc = (LAS float*)(L + RING_OFF);
                LAS float* po = (LAS float*)(L + RING_OFF + 1024);
                for (int it = vcu; it < MS * NH; it += G) {
                    const int b = it >> 2, h = it & 3;
                    const v2u qw = *(const v2u*)(P0S + (size_t)b * D + h * 256 + lane * 4);
                    const f32x4 q4 = {bflo(qw.x), bfhi(qw.x), bflo(qw.y), bfhi(qw.y)};
                    const float* kp = cache_k + (((size_t)l * MS + b) * NMEM + wave * 32) * D + h * 256 + lane * 4;
                    const float* vp = cache_v + (((size_t)l * MS + b) * NMEM + wave * 32) * D + h * 256 + lane * 4;
#pragma unroll 8
                    for (int n = 0; n < 32; ++n) { const f32x4 kv = *(const f32x4*)(kp + (size_t)n * D); float s = (q4[0] * kv[0] + q4[1] * kv[1]) + (q4[2] * kv[2] + q4[3] * kv[3]);
                        s = wave_sum(s); if (lane == 0) sc[wave * 32 + n] = s; }
                    LDS_WAIT(); __syncthreads();
                    float mx = -3.0e38f, sm = 0.f; f32x4 sv = *(const LAS f32x4*)(sc + lane * 4);
                    mx = fmaxf(fmaxf(sv[0], sv[1]), fmaxf(sv[2], sv[3]));
                    mx = wave_max(mx);
#pragma unroll
                    for (int j = 0; j < 4; ++j) sm += __builtin_amdgcn_exp2f(sv[j] - mx);
                    sm = wave_sum(sm);
                    f32x4 acc = {0.f, 0.f, 0.f, 0.f};
#pragma unroll 8
                    for (int n = 0; n < 32; ++n) { const float p = __builtin_amdgcn_exp2f(sc[wave * 32 + n] - mx); const f32x4 vv = *(const f32x4*)(vp + (size_t)n * D); acc += vv * p; }
                    *(LAS f32x4*)(po + wave * 256 + lane * 4) = acc;
                    LDS_WAIT(); __syncthreads();
                    if (tid < 256) { float o = 0.f;
#pragma unroll
                        for (int w = 0; w < 8; ++w) o += po[w * 256 + tid];
                        OS[(size_t)b * D + h * 256 + tid] = (bf16)f2bf(o / sm); }
                    __syncthreads();
                }
            }
        }
        SEAM(pb + 1);
        if (IN(pb + 2)) { PH_BEGIN LAYER_W
            { pg8::Gemm g{D, D, D}; pg8::StaticOrder S; S.init(MP / 256, 4, G, bx, OB, (size_t)256 * D * 2, WOl, (size_t)256 * D * 2);
              pg8::EpiRes E{X, X, XG, g_ffn + l * D, SSQ, nullptr};
              pg8::gemm_phase<pg8::EpiRes, pg8::StaticOrder, true>(L + RING_OFF, g, S, E, tid); }
            { RELANE for (int mu = vcu; mu < 32; mu += G) s_res_unit(OS, D, WOl, D, D, mu, XS, XS, XGS, SSQS, g_ffn + l * D, nullptr, wave, lane); }
        }
        SEAM(pb + 2);
        if (IN(pb + 3)) { PH_BEGIN LAYER_W
            { pg8::Gemm g{D, D, D}; pg8::StaticOrder S; S.init(MP / 256, 16, G, bx, XG, (size_t)256 * D * 2, WUPl, (size_t)256 * D * 2);
              pg8::EpiRow<1> E{HB, FF, SSQ, 1.f, nullptr, nullptr};
              pg8::gemm_phase<pg8::EpiRow<1>, pg8::StaticOrder, true>(L + RING_OFF, g, S, E, tid); }
            { RELANE for (int mu = vcu; mu < 128; mu += G) s_row_unit<1>(XGS, D, WUPl, D, D, mu, HS, FF, SSQS, 1.f, wave, lane); }
        }
        SEAM(pb + 3);
        if (IN(pb + 4)) { PH_BEGIN LAYER_W
            const float* gn = (l == 0) ? (g_mix + D) : g_final;
            float* xo = (l == 0) ? X : (out + OY); float* xso = (l == 0) ? XS : (out + OYS);
            { pg8::Gemm g{FF, FF, FF}; pg8::StaticOrder S; S.init(MP / 256, 4, G, bx, HB, (size_t)256 * FF * 2, WDNl, (size_t)256 * FF * 2);
              pg8::EpiRes E{X, xo, XG, gn, SSQ, nullptr};
              pg8::gemm_phase<pg8::EpiRes, pg8::StaticOrder, true>(L + RING_OFF, g, S, E, tid); }
            { RELANE for (int mu = vcu; mu < 32; mu += G) s_res_unit(HS, FF, WDNl, FF, FF, mu, XS, xso, XGS, SSQS, gn, nullptr, wave, lane); }
        }
        SEAM(pb + 4);
    }
    if (IN(15)) { PH_BEGIN
        for (int m = gw; m < MP + MS; m += NGW) {
            float rs; float* yr;
            if (m < MP) { const float v = (lane < 16) ? SSQ[(size_t)m * 16 + lane] : 0.f; rs = __builtin_amdgcn_rsqf(wave_sum(v) * (1.f / D) + EPS); yr = out + OY + (size_t)m * D; }
            else { const int r = m - MP; const float v = (lane < 32) ? SSQS[r * 32 + lane] : 0.f; rs = __builtin_amdgcn_rsqf(wave_sum(v) * (1.f / D) + EPS); yr = out + OYS + (size_t)r * D; }
            f32x4* yp = (f32x4*)yr + lane;
#pragma unroll
            for (int j = 0; j < 4; ++j) { const f32x4 gg = *((const f32x4*)g_final + lane + 64 * j); yp[64 * j] = yp[64 * j] * (rs * DBGF(m < MP ? 0 : 1)) * gg; }
        }
    }
#if defined(DBG_SCALE_MASK)
    if (IN(15)) { PH_BEGIN
        __syncthreads();
        const size_t obeg[9] = {OY, OYS, OPP, OCP, OMK, OMV, OPS, OCS, 27664384};
        const size_t gt = (size_t)vcu * NTHREADS + tid, NT = (size_t)G * NTHREADS;
#pragma unroll 1
        for (int k = 2; k < 8; ++k) if ((DBG_SCALE_MASK >> k) & 1) for (size_t i = obeg[k] + gt; i < obeg[k + 1]; i += NT) out[i] *= 0.8f;
    }
#endif
    if (ph + 1 < hi) GRID_BAR();
    }
#undef IN
#undef SEAM
#undef GRID_BAR
}

extern "C" void kernel_launch(void* const* d_in, const int* in_sizes, int n_in, void* d_out, int out_size, void* d_ws, size_t ws_size, hipStream_t stream) {
    static int grid = 0;
    if (grid == 0) {
        if (n_in != 22 || ws_size < WS_END) { fprintf(stderr, "kernel_launch: unexpected inputs (n_in %d, ws %zu)\n", n_in, ws_size); grid = -1; return; }
        int dev = 0, cus = 0, per_cu = 0;
        if (hipGetDevice(&dev) != hipSuccess || hipDeviceGetAttribute(&cus, hipDeviceAttributeMultiprocessorCount, dev) != hipSuccess) { grid = -1; return; }
        if (hipFuncSetAttribute((const void*)mk_fwd, hipFuncAttributeMaxDynamicSharedMemorySize, LDS_BYTES) != hipSuccess) { fprintf(stderr, "kernel_launch: hipFuncSetAttribute failed\n"); grid = -1; return; }
        if (hipOccupancyMaxActiveBlocksPerMultiprocessor(&per_cu, (const void*)mk_fwd, NTHREADS, LDS_BYTES) != hipSuccess || per_cu < 1)
            fprintf(stderr, "kernel_launch: note: occupancy query reports %d workgroups per CU\n", per_cu);
        (void)hipGetLastError();
        grid = cus;
    }
    if (grid < 0) return;
    (void)hipMemsetAsync((char*)d_ws + WS_CTL, 0, CTL_ZERO_BYTES, stream);
    Args a{};
    for (int i = 0; i < 22; ++i) a.in[i] = (const float*)d_in[i];
    a.out = (float*)d_out; a.ws = (unsigned char*)d_ws;
#if MK_PER_PHASE
    for (int p = 0; p < NPHASES; ++p) { a.ph_lo = p; a.ph_hi = p + 1; hipLaunchKernelGGL(mk_fwd, dim3(grid), dim3(NTHREADS), LDS_BYTES, stream, a); }
#else
    a.ph_lo = 0; a.ph_hi = NPHASES; hipLaunchKernelGGL(mk_fwd, dim3(grid), dim3(NTHREADS), LDS_BYTES, stream, a);
#endif
}
```

```cpp
#include <hip/hip_runtime.h>
#include <cstdio>
#include <cstdint>

#define DBG_SCALE_MASK 0x00
#define DBGF(k) (((DBG_SCALE_MASK >> (k)) & 1) ? 0.8f : 1.0f)
#ifndef MK_PER_PHASE
#define MK_PER_PHASE 0
#endif

constexpr int D = 1024, BATCH = 8, SEQ = 2048, MP = BATCH * SEQ  , MS = 128  ;
constexpr int NMEM = 256, NH = 4, HD = 256, FF = 4096, MEMROWS = BATCH * NMEM  ;
constexpr float EPS = 1e-6f;
constexpr float QSCALE = 0.0625f * 1.4426950408889634f;

constexpr size_t OY = 0, OYS = 16777216, OPP = 16908288, OCP = 17031168, OMK = 17047552, OMV = 21241856, OPS = 25436160, OCS = 27402240;

#define SWZ_XOR(v, m) __builtin_bit_cast(float, __builtin_amdgcn_ds_swizzle(__builtin_bit_cast(int, (float)(v)), (((m) << 10) | 0x1f)))
__device__ __forceinline__ void swap32(float& a, float& b) { asm volatile("s_nop 1\n\tv_permlane32_swap_b32 %0, %1\n\ts_nop 1" : "+v"(a), "+v"(b)); }
__device__ __forceinline__ float add_x32(float v) { float a = v, b = v; swap32(a, b); return a + b; }
__device__ __forceinline__ float max_x32(float v) { float a = v, b = v; swap32(a, b); return fmaxf(a, b); }
__device__ __forceinline__ float add_x16_x32(float v) { v += SWZ_XOR(v, 16); return add_x32(v); }
__device__ __forceinline__ float max_x16_x32(float v) { v = fmaxf(v, SWZ_XOR(v, 16)); return max_x32(v); }
__device__ __forceinline__ float wave_sum(float v) { v += SWZ_XOR(v, 1); v += SWZ_XOR(v, 2); v += SWZ_XOR(v, 4); v += SWZ_XOR(v, 8); v += SWZ_XOR(v, 16); return add_x32(v); }
__device__ __forceinline__ float wave_max(float v) { v = fmaxf(v, SWZ_XOR(v, 1)); v = fmaxf(v, SWZ_XOR(v, 2)); v = fmaxf(v, SWZ_XOR(v, 4)); v = fmaxf(v, SWZ_XOR(v, 8)); v = fmaxf(v, SWZ_XOR(v, 16)); return max_x32(v); }

namespace pg8 {
#define PG8_LAS __attribute__((address_space(3)))
typedef unsigned short bf16_t;
typedef short bf16x8 __attribute__((ext_vector_type(8)));
typedef float f32x4 __attribute__((ext_vector_type(4)));
typedef float f32x2 __attribute__((ext_vector_type(2)));
typedef unsigned u32x4 __attribute__((ext_vector_type(4)));
typedef unsigned u32x2 __attribute__((ext_vector_type(2)));
constexpr int BM = 256, BK = 64, HALF = 128, HTB = HALF * BK * 2, STAGE_BYTES = 8 * HTB, NXCD = 8, WGM = 8;

__host__ __device__ __forceinline__ int lds_byte(int r, int c) { const int st = (r >> 4) * 2 + (c >> 5), rr = r & 15, cc = c & 31, ob = rr * 64 + cc * 2; return st * 1024 + (ob ^ (((ob >> 9) & 1) << 5)); }
__host__ __device__ __forceinline__ void stage_rc(int b, int& R, int& C) { const int st = b / 1024, sb = b % 1024, swz = sb ^ (((sb >> 9) & 1) << 5); R = (st >> 1) * 16 + swz / 64; C = (st & 1) * 32 + (swz % 64) / 2; }
__host__ __device__ __forceinline__ int perm32(int rho) { const int n = rho >> 4, i = rho & 15; return 8 * (i >> 2) + 4 * n + (i & 3); }

struct Unit { int pm, pn; };
struct Gemm { int lda, ldb, K; };

__device__ __forceinline__ unsigned cvt_pk_bf16(float lo, float hi) { unsigned r; asm volatile("v_cvt_pk_bf16_f32 %0, %1, %2" : "=v"(r) : "v"(lo), "v"(hi)); return r; }

struct StaticOrder {
    int nM, nN, nwg, G, c;
    const char* A; const char* B; size_t astep, bstep, apn;
    __device__ void init(int nM_, int nN_, int G_, int c_, const void* A_, size_t astep_, const void* B_, size_t bstep_, size_t apn_ = 0) {
        nM = nM_; nN = nN_; nwg = nM * nN; G = G_; c = c_; A = (const char*)A_; B = (const char*)B_; astep = astep_; bstep = bstep_; apn = apn_; }
    __device__ bool next(int i, Unit& u) const {
        const long L = (long)i * G + c; if (L >= nwg) return false;
        int wgid = (int)L; { const int q = nwg / NXCD, r = nwg % NXCD, xcd = wgid % NXCD, off = wgid / NXCD; wgid = (xcd < r ? xcd * (q + 1) : r * (q + 1) + (xcd - r) * q) + off; }
        const int nig = WGM * nN, gid = wgid / nig, fm = gid * WGM, gsz = (nM - fm) < WGM ? (nM - fm) : WGM;
        u.pm = fm + ((wgid % nig) % gsz); u.pn = (wgid % nig) / gsz; return true;
    }
    __device__ __forceinline__ const char* aptr(const Unit& u) const { return A + (size_t)u.pm * astep + (size_t)u.pn * apn; }
    __device__ __forceinline__ const char* bptr(const Unit& u) const { return B + (size_t)u.pn * bstep; }
};
struct KvOrder {
    int G, c; const char* A; const char* B;
    __device__ bool next(int i, Unit& u) const { const int L = i * G + c; if (L >= 128) return false; u.pm = L >> 3; u.pn = L & 7; return true; }
    __device__ __forceinline__ const char* aptr(const Unit& u) const { return A + (size_t)u.pm * (256 * 1024 * 2); }
    __device__ __forceinline__ const char* bptr(const Unit& u) const { return B + (size_t)((u.pm >> 3) * 2048 + u.pn * 256) * (1024 * 2); }
};
struct SingleOrder {
    Unit u0; const char* A; const char* B;
    __device__ bool next(int i, Unit& u) const { if (i) return false; u = u0; return true; }
    __device__ __forceinline__ const char* aptr(const Unit&) const { return A; }
    __device__ __forceinline__ const char* bptr(const Unit&) const { return B; }
};


struct EpiRes {
    static constexpr bool PERM = false, AFTER_DRAIN = false;
    const float* base; float* out; bf16_t* xg; const float* gnext; float* ssq; const float* cscale;
    __device__ __forceinline__ void operator()(const f32x4 (&acc)[2][2][4][2], const Unit& u, int wr, int wc, int fr, int fq) const {
        const int col0 = u.pn * BM + wc * 32 + 4 * fq;
        f32x4 gv[2][2], cs[2][2];
#pragma unroll
        for (int bj = 0; bj < 2; ++bj)
#pragma unroll
            for (int n = 0; n < 2; ++n) { gv[bj][n] = *(const f32x4*)(gnext + col0 + bj * HALF + n * 16);
                cs[bj][n] = cscale ? *(const f32x4*)(cscale + col0 + bj * HALF + n * 16) : (f32x4){1.f, 1.f, 1.f, 1.f}; }
#pragma unroll
        for (int ai = 0; ai < 2; ++ai)
#pragma unroll
            for (int m = 0; m < 4; ++m) { const int row = u.pm * BM + ai * HALF + wr * 64 + m * 16 + fr; const size_t off = (size_t)row * D + col0; float ss = 0.f;
#pragma unroll
                for (int bj = 0; bj < 2; ++bj)
#pragma unroll
                    for (int n = 0; n < 2; ++n) { const f32x4 b = *(const f32x4*)(base + off + bj * HALF + n * 16); const f32x4 v = b + acc[ai][bj][m][n] * cs[bj][n];
                        *(f32x4*)(out + off + bj * HALF + n * 16) = v; ss += (v[0] * v[0] + v[1] * v[1]) + (v[2] * v[2] + v[3] * v[3]);
                        const f32x4 w = v * gv[bj][n]; u32x2 p; p.x = cvt_pk_bf16(w[0], w[1]); p.y = cvt_pk_bf16(w[2], w[3]); *(u32x2*)(xg + off + bj * HALF + n * 16) = p; }
                ss = add_x16_x32(ss);
                if (fq == 0) ssq[(size_t)row * 16 + u.pn * 4 + wc] = ss; }
    }
};
__device__ __forceinline__ float rstd_from_ssq16(const float* ssq, int row) {
    const f32x4* sp = (const f32x4*)(ssq + (size_t)row * 16); const f32x4 s = (sp[0] + sp[1]) + (sp[2] + sp[3]);
    return __builtin_amdgcn_rsqf(((s[0] + s[1]) + (s[2] + s[3])) * (1.0f / D) + EPS);
}
template <int MODE> struct EpiRow {
    static constexpr bool PERM = true, AFTER_DRAIN = false;
    bf16_t* O; int ldc; const float* ssq; float scale; bf16_t* O2; float* convout;
    __device__ __forceinline__ void operator()(const f32x4 (&acc)[2][2][4][2], const Unit& u, int wr, int wc, int fr, int fq) const {
        const int colw = wc * 32 + 8 * fq;
#pragma unroll
        for (int ai = 0; ai < 2; ++ai)
#pragma unroll
            for (int m = 0; m < 4; ++m) { const int row = u.pm * BM + ai * HALF + wr * 64 + m * 16 + fr; const float rs = rstd_from_ssq16(ssq, row);
                if (MODE == 2 && u.pn >= 4) {
                    const float r2 = rs * rs; const f32x4 v0 = acc[ai][0][m][0] * acc[ai][1][m][0] * r2, v1 = acc[ai][0][m][1] * acc[ai][1][m][1] * r2;
                    const int ch = (u.pn - 4) * 128 + colw;
                    u32x4 w; w.x = cvt_pk_bf16(v0[0], v0[1]); w.y = cvt_pk_bf16(v0[2], v0[3]); w.z = cvt_pk_bf16(v1[0], v1[1]); w.w = cvt_pk_bf16(v1[2], v1[3]);
                    *(u32x4*)(O2 + (size_t)row * D + ch) = w;
                    const int t = row & (SEQ - 1);
                    if (t >= SEQ - 2) { float* cp = convout + ((size_t)(row >> 11) * 2 + (t - (SEQ - 2))) * D + ch; *(f32x4*)cp = v0; *(f32x4*)(cp + 4) = v1; }
                } else {
                    const float sc = (MODE == 0) ? rs * scale : rs;
#pragma unroll
                    for (int bj = 0; bj < 2; ++bj) { f32x4 v0 = acc[ai][bj][m][0] * sc, v1 = acc[ai][bj][m][1] * sc;
                        if (MODE == 1) {
#pragma unroll
                            for (int j = 0; j < 4; ++j) { const float a = fmaxf(v0[j], 0.f), b = fmaxf(v1[j], 0.f); v0[j] = a * a; v1[j] = b * b; } }
                        u32x4 w; w.x = cvt_pk_bf16(v0[0], v0[1]); w.y = cvt_pk_bf16(v0[2], v0[3]); w.z = cvt_pk_bf16(v1[0], v1[1]); w.w = cvt_pk_bf16(v1[2], v1[3]);
                        *(u32x4*)(O + (size_t)row * ldc + u.pn * BM + bj * HALF + colw) = w; }
                } }
    }
};
struct EpiBf16 {
    static constexpr bool PERM = true, AFTER_DRAIN = false;
    bf16_t* O; int ldc;
    __device__ __forceinline__ void operator()(const f32x4 (&acc)[2][2][4][2], const Unit& u, int wr, int wc, int fr, int fq) const {
        const int colw = u.pn * BM + wc * 32 + 8 * fq;
#pragma unroll
        for (int ai = 0; ai < 2; ++ai)
#pragma unroll
            for (int m = 0; m < 4; ++m) { const int row = u.pm * BM + ai * HALF + wr * 64 + m * 16 + fr;
#pragma unroll
                for (int bj = 0; bj < 2; ++bj) { const f32x4 v0 = acc[ai][bj][m][0], v1 = acc[ai][bj][m][1];
                    u32x4 w; w.x = cvt_pk_bf16(v0[0], v0[1]); w.y = cvt_pk_bf16(v0[2], v0[3]); w.z = cvt_pk_bf16(v1[0], v1[1]); w.w = cvt_pk_bf16(v1[2], v1[3]);
                    *(u32x4*)(O + (size_t)row * ldc + colw + bj * HALF) = w; } }
    }
};
struct EpiKV {
    static constexpr bool PERM = false, AFTER_DRAIN = false;
    float* outk; float* outv; bf16_t* Kb; bf16_t* Vt;
    __device__ __forceinline__ void operator()(const f32x4 (&acc)[2][2][4][2], const Unit& u, int wr, int wc, int fr, int fq) const {
        const int layer = u.pm >> 3; const bool isV = u.pn >= 4; const int col0 = (u.pn & 3) * BM + wc * 32 + 4 * fq;
        float* outp = isV ? outv : outk;
#pragma unroll
        for (int ai = 0; ai < 2; ++ai)
#pragma unroll
            for (int m = 0; m < 4; ++m) { const int rowl = (u.pm & 7) * BM + ai * HALF + wr * 64 + m * 16 + fr; const size_t off = ((size_t)layer * MEMROWS + rowl) * D + col0;
#pragma unroll
                for (int bj = 0; bj < 2; ++bj)
#pragma unroll
                    for (int n = 0; n < 2; ++n) { const f32x4 v = acc[ai][bj][m][n]; *(f32x4*)(outp + off + bj * HALF + n * 16) = v;
                        if (!isV) { u32x2 p; p.x = cvt_pk_bf16(v[0], v[1]); p.y = cvt_pk_bf16(v[2], v[3]); *(u32x2*)(Kb + off + bj * HALF + n * 16) = p; }
                        else { const int b = rowl >> 8, nn = rowl & 255; bf16_t* vp = Vt + ((size_t)(layer * BATCH + b) * D + col0 + bj * HALF + n * 16) * NMEM + nn;
                            const unsigned p0 = cvt_pk_bf16(v[0], v[1]), p1 = cvt_pk_bf16(v[2], v[3]);
                            vp[0] = (bf16_t)(p0 & 0xffffu); vp[NMEM] = (bf16_t)(p0 >> 16); vp[2 * NMEM] = (bf16_t)(p1 & 0xffffu); vp[3 * NMEM] = (bf16_t)(p1 >> 16); } } }
    }
};
struct EpiSoftmax {
    static constexpr bool PERM = true, AFTER_DRAIN = true;
    bf16_t* P;
    __device__ __forceinline__ void operator()(const f32x4 (&)[2][2][4][2], const Unit&, int, int, int, int) const {}
    __device__ __forceinline__ void fused(f32x4 (&acc)[2][2][4][2], const Unit& u, int wr, int wc, int fr, int fq, PG8_LAS unsigned char* lds, int wid, int lane) const {
        PG8_LAS float* Pm = (PG8_LAS float*)lds;
        PG8_LAS float* Ps = (PG8_LAS float*)(lds + 4096);
#pragma unroll
        for (int ai = 0; ai < 2; ++ai)
#pragma unroll
            for (int m = 0; m < 4; ++m) { float mx = -3.0e38f;
#pragma unroll
                for (int bj = 0; bj < 2; ++bj)
#pragma unroll
                    for (int n = 0; n < 2; ++n) { const f32x4 x = acc[ai][bj][m][n]; mx = fmaxf(mx, fmaxf(fmaxf(x[0], x[1]), fmaxf(x[2], x[3]))); }
                mx = max_x16_x32(mx);
                if (fq == 0) Pm[(ai * HALF + wr * 64 + m * 16 + fr) * 4 + wc] = mx; }
        asm volatile("s_waitcnt lgkmcnt(0)" ::: "memory"); __builtin_amdgcn_s_barrier(); asm volatile("" ::: "memory");
#pragma unroll
        for (int ai = 0; ai < 2; ++ai)
#pragma unroll
            for (int m = 0; m < 4; ++m) { const int r = ai * HALF + wr * 64 + m * 16 + fr; const f32x4 q = *(const PG8_LAS f32x4*)(Pm + r * 4);
                const float mx = fmaxf(fmaxf(q[0], q[1]), fmaxf(q[2], q[3])); float s = 0.f;
#pragma unroll
                for (int bj = 0; bj < 2; ++bj)
#pragma unroll
                    for (int n = 0; n < 2; ++n) { f32x4 x = acc[ai][bj][m][n];
#pragma unroll
                        for (int j = 0; j < 4; ++j) { x[j] = __builtin_amdgcn_exp2f(x[j] - mx); s += x[j]; }
                        acc[ai][bj][m][n] = x; }
                s = add_x16_x32(s);
                if (fq == 0) Ps[r * 4 + wc] = s; }
        asm volatile("s_waitcnt lgkmcnt(0)" ::: "memory"); __builtin_amdgcn_s_barrier(); asm volatile("" ::: "memory");
        const int colw = wc * 32 + 8 * fq;
#pragma unroll
        for (int ai = 0; ai < 2; ++ai)
#pragma unroll
            for (int m = 0; m < 4; ++m) { const int r = ai * HALF + wr * 64 + m * 16 + fr; const f32x4 q = *(const PG8_LAS f32x4*)(Ps + r * 4);
                const float inv = __builtin_amdgcn_rcpf((q[0] + q[1]) + (q[2] + q[3]));
#pragma unroll
                for (int bj = 0; bj < 2; ++bj) { const f32x4 v0 = acc[ai][bj][m][0] * inv, v1 = acc[ai][bj][m][1] * inv;
                    u32x4 w; w.x = cvt_pk_bf16(v0[0], v0[1]); w.y = cvt_pk_bf16(v0[2], v0[3]); w.z = cvt_pk_bf16(v1[0], v1[1]); w.w = cvt_pk_bf16(v1[2], v1[3]);
                    *(u32x4*)(P + (size_t)r * 256 + bj * HALF + colw) = w; } }
    }
};

template <class Epi, class Sched, bool ALIGN_EPI>
__device__ __forceinline__ void gemm_phase(PG8_LAS unsigned char* lds, const Gemm g, const Sched& S, const Epi& E, int tid) {
    asm volatile("" : "+v"(tid));
    const int wid = __builtin_amdgcn_readfirstlane(tid >> 6), lane = tid & 63, wr = wid >> 2, wc = wid & 3, fr = lane & 15, fq = lane >> 4;
    const int nt = g.K / BK;
    unsigned voffA[2], voffB[2];
#pragma unroll
    for (int i = 0; i < 2; ++i) { int R, C; stage_rc(tid * 16 + i * 8192, R, C); const int Rb = Epi::PERM ? ((R & ~31) + perm32(R & 31)) : R;
        voffA[i] = (unsigned)(R * g.lda + C) * 2u; voffB[i] = (unsigned)(Rb * g.ldb + C) * 2u; }
    const size_t kstep = (size_t)(BK * 2);
    const size_t hstepA = (size_t)HALF * g.lda * 2, hstepB = (size_t)HALF * g.ldb * 2;
    const unsigned ldsw = (unsigned)wid * 1024u;
    const int aoff = lds_byte(wr * 64 + fr, fq * 8), boff = lds_byte(wc * 32 + fr, fq * 8);
#define PG8_SA(b, h) (((b) * 2 + (h)) * HTB)
#define PG8_SB(b, h) ((4 + (b) * 2 + (h)) * HTB)
#define PG8_STAGE(bufoff, gbase, voff) do { _Pragma("unroll") for (int _i = 0; _i < 2; ++_i) \
        __builtin_amdgcn_global_load_lds((const unsigned*)((const char*)(gbase) + (voff)[_i]), (PG8_LAS unsigned*)(lds + (bufoff) + ldsw + _i * 8192), 16, 0, 0); } while (0)
#define PG8_LDA(dst, b, h) do { _Pragma("unroll") for (int m = 0; m < 4; ++m) _Pragma("unroll") for (int k = 0; k < 2; ++k) dst[m][k] = *(const PG8_LAS bf16x8*)(lds + PG8_SA(b, h) + aoff + m * 2048 + k * 1024); } while (0)
#define PG8_LDB(dst, b, h) do { _Pragma("unroll") for (int n = 0; n < 2; ++n) _Pragma("unroll") for (int k = 0; k < 2; ++k) dst[n][k] = *(const PG8_LAS bf16x8*)(lds + PG8_SB(b, h) + boff + n * 2048 + k * 1024); } while (0)
#define PG8_MMA(ai, bj, At, Bt) do { __builtin_amdgcn_s_setprio(1); _Pragma("unroll") for (int m = 0; m < 4; ++m) _Pragma("unroll") for (int n = 0; n < 2; ++n) _Pragma("unroll") for (int k = 0; k < 2; ++k) \
        acc[ai][bj][m][n] = __builtin_amdgcn_mfma_f32_16x16x32_bf16(Bt[n][k], At[m][k], acc[ai][bj][m][n], 0, 0, 0); __builtin_amdgcn_s_setprio(0); } while (0)
#define PG8_WAIT_V(n) asm volatile("s_waitcnt vmcnt(" #n ")" ::: "memory")
#define PG8_WAIT_L(n) asm volatile("s_waitcnt lgkmcnt(" #n ")" ::: "memory")
#define PG8_BAR __builtin_amdgcn_s_barrier()
#define PG8_SCHED __builtin_amdgcn_sched_barrier(0)
    Unit cur, nxt; int ui = 0;
    if (!S.next(0, cur)) return;
    f32x4 acc[2][2][4][2];
#pragma unroll
    for (int a = 0; a < 2; ++a)
#pragma unroll
        for (int b = 0; b < 2; ++b)
#pragma unroll
            for (int m = 0; m < 4; ++m)
#pragma unroll
                for (int n = 0; n < 2; ++n) acc[a][b][m][n] = (f32x4){0.f, 0.f, 0.f, 0.f};
    bf16x8 At[4][2], B0[2][2], B1[2][2];
    const char* cA = S.aptr(cur); const char* cB = S.bptr(cur);
    PG8_STAGE(PG8_SB(0, 0), cB, voffB); PG8_STAGE(PG8_SB(0, 1), cB + hstepB, voffB); PG8_STAGE(PG8_SA(0, 0), cA, voffA); PG8_STAGE(PG8_SA(0, 1), cA + hstepA, voffA);
    if (wr == 1) PG8_BAR;
    PG8_WAIT_V(2); PG8_BAR;
    PG8_STAGE(PG8_SB(1, 0), cB + kstep, voffB); PG8_STAGE(PG8_SA(1, 0), cA + kstep, voffA); PG8_STAGE(PG8_SB(1, 1), cB + hstepB + kstep, voffB);
    PG8_WAIT_V(6); PG8_BAR;
    for (;;) {
        const bool has_next = S.next(ui + 1, nxt);
        const char* nA = has_next ? S.aptr(nxt) : cA; const char* nB = has_next ? S.bptr(nxt) : cB;
        for (int t = 0; t < nt; t += 2) {
            const bool last = (t == nt - 2);
            const char* a1 = cA + (size_t)(t + 1) * kstep;
            const char* a2 = last ? nA : cA + (size_t)(t + 2) * kstep; const char* b2 = last ? nB : cB + (size_t)(t + 2) * kstep;
            const char* a3 = a2 + kstep; const char* b3 = b2 + kstep;
            PG8_LDB(B0, 0, 0); PG8_LDB(B1, 0, 1); PG8_SCHED; PG8_LDA(At, 0, 0); PG8_STAGE(PG8_SA(1, 1), a1 + hstepA, voffA);
            PG8_WAIT_V(8); PG8_WAIT_L(0); PG8_BAR; PG8_MMA(0, 0, At, B0); PG8_MMA(0, 1, At, B1); PG8_BAR; PG8_SCHED;
            PG8_LDA(At, 0, 1); PG8_STAGE(PG8_SB(0, 0), b2, voffB); PG8_STAGE(PG8_SB(0, 1), b2 + hstepB, voffB); PG8_STAGE(PG8_SA(0, 0), a2, voffA);
            PG8_WAIT_V(8); PG8_WAIT_L(0); PG8_BAR; PG8_MMA(1, 0, At, B0); PG8_MMA(1, 1, At, B1); PG8_BAR; PG8_SCHED;
            PG8_LDB(B0, 1, 0); PG8_LDB(B1, 1, 1); PG8_SCHED; PG8_LDA(At, 1, 0); PG8_STAGE(PG8_SA(0, 1), a2 + hstepA, voffA);
            PG8_WAIT_V(8); PG8_WAIT_L(0); PG8_BAR; PG8_MMA(0, 0, At, B0); PG8_MMA(0, 1, At, B1); PG8_BAR; PG8_SCHED;
            PG8_LDA(At, 1, 1); PG8_STAGE(PG8_SB(1, 0), b3, voffB); PG8_STAGE(PG8_SB(1, 1), b3 + hstepB, voffB); PG8_STAGE(PG8_SA(1, 0), a3, voffA);
            PG8_WAIT_V(8); PG8_WAIT_L(0); PG8_BAR; PG8_MMA(1, 0, At, B0); PG8_MMA(1, 1, At, B1); PG8_BAR; PG8_SCHED;
        }
        if constexpr (ALIGN_EPI) { if (wr == 0) PG8_BAR; }
        if constexpr (!Epi::AFTER_DRAIN) { E(acc, cur, wr, wc, fr, fq); }
        if (!has_next) break;
#pragma unroll
        for (int a = 0; a < 2; ++a)
#pragma unroll
            for (int b = 0; b < 2; ++b)
#pragma unroll
                for (int m = 0; m < 4; ++m)
#pragma unroll
                    for (int n = 0; n < 2; ++n) acc[a][b][m][n] = (f32x4){0.f, 0.f, 0.f, 0.f};
        cur = nxt; cA = nA; cB = nB; ++ui;
        if constexpr (ALIGN_EPI) { if (wr == 1) PG8_BAR; }
    }
    PG8_WAIT_V(0);
    if constexpr (!ALIGN_EPI) { if (wr == 0) PG8_BAR; }
    PG8_BAR;
    if constexpr (Epi::AFTER_DRAIN) { E.fused(acc, cur, wr, wc, fr, fq, lds, wid, lane); }
#undef PG8_SA
#undef PG8_SB
#undef PG8_STAGE
#undef PG8_LDA
#undef PG8_LDB
#undef PG8_MMA
#undef PG8_WAIT_V
#undef PG8_WAIT_L
#undef PG8_BAR
#undef PG8_SCHED
}
}

constexpr int NWAVES = 8, NTHREADS = 512;
constexpr size_t MiB = 1u << 20;
constexpr size_t WS_CTL = 0, CTL_ZERO_BYTES = 64 * 1024;
constexpr size_t WS_WPOOL = 1 * MiB;
constexpr size_t WS_WQ = 2 * MiB;
constexpr size_t WS_WO = 6 * MiB;
constexpr size_t WS_WKV = 10 * MiB;
constexpr size_t WS_WUP = 18 * MiB;
constexpr size_t WS_WDN = 34 * MiB;
constexpr size_t WS_WIN = 50 * MiB;
constexpr size_t WS_WOUT = 56 * MiB;
constexpr size_t WS_MN = 58 * MiB;
constexpr size_t WS_KB = 66 * MiB;
constexpr size_t WS_VT = 74 * MiB;
constexpr size_t WS_SSQ = 82 * MiB;
constexpr size_t WS_SMALL = 84 * MiB;
constexpr size_t WS_X = 96 * MiB;
constexpr size_t WS_XG = 160 * MiB;
constexpr size_t WS_P0 = 192 * MiB;
constexpr size_t WS_O = 224 * MiB;
constexpr size_t WS_CH = 256 * MiB;
constexpr size_t WS_PS = 288 * MiB;
constexpr size_t WS_H = 320 * MiB;
constexpr size_t WS_END = 448 * MiB;
constexpr size_t SS_X = WS_SMALL;
constexpr size_t SS_XG = SS_X + 512 * 1024;
constexpr size_t SS_SSQ = SS_XG + 256 * 1024;
constexpr size_t SS_P0 = SS_SSQ + 32 * 1024;
constexpr size_t SS_O = SS_P0 + 256 * 1024;
constexpr size_t SS_CH = SS_O + 256 * 1024;
constexpr size_t SS_H = SS_CH + 512 * 1024;
static_assert(SS_H + 1024 * 1024 <= WS_X, "sample buffers");
constexpr int CW_BAR = 4096;

constexpr int RING_OFF = 0, RING_BYTES = 131072;
constexpr int LDSCTL_OFF = RING_BYTES, MISC_OFF = LDSCTL_OFF + 320;
constexpr int LDS_BYTES = 147456;

#define GAS __attribute__((address_space(1)))
#define LAS __attribute__((address_space(3)))
typedef unsigned short bf16;
typedef unsigned v4u __attribute__((ext_vector_type(4)));
typedef unsigned v2u __attribute__((ext_vector_type(2)));
typedef float f32x4 __attribute__((ext_vector_type(4)));
typedef short bf16x8 __attribute__((ext_vector_type(8)));
#define LDS_WAIT() asm volatile("s_waitcnt lgkmcnt(0)" ::: "memory")
#define VM_WAIT() asm volatile("s_waitcnt vmcnt(0)" ::: "memory")
__device__ __forceinline__ unsigned f2bf(float f) { unsigned u = __builtin_bit_cast(unsigned, f); return (u + 0x7fffu + ((u >> 16) & 1u)) >> 16; }
__device__ __forceinline__ unsigned pk2(float lo, float hi) { return f2bf(lo) | (f2bf(hi) << 16); }
__device__ __forceinline__ float bf2f(unsigned short h) { return __builtin_bit_cast(float, (unsigned)h << 16); }
__device__ __forceinline__ float bflo(unsigned w) { return __builtin_bit_cast(float, w << 16); }
__device__ __forceinline__ float bfhi(unsigned w) { return __builtin_bit_cast(float, w & 0xffff0000u); }

#define XB_TMO      128
#define XB_XCNT(j)  (256  + 64 * (j))
#define XB_XSUB(j)  (1280 + 64 * (j))
#define XB_XGEN(j)  (2304 + 64 * (j))
#define XB_TOP      3328
#define XB_TOPGEN   3392
#define XCD_BAR_WORDS 3456
#define XB_SPIN_CAP (1u << 18)
__device__ __forceinline__ unsigned xb_ld(unsigned* p)              { return __hip_atomic_load(p, __ATOMIC_RELAXED, __HIP_MEMORY_SCOPE_AGENT); }
__device__ __forceinline__ unsigned xb_add(unsigned* p, unsigned v) { return __hip_atomic_fetch_add(p, v, __ATOMIC_RELAXED, __HIP_MEMORY_SCOPE_AGENT); }
__device__ __forceinline__ unsigned xb_xcc_id() { return (unsigned)__builtin_amdgcn_s_getreg((3 << 11) | 20) & 0xFu; }
#define XB_SPIN(cond, bar) do { unsigned _sp = 0; while (cond) { __builtin_amdgcn_s_sleep(1); \
    if ((++_sp & 255u) == 0u) { if (xb_ld(&(bar)[XB_TMO])) break; if (_sp > XB_SPIN_CAP) { atomicAdd(&(bar)[XB_TMO], 1u); break; } } } } while (0)
struct XcdBarrier { unsigned* bar; unsigned x; volatile LAS unsigned* st; };
__device__ __forceinline__ XcdBarrier xcd_barrier_post(unsigned* bar, volatile LAS unsigned* st) {
    XcdBarrier b; b.bar = bar; b.x = xb_xcc_id(); b.st = st;
    if (threadIdx.x == 0) (void)xb_add(&bar[XB_XCNT(b.x)], 1u);
    return b;
}
__device__ __forceinline__ void xcd_barrier_complete(unsigned* bar, unsigned x, unsigned& nloc, unsigned& nx) {
    const unsigned G = gridDim.x * gridDim.y * gridDim.z;
    unsigned sum, cnt, mine, sp = 0u;
    for (;;) {
        sum = 0u; cnt = 0u; mine = 0u;
#pragma unroll
        for (unsigned j = 0; j < 16; ++j) { const unsigned c = xb_ld(&bar[XB_XCNT(j)]); sum += c; cnt += (c > 0u) ? 1u : 0u; mine = (j == x) ? c : mine; }
        if (sum == G) break;
        __builtin_amdgcn_s_sleep(1);
        if ((++sp & 255u) == 0u) { if (xb_ld(&bar[XB_TMO])) break; if (sp > XB_SPIN_CAP) { atomicAdd(&bar[XB_TMO], 1u); break; } }
    }
    nloc = mine > 0u ? mine : 1u; nx = cnt > 0u ? cnt : 1u;
}
__device__ __forceinline__ void xcd_barrier(const XcdBarrier& b, const int tid) {
    asm volatile("s_waitcnt vmcnt(0)" ::: "memory");
    __syncthreads();
    if (tid == 0) {
        unsigned* bar = b.bar; asm volatile("" : "+s"(bar));
        __builtin_amdgcn_s_waitcnt(0);
        unsigned nloc = b.st[0], nx = b.st[1];
        if (nloc == 0u) { xcd_barrier_complete(bar, b.x, nloc, nx); b.st[0] = nloc; b.st[1] = nx; }
        const unsigned old = xb_add(&bar[XB_XSUB(b.x)], 1u);
        const unsigned gen = old / nloc;
        if (old + 1u == (gen + 1u) * nloc) {
            __builtin_amdgcn_fence(__ATOMIC_RELEASE, "agent");
            asm volatile("s_waitcnt vmcnt(0)" ::: "memory");
            const unsigned og = xb_add(&bar[XB_TOP], 1u);
            const unsigned tg = og / nx;
            if (og + 1u == (tg + 1u) * nx) xb_add(&bar[XB_TOPGEN], 1u);
            else XB_SPIN(xb_ld(&bar[XB_TOPGEN]) == tg, bar);
            __builtin_amdgcn_fence(__ATOMIC_ACQUIRE, "agent");
            xb_add(&bar[XB_XGEN(b.x)], 1u);
            asm volatile("s_waitcnt vmcnt(0)" ::: "memory");
        } else {
            XB_SPIN(xb_ld(&bar[XB_XGEN(b.x)]) == gen, bar);
            __builtin_amdgcn_fence(__ATOMIC_ACQUIRE, "agent");
            asm volatile("s_waitcnt vmcnt(0)" ::: "memory");
        }
    }
    __syncthreads();
}

__device__ __forceinline__ int opq_v(int x) { asm volatile("" : "+v"(x)); return x; }
__device__ __forceinline__ int lane_id_opaque() { int l; asm volatile("v_mbcnt_lo_u32_b32 %0, -1, 0\n\tv_mbcnt_hi_u32_b32 %0, -1, %0" : "=v"(l)); return l; }
struct Args { const float* in[22]; float* out; unsigned char* ws; int ph_lo, ph_hi; };


__device__ __forceinline__ void p0_transpose_item(const float* W, int K, int N, bf16* WT, int k0, int n0, int drow0, LAS float* scr, int lane) {
#pragma unroll 8
    for (int i = 0; i < 32; ++i) { const int kk = 2 * i + (lane >> 5); scr[kk * 33 + (lane & 31)] = W[(size_t)(k0 + kk) * N + n0 + (lane & 31)]; }
    LDS_WAIT(); asm volatile("" ::: "memory");
    const int c = lane & 7;
#pragma unroll
    for (int j = 0; j < 4; ++j) { const int n = (lane >> 3) + 8 * j; const LAS float* s = scr + (8 * c) * 33 + n;
        v4u o; o.x = pk2(s[0 * 33], s[1 * 33]); o.y = pk2(s[2 * 33], s[3 * 33]); o.z = pk2(s[4 * 33], s[5 * 33]); o.w = pk2(s[6 * 33], s[7 * 33]);
        *(GAS v4u*)(WT + (size_t)(drow0 + n) * K + k0 + 8 * c) = o; }
    LDS_WAIT(); asm volatile("" ::: "memory");
}
__device__ __forceinline__ int win_dest_row(int n) {
    if (n < 1024) return n;
    if (n < 2048) { const int ch = n - 1024; return 1024 + (ch >> 7) * 256 + (ch & 127); }
    const int ch = n - 2048; return 1024 + (ch >> 7) * 256 + 128 + (ch & 127);
}

template <int W>
__device__ __forceinline__ void pool_wave(const float* xb  , const LAS float* rs, f32x4 g4, int tA, bf16* pout  , float* poolout  ) {
    f32x4 ring[16]; f32x4 S = {0.f, 0.f, 0.f, 0.f};
#pragma unroll
    for (int i = 16 - W; i < 31; ++i) {
        const int t = tA - 15 + i;
        f32x4 u = {0.f, 0.f, 0.f, 0.f};
        if (t >= 0) { const f32x4 xv = *(const f32x4*)(xb + (size_t)t * D); u = xv * rs[i] * g4; }
        S += u; if (i - W >= 16 - W) S -= ring[(i - W) & 15];
        ring[i & 15] = u;
        if (i >= 15) {
            const int cnt = (t + 1 < W) ? (t + 1) : W; const float ic = 1.0f / (float)cnt;
            const f32x4 p = S * ic - u; v2u o; o.x = pk2(p[0], p[1]); o.y = pk2(p[2], p[3]);
            *(v2u*)(pout + (size_t)t * D) = o;
            if (t >= SEQ - 15) *(f32x4*)(poolout + (size_t)(t - (SEQ - 15)) * D) = u;
        }
    }
}

template <int RT, int CT, class F>
__device__ __forceinline__ void sgemm2(const bf16* A, int lda, int row0, const bf16* Bt, int ldb, const int (&brow)[CT], int K, LAS unsigned char* red, int wave, int lane, const F& f) {
    const int fr = lane & 15, fq = lane >> 4, kw = K >> 3;
    const bf16* ap = A + (size_t)(row0 + fr) * lda + wave * kw + fq * 8;
    const bf16* bp[CT];
#pragma unroll
    for (int ct = 0; ct < CT; ++ct) bp[ct] = Bt + (size_t)(brow[ct] + fr) * ldb + wave * kw + fq * 8;
    f32x4 acc[RT][CT];
#pragma unroll
    for (int rt = 0; rt < RT; ++rt)
#pragma unroll
        for (int ct = 0; ct < CT; ++ct) acc[rt][ct] = (f32x4){0.f, 0.f, 0.f, 0.f};
#pragma unroll 4
    for (int k0 = 0; k0 < kw; k0 += 32) {
        bf16x8 a[RT], b[CT];
#pragma unroll
        for (int rt = 0; rt < RT; ++rt) a[rt] = *(const bf16x8*)(ap + (size_t)rt * 16 * lda + k0);
#pragma unroll
        for (int ct = 0; ct < CT; ++ct) b[ct] = *(const bf16x8*)(bp[ct] + k0);
#pragma unroll
        for (int rt = 0; rt < RT; ++rt)
#pragma unroll
            for (int ct = 0; ct < CT; ++ct) acc[rt][ct] = __builtin_amdgcn_mfma_f32_16x16x32_bf16(b[ct], a[rt], acc[rt][ct], 0, 0, 0);
    }
#pragma unroll
    for (int rt = 0; rt < RT; ++rt)
#pragma unroll
        for (int ct = 0; ct < CT; ++ct) *(LAS f32x4*)(red + ((((wave * RT + rt) * CT + ct) * 64 + lane) << 4)) = acc[rt][ct];
    LDS_WAIT(); __syncthreads();
    if (wave < RT) {
        f32x4 sacc[CT];
#pragma unroll
        for (int ct = 0; ct < CT; ++ct) { f32x4 t = {0.f, 0.f, 0.f, 0.f};
#pragma unroll
            for (int w = 0; w < 8; ++w) t += *(const LAS f32x4*)(red + ((((w * RT + wave) * CT + ct) * 64 + lane) << 4));
            sacc[ct] = t; }
        f(sacc, row0 + 16 * wave + fr, fq);
    }
    __syncthreads();
}
__device__ __forceinline__ float srstd(const float* ssq, int row, int fq) {
    const f32x4* sp = (const f32x4*)(ssq + row * 64 + fq * 16); const f32x4 s = (sp[0] + sp[1]) + (sp[2] + sp[3]); float t = (s[0] + s[1]) + (s[2] + s[3]);
    t = add_x16_x32(t);
    return __builtin_amdgcn_rsqf(t * (1.0f / D) + EPS);
}
__device__ __forceinline__ void s_res_unit(const bf16* A, int lda, const bf16* Bt, int ldb, int K, int u, const float* base, float* xs, bf16* xg, float* ssq, const float* gnext, const float* cscale, LAS unsigned char* red, int wave, int lane) {
    const int ctile = u >> 2; const int brow[1] = {16 * ctile};
    sgemm2<2, 1>(A, lda, 32 * (u & 3), Bt, ldb, brow, K, red, wave, lane, [&](f32x4 (&a)[1], int row, int fq) {
        const int c0 = 16 * ctile + 4 * fq; const size_t off = (size_t)row * D + c0;
        f32x4 cs = {1.f, 1.f, 1.f, 1.f}; if (cscale) cs = *(const f32x4*)(cscale + c0);
        const f32x4 v = *(const f32x4*)(base + off) + a[0] * cs;
        *(f32x4*)(xs + off) = v;
        float ss = (v[0] * v[0] + v[1] * v[1]) + (v[2] * v[2] + v[3] * v[3]);
        ss = add_x16_x32(ss);
        if (fq == 0) ssq[row * 64 + ctile] = ss;
        const f32x4 w = v * *(const f32x4*)(gnext + c0);
        v2u p; p.x = pk2(w[0], w[1]); p.y = pk2(w[2], w[3]); *(v2u*)(xg + off) = p; });
}
__device__ __forceinline__ f32x4 relu2(f32x4 v) {
#pragma unroll
    for (int j = 0; j < 4; ++j) { const float a = fmaxf(v[j], 0.f); v[j] = a * a; }
    return v;
}

constexpr int NPHASES = 16;
__global__ void __launch_bounds__(NTHREADS, 2) mk_fwd(Args args) {
    extern __shared__ __attribute__((aligned(16))) unsigned char lds[];
    LAS unsigned char* L = (LAS unsigned char*)lds;
    volatile LAS unsigned* MISC = (volatile LAS unsigned*)(L + MISC_OFF);
    const int wave0 = __builtin_amdgcn_readfirstlane((int)threadIdx.x >> 6);
    const int G = gridDim.x; const int bx = blockIdx.x; const int vcu = (G % 8 == 0) ? (bx % 8) * (G / 8) + bx / 8 : bx;
    for (int u = threadIdx.x; u < (LDS_BYTES - LDSCTL_OFF) / 4; u += NTHREADS) ((LAS unsigned*)(L + LDSCTL_OFF))[u] = 0u;
    __syncthreads();
#if MK_PER_PHASE
    XcdBarrier bar; bar.bar = nullptr; bar.x = 0; bar.st = nullptr;
#define GRID_BAR() do { } while (0)
#else
    XcdBarrier bar = xcd_barrier_post((unsigned*)(args.ws + WS_CTL) + CW_BAR, MISC + 8);
#define GRID_BAR() xcd_barrier(bar, wave0 * 64 + lane_id_opaque())
#endif
    const int lo = args.ph_lo, hi = args.ph_hi;
#define IN(k) (ph == (k))
#define SEAM(k) do { } while (0)
    const int NGW = G * NWAVES;
#define RELANE const int tid = wave0 * 64 + lane_id_opaque(), lane = tid & 63; (void)tid; (void)lane;
#define KA_PTR(T, off) (*(T const __attribute__((address_space(4)))*)(ka + (off)))
#define PH_BEGIN const int tid = wave0 * 64 + lane_id_opaque(), lane = tid & 63, wave = wave0, gw = vcu * NWAVES + wave; (void)lane; (void)gw; \
    const __attribute__((address_space(4))) char* ka = (const __attribute__((address_space(4))) char*)__builtin_amdgcn_kernarg_segment_ptr(); asm volatile("" : "+s"(ka)); \
    unsigned char* const ws = KA_PTR(unsigned char*, 184); float* const out = KA_PTR(float*, 176); (void)ws; (void)out; \
    const float* const x_prompt = KA_PTR(const float*, 0); const float* const x_sample = KA_PTR(const float*, 8); const float* const state_pool = KA_PTR(const float*, 16); const float* const state_conv = KA_PTR(const float*, 24); \
    const float* const cache_k = KA_PTR(const float*, 32); const float* const cache_v = KA_PTR(const float*, 40); const float* const mem_prompt = KA_PTR(const float*, 48); \
    const float* const g_mix = KA_PTR(const float*, 56); const float* const g_attn = KA_PTR(const float*, 64); const float* const g_mem = KA_PTR(const float*, 72); const float* const g_ffn = KA_PTR(const float*, 80); const float* const g_final = KA_PTR(const float*, 88); \
    const float* const w_pool = KA_PTR(const float*, 96); const float* const pool_scale = KA_PTR(const float*, 104); const float* const w_conv_in = KA_PTR(const float*, 112); const float* const w_conv = KA_PTR(const float*, 120); const float* const w_conv_out = KA_PTR(const float*, 128); \
    const float* const w_q = KA_PTR(const float*, 136); const float* const w_kv = KA_PTR(const float*, 144); const float* const w_o = KA_PTR(const float*, 152); const float* const w_up = KA_PTR(const float*, 160); const float* const w_down = KA_PTR(const float*, 168); \
    (void)x_prompt; (void)x_sample; (void)state_pool; (void)state_conv; (void)cache_k; (void)cache_v; (void)mem_prompt; (void)g_mix; (void)g_attn; (void)g_mem; (void)g_ffn; (void)g_final; (void)w_pool; (void)pool_scale; (void)w_conv_in; (void)w_conv; (void)w_conv_out; (void)w_q; (void)w_kv; (void)w_o; (void)w_up; (void)w_down; \
    bf16* const WPOOL = (bf16*)(ws + WS_WPOOL); bf16* const WQ = (bf16*)(ws + WS_WQ); bf16* const WO = (bf16*)(ws + WS_WO); bf16* const WKV = (bf16*)(ws + WS_WKV); \
    bf16* const WUP = (bf16*)(ws + WS_WUP); bf16* const WDN = (bf16*)(ws + WS_WDN); bf16* const WIN = (bf16*)(ws + WS_WIN); bf16* const WOUT = (bf16*)(ws + WS_WOUT); \
    bf16* const MN = (bf16*)(ws + WS_MN); bf16* const KB = (bf16*)(ws + WS_KB); bf16* const VT = (bf16*)(ws + WS_VT); float* const SSQ = (float*)(ws + WS_SSQ); \
    float* const X = (float*)(ws + WS_X); bf16* const XG = (bf16*)(ws + WS_XG); bf16* const P0 = (bf16*)(ws + WS_P0); bf16* const OB = (bf16*)(ws + WS_O); bf16* const CH = (bf16*)(ws + WS_CH); \
    bf16* const PS = (bf16*)(ws + WS_PS); bf16* const HB = (bf16*)(ws + WS_H); \
    float* const XS = (float*)(ws + SS_X); bf16* const XGS = (bf16*)(ws + SS_XG); float* const SSQS = (float*)(ws + SS_SSQ); bf16* const P0S = (bf16*)(ws + SS_P0); bf16* const OS = (bf16*)(ws + SS_O); \
    float* const CHS = (float*)(ws + SS_CH); bf16* const HS = (bf16*)(ws + SS_H); \
    (void)WPOOL; (void)WQ; (void)WO; (void)WKV; (void)WUP; (void)WDN; (void)WIN; (void)WOUT; (void)MN; (void)KB; (void)VT; (void)SSQ; (void)X; (void)XG; (void)P0; (void)OB; (void)CH; (void)PS; (void)HB; (void)XS; (void)XGS; (void)SSQS; (void)P0S; (void)OS; (void)CHS; (void)HS;

#pragma unroll 1
    for (int ph = lo; ph < hi; ++ph) {
    if (IN(0)) { PH_BEGIN
        LAS float* scr = (LAS float*)(L + RING_OFF + wave * 16384);
        {
            constexpr int I_POOL = 4 * 4 * 8, I_Q = 16 * 32, I_KV = 16 * 64, I_UP = 16 * 128, I_DN = 64 * 32, I_IN = 16 * 96;
            constexpr int NITEMS = I_POOL + 2 * (I_Q + I_KV + I_Q + I_UP + I_DN) + I_IN + I_Q;
            for (int it = gw; it < NITEMS; it += NGW) {
                int r = it;
                if (r < I_POOL) { const int g = r >> 5, rr = r & 31, kb = rr >> 3, nb = rr & 7; p0_transpose_item(w_pool + g * 65536, 256, 256, WPOOL + g * 65536, 64 * kb, 32 * nb, 32 * nb, scr, lane); continue; } r -= I_POOL;
                bool done = false;
#pragma unroll 1
                for (int l = 0; l < 2 && !done; ++l) {
                    if (r < I_Q) { const int kb = r >> 5, nb = r & 31; p0_transpose_item(w_q + (size_t)l * D * D, D, D, WQ + (size_t)l * D * D, 64 * kb, 32 * nb, 32 * nb, scr, lane); done = true; break; } r -= I_Q;
                    if (r < I_KV) { const int kb = r >> 6, nb = r & 63; p0_transpose_item(w_kv + (size_t)l * D * 2048, D, 2048, WKV + (size_t)l * 2048 * D, 64 * kb, 32 * nb, 32 * nb, scr, lane); done = true; break; } r -= I_KV;
                    if (r < I_Q) { const int kb = r >> 5, nb = r & 31; p0_transpose_item(w_o + (size_t)l * D * D, D, D, WO + (size_t)l * D * D, 64 * kb, 32 * nb, 32 * nb, scr, lane); done = true; break; } r -= I_Q;
                    if (r < I_UP) { const int kb = r >> 7, nb = r & 127; p0_transpose_item(w_up + (size_t)l * D * FF, D, FF, WUP + (size_t)l * FF * D, 64 * kb, 32 * nb, 32 * nb, scr, lane); done = true; break; } r -= I_UP;
                    if (r < I_DN) { const int kb = r >> 5, nb = r & 31; p0_transpose_item(w_down + (size_t)l * FF * D, FF, D, WDN + (size_t)l * D * FF, 64 * kb, 32 * nb, 32 * nb, scr, lane); done = true; break; } r -= I_DN;
                }
                if (done) continue;
                if (r < I_IN) { const int kb = r / 96, nb = r % 96; p0_transpose_item(w_conv_in, D, 3072, WIN, 64 * kb, 32 * nb, win_dest_row(32 * nb), scr, lane); continue; } r -= I_IN;
                { const int kb = r >> 5, nb = r & 31; p0_transpose_item(w_conv_out, D, D, WOUT, 64 * kb, 32 * nb, 32 * nb, scr, lane); }
            }
        }
        for (int m = gw; m < MEMROWS; m += NGW) {
            const f32x4* xr = (const f32x4*)(mem_prompt + (size_t)m * D) + lane; f32x4 v[4]; float s = 0.f;
#pragma unroll
            for (int j = 0; j < 4; ++j) { v[j] = xr[64 * j]; s += (v[j][0] * v[j][0] + v[j][1] * v[j][1]) + (v[j][2] * v[j][2] + v[j][3] * v[j][3]); }
            const float rstd = __builtin_amdgcn_rsqf(wave_sum(s) * (1.f / D) + EPS);
#pragma unroll
            for (int l = 0; l < 2; ++l) { v2u* o8 = (v2u*)(MN + ((size_t)l * MEMROWS + m) * D) + lane;
#pragma unroll
                for (int j = 0; j < 4; ++j) { const f32x4 gg = *((const f32x4*)(g_mem + l * D) + lane + 64 * j); const f32x4 w = v[j] * rstd * gg; v2u o; o.x = pk2(w[0], w[1]); o.y = pk2(w[2], w[3]); o8[64 * j] = o; } }
        }
        for (int it = gw; it < MS * 4; it += NGW) {
            const int b = it >> 2, g = it & 3, c4 = g * 256 + lane * 4;
            const f32x4* xr = (const f32x4*)(x_sample + (size_t)b * D) + lane; float s = 0.f;
#pragma unroll
            for (int j = 0; j < 4; ++j) { const f32x4 v = xr[64 * j]; s += (v[0] * v[0] + v[1] * v[1]) + (v[2] * v[2] + v[3] * v[3]); }
            const float rstd = __builtin_amdgcn_rsqf(wave_sum(s) * (1.f / D) + EPS);
            const f32x4 u = *(const f32x4*)(x_sample + (size_t)b * D + c4) * rstd * *(const f32x4*)(g_mix + c4);
            const int W = 2 << g; f32x4 S = u;
            const float* sp = state_pool + (size_t)b * 15 * D + c4;
            float* po = out + OPS + (size_t)b * 15 * D + c4;
            for (int r = 0; r < 15; ++r) { const f32x4 sv = *(const f32x4*)(sp + (size_t)r * D); if (r >= 16 - W) S += sv; if (r >= 1) *(f32x4*)(po + (size_t)(r - 1) * D) = sv; }
            *(f32x4*)(po + (size_t)14 * D) = u;
            const f32x4 p = S * (1.0f / (float)W) - u; v2u o; o.x = pk2(p[0], p[1]); o.y = pk2(p[2], p[3]); *(v2u*)(P0S + (size_t)b * D + c4) = o;
        }
        __syncthreads();
        {
            LAS float* rs = (LAS float*)(L + RING_OFF);
            for (int it = vcu; it < BATCH * (SEQ / 32); it += G) {
                const int b = it >> 6, t0 = (it & 63) * 32;
                for (int r = wave; r < 47; r += NWAVES) { const int t = t0 - 15 + r; float rv = 0.f;
                    if (t >= 0) { const f32x4* xr = (const f32x4*)(x_prompt + ((size_t)b * SEQ + t) * D) + lane; float s = 0.f;
#pragma unroll
                        for (int j = 0; j < 4; ++j) { const f32x4 v = xr[64 * j]; s += (v[0] * v[0] + v[1] * v[1]) + (v[2] * v[2] + v[3] * v[3]); }
                        rv = __builtin_amdgcn_rsqf(wave_sum(s) * (1.f / D) + EPS); }
                    if (lane == 0) rs[r] = rv; }
                LDS_WAIT(); __syncthreads();
                const int g = wave & 3, tA = t0 + (wave >> 2) * 16, c4 = g * 256 + lane * 4;
                const float* xb = x_prompt + (size_t)b * SEQ * D + c4; const f32x4 g4 = *(const f32x4*)(g_mix + c4);
                bf16* pout = P0 + (size_t)b * SEQ * D + c4; float* poolout = out + OPP + (size_t)b * 15 * D + c4;
                const LAS float* rsw = rs + (wave >> 2) * 16;
                if (g == 0) pool_wave<2>(xb, rsw, g4, tA, pout, poolout); else if (g == 1) pool_wave<4>(xb, rsw, g4, tA, pout, poolout);
                else if (g == 2) pool_wave<8>(xb, rsw, g4, tA, pout, poolout); else pool_wave<16>(xb, rsw, g4, tA, pout, poolout);
                __syncthreads();
            }
        }
    }
    SEAM(0);

    if (IN(1)) { PH_BEGIN
        { pg8::Gemm g{D, D, D}; pg8::KvOrder S{G, bx, (const char*)MN, (const char*)WKV};
          pg8::EpiKV E{out + OMK, out + OMV, KB, VT};
          pg8::gemm_phase<pg8::EpiKV, pg8::KvOrder, true>(L + RING_OFF, g, S, E, tid); }
        { pg8::Gemm g{D, 256, 256}; pg8::StaticOrder S; S.init(MP / 256, 4, G, bx, P0, (size_t)256 * D * 2, WPOOL, (size_t)65536 * 2, (size_t)256 * 2);
          pg8::EpiRes E{x_prompt, X, XG, g_attn, SSQ, pool_scale};
          pg8::gemm_phase<pg8::EpiRes, pg8::StaticOrder, true>(L + RING_OFF, g, S, E, tid); }
        { RELANE for (int u = vcu; u < 256; u += G) s_res_unit(P0S + (u >> 6) * 256, D, WPOOL, 256, 256, u, x_sample, XS, XGS, SSQS, g_attn, pool_scale, L + RING_OFF, wave, lane); }
    }
    SEAM(1);

    {
        const int l = (ph >= 7) ? 1 : 0, pb = l ? 10 : 2;
        {
            if (IN(7)) { PH_BEGIN
                { pg8::Gemm g{D, D, D}; pg8::StaticOrder S; S.init(MP / 256, 12, G, bx, XG, (size_t)256 * D * 2, WIN, (size_t)256 * D * 2);
                  pg8::EpiRow<2> E{OB, D, SSQ, 1.f, CH, out + OCP};
                  pg8::gemm_phase<pg8::EpiRow<2>, pg8::StaticOrder, true>(L + RING_OFF, g, S, E, tid); }
                { RELANE
                for (int u = vcu; u < 256; u += G) {
                    if (u < 128) { const int ctile = u >> 1; const int brow[1] = {16 * ctile};
                        sgemm2<4, 1>(XGS, D, 64 * (u & 1), WIN, D, brow, D, L + RING_OFF, wave, lane, [&](f32x4 (&a)[1], int row, int fq) {
                            const float rs = srstd(SSQS, row, fq); const f32x4 v = a[0] * rs; v2u p; p.x = pk2(v[0], v[1]); p.y = pk2(v[2], v[3]);
                            *(v2u*)(OS + (size_t)row * D + 16 * ctile + 4 * fq) = p; }); }
                    else { const int c0 = ((u - 128) >> 1) * 16; const int r0 = 1024 + (c0 >> 7) * 256 + (c0 & 127); const int brow[2] = {r0, r0 + 128};
                        sgemm2<4, 2>(XGS, D, 64 * (u & 1), WIN, D, brow, D, L + RING_OFF, wave, lane, [&](f32x4 (&a)[2], int row, int fq) {
                            const float rs = srstd(SSQS, row, fq); const f32x4 v = a[0] * a[1] * (rs * rs);
                            *(f32x4*)(CHS + (size_t)row * D + c0 + 4 * fq) = v; *(f32x4*)(out + OCS + ((size_t)row * 2 + 1) * D + c0 + 4 * fq) = v; }); }
                }
                }
            }
            SEAM(7);
            if (IN(8)) { PH_BEGIN
                const int gt = vcu * NTHREADS + tid, NT = G * NTHREADS;
                for (int idx = gt; idx < MP * 128; idx += NT) {
                    const int row = idx >> 7, c8 = (idx & 127) * 8, t = row & (SEQ - 1);
                    const v4u gb = *(const v4u*)(OB + (size_t)row * D + c8); const v4u c2 = *(const v4u*)(CH + (size_t)row * D + c8);
                    v4u c1 = {0u, 0u, 0u, 0u}, c0 = {0u, 0u, 0u, 0u};
                    if (t >= 1) c1 = *(const v4u*)(CH + (size_t)(row - 1) * D + c8);
                    if (t >= 2) c0 = *(const v4u*)(CH + (size_t)(row - 2) * D + c8);
                    const f32x4 w0a = *(const f32x4*)(w_conv + c8), w0b = *(const f32x4*)(w_conv + c8 + 4), w1a = *(const f32x4*)(w_conv + D + c8), w1b = *(const f32x4*)(w_conv + D + c8 + 4),
                                w2a = *(const f32x4*)(w_conv + 2 * D + c8), w2b = *(const f32x4*)(w_conv + 2 * D + c8 + 4);
                    v4u o;
#pragma unroll
                    for (int j = 0; j < 4; ++j) { const float wl0 = (j < 2) ? w0a[2 * j] : w0b[2 * j - 4], wh0 = (j < 2) ? w0a[2 * j + 1] : w0b[2 * j - 3];
                        const float wl1 = (j < 2) ? w1a[2 * j] : w1b[2 * j - 4], wh1 = (j < 2) ? w1a[2 * j + 1] : w1b[2 * j - 3];
                        const float wl2 = (j < 2) ? w2a[2 * j] : w2b[2 * j - 4], wh2 = (j < 2) ? w2a[2 * j + 1] : w2b[2 * j - 3];
                        const float lo_ = bflo(gb[j]) * (bflo(c0[j]) * wl0 + bflo(c1[j]) * wl1 + bflo(c2[j]) * wl2);
                        const float hi_ = bfhi(gb[j]) * (bfhi(c0[j]) * wh0 + bfhi(c1[j]) * wh1 + bfhi(c2[j]) * wh2);
                        o[j] = pk2(lo_, hi_); }
                    *(v4u*)(P0 + (size_t)row * D + c8) = o;
                }
                for (int idx = gt; idx < MS * 256; idx += NT) {
                    const int b = idx >> 8, c4 = (idx & 255) * 4;
                    const f32x4 s0 = *(const f32x4*)(state_conv + ((size_t)b * 2 + 0) * D + c4), s1 = *(const f32x4*)(state_conv + ((size_t)b * 2 + 1) * D + c4), chv = *(const f32x4*)(CHS + (size_t)b * D + c4);
                    const f32x4 cv = s0 * *(const f32x4*)(w_conv + c4) + s1 * *(const f32x4*)(w_conv + D + c4) + chv * *(const f32x4*)(w_conv + 2 * D + c4);
                    const v2u gbw = *(const v2u*)(OS + (size_t)b * D + c4);
                    v2u o; o.x = pk2(bflo(gbw.x) * cv[0], bfhi(gbw.x) * cv[1]); o.y = pk2(bflo(gbw.y) * cv[2], bfhi(gbw.y) * cv[3]);
                    *(v2u*)(P0S + (size_t)b * D + c4) = o;
                    *(f32x4*)(out + OCS + ((size_t)b * 2 + 0) * D + c4) = s1;
                }
            }
            SEAM(8);
            if (IN(9)) { PH_BEGIN
                { pg8::Gemm g{D, D, D}; pg8::StaticOrder S; S.init(MP / 256, 4, G, bx, P0, (size_t)256 * D * 2, WOUT, (size_t)256 * D * 2);
                  pg8::EpiRes E{X, X, XG, g_attn + D, SSQ, nullptr};
                  pg8::gemm_phase<pg8::EpiRes, pg8::StaticOrder, true>(L + RING_OFF, g, S, E, tid); }
                { RELANE for (int u = vcu; u < 256; u += G) s_res_unit(P0S, D, WOUT, D, D, u, XS, XS, XGS, SSQS, g_attn + D, nullptr, L + RING_OFF, wave, lane); }
            }
            SEAM(9);
        }
#define LAYER_W const bf16* WQl = WQ + (size_t)l * D * D; const bf16* WOl = WO + (size_t)l * D * D; const bf16* WUPl = WUP + (size_t)l * FF * D; const bf16* WDNl = WDN + (size_t)l * D * FF; (void)WQl; (void)WOl; (void)WUPl; (void)WDNl;
        if (IN(pb)) { PH_BEGIN LAYER_W
            { pg8::Gemm g{D, D, D}; pg8::StaticOrder S; S.init(MP / 256, 4, G, bx, XG, (size_t)256 * D * 2, WQl, (size_t)256 * D * 2);
              pg8::EpiRow<0> E{P0, D, SSQ, QSCALE, nullptr, nullptr};
              pg8::gemm_phase<pg8::EpiRow<0>, pg8::StaticOrder, true>(L + RING_OFF, g, S, E, tid); }
            { RELANE for (int u = vcu; u < 256; u += G) { const int ctile = u >> 2; const int brow[1] = {16 * ctile};
                sgemm2<2, 1>(XGS, D, 32 * (u & 3), WQl, D, brow, D, L + RING_OFF, wave, lane, [&](f32x4 (&a)[1], int row, int fq) {
                    const float rs = srstd(SSQS, row, fq); const f32x4 v = a[0] * (rs * QSCALE); v2u p; p.x = pk2(v[0], v[1]); p.y = pk2(v[2], v[3]);
                    *(v2u*)(P0S + (size_t)row * D + 16 * ctile + 4 * fq) = p; }); } }
        }
        SEAM(pb);
        if (IN(pb + 1)) { PH_BEGIN LAYER_W
            for (int it = bx; it < 256; it += G) {
                const int pm = it >> 2, h = it & 3, b = pm >> 3;
                bf16* Pu = PS + (size_t)it * 65536;
                { pg8::Gemm g{D, D, 256}; pg8::SingleOrder S{{pm, h}, (const char*)(P0 + (size_t)pm * 256 * D + h * 256), (const char*)(KB + ((size_t)l * MEMROWS + b * 256) * D + h * 256)};
                  pg8::EpiSoftmax E{Pu};
                  pg8::gemm_phase<pg8::EpiSoftmax, pg8::SingleOrder, false>(L + RING_OFF, g, S, E, tid); }
                VM_WAIT(); __syncthreads();
                { pg8::Gemm g{256, 256, 256}; pg8::SingleOrder S{{pm, h}, (const char*)Pu, (const char*)(VT + ((size_t)(l * BATCH + b) * D + h * 256) * NMEM)};
                  pg8::EpiBf16 E{OB, D};
                  pg8::gemm_phase<pg8::EpiBf16, pg8::SingleOrder, true>(L + RING_OFF, g, S, E, tid); }
                __syncthreads();
            }
            { RELANE
                LAS float* sc = (LAS float*)(L + RING_OFF);
                LAS float* po = (LAS float*)(L + RING_OFF + 1024);
                for (int it = vcu; it < MS * NH; it += G) {
                    const int b = it >> 2, h = it & 3;
                    const v2u qw = *(const v2u*)(P0S + (size_t)b * D + h * 256 + lane * 4);
                    const f32x4 q4 = {bflo(qw.x), bfhi(qw.x), bflo(qw.y), bfhi(qw.y)};
                    const float* kp = cache_k + (((size_t)l * MS + b) * NMEM + wave * 32) * D + h * 256 + lane * 4;
                    const float* vp = cache_v + (((size_t)l * MS + b) * NMEM + wave * 32) * D + h * 256 + lane * 4;
                    float p[32];
#pragma unroll
                    for (int n = 0; n < 32; ++n) { const f32x4 kv = *(const f32x4*)(kp + (size_t)n * D); p[n] = (q4[0] * kv[0] + q4[1] * kv[1]) + (q4[2] * kv[2] + q4[3] * kv[3]); }
#pragma unroll
                    for (int i = 0; i < 16; ++i) { swap32(p[i], p[i + 16]); p[i] += p[i + 16]; }
                    { const bool b4 = (lane & 16) != 0;
#pragma unroll
                      for (int i = 0; i < 8; ++i) { const float keep = b4 ? p[i + 8] : p[i], send = b4 ? p[i] : p[i + 8]; p[i] = keep + SWZ_XOR(send, 16); } }
                    { const bool b3 = (lane & 8) != 0;
#pragma unroll
                      for (int i = 0; i < 4; ++i) { const float keep = b3 ? p[i + 4] : p[i], send = b3 ? p[i] : p[i + 4]; p[i] = keep + SWZ_XOR(send, 8); } }
                    { const bool b2 = (lane & 4) != 0;
#pragma unroll
                      for (int i = 0; i < 2; ++i) { const float keep = b2 ? p[i + 2] : p[i], send = b2 ? p[i] : p[i + 2]; p[i] = keep + SWZ_XOR(send, 4); } }
                    { const bool b1 = (lane & 2) != 0; const float keep = b1 ? p[1] : p[0], send = b1 ? p[0] : p[1]; p[0] = keep + SWZ_XOR(send, 2); }
                    p[0] += SWZ_XOR(p[0], 1);
                    if ((lane & 1) == 0) sc[wave * 32 + (lane >> 1)] = p[0];
                    LDS_WAIT(); __syncthreads();
                    float mx = -3.0e38f, sm = 0.f; f32x4 sv = *(const LAS f32x4*)(sc + lane * 4);
                    mx = fmaxf(fmaxf(sv[0], sv[1]), fmaxf(sv[2], sv[3]));
                    mx = wave_max(mx);
#pragma unroll
                    for (int j = 0; j < 4; ++j) sm += __builtin_amdgcn_exp2f(sv[j] - mx);
                    sm = wave_sum(sm);
                    f32x4 acc = {0.f, 0.f, 0.f, 0.f};
#pragma unroll 8
                    for (int n = 0; n < 32; ++n) { const float p = __builtin_amdgcn_exp2f(sc[wave * 32 + n] - mx); const f32x4 vv = *(const f32x4*)(vp + (size_t)n * D); acc += vv * p; }
                    *(LAS f32x4*)(po + wave * 256 + lane * 4) = acc;
                    LDS_WAIT(); __syncthreads();
                    if (tid < 256) { float o = 0.f;
#pragma unroll
                        for (int w = 0; w < 8; ++w) o += po[w * 256 + tid];
                        OS[(size_t)b * D + h * 256 + tid] = (bf16)f2bf(o / sm); }
                    __syncthreads();
                }
            }
        }
        SEAM(pb + 1);
        if (IN(pb + 2)) { PH_BEGIN LAYER_W
            { pg8::Gemm g{D, D, D}; pg8::StaticOrder S; S.init(MP / 256, 4, G, bx, OB, (size_t)256 * D * 2, WOl, (size_t)256 * D * 2);
              pg8::EpiRes E{X, X, XG, g_ffn + l * D, SSQ, nullptr};
              pg8::gemm_phase<pg8::EpiRes, pg8::StaticOrder, true>(L + RING_OFF, g, S, E, tid); }
            { RELANE for (int u = vcu; u < 256; u += G) s_res_unit(OS, D, WOl, D, D, u, XS, XS, XGS, SSQS, g_ffn + l * D, nullptr, L + RING_OFF, wave, lane); }
        }
        SEAM(pb + 2);
        if (IN(pb + 3)) { PH_BEGIN LAYER_W
            { pg8::Gemm g{D, D, D}; pg8::StaticOrder S; S.init(MP / 256, 16, G, bx, XG, (size_t)256 * D * 2, WUPl, (size_t)256 * D * 2);
              pg8::EpiRow<1> E{HB, FF, SSQ, 1.f, nullptr, nullptr};
              pg8::gemm_phase<pg8::EpiRow<1>, pg8::StaticOrder, true>(L + RING_OFF, g, S, E, tid); }
            { RELANE for (int u = vcu; u < 256; u += G) { const int cp = u >> 1; const int brow[2] = {32 * cp, 32 * cp + 16};
                sgemm2<4, 2>(XGS, D, 64 * (u & 1), WUPl, D, brow, D, L + RING_OFF, wave, lane, [&](f32x4 (&a)[2], int row, int fq) {
                    const float rs = srstd(SSQS, row, fq); const f32x4 v0 = relu2(a[0] * rs), v1 = relu2(a[1] * rs);
                    v2u p0, p1; p0.x = pk2(v0[0], v0[1]); p0.y = pk2(v0[2], v0[3]); p1.x = pk2(v1[0], v1[1]); p1.y = pk2(v1[2], v1[3]);
                    bf16* op = HS + (size_t)row * FF + 32 * cp + 4 * fq; *(v2u*)op = p0; *(v2u*)(op + 16) = p1; }); } }
        }
        SEAM(pb + 3);
        if (IN(pb + 4)) { PH_BEGIN LAYER_W
            const float* gn = (l == 0) ? (g_mix + D) : g_final;
            float* xo = (l == 0) ? X : (out + OY); float* xso = (l == 0) ? XS : (out + OYS);
            { pg8::Gemm g{FF, FF, FF}; pg8::StaticOrder S; S.init(MP / 256, 4, G, bx, HB, (size_t)256 * FF * 2, WDNl, (size_t)256 * FF * 2);
              pg8::EpiRes E{X, xo, XG, gn, SSQ, nullptr};
              pg8::gemm_phase<pg8::EpiRes, pg8::StaticOrder, true>(L + RING_OFF, g, S, E, tid); }
            { RELANE for (int u = vcu; u < 256; u += G) s_res_unit(HS, FF, WDNl, FF, FF, u, XS, xso, XGS, SSQS, gn, nullptr, L + RING_OFF, wave, lane); }
        }
        SEAM(pb + 4);
    }
    if (IN(15)) { PH_BEGIN
        for (int m = gw; m < MP + MS; m += NGW) {
            float rs; float* yr;
            if (m < MP) { const float v = (lane < 16) ? SSQ[(size_t)m * 16 + lane] : 0.f; rs = __builtin_amdgcn_rsqf(wave_sum(v) * (1.f / D) + EPS); yr = out + OY + (size_t)m * D; }
            else { const int r = m - MP; const float v = SSQS[r * 64 + lane]; rs = __builtin_amdgcn_rsqf(wave_sum(v) * (1.f / D) + EPS); yr = out + OYS + (size_t)r * D; }
            f32x4* yp = (f32x4*)yr + lane;
#pragma unroll
            for (int j = 0; j < 4; ++j) { const f32x4 gg = *((const f32x4*)g_final + lane + 64 * j); yp[64 * j] = yp[64 * j] * (rs * DBGF(m < MP ? 0 : 1)) * gg; }
        }
    }
#if defined(DBG_SCALE_MASK)
    if (IN(15)) { PH_BEGIN
        __syncthreads();
        const size_t obeg[9] = {OY, OYS, OPP, OCP, OMK, OMV, OPS, OCS, 27664384};
        const size_t gt = (size_t)vcu * NTHREADS + tid, NT = (size_t)G * NTHREADS;
#pragma unroll 1
        for (int k = 2; k < 8; ++k) if ((DBG_SCALE_MASK >> k) & 1) for (size_t i = obeg[k] + gt; i < obeg[k + 1]; i += NT) out[i] *= 0.8f;
    }
#endif
    if (ph + 1 < hi) GRID_BAR();
    }
#undef IN
#undef SEAM
#undef GRID_BAR
}

extern "C" void kernel_launch(void* const* d_in, const int* in_sizes, int n_in, void* d_out, int out_size, void* d_ws, size_t ws_size, hipStream_t stream) {
    static int grid = 0;
    if (grid == 0) {
        if (n_in != 22 || ws_size < WS_END) { fprintf(stderr, "kernel_launch: unexpected inputs (n_in %d, ws %zu)\n", n_in, ws_size); grid = -1; return; }
        int dev = 0, cus = 0, per_cu = 0;
        if (hipGetDevice(&dev) != hipSuccess || hipDeviceGetAttribute(&cus, hipDeviceAttributeMultiprocessorCount, dev) != hipSuccess) { grid = -1; return; }
        if (hipFuncSetAttribute((const void*)mk_fwd, hipFuncAttributeMaxDynamicSharedMemorySize, LDS_BYTES) != hipSuccess) { fprintf(stderr, "kernel_launch: hipFuncSetAttribute failed\n"); grid = -1; return; }
        if (hipOccupancyMaxActiveBlocksPerMultiprocessor(&per_cu, (const void*)mk_fwd, NTHREADS, LDS_BYTES) != hipSuccess || per_cu < 1)
            fprintf(stderr, "kernel_launch: note: occupancy query reports %d workgroups per CU\n", per_cu);
        (void)hipGetLastError();
        grid = cus;
    }
    if (grid < 0) return;
    (void)hipMemsetAsync((char*)d_ws + WS_CTL, 0, CTL_ZERO_BYTES, stream);
    Args a{};
    for (int i = 0; i < 22; ++i) a.in[i] = (const float*)d_in[i];
    a.out = (float*)d_out; a.ws = (unsigned char*)d_ws;
#if MK_PER_PHASE
    for (int p = 0; p < NPHASES; ++p) { a.ph_lo = p; a.ph_hi = p + 1; hipLaunchKernelGGL(mk_fwd, dim3(grid), dim3(NTHREADS), LDS_BYTES, stream, a); }
#else
    a.ph_lo = 0; a.ph_hi = NPHASES; hipLaunchKernelGGL(mk_fwd, dim3(grid), dim3(NTHREADS), LDS_BYTES, stream, a);
#endif
}
```

```cpp
#include <hip/hip_runtime.h>
#include <cstdio>
#include <cstdint>

#define DBG_SCALE_MASK 0x00
#define DBGF(k) (((DBG_SCALE_MASK >> (k)) & 1) ? 0.8f : 1.0f)
#ifndef MK_PER_PHASE
#define MK_PER_PHASE 0
#endif

constexpr int D = 1024, BATCH = 8, SEQ = 2048, MP = BATCH * SEQ  , MS = 128  ;
constexpr int NMEM = 256, NH = 4, HD = 256, FF = 4096, MEMROWS = BATCH * NMEM  ;
constexpr float EPS = 1e-6f;
constexpr float QSCALE = 0.0625f * 1.4426950408889634f;

constexpr size_t OY = 0, OYS = 16777216, OPP = 16908288, OCP = 17031168, OMK = 17047552, OMV = 21241856, OPS = 25436160, OCS = 27402240;

#define SWZ_XOR(v, m) __builtin_bit_cast(float, __builtin_amdgcn_ds_swizzle(__builtin_bit_cast(int, (float)(v)), (((m) << 10) | 0x1f)))
__device__ __forceinline__ void swap32(float& a, float& b) { asm volatile("s_nop 1\n\tv_permlane32_swap_b32 %0, %1\n\ts_nop 1" : "+v"(a), "+v"(b)); }
__device__ __forceinline__ float add_x32(float v) { float a = v, b = v; swap32(a, b); return a + b; }
__device__ __forceinline__ float max_x32(float v) { float a = v, b = v; swap32(a, b); return fmaxf(a, b); }
__device__ __forceinline__ float add_x16_x32(float v) { v += SWZ_XOR(v, 16); return add_x32(v); }
__device__ __forceinline__ float max_x16_x32(float v) { v = fmaxf(v, SWZ_XOR(v, 16)); return max_x32(v); }
__device__ __forceinline__ float wave_sum(float v) { v += SWZ_XOR(v, 1); v += SWZ_XOR(v, 2); v += SWZ_XOR(v, 4); v += SWZ_XOR(v, 8); v += SWZ_XOR(v, 16); return add_x32(v); }
__device__ __forceinline__ float wave_max(float v) { v = fmaxf(v, SWZ_XOR(v, 1)); v = fmaxf(v, SWZ_XOR(v, 2)); v = fmaxf(v, SWZ_XOR(v, 4)); v = fmaxf(v, SWZ_XOR(v, 8)); v = fmaxf(v, SWZ_XOR(v, 16)); return max_x32(v); }

namespace pg8 {
#define PG8_LAS __attribute__((address_space(3)))
typedef unsigned short bf16_t;
typedef short bf16x8 __attribute__((ext_vector_type(8)));
typedef float f32x4 __attribute__((ext_vector_type(4)));
typedef float f32x2 __attribute__((ext_vector_type(2)));
typedef unsigned u32x4 __attribute__((ext_vector_type(4)));
typedef unsigned u32x2 __attribute__((ext_vector_type(2)));
constexpr int BM = 256, BK = 64, HALF = 128, HTB = HALF * BK * 2, STAGE_BYTES = 8 * HTB, NXCD = 8, WGM = 8;

__host__ __device__ __forceinline__ int lds_byte(int r, int c) { const int st = (r >> 4) * 2 + (c >> 5), rr = r & 15, cc = c & 31, ob = rr * 64 + cc * 2; return st * 1024 + (ob ^ (((ob >> 9) & 1) << 5)); }
__host__ __device__ __forceinline__ void stage_rc(int b, int& R, int& C) { const int st = b / 1024, sb = b % 1024, swz = sb ^ (((sb >> 9) & 1) << 5); R = (st >> 1) * 16 + swz / 64; C = (st & 1) * 32 + (swz % 64) / 2; }
__host__ __device__ __forceinline__ int perm32(int rho) { const int n = rho >> 4, i = rho & 15; return 8 * (i >> 2) + 4 * n + (i & 3); }

struct Unit { int pm, pn; };
struct Gemm { int lda, ldb, K; };

__device__ __forceinline__ unsigned cvt_pk_bf16(float lo, float hi) { unsigned r; asm volatile("v_cvt_pk_bf16_f32 %0, %1, %2" : "=v"(r) : "v"(lo), "v"(hi)); return r; }

struct StaticOrder {
    int nM, nN, nwg, G, c;
    const char* A; const char* B; size_t astep, bstep, apn;
    __device__ void init(int nM_, int nN_, int G_, int c_, const void* A_, size_t astep_, const void* B_, size_t bstep_, size_t apn_ = 0) {
        nM = nM_; nN = nN_; nwg = nM * nN; G = G_; c = c_; A = (const char*)A_; B = (const char*)B_; astep = astep_; bstep = bstep_; apn = apn_; }
    __device__ bool next(int i, Unit& u) const {
        const long L = (long)i * G + c; if (L >= nwg) return false;
        int wgid = (int)L; { const int q = nwg / NXCD, r = nwg % NXCD, xcd = wgid % NXCD, off = wgid / NXCD; wgid = (xcd < r ? xcd * (q + 1) : r * (q + 1) + (xcd - r) * q) + off; }
        const int nig = WGM * nN, gid = wgid / nig, fm = gid * WGM, gsz = (nM - fm) < WGM ? (nM - fm) : WGM;
        u.pm = fm + ((wgid % nig) % gsz); u.pn = (wgid % nig) / gsz; return true;
    }
    __device__ __forceinline__ const char* aptr(const Unit& u) const { return A + (size_t)u.pm * astep + (size_t)u.pn * apn; }
    __device__ __forceinline__ const char* bptr(const Unit& u) const { return B + (size_t)u.pn * bstep; }
};
struct KvOrder {
    int G, c; const char* A; const char* B;
    __device__ bool next(int i, Unit& u) const { const int L = i * G + c; if (L >= 128) return false; u.pm = L >> 3; u.pn = L & 7; return true; }
    __device__ __forceinline__ const char* aptr(const Unit& u) const { return A + (size_t)u.pm * (256 * 1024 * 2); }
    __device__ __forceinline__ const char* bptr(const Unit& u) const { return B + (size_t)((u.pm >> 3) * 2048 + u.pn * 256) * (1024 * 2); }
};
struct SingleOrder {
    Unit u0; const char* A; const char* B;
    __device__ bool next(int i, Unit& u) const { if (i) return false; u = u0; return true; }
    __device__ __forceinline__ const char* aptr(const Unit&) const { return A; }
    __device__ __forceinline__ const char* bptr(const Unit&) const { return B; }
};


template <bool BASE32> struct EpiRes {
    static constexpr bool PERM = true, AFTER_DRAIN = false;
    const float* base32; bf16_t* x16; float* ssq; const float* cscale;
    __device__ __forceinline__ void operator()(const f32x4 (&acc)[2][2][4][2], const Unit& u, int wr, int wc, int fr, int fq) const {
        const int col0 = u.pn * BM + wc * 32 + 8 * fq;
        f32x4 cs[2][2];
#pragma unroll
        for (int bj = 0; bj < 2; ++bj)
#pragma unroll
            for (int n = 0; n < 2; ++n) cs[bj][n] = cscale ? *(const f32x4*)(cscale + col0 + bj * HALF + n * 4) : (f32x4){1.f, 1.f, 1.f, 1.f};
#pragma unroll
        for (int ai = 0; ai < 2; ++ai)
#pragma unroll
            for (int m = 0; m < 4; ++m) { const int row = u.pm * BM + ai * HALF + wr * 64 + m * 16 + fr; const size_t off = (size_t)row * D + col0; float ss = 0.f;
#pragma unroll
                for (int bj = 0; bj < 2; ++bj) { f32x4 b0, b1;
                    if (BASE32) { b0 = *(const f32x4*)(base32 + off + bj * HALF); b1 = *(const f32x4*)(base32 + off + bj * HALF + 4); }
                    else { const u32x4 w = *(const u32x4*)(x16 + off + bj * HALF);
                        b0 = (f32x4){__builtin_bit_cast(float, w.x << 16), __builtin_bit_cast(float, w.x & 0xffff0000u), __builtin_bit_cast(float, w.y << 16), __builtin_bit_cast(float, w.y & 0xffff0000u)};
                        b1 = (f32x4){__builtin_bit_cast(float, w.z << 16), __builtin_bit_cast(float, w.z & 0xffff0000u), __builtin_bit_cast(float, w.w << 16), __builtin_bit_cast(float, w.w & 0xffff0000u)}; }
                    const f32x4 v0 = b0 + acc[ai][bj][m][0] * cs[bj][0], v1 = b1 + acc[ai][bj][m][1] * cs[bj][1];
                    ss += ((v0[0] * v0[0] + v0[1] * v0[1]) + (v0[2] * v0[2] + v0[3] * v0[3])) + ((v1[0] * v1[0] + v1[1] * v1[1]) + (v1[2] * v1[2] + v1[3] * v1[3]));
                    u32x4 o; o.x = cvt_pk_bf16(v0[0], v0[1]); o.y = cvt_pk_bf16(v0[2], v0[3]); o.z = cvt_pk_bf16(v1[0], v1[1]); o.w = cvt_pk_bf16(v1[2], v1[3]);
                    *(u32x4*)(x16 + off + bj * HALF) = o; }
                ss = add_x16_x32(ss);
                if (fq == 0) ssq[(size_t)row * 16 + u.pn * 4 + wc] = ss; }
    }
};
__device__ __forceinline__ float rstd_from_ssq16(const float* ssq, int row) {
    const f32x4* sp = (const f32x4*)(ssq + (size_t)row * 16); const f32x4 s = (sp[0] + sp[1]) + (sp[2] + sp[3]);
    return __builtin_amdgcn_rsqf(((s[0] + s[1]) + (s[2] + s[3])) * (1.0f / D) + EPS);
}
template <int MODE> struct EpiRow {
    static constexpr bool PERM = true, AFTER_DRAIN = false;
    bf16_t* O; int ldc; const float* ssq; float scale; bf16_t* O2; float* convout;
    __device__ __forceinline__ void operator()(const f32x4 (&acc)[2][2][4][2], const Unit& u, int wr, int wc, int fr, int fq) const {
        const int colw = wc * 32 + 8 * fq;
#pragma unroll
        for (int ai = 0; ai < 2; ++ai)
#pragma unroll
            for (int m = 0; m < 4; ++m) { const int row = u.pm * BM + ai * HALF + wr * 64 + m * 16 + fr; const float rs = rstd_from_ssq16(ssq, row);
                if (MODE == 2 && u.pn >= 4) {
                    const float r2 = rs * rs; const f32x4 v0 = acc[ai][0][m][0] * acc[ai][1][m][0] * r2, v1 = acc[ai][0][m][1] * acc[ai][1][m][1] * r2;
                    const int ch = (u.pn - 4) * 128 + colw;
                    u32x4 w; w.x = cvt_pk_bf16(v0[0], v0[1]); w.y = cvt_pk_bf16(v0[2], v0[3]); w.z = cvt_pk_bf16(v1[0], v1[1]); w.w = cvt_pk_bf16(v1[2], v1[3]);
                    *(u32x4*)(O2 + (size_t)row * D + ch) = w;
                    const int t = row & (SEQ - 1);
                    if (t >= SEQ - 2) { float* cp = convout + ((size_t)(row >> 11) * 2 + (t - (SEQ - 2))) * D + ch; *(f32x4*)cp = v0; *(f32x4*)(cp + 4) = v1; }
                } else {
                    const float sc = (MODE == 0) ? rs * scale : rs;
#pragma unroll
                    for (int bj = 0; bj < 2; ++bj) { f32x4 v0 = acc[ai][bj][m][0] * sc, v1 = acc[ai][bj][m][1] * sc;
                        if (MODE == 1) {
#pragma unroll
                            for (int j = 0; j < 4; ++j) { const float a = fmaxf(v0[j], 0.f), b = fmaxf(v1[j], 0.f); v0[j] = a * a; v1[j] = b * b; } }
                        u32x4 w; w.x = cvt_pk_bf16(v0[0], v0[1]); w.y = cvt_pk_bf16(v0[2], v0[3]); w.z = cvt_pk_bf16(v1[0], v1[1]); w.w = cvt_pk_bf16(v1[2], v1[3]);
                        *(u32x4*)(O + (size_t)row * ldc + u.pn * BM + bj * HALF + colw) = w; }
                } }
    }
};
struct EpiBf16 {
    static constexpr bool PERM = true, AFTER_DRAIN = false;
    bf16_t* O; int ldc;
    __device__ __forceinline__ void operator()(const f32x4 (&acc)[2][2][4][2], const Unit& u, int wr, int wc, int fr, int fq) const {
        const int colw = u.pn * BM + wc * 32 + 8 * fq;
#pragma unroll
        for (int ai = 0; ai < 2; ++ai)
#pragma unroll
            for (int m = 0; m < 4; ++m) { const int row = u.pm * BM + ai * HALF + wr * 64 + m * 16 + fr;
#pragma unroll
                for (int bj = 0; bj < 2; ++bj) { const f32x4 v0 = acc[ai][bj][m][0], v1 = acc[ai][bj][m][1];
                    u32x4 w; w.x = cvt_pk_bf16(v0[0], v0[1]); w.y = cvt_pk_bf16(v0[2], v0[3]); w.z = cvt_pk_bf16(v1[0], v1[1]); w.w = cvt_pk_bf16(v1[2], v1[3]);
                    *(u32x4*)(O + (size_t)row * ldc + colw + bj * HALF) = w; } }
    }
};
struct EpiKV {
    static constexpr bool PERM = false, AFTER_DRAIN = false;
    float* outk; float* outv; bf16_t* Kb; bf16_t* Vt;
    __device__ __forceinline__ void operator()(const f32x4 (&acc)[2][2][4][2], const Unit& u, int wr, int wc, int fr, int fq) const {
        const int layer = u.pm >> 3; const bool isV = u.pn >= 4; const int col0 = (u.pn & 3) * BM + wc * 32 + 4 * fq;
        float* outp = isV ? outv : outk;
#pragma unroll
        for (int ai = 0; ai < 2; ++ai)
#pragma unroll
            for (int m = 0; m < 4; ++m) { const int rowl = (u.pm & 7) * BM + ai * HALF + wr * 64 + m * 16 + fr; const size_t off = ((size_t)layer * MEMROWS + rowl) * D + col0;
#pragma unroll
                for (int bj = 0; bj < 2; ++bj)
#pragma unroll
                    for (int n = 0; n < 2; ++n) { const f32x4 v = acc[ai][bj][m][n]; *(f32x4*)(outp + off + bj * HALF + n * 16) = v;
                        if (!isV) { u32x2 p; p.x = cvt_pk_bf16(v[0], v[1]); p.y = cvt_pk_bf16(v[2], v[3]); *(u32x2*)(Kb + off + bj * HALF + n * 16) = p; }
                        else { const int b = rowl >> 8, nn = rowl & 255; bf16_t* vp = Vt + ((size_t)(layer * BATCH + b) * D + col0 + bj * HALF + n * 16) * NMEM + nn;
                            const unsigned p0 = cvt_pk_bf16(v[0], v[1]), p1 = cvt_pk_bf16(v[2], v[3]);
                            vp[0] = (bf16_t)(p0 & 0xffffu); vp[NMEM] = (bf16_t)(p0 >> 16); vp[2 * NMEM] = (bf16_t)(p1 & 0xffffu); vp[3 * NMEM] = (bf16_t)(p1 >> 16); } } }
    }
};
struct EpiSoftmax {
    static constexpr bool PERM = true, AFTER_DRAIN = true;
    bf16_t* P;
    __device__ __forceinline__ void operator()(const f32x4 (&)[2][2][4][2], const Unit&, int, int, int, int) const {}
    __device__ __forceinline__ void fused(f32x4 (&acc)[2][2][4][2], const Unit& u, int wr, int wc, int fr, int fq, PG8_LAS unsigned char* lds, int wid, int lane) const {
        PG8_LAS float* Pm = (PG8_LAS float*)lds;
        PG8_LAS float* Ps = (PG8_LAS float*)(lds + 4096);
#pragma unroll
        for (int ai = 0; ai < 2; ++ai)
#pragma unroll
            for (int m = 0; m < 4; ++m) { float mx = -3.0e38f;
#pragma unroll
                for (int bj = 0; bj < 2; ++bj)
#pragma unroll
                    for (int n = 0; n < 2; ++n) { const f32x4 x = acc[ai][bj][m][n]; mx = fmaxf(mx, fmaxf(fmaxf(x[0], x[1]), fmaxf(x[2], x[3]))); }
                mx = max_x16_x32(mx);
                if (fq == 0) Pm[(ai * HALF + wr * 64 + m * 16 + fr) * 4 + wc] = mx; }
        asm volatile("s_waitcnt lgkmcnt(0)" ::: "memory"); __builtin_amdgcn_s_barrier(); asm volatile("" ::: "memory");
#pragma unroll
        for (int ai = 0; ai < 2; ++ai)
#pragma unroll
            for (int m = 0; m < 4; ++m) { const int r = ai * HALF + wr * 64 + m * 16 + fr; const f32x4 q = *(const PG8_LAS f32x4*)(Pm + r * 4);
                const float mx = fmaxf(fmaxf(q[0], q[1]), fmaxf(q[2], q[3])); float s = 0.f;
#pragma unroll
                for (int bj = 0; bj < 2; ++bj)
#pragma unroll
                    for (int n = 0; n < 2; ++n) { f32x4 x = acc[ai][bj][m][n];
#pragma unroll
                        for (int j = 0; j < 4; ++j) { x[j] = __builtin_amdgcn_exp2f(x[j] - mx); s += x[j]; }
                        acc[ai][bj][m][n] = x; }
                s = add_x16_x32(s);
                if (fq == 0) Ps[r * 4 + wc] = s; }
        asm volatile("s_waitcnt lgkmcnt(0)" ::: "memory"); __builtin_amdgcn_s_barrier(); asm volatile("" ::: "memory");
        const int colw = wc * 32 + 8 * fq;
#pragma unroll
        for (int ai = 0; ai < 2; ++ai)
#pragma unroll
            for (int m = 0; m < 4; ++m) { const int r = ai * HALF + wr * 64 + m * 16 + fr; const f32x4 q = *(const PG8_LAS f32x4*)(Ps + r * 4);
                const float inv = __builtin_amdgcn_rcpf((q[0] + q[1]) + (q[2] + q[3]));
#pragma unroll
                for (int bj = 0; bj < 2; ++bj) { const f32x4 v0 = acc[ai][bj][m][0] * inv, v1 = acc[ai][bj][m][1] * inv;
                    u32x4 w; w.x = cvt_pk_bf16(v0[0], v0[1]); w.y = cvt_pk_bf16(v0[2], v0[3]); w.z = cvt_pk_bf16(v1[0], v1[1]); w.w = cvt_pk_bf16(v1[2], v1[3]);
                    *(u32x4*)(P + (size_t)r * 256 + bj * HALF + colw) = w; } }
    }
};

template <class Epi, class Sched, bool ALIGN_EPI>
__device__ __forceinline__ void gemm_phase(PG8_LAS unsigned char* lds, const Gemm g, const Sched& S, const Epi& E, int tid) {
    asm volatile("" : "+v"(tid));
    const int wid = __builtin_amdgcn_readfirstlane(tid >> 6), lane = tid & 63, wr = wid >> 2, wc = wid & 3, fr = lane & 15, fq = lane >> 4;
    const int nt = g.K / BK;
    unsigned voffA[2], voffB[2];
#pragma unroll
    for (int i = 0; i < 2; ++i) { int R, C; stage_rc(tid * 16 + i * 8192, R, C); const int Rb = Epi::PERM ? ((R & ~31) + perm32(R & 31)) : R;
        voffA[i] = (unsigned)(R * g.lda + C) * 2u; voffB[i] = (unsigned)(Rb * g.ldb + C) * 2u; }
    const size_t kstep = (size_t)(BK * 2);
    const size_t hstepA = (size_t)HALF * g.lda * 2, hstepB = (size_t)HALF * g.ldb * 2;
    const unsigned ldsw = (unsigned)wid * 1024u;
    const int aoff = lds_byte(wr * 64 + fr, fq * 8), boff = lds_byte(wc * 32 + fr, fq * 8);
#define PG8_SA(b, h) (((b) * 2 + (h)) * HTB)
#define PG8_SB(b, h) ((4 + (b) * 2 + (h)) * HTB)
#define PG8_STAGE(bufoff, gbase, voff) do { _Pragma("unroll") for (int _i = 0; _i < 2; ++_i) \
        __builtin_amdgcn_global_load_lds((const unsigned*)((const char*)(gbase) + (voff)[_i]), (PG8_LAS unsigned*)(lds + (bufoff) + ldsw + _i * 8192), 16, 0, 0); } while (0)
#define PG8_LDA(dst, b, h) do { _Pragma("unroll") for (int m = 0; m < 4; ++m) _Pragma("unroll") for (int k = 0; k < 2; ++k) dst[m][k] = *(const PG8_LAS bf16x8*)(lds + PG8_SA(b, h) + aoff + m * 2048 + k * 1024); } while (0)
#define PG8_LDB(dst, b, h) do { _Pragma("unroll") for (int n = 0; n < 2; ++n) _Pragma("unroll") for (int k = 0; k < 2; ++k) dst[n][k] = *(const PG8_LAS bf16x8*)(lds + PG8_SB(b, h) + boff + n * 2048 + k * 1024); } while (0)
#define PG8_MMA(ai, bj, At, Bt) do { __builtin_amdgcn_s_setprio(1); _Pragma("unroll") for (int m = 0; m < 4; ++m) _Pragma("unroll") for (int n = 0; n < 2; ++n) _Pragma("unroll") for (int k = 0; k < 2; ++k) \
        acc[ai][bj][m][n] = __builtin_amdgcn_mfma_f32_16x16x32_bf16(Bt[n][k], At[m][k], acc[ai][bj][m][n], 0, 0, 0); __builtin_amdgcn_s_setprio(0); } while (0)
#define PG8_WAIT_V(n) asm volatile("s_waitcnt vmcnt(" #n ")" ::: "memory")
#define PG8_WAIT_L(n) asm volatile("s_waitcnt lgkmcnt(" #n ")" ::: "memory")
#define PG8_BAR __builtin_amdgcn_s_barrier()
#define PG8_SCHED __builtin_amdgcn_sched_barrier(0)
    Unit cur, nxt; int ui = 0;
    if (!S.next(0, cur)) return;
    f32x4 acc[2][2][4][2];
#pragma unroll
    for (int a = 0; a < 2; ++a)
#pragma unroll
        for (int b = 0; b < 2; ++b)
#pragma unroll
            for (int m = 0; m < 4; ++m)
#pragma unroll
                for (int n = 0; n < 2; ++n) acc[a][b][m][n] = (f32x4){0.f, 0.f, 0.f, 0.f};
    bf16x8 At[4][2], B0[2][2], B1[2][2];
    const char* cA = S.aptr(cur); const char* cB = S.bptr(cur);
    PG8_STAGE(PG8_SB(0, 0), cB, voffB); PG8_STAGE(PG8_SB(0, 1), cB + hstepB, voffB); PG8_STAGE(PG8_SA(0, 0), cA, voffA); PG8_STAGE(PG8_SA(0, 1), cA + hstepA, voffA);
    if (wr == 1) PG8_BAR;
    PG8_WAIT_V(2); PG8_BAR;
    PG8_STAGE(PG8_SB(1, 0), cB + kstep, voffB); PG8_STAGE(PG8_SA(1, 0), cA + kstep, voffA); PG8_STAGE(PG8_SB(1, 1), cB + hstepB + kstep, voffB);
    PG8_WAIT_V(6); PG8_BAR;
    for (;;) {
        const bool has_next = S.next(ui + 1, nxt);
        const char* nA = has_next ? S.aptr(nxt) : cA; const char* nB = has_next ? S.bptr(nxt) : cB;
        for (int t = 0; t < nt; t += 2) {
            const bool last = (t == nt - 2);
            const char* a1 = cA + (size_t)(t + 1) * kstep;
            const char* a2 = last ? nA : cA + (size_t)(t + 2) * kstep; const char* b2 = last ? nB : cB + (size_t)(t + 2) * kstep;
            const char* a3 = a2 + kstep; const char* b3 = b2 + kstep;
            PG8_LDB(B0, 0, 0); PG8_LDB(B1, 0, 1); PG8_SCHED; PG8_LDA(At, 0, 0); PG8_STAGE(PG8_SA(1, 1), a1 + hstepA, voffA);
            PG8_WAIT_V(8); PG8_WAIT_L(0); PG8_BAR; PG8_MMA(0, 0, At, B0); PG8_MMA(0, 1, At, B1); PG8_BAR; PG8_SCHED;
            PG8_LDA(At, 0, 1); PG8_STAGE(PG8_SB(0, 0), b2, voffB); PG8_STAGE(PG8_SB(0, 1), b2 + hstepB, voffB); PG8_STAGE(PG8_SA(0, 0), a2, voffA);
            PG8_WAIT_V(8); PG8_WAIT_L(0); PG8_BAR; PG8_MMA(1, 0, At, B0); PG8_MMA(1, 1, At, B1); PG8_BAR; PG8_SCHED;
            PG8_LDB(B0, 1, 0); PG8_LDB(B1, 1, 1); PG8_SCHED; PG8_LDA(At, 1, 0); PG8_STAGE(PG8_SA(0, 1), a2 + hstepA, voffA);
            PG8_WAIT_V(8); PG8_WAIT_L(0); PG8_BAR; PG8_MMA(0, 0, At, B0); PG8_MMA(0, 1, At, B1); PG8_BAR; PG8_SCHED;
            PG8_LDA(At, 1, 1); PG8_STAGE(PG8_SB(1, 0), b3, voffB); PG8_STAGE(PG8_SB(1, 1), b3 + hstepB, voffB); PG8_STAGE(PG8_SA(1, 0), a3, voffA);
            PG8_WAIT_V(8); PG8_WAIT_L(0); PG8_BAR; PG8_MMA(1, 0, At, B0); PG8_MMA(1, 1, At, B1); PG8_BAR; PG8_SCHED;
        }
        if constexpr (ALIGN_EPI) { if (wr == 0) PG8_BAR; }
        if constexpr (!Epi::AFTER_DRAIN) { int l2 = lane; asm volatile("" : "+v"(l2)); E(acc, cur, wr, wc, l2 & 15, l2 >> 4); }
        if (!has_next) break;
#pragma unroll
        for (int a = 0; a < 2; ++a)
#pragma unroll
            for (int b = 0; b < 2; ++b)
#pragma unroll
                for (int m = 0; m < 4; ++m)
#pragma unroll
                    for (int n = 0; n < 2; ++n) acc[a][b][m][n] = (f32x4){0.f, 0.f, 0.f, 0.f};
        cur = nxt; cA = nA; cB = nB; ++ui;
        if constexpr (ALIGN_EPI) { if (wr == 1) PG8_BAR; }
    }
    PG8_WAIT_V(0);
    if constexpr (!ALIGN_EPI) { if (wr == 0) PG8_BAR; }
    PG8_BAR;
    if constexpr (Epi::AFTER_DRAIN) { int l2 = lane; asm volatile("" : "+v"(l2)); E.fused(acc, cur, wr, wc, l2 & 15, l2 >> 4, lds, wid, l2); }
#undef PG8_SA
#undef PG8_SB
#undef PG8_STAGE
#undef PG8_LDA
#undef PG8_LDB
#undef PG8_MMA
#undef PG8_WAIT_V
#undef PG8_WAIT_L
#undef PG8_BAR
#undef PG8_SCHED
}
}

constexpr int NWAVES = 8, NTHREADS = 512;
constexpr size_t MiB = 1u << 20;
constexpr size_t WS_CTL = 0, CTL_ZERO_BYTES = 64 * 1024;
constexpr size_t WS_WPOOL = 1 * MiB;
constexpr size_t WS_WQ = 2 * MiB;
constexpr size_t WS_WO = 6 * MiB;
constexpr size_t WS_WKV = 10 * MiB;
constexpr size_t WS_WUP = 18 * MiB;
constexpr size_t WS_WDN = 34 * MiB;
constexpr size_t WS_WIN = 50 * MiB;
constexpr size_t WS_WOUT = 56 * MiB;
constexpr size_t WS_MN = 58 * MiB;
constexpr size_t WS_KB = 66 * MiB;
constexpr size_t WS_VT = 74 * MiB;
constexpr size_t WS_SSQ = 82 * MiB;
constexpr size_t WS_SMALL = 84 * MiB;
constexpr size_t WS_X = 96 * MiB;
constexpr size_t WS_XG = 160 * MiB;
constexpr size_t WS_P0 = 192 * MiB;
constexpr size_t WS_O = 224 * MiB;
constexpr size_t WS_CH = 256 * MiB;
constexpr size_t WS_PS = 288 * MiB;
constexpr size_t WS_H = 320 * MiB;
constexpr size_t WS_END = 448 * MiB;
constexpr size_t SS_X = WS_SMALL;
constexpr size_t SS_XG = SS_X + 512 * 1024;
constexpr size_t SS_SSQ = SS_XG + 256 * 1024;
constexpr size_t SS_P0 = SS_SSQ + 32 * 1024;
constexpr size_t SS_O = SS_P0 + 256 * 1024;
constexpr size_t SS_CH = SS_O + 256 * 1024;
constexpr size_t SS_H = SS_CH + 512 * 1024;
static_assert(SS_H + 1024 * 1024 <= WS_X, "sample buffers");
constexpr int CW_BAR = 4096;

constexpr int RING_OFF = 0, RING_BYTES = 131072;
constexpr int LDSCTL_OFF = RING_BYTES, MISC_OFF = LDSCTL_OFF + 320;
constexpr int LDS_BYTES = 147456;

#define GAS __attribute__((address_space(1)))
#define LAS __attribute__((address_space(3)))
typedef unsigned short bf16;
typedef unsigned v4u __attribute__((ext_vector_type(4)));
typedef unsigned v2u __attribute__((ext_vector_type(2)));
typedef float f32x4 __attribute__((ext_vector_type(4)));
typedef short bf16x8 __attribute__((ext_vector_type(8)));
#define LDS_WAIT() asm volatile("s_waitcnt lgkmcnt(0)" ::: "memory")
#define VM_WAIT() asm volatile("s_waitcnt vmcnt(0)" ::: "memory")
__device__ __forceinline__ unsigned f2bf(float f) { unsigned u = __builtin_bit_cast(unsigned, f); return (u + 0x7fffu + ((u >> 16) & 1u)) >> 16; }
__device__ __forceinline__ unsigned pk2(float lo, float hi) { return f2bf(lo) | (f2bf(hi) << 16); }
__device__ __forceinline__ float bf2f(unsigned short h) { return __builtin_bit_cast(float, (unsigned)h << 16); }
__device__ __forceinline__ float bflo(unsigned w) { return __builtin_bit_cast(float, w << 16); }
__device__ __forceinline__ float bfhi(unsigned w) { return __builtin_bit_cast(float, w & 0xffff0000u); }

#define XB_TMO      128
#define XB_XCNT(j)  (256  + 64 * (j))
#define XB_XSUB(j)  (1280 + 64 * (j))
#define XB_XGEN(j)  (2304 + 64 * (j))
#define XB_TOP      3328
#define XB_TOPGEN   3392
#define XCD_BAR_WORDS 3456
#define XB_SPIN_CAP (1u << 18)
__device__ __forceinline__ unsigned xb_ld(unsigned* p)              { return __hip_atomic_load(p, __ATOMIC_RELAXED, __HIP_MEMORY_SCOPE_AGENT); }
__device__ __forceinline__ unsigned xb_add(unsigned* p, unsigned v) { return __hip_atomic_fetch_add(p, v, __ATOMIC_RELAXED, __HIP_MEMORY_SCOPE_AGENT); }
__device__ __forceinline__ unsigned xb_xcc_id() { return (unsigned)__builtin_amdgcn_s_getreg((3 << 11) | 20) & 0xFu; }
#define XB_SPIN(cond, bar) do { unsigned _sp = 0; while (cond) { __builtin_amdgcn_s_sleep(1); \
    if ((++_sp & 255u) == 0u) { if (xb_ld(&(bar)[XB_TMO])) break; if (_sp > XB_SPIN_CAP) { atomicAdd(&(bar)[XB_TMO], 1u); break; } } } } while (0)
struct XcdBarrier { unsigned* bar; unsigned x; volatile LAS unsigned* st; };
__device__ __forceinline__ XcdBarrier xcd_barrier_post(unsigned* bar, volatile LAS unsigned* st) {
    XcdBarrier b; b.bar = bar; b.x = xb_xcc_id(); b.st = st;
    if (threadIdx.x == 0) (void)xb_add(&bar[XB_XCNT(b.x)], 1u);
    return b;
}
__device__ __forceinline__ void xcd_barrier_complete(unsigned* bar, unsigned x, unsigned& nloc, unsigned& nx) {
    const unsigned G = gridDim.x * gridDim.y * gridDim.z;
    unsigned sum, cnt, mine, sp = 0u;
    for (;;) {
        sum = 0u; cnt = 0u; mine = 0u;
#pragma unroll
        for (unsigned j = 0; j < 16; ++j) { const unsigned c = xb_ld(&bar[XB_XCNT(j)]); sum += c; cnt += (c > 0u) ? 1u : 0u; mine = (j == x) ? c : mine; }
        if (sum == G) break;
        __builtin_amdgcn_s_sleep(1);
        if ((++sp & 255u) == 0u) { if (xb_ld(&bar[XB_TMO])) break; if (sp > XB_SPIN_CAP) { atomicAdd(&bar[XB_TMO], 1u); break; } }
    }
    nloc = mine > 0u ? mine : 1u; nx = cnt > 0u ? cnt : 1u;
}
__device__ __forceinline__ void xcd_barrier(const XcdBarrier& b, const int tid) {
    asm volatile("s_waitcnt vmcnt(0)" ::: "memory");
    __syncthreads();
    if (tid == 0) {
        unsigned* bar = b.bar; asm volatile("" : "+s"(bar));
        __builtin_amdgcn_s_waitcnt(0);
        unsigned nloc = b.st[0], nx = b.st[1];
        if (nloc == 0u) { xcd_barrier_complete(bar, b.x, nloc, nx); b.st[0] = nloc; b.st[1] = nx; }
        const unsigned old = xb_add(&bar[XB_XSUB(b.x)], 1u);
        const unsigned gen = old / nloc;
        if (old + 1u == (gen + 1u) * nloc) {
            __builtin_amdgcn_fence(__ATOMIC_RELEASE, "agent");
            asm volatile("s_waitcnt vmcnt(0)" ::: "memory");
            const unsigned og = xb_add(&bar[XB_TOP], 1u);
            const unsigned tg = og / nx;
            if (og + 1u == (tg + 1u) * nx) xb_add(&bar[XB_TOPGEN], 1u);
            else XB_SPIN(xb_ld(&bar[XB_TOPGEN]) == tg, bar);
            __builtin_amdgcn_fence(__ATOMIC_ACQUIRE, "agent");
            xb_add(&bar[XB_XGEN(b.x)], 1u);
            asm volatile("s_waitcnt vmcnt(0)" ::: "memory");
        } else {
            XB_SPIN(xb_ld(&bar[XB_XGEN(b.x)]) == gen, bar);
            __builtin_amdgcn_fence(__ATOMIC_ACQUIRE, "agent");
            asm volatile("s_waitcnt vmcnt(0)" ::: "memory");
        }
    }
    __syncthreads();
}

__device__ __forceinline__ int opq_v(int x) { asm volatile("" : "+v"(x)); return x; }
__device__ __forceinline__ int lane_id_opaque() { int l; asm volatile("v_mbcnt_lo_u32_b32 %0, -1, 0\n\tv_mbcnt_hi_u32_b32 %0, -1, %0" : "=v"(l)); return l; }
struct Args { const float* in[22]; float* out; unsigned char* ws; int ph_lo, ph_hi; };


__device__ __forceinline__ void p0_transpose_item(const float* W, int K, int N, bf16* WT, int k0, int n0, int drow0, LAS float* scr, int lane, const float* gk = nullptr) {
#pragma unroll 8
    for (int i = 0; i < 32; ++i) { const int kk = 2 * i + (lane >> 5); const float gg = gk ? gk[k0 + kk] : 1.f; scr[kk * 33 + (lane & 31)] = W[(size_t)(k0 + kk) * N + n0 + (lane & 31)] * gg; }
    LDS_WAIT(); asm volatile("" ::: "memory");
    const int c = lane & 7;
#pragma unroll
    for (int j = 0; j < 4; ++j) { const int n = (lane >> 3) + 8 * j; const LAS float* s = scr + (8 * c) * 33 + n;
        v4u o; o.x = pk2(s[0 * 33], s[1 * 33]); o.y = pk2(s[2 * 33], s[3 * 33]); o.z = pk2(s[4 * 33], s[5 * 33]); o.w = pk2(s[6 * 33], s[7 * 33]);
        *(GAS v4u*)(WT + (size_t)(drow0 + n) * K + k0 + 8 * c) = o; }
    LDS_WAIT(); asm volatile("" ::: "memory");
}
__device__ __forceinline__ int win_dest_row(int n) {
    if (n < 1024) return n;
    if (n < 2048) { const int ch = n - 1024; return 1024 + (ch >> 7) * 256 + (ch & 127); }
    const int ch = n - 2048; return 1024 + (ch >> 7) * 256 + 128 + (ch & 127);
}

template <int W>
__device__ __forceinline__ void pool_wave(const float* xb  , const LAS float* rs, f32x4 g4, int tA, bf16* pout  , float* poolout  ) {
    f32x4 ring[16]; f32x4 S = {0.f, 0.f, 0.f, 0.f};
#pragma unroll
    for (int i = 16 - W; i < 31; ++i) {
        const int t = tA - 15 + i;
        f32x4 u = {0.f, 0.f, 0.f, 0.f};
        if (t >= 0) { const f32x4 xv = *(const f32x4*)(xb + (size_t)t * D); u = xv * rs[i] * g4; }
        S += u; if (i - W >= 16 - W) S -= ring[(i - W) & 15];
        ring[i & 15] = u;
        if (i >= 15) {
            const int cnt = (t + 1 < W) ? (t + 1) : W; const float ic = 1.0f / (float)cnt;
            const f32x4 p = S * ic - u; v2u o; o.x = pk2(p[0], p[1]); o.y = pk2(p[2], p[3]);
            *(v2u*)(pout + (size_t)t * D) = o;
            if (t >= SEQ - 15) *(f32x4*)(poolout + (size_t)(t - (SEQ - 15)) * D) = u;
        }
    }
}

template <int RT, int CT, class F>
__device__ __forceinline__ void sgemm2(const bf16* A, int lda, int row0, const bf16* Bt, int ldb, const int (&brow)[CT], int K, LAS unsigned char* red, int wave, int lane, const F& f) {
    const int fr = lane & 15, fq = lane >> 4, kw = K >> 3;
    const bf16* ap = A + (size_t)(row0 + fr) * lda + wave * kw + fq * 8;
    const bf16* bp[CT];
#pragma unroll
    for (int ct = 0; ct < CT; ++ct) bp[ct] = Bt + (size_t)(brow[ct] + fr) * ldb + wave * kw + fq * 8;
    f32x4 acc[RT][CT];
#pragma unroll
    for (int rt = 0; rt < RT; ++rt)
#pragma unroll
        for (int ct = 0; ct < CT; ++ct) acc[rt][ct] = (f32x4){0.f, 0.f, 0.f, 0.f};
#pragma unroll 4
    for (int k0 = 0; k0 < kw; k0 += 32) {
        bf16x8 a[RT], b[CT];
#pragma unroll
        for (int rt = 0; rt < RT; ++rt) a[rt] = *(const bf16x8*)(ap + (size_t)rt * 16 * lda + k0);
#pragma unroll
        for (int ct = 0; ct < CT; ++ct) b[ct] = *(const bf16x8*)(bp[ct] + k0);
#pragma unroll
        for (int rt = 0; rt < RT; ++rt)
#pragma unroll
            for (int ct = 0; ct < CT; ++ct) acc[rt][ct] = __builtin_amdgcn_mfma_f32_16x16x32_bf16(b[ct], a[rt], acc[rt][ct], 0, 0, 0);
    }
#pragma unroll
    for (int rt = 0; rt < RT; ++rt)
#pragma unroll
        for (int ct = 0; ct < CT; ++ct) *(LAS f32x4*)(red + ((((wave * RT + rt) * CT + ct) * 64 + lane) << 4)) = acc[rt][ct];
    LDS_WAIT(); __syncthreads();
    if (wave < RT) {
        f32x4 sacc[CT];
#pragma unroll
        for (int ct = 0; ct < CT; ++ct) { f32x4 t = {0.f, 0.f, 0.f, 0.f};
#pragma unroll
            for (int w = 0; w < 8; ++w) t += *(const LAS f32x4*)(red + ((((w * RT + wave) * CT + ct) * 64 + lane) << 4));
            sacc[ct] = t; }
        f(sacc, row0 + 16 * wave + fr, fq);
    }
    __syncthreads();
}
__device__ __forceinline__ float srstd(const float* ssq, int row, int fq) {
    const f32x4* sp = (const f32x4*)(ssq + row * 64 + fq * 16); const f32x4 s = (sp[0] + sp[1]) + (sp[2] + sp[3]); float t = (s[0] + s[1]) + (s[2] + s[3]);
    t = add_x16_x32(t);
    return __builtin_amdgcn_rsqf(t * (1.0f / D) + EPS);
}
__device__ __forceinline__ void s_res_unit(const bf16* A, int lda, const bf16* Bt, int ldb, int K, int u, const float* base32, bf16* xs16, float* ssq, const float* cscale, LAS unsigned char* red, int wave, int lane) {
    const int ctile = u >> 2; const int brow[1] = {16 * ctile};
    sgemm2<2, 1>(A, lda, 32 * (u & 3), Bt, ldb, brow, K, red, wave, lane, [&](f32x4 (&a)[1], int row, int fq) {
        const int c0 = 16 * ctile + 4 * fq; const size_t off = (size_t)row * D + c0;
        f32x4 cs = {1.f, 1.f, 1.f, 1.f}; if (cscale) cs = *(const f32x4*)(cscale + c0);
        f32x4 b; if (base32) b = *(const f32x4*)(base32 + off); else { const v2u w = *(const v2u*)(xs16 + off); b = (f32x4){bflo(w.x), bfhi(w.x), bflo(w.y), bfhi(w.y)}; }
        const f32x4 v = b + a[0] * cs;
        float ss = (v[0] * v[0] + v[1] * v[1]) + (v[2] * v[2] + v[3] * v[3]);
        ss = add_x16_x32(ss);
        if (fq == 0) ssq[row * 64 + ctile] = ss;
        v2u p; p.x = pk2(v[0], v[1]); p.y = pk2(v[2], v[3]); *(v2u*)(xs16 + off) = p; });
}
__device__ __forceinline__ f32x4 relu2(f32x4 v) {
#pragma unroll
    for (int j = 0; j < 4; ++j) { const float a = fmaxf(v[j], 0.f); v[j] = a * a; }
    return v;
}

constexpr int NPHASES = 16;
__global__ void __launch_bounds__(NTHREADS, 2) mk_fwd(Args args) {
    extern __shared__ __attribute__((aligned(16))) unsigned char lds[];
    LAS unsigned char* L = (LAS unsigned char*)lds;
    volatile LAS unsigned* MISC = (volatile LAS unsigned*)(L + MISC_OFF);
    const int wave0 = __builtin_amdgcn_readfirstlane((int)threadIdx.x >> 6);
    const int G = gridDim.x; const int bx = blockIdx.x; const int vcu = (G % 8 == 0) ? (bx % 8) * (G / 8) + bx / 8 : bx;
    for (int u = threadIdx.x; u < (LDS_BYTES - LDSCTL_OFF) / 4; u += NTHREADS) ((LAS unsigned*)(L + LDSCTL_OFF))[u] = 0u;
    __syncthreads();
#if MK_PER_PHASE
    XcdBarrier bar; bar.bar = nullptr; bar.x = 0; bar.st = nullptr;
#define GRID_BAR() do { } while (0)
#else
    XcdBarrier bar = xcd_barrier_post((unsigned*)(args.ws + WS_CTL) + CW_BAR, MISC + 8);
#define GRID_BAR() xcd_barrier(bar, wave0 * 64 + lane_id_opaque())
#endif
    const int lo = args.ph_lo, hi = args.ph_hi;
#define IN(k) (ph == (k))
#define SEAM(k) do { } while (0)
    const int NGW = G * NWAVES;
#define RELANE const int tid = wave0 * 64 + lane_id_opaque(), lane = tid & 63; (void)tid; (void)lane;
#define KA_PTR(T, off) (*(T const __attribute__((address_space(4)))*)(ka + (off)))
#define PH_BEGIN const int tid = wave0 * 64 + lane_id_opaque(), lane = tid & 63, wave = wave0, gw = vcu * NWAVES + wave; (void)lane; (void)gw; \
    const __attribute__((address_space(4))) char* ka = (const __attribute__((address_space(4))) char*)__builtin_amdgcn_kernarg_segment_ptr(); asm volatile("" : "+s"(ka)); \
    unsigned char* const ws = KA_PTR(unsigned char*, 184); float* const out = KA_PTR(float*, 176); (void)ws; (void)out; \
    const float* const x_prompt = KA_PTR(const float*, 0); const float* const x_sample = KA_PTR(const float*, 8); const float* const state_pool = KA_PTR(const float*, 16); const float* const state_conv = KA_PTR(const float*, 24); \
    const float* const cache_k = KA_PTR(const float*, 32); const float* const cache_v = KA_PTR(const float*, 40); const float* const mem_prompt = KA_PTR(const float*, 48); \
    const float* const g_mix = KA_PTR(const float*, 56); const float* const g_attn = KA_PTR(const float*, 64); const float* const g_mem = KA_PTR(const float*, 72); const float* const g_ffn = KA_PTR(const float*, 80); const float* const g_final = KA_PTR(const float*, 88); \
    const float* const w_pool = KA_PTR(const float*, 96); const float* const pool_scale = KA_PTR(const float*, 104); const float* const w_conv_in = KA_PTR(const float*, 112); const float* const w_conv = KA_PTR(const float*, 120); const float* const w_conv_out = KA_PTR(const float*, 128); \
    const float* const w_q = KA_PTR(const float*, 136); const float* const w_kv = KA_PTR(const float*, 144); const float* const w_o = KA_PTR(const float*, 152); const float* const w_up = KA_PTR(const float*, 160); const float* const w_down = KA_PTR(const float*, 168); \
    (void)x_prompt; (void)x_sample; (void)state_pool; (void)state_conv; (void)cache_k; (void)cache_v; (void)mem_prompt; (void)g_mix; (void)g_attn; (void)g_mem; (void)g_ffn; (void)g_final; (void)w_pool; (void)pool_scale; (void)w_conv_in; (void)w_conv; (void)w_conv_out; (void)w_q; (void)w_kv; (void)w_o; (void)w_up; (void)w_down; \
    bf16* const WPOOL = (bf16*)(ws + WS_WPOOL); bf16* const WQ = (bf16*)(ws + WS_WQ); bf16* const WO = (bf16*)(ws + WS_WO); bf16* const WKV = (bf16*)(ws + WS_WKV); \
    bf16* const WUP = (bf16*)(ws + WS_WUP); bf16* const WDN = (bf16*)(ws + WS_WDN); bf16* const WIN = (bf16*)(ws + WS_WIN); bf16* const WOUT = (bf16*)(ws + WS_WOUT); \
    bf16* const MN = (bf16*)(ws + WS_MN); bf16* const KB = (bf16*)(ws + WS_KB); bf16* const VT = (bf16*)(ws + WS_VT); float* const SSQ = (float*)(ws + WS_SSQ); \
    bf16* const X16 = (bf16*)(ws + WS_X); bf16* const P0 = (bf16*)(ws + WS_P0); bf16* const OB = (bf16*)(ws + WS_O); bf16* const CH = (bf16*)(ws + WS_CH); \
    bf16* const PS = (bf16*)(ws + WS_PS); bf16* const HB = (bf16*)(ws + WS_H); \
    bf16* const XS16 = (bf16*)(ws + SS_X); float* const SSQS = (float*)(ws + SS_SSQ); bf16* const P0S = (bf16*)(ws + SS_P0); bf16* const OS = (bf16*)(ws + SS_O); \
    float* const CHS = (float*)(ws + SS_CH); bf16* const HS = (bf16*)(ws + SS_H); \
    (void)WPOOL; (void)WQ; (void)WO; (void)WKV; (void)WUP; (void)WDN; (void)WIN; (void)WOUT; (void)MN; (void)KB; (void)VT; (void)SSQ; (void)X16; (void)P0; (void)OB; (void)CH; (void)PS; (void)HB; (void)XS16; (void)SSQS; (void)P0S; (void)OS; (void)CHS; (void)HS;

#pragma unroll 1
    for (int ph = lo; ph < hi; ++ph) {
    if (IN(0)) { PH_BEGIN
        LAS float* scr = (LAS float*)(L + RING_OFF + wave * 16384);
        {
            constexpr int I_POOL = 4 * 4 * 8, I_Q = 16 * 32, I_KV = 16 * 64, I_UP = 16 * 128, I_DN = 64 * 32, I_IN = 16 * 96;
            constexpr int NITEMS = I_POOL + 2 * (I_Q + I_KV + I_Q + I_UP + I_DN) + I_IN + I_Q;
            for (int it = gw; it < NITEMS; it += NGW) {
                int r = it;
                if (r < I_POOL) { const int g = r >> 5, rr = r & 31, kb = rr >> 3, nb = rr & 7; p0_transpose_item(w_pool + g * 65536, 256, 256, WPOOL + g * 65536, 64 * kb, 32 * nb, 32 * nb, scr, lane); continue; } r -= I_POOL;
                bool done = false;
#pragma unroll 1
                for (int l = 0; l < 2 && !done; ++l) {
                    if (r < I_Q) { const int kb = r >> 5, nb = r & 31; p0_transpose_item(w_q + (size_t)l * D * D, D, D, WQ + (size_t)l * D * D, 64 * kb, 32 * nb, 32 * nb, scr, lane, g_attn + l * D); done = true; break; } r -= I_Q;
                    if (r < I_KV) { const int kb = r >> 6, nb = r & 63; p0_transpose_item(w_kv + (size_t)l * D * 2048, D, 2048, WKV + (size_t)l * 2048 * D, 64 * kb, 32 * nb, 32 * nb, scr, lane); done = true; break; } r -= I_KV;
                    if (r < I_Q) { const int kb = r >> 5, nb = r & 31; p0_transpose_item(w_o + (size_t)l * D * D, D, D, WO + (size_t)l * D * D, 64 * kb, 32 * nb, 32 * nb, scr, lane); done = true; break; } r -= I_Q;
                    if (r < I_UP) { const int kb = r >> 7, nb = r & 127; p0_transpose_item(w_up + (size_t)l * D * FF, D, FF, WUP + (size_t)l * FF * D, 64 * kb, 32 * nb, 32 * nb, scr, lane, g_ffn + l * D); done = true; break; } r -= I_UP;
                    if (r < I_DN) { const int kb = r >> 5, nb = r & 31; p0_transpose_item(w_down + (size_t)l * FF * D, FF, D, WDN + (size_t)l * D * FF, 64 * kb, 32 * nb, 32 * nb, scr, lane); done = true; break; } r -= I_DN;
                }
                if (done) continue;
                if (r < I_IN) { const int kb = r / 96, nb = r % 96; p0_transpose_item(w_conv_in, D, 3072, WIN, 64 * kb, 32 * nb, win_dest_row(32 * nb), scr, lane, g_mix + D); continue; } r -= I_IN;
                { const int kb = r >> 5, nb = r & 31; p0_transpose_item(w_conv_out, D, D, WOUT, 64 * kb, 32 * nb, 32 * nb, scr, lane); }
            }
        }
        for (int m = gw; m < MEMROWS; m += NGW) {
            const f32x4* xr = (const f32x4*)(mem_prompt + (size_t)m * D) + lane; f32x4 v[4]; float s = 0.f;
#pragma unroll
            for (int j = 0; j < 4; ++j) { v[j] = xr[64 * j]; s += (v[j][0] * v[j][0] + v[j][1] * v[j][1]) + (v[j][2] * v[j][2] + v[j][3] * v[j][3]); }
            const float rstd = __builtin_amdgcn_rsqf(wave_sum(s) * (1.f / D) + EPS);
#pragma unroll
            for (int l = 0; l < 2; ++l) { v2u* o8 = (v2u*)(MN + ((size_t)l * MEMROWS + m) * D) + lane;
#pragma unroll
                for (int j = 0; j < 4; ++j) { const f32x4 gg = *((const f32x4*)(g_mem + l * D) + lane + 64 * j); const f32x4 w = v[j] * rstd * gg; v2u o; o.x = pk2(w[0], w[1]); o.y = pk2(w[2], w[3]); o8[64 * j] = o; } }
        }
        for (int it = gw; it < MS * 4; it += NGW) {
            const int b = it >> 2, g = it & 3, c4 = g * 256 + lane * 4;
            const f32x4* xr = (const f32x4*)(x_sample + (size_t)b * D) + lane; float s = 0.f;
#pragma unroll
            for (int j = 0; j < 4; ++j) { const f32x4 v = xr[64 * j]; s += (v[0] * v[0] + v[1] * v[1]) + (v[2] * v[2] + v[3] * v[3]); }
            const float rstd = __builtin_amdgcn_rsqf(wave_sum(s) * (1.f / D) + EPS);
            const f32x4 u = *(const f32x4*)(x_sample + (size_t)b * D + c4) * rstd * *(const f32x4*)(g_mix + c4);
            const int W = 2 << g; f32x4 S = u;
            const float* sp = state_pool + (size_t)b * 15 * D + c4;
            float* po = out + OPS + (size_t)b * 15 * D + c4;
            for (int r = 0; r < 15; ++r) { const f32x4 sv = *(const f32x4*)(sp + (size_t)r * D); if (r >= 16 - W) S += sv; if (r >= 1) *(f32x4*)(po + (size_t)(r - 1) * D) = sv; }
            *(f32x4*)(po + (size_t)14 * D) = u;
            const f32x4 p = S * (1.0f / (float)W) - u; v2u o; o.x = pk2(p[0], p[1]); o.y = pk2(p[2], p[3]); *(v2u*)(P0S + (size_t)b * D + c4) = o;
        }
        __syncthreads();
        {
            LAS float* rs = (LAS float*)(L + RING_OFF);
            for (int it = vcu; it < BATCH * (SEQ / 32); it += G) {
                const int b = it >> 6, t0 = (it & 63) * 32;
                for (int r = wave; r < 47; r += NWAVES) { const int t = t0 - 15 + r; float rv = 0.f;
                    if (t >= 0) { const f32x4* xr = (const f32x4*)(x_prompt + ((size_t)b * SEQ + t) * D) + lane; float s = 0.f;
#pragma unroll
                        for (int j = 0; j < 4; ++j) { const f32x4 v = xr[64 * j]; s += (v[0] * v[0] + v[1] * v[1]) + (v[2] * v[2] + v[3] * v[3]); }
                        rv = __builtin_amdgcn_rsqf(wave_sum(s) * (1.f / D) + EPS); }
                    if (lane == 0) rs[r] = rv; }
                LDS_WAIT(); __syncthreads();
                const int g = wave & 3, tA = t0 + (wave >> 2) * 16, c4 = g * 256 + lane * 4;
                const float* xb = x_prompt + (size_t)b * SEQ * D + c4; const f32x4 g4 = *(const f32x4*)(g_mix + c4);
                bf16* pout = P0 + (size_t)b * SEQ * D + c4; float* poolout = out + OPP + (size_t)b * 15 * D + c4;
                const LAS float* rsw = rs + (wave >> 2) * 16;
                if (g == 0) pool_wave<2>(xb, rsw, g4, tA, pout, poolout); else if (g == 1) pool_wave<4>(xb, rsw, g4, tA, pout, poolout);
                else if (g == 2) pool_wave<8>(xb, rsw, g4, tA, pout, poolout); else pool_wave<16>(xb, rsw, g4, tA, pout, poolout);
                __syncthreads();
            }
        }
    }
    SEAM(0);

    if (IN(1)) { PH_BEGIN
        { pg8::Gemm g{D, D, D}; pg8::KvOrder S{G, bx, (const char*)MN, (const char*)WKV};
          pg8::EpiKV E{out + OMK, out + OMV, KB, VT};
          pg8::gemm_phase<pg8::EpiKV, pg8::KvOrder, true>(L + RING_OFF, g, S, E, tid); }
        { pg8::Gemm g{D, 256, 256}; pg8::StaticOrder S;
          if (G == 256) S.init(MP / 256, 4, 128, bx >= 128 ? bx - 128 : 1 << 20, P0, (size_t)256 * D * 2, WPOOL, (size_t)65536 * 2, (size_t)256 * 2);
          else S.init(MP / 256, 4, G, bx, P0, (size_t)256 * D * 2, WPOOL, (size_t)65536 * 2, (size_t)256 * 2);
          pg8::EpiRes<true> E{x_prompt, X16, SSQ, pool_scale};
          pg8::gemm_phase<pg8::EpiRes<true>, pg8::StaticOrder, true>(L + RING_OFF, g, S, E, tid); }
        { RELANE for (int u = vcu; u < 256; u += G) s_res_unit(P0S + (u >> 6) * 256, D, WPOOL, 256, 256, u, x_sample, XS16, SSQS, pool_scale, L + RING_OFF, wave, lane); }
    }
    SEAM(1);

    {
        const int l = (ph >= 7) ? 1 : 0, pb = l ? 10 : 2;
        {
            if (IN(7)) { PH_BEGIN
                { pg8::Gemm g{D, D, D}; pg8::StaticOrder S; S.init(MP / 256, 12, G, bx, X16, (size_t)256 * D * 2, WIN, (size_t)256 * D * 2);
                  pg8::EpiRow<2> E{OB, D, SSQ, 1.f, CH, out + OCP};
                  pg8::gemm_phase<pg8::EpiRow<2>, pg8::StaticOrder, true>(L + RING_OFF, g, S, E, tid); }
                { RELANE
                for (int u = vcu; u < 256; u += G) {
                    if (u < 128) { const int ctile = u >> 1; const int brow[1] = {16 * ctile};
                        sgemm2<4, 1>(XS16, D, 64 * (u & 1), WIN, D, brow, D, L + RING_OFF, wave, lane, [&](f32x4 (&a)[1], int row, int fq) {
                            const float rs = srstd(SSQS, row, fq); const f32x4 v = a[0] * rs; v2u p; p.x = pk2(v[0], v[1]); p.y = pk2(v[2], v[3]);
                            *(v2u*)(OS + (size_t)row * D + 16 * ctile + 4 * fq) = p; }); }
                    else { const int c0 = ((u - 128) >> 1) * 16; const int r0 = 1024 + (c0 >> 7) * 256 + (c0 & 127); const int brow[2] = {r0, r0 + 128};
                        sgemm2<4, 2>(XS16, D, 64 * (u & 1), WIN, D, brow, D, L + RING_OFF, wave, lane, [&](f32x4 (&a)[2], int row, int fq) {
                            const float rs = srstd(SSQS, row, fq); const f32x4 v = a[0] * a[1] * (rs * rs);
                            *(f32x4*)(CHS + (size_t)row * D + c0 + 4 * fq) = v; *(f32x4*)(out + OCS + ((size_t)row * 2 + 1) * D + c0 + 4 * fq) = v; }); }
                }
                }
            }
            SEAM(7);
            if (IN(8)) { PH_BEGIN
                const int gt = vcu * NTHREADS + tid, NT = G * NTHREADS;
                for (int idx = gt; idx < MP * 128; idx += NT) {
                    const int row = idx >> 7, c8 = (idx & 127) * 8, t = row & (SEQ - 1);
                    const v4u gb = *(const v4u*)(OB + (size_t)row * D + c8); const v4u c2 = *(const v4u*)(CH + (size_t)row * D + c8);
                    v4u c1 = {0u, 0u, 0u, 0u}, c0 = {0u, 0u, 0u, 0u};
                    if (t >= 1) c1 = *(const v4u*)(CH + (size_t)(row - 1) * D + c8);
                    if (t >= 2) c0 = *(const v4u*)(CH + (size_t)(row - 2) * D + c8);
                    const f32x4 w0a = *(const f32x4*)(w_conv + c8), w0b = *(const f32x4*)(w_conv + c8 + 4), w1a = *(const f32x4*)(w_conv + D + c8), w1b = *(const f32x4*)(w_conv + D + c8 + 4),
                                w2a = *(const f32x4*)(w_conv + 2 * D + c8), w2b = *(const f32x4*)(w_conv + 2 * D + c8 + 4);
                    v4u o;
#pragma unroll
                    for (int j = 0; j < 4; ++j) { const float wl0 = (j < 2) ? w0a[2 * j] : w0b[2 * j - 4], wh0 = (j < 2) ? w0a[2 * j + 1] : w0b[2 * j - 3];
                        const float wl1 = (j < 2) ? w1a[2 * j] : w1b[2 * j - 4], wh1 = (j < 2) ? w1a[2 * j + 1] : w1b[2 * j - 3];
                        const float wl2 = (j < 2) ? w2a[2 * j] : w2b[2 * j - 4], wh2 = (j < 2) ? w2a[2 * j + 1] : w2b[2 * j - 3];
                        const float lo_ = bflo(gb[j]) * (bflo(c0[j]) * wl0 + bflo(c1[j]) * wl1 + bflo(c2[j]) * wl2);
                        const float hi_ = bfhi(gb[j]) * (bfhi(c0[j]) * wh0 + bfhi(c1[j]) * wh1 + bfhi(c2[j]) * wh2);
                        o[j] = pk2(lo_, hi_); }
                    *(v4u*)(P0 + (size_t)row * D + c8) = o;
                }
                for (int idx = gt; idx < MS * 256; idx += NT) {
                    const int b = idx >> 8, c4 = (idx & 255) * 4;
                    const f32x4 s0 = *(const f32x4*)(state_conv + ((size_t)b * 2 + 0) * D + c4), s1 = *(const f32x4*)(state_conv + ((size_t)b * 2 + 1) * D + c4), chv = *(const f32x4*)(CHS + (size_t)b * D + c4);
                    const f32x4 cv = s0 * *(const f32x4*)(w_conv + c4) + s1 * *(const f32x4*)(w_conv + D + c4) + chv * *(const f32x4*)(w_conv + 2 * D + c4);
                    const v2u gbw = *(const v2u*)(OS + (size_t)b * D + c4);
                    v2u o; o.x = pk2(bflo(gbw.x) * cv[0], bfhi(gbw.x) * cv[1]); o.y = pk2(bflo(gbw.y) * cv[2], bfhi(gbw.y) * cv[3]);
                    *(v2u*)(P0S + (size_t)b * D + c4) = o;
                    *(f32x4*)(out + OCS + ((size_t)b * 2 + 0) * D + c4) = s1;
                }
            }
            SEAM(8);
            if (IN(9)) { PH_BEGIN
                { pg8::Gemm g{D, D, D}; pg8::StaticOrder S; S.init(MP / 256, 4, G, bx, P0, (size_t)256 * D * 2, WOUT, (size_t)256 * D * 2);
                  pg8::EpiRes<false> E{nullptr, X16, SSQ, nullptr};
                  pg8::gemm_phase<pg8::EpiRes<false>, pg8::StaticOrder, true>(L + RING_OFF, g, S, E, tid); }
                { RELANE for (int u = vcu; u < 256; u += G) s_res_unit(P0S, D, WOUT, D, D, u, nullptr, XS16, SSQS, nullptr, L + RING_OFF, wave, lane); }
            }
            SEAM(9);
        }
#define LAYER_W const bf16* WQl = WQ + (size_t)l * D * D; const bf16* WOl = WO + (size_t)l * D * D; const bf16* WUPl = WUP + (size_t)l * FF * D; const bf16* WDNl = WDN + (size_t)l * D * FF; (void)WQl; (void)WOl; (void)WUPl; (void)WDNl;
        if (IN(pb)) { PH_BEGIN LAYER_W
            { pg8::Gemm g{D, D, D}; pg8::StaticOrder S; S.init(MP / 256, 4, G, bx, X16, (size_t)256 * D * 2, WQl, (size_t)256 * D * 2);
              pg8::EpiRow<0> E{P0, D, SSQ, QSCALE, nullptr, nullptr};
              pg8::gemm_phase<pg8::EpiRow<0>, pg8::StaticOrder, true>(L + RING_OFF, g, S, E, tid); }
            { RELANE for (int u = vcu; u < 256; u += G) { const int ctile = u >> 2; const int brow[1] = {16 * ctile};
                sgemm2<2, 1>(XS16, D, 32 * (u & 3), WQl, D, brow, D, L + RING_OFF, wave, lane, [&](f32x4 (&a)[1], int row, int fq) {
                    const float rs = srstd(SSQS, row, fq); const f32x4 v = a[0] * (rs * QSCALE); v2u p; p.x = pk2(v[0], v[1]); p.y = pk2(v[2], v[3]);
                    *(v2u*)(P0S + (size_t)row * D + 16 * ctile + 4 * fq) = p; }); } }
        }
        SEAM(pb);
        if (IN(pb + 1)) { PH_BEGIN LAYER_W
            for (int it = bx; it < 256; it += G) {
                const int pm = it >> 2, h = it & 3, b = pm >> 3;
                bf16* Pu = PS + (size_t)it * 65536;
                { pg8::Gemm g{D, D, 256}; pg8::SingleOrder S{{pm, h}, (const char*)(P0 + (size_t)pm * 256 * D + h * 256), (const char*)(KB + ((size_t)l * MEMROWS + b * 256) * D + h * 256)};
                  pg8::EpiSoftmax E{Pu};
                  pg8::gemm_phase<pg8::EpiSoftmax, pg8::SingleOrder, false>(L + RING_OFF, g, S, E, tid); }
                VM_WAIT(); __syncthreads();
                { pg8::Gemm g{256, 256, 256}; pg8::SingleOrder S{{pm, h}, (const char*)Pu, (const char*)(VT + ((size_t)(l * BATCH + b) * D + h * 256) * NMEM)};
                  pg8::EpiBf16 E{OB, D};
                  pg8::gemm_phase<pg8::EpiBf16, pg8::SingleOrder, true>(L + RING_OFF, g, S, E, tid); }
                __syncthreads();
            }
            { RELANE
                LAS float* sc = (LAS float*)(L + RING_OFF);
                LAS float* po = (LAS float*)(L + RING_OFF + 1024);
                for (int it = vcu; it < MS * NH; it += G) {
                    const int b = it >> 2, h = it & 3;
                    const v2u qw = *(const v2u*)(P0S + (size_t)b * D + h * 256 + lane * 4);
                    const f32x4 q4 = {bflo(qw.x), bfhi(qw.x), bflo(qw.y), bfhi(qw.y)};
                    const float* kp = cache_k + (((size_t)l * MS + b) * NMEM + wave * 32) * D + h * 256 + lane * 4;
                    const float* vp = cache_v + (((size_t)l * MS + b) * NMEM + wave * 32) * D + h * 256 + lane * 4;
                    float p[32];
#pragma unroll
                    for (int n = 0; n < 32; ++n) { const f32x4 kv = *(const f32x4*)(kp + (size_t)n * D); p[n] = (q4[0] * kv[0] + q4[1] * kv[1]) + (q4[2] * kv[2] + q4[3] * kv[3]); }
#pragma unroll
                    for (int i = 0; i < 16; ++i) { swap32(p[i], p[i + 16]); p[i] += p[i + 16]; }
                    { const bool b4 = (lane & 16) != 0;
#pragma unroll
                      for (int i = 0; i < 8; ++i) { const float keep = b4 ? p[i + 8] : p[i], send = b4 ? p[i] : p[i + 8]; p[i] = keep + SWZ_XOR(send, 16); } }
                    { const bool b3 = (lane & 8) != 0;
#pragma unroll
                      for (int i = 0; i < 4; ++i) { const float keep = b3 ? p[i + 4] : p[i], send = b3 ? p[i] : p[i + 4]; p[i] = keep + SWZ_XOR(send, 8); } }
                    { const bool b2 = (lane & 4) != 0;
#pragma unroll
                      for (int i = 0; i < 2; ++i) { const float keep = b2 ? p[i + 2] : p[i], send = b2 ? p[i] : p[i + 2]; p[i] = keep + SWZ_XOR(send, 4); } }
                    { const bool b1 = (lane & 2) != 0; const float keep = b1 ? p[1] : p[0], send = b1 ? p[0] : p[1]; p[0] = keep + SWZ_XOR(send, 2); }
                    p[0] += SWZ_XOR(p[0], 1);
                    if ((lane & 1) == 0) sc[wave * 32 + (lane >> 1)] = p[0];
                    LDS_WAIT(); __syncthreads();
                    float mx = -3.0e38f, sm = 0.f; f32x4 sv = *(const LAS f32x4*)(sc + lane * 4);
                    mx = fmaxf(fmaxf(sv[0], sv[1]), fmaxf(sv[2], sv[3]));
                    mx = wave_max(mx);
#pragma unroll
                    for (int j = 0; j < 4; ++j) sm += __builtin_amdgcn_exp2f(sv[j] - mx);
                    sm = wave_sum(sm);
                    f32x4 acc = {0.f, 0.f, 0.f, 0.f};
#pragma unroll 8
                    for (int n = 0; n < 32; ++n) { const float p = __builtin_amdgcn_exp2f(sc[wave * 32 + n] - mx); const f32x4 vv = *(const f32x4*)(vp + (size_t)n * D); acc += vv * p; }
                    *(LAS f32x4*)(po + wave * 256 + lane * 4) = acc;
                    LDS_WAIT(); __syncthreads();
                    if (tid < 256) { float o = 0.f;
#pragma unroll
                        for (int w = 0; w < 8; ++w) o += po[w * 256 + tid];
                        OS[(size_t)b * D + h * 256 + tid] = (bf16)f2bf(o / sm); }
                    __syncthreads();
                }
            }
        }
        SEAM(pb + 1);
        if (IN(pb + 2)) { PH_BEGIN LAYER_W
            { pg8::Gemm g{D, D, D}; pg8::StaticOrder S; S.init(MP / 256, 4, G, bx, OB, (size_t)256 * D * 2, WOl, (size_t)256 * D * 2);
              pg8::EpiRes<false> E{nullptr, X16, SSQ, nullptr};
              pg8::gemm_phase<pg8::EpiRes<false>, pg8::StaticOrder, true>(L + RING_OFF, g, S, E, tid); }
            { RELANE for (int u = vcu; u < 256; u += G) s_res_unit(OS, D, WOl, D, D, u, nullptr, XS16, SSQS, nullptr, L + RING_OFF, wave, lane); }
        }
        SEAM(pb + 2);
        if (IN(pb + 3)) { PH_BEGIN LAYER_W
            { pg8::Gemm g{D, D, D}; pg8::StaticOrder S; S.init(MP / 256, 16, G, bx, X16, (size_t)256 * D * 2, WUPl, (size_t)256 * D * 2);
              pg8::EpiRow<1> E{HB, FF, SSQ, 1.f, nullptr, nullptr};
              pg8::gemm_phase<pg8::EpiRow<1>, pg8::StaticOrder, true>(L + RING_OFF, g, S, E, tid); }
            { RELANE for (int u = vcu; u < 256; u += G) { const int cp = u >> 1; const int brow[2] = {32 * cp, 32 * cp + 16};
                sgemm2<4, 2>(XS16, D, 64 * (u & 1), WUPl, D, brow, D, L + RING_OFF, wave, lane, [&](f32x4 (&a)[2], int row, int fq) {
                    const float rs = srstd(SSQS, row, fq); const f32x4 v0 = relu2(a[0] * rs), v1 = relu2(a[1] * rs);
                    v2u p0, p1; p0.x = pk2(v0[0], v0[1]); p0.y = pk2(v0[2], v0[3]); p1.x = pk2(v1[0], v1[1]); p1.y = pk2(v1[2], v1[3]);
                    bf16* op = HS + (size_t)row * FF + 32 * cp + 4 * fq; *(v2u*)op = p0; *(v2u*)(op + 16) = p1; }); } }
        }
        SEAM(pb + 3);
        if (IN(pb + 4)) { PH_BEGIN LAYER_W
            { pg8::Gemm g{FF, FF, FF}; pg8::StaticOrder S; S.init(MP / 256, 4, G, bx, HB, (size_t)256 * FF * 2, WDNl, (size_t)256 * FF * 2);
              pg8::EpiRes<false> E{nullptr, X16, SSQ, nullptr};
              pg8::gemm_phase<pg8::EpiRes<false>, pg8::StaticOrder, true>(L + RING_OFF, g, S, E, tid); }
            { RELANE for (int u = vcu; u < 256; u += G) s_res_unit(HS, FF, WDNl, FF, FF, u, nullptr, XS16, SSQS, nullptr, L + RING_OFF, wave, lane); }
        }
        SEAM(pb + 4);
    }
    if (IN(15)) { PH_BEGIN
        for (int m = gw; m < MP + MS; m += NGW) {
            float rs; float* yr; const bf16* xr;
            if (m < MP) { const float v = (lane < 16) ? SSQ[(size_t)m * 16 + lane] : 0.f; rs = __builtin_amdgcn_rsqf(wave_sum(v) * (1.f / D) + EPS); yr = out + OY + (size_t)m * D; xr = X16 + (size_t)m * D; }
            else { const int r = m - MP; const float v = SSQS[r * 64 + lane]; rs = __builtin_amdgcn_rsqf(wave_sum(v) * (1.f / D) + EPS); yr = out + OYS + (size_t)r * D; xr = XS16 + (size_t)r * D; }
#pragma unroll
            for (int j = 0; j < 2; ++j) { const v4u w = *((const v4u*)xr + lane + 64 * j); const f32x4 g0 = *((const f32x4*)g_final + 2 * (lane + 64 * j)), g1 = *((const f32x4*)g_final + 2 * (lane + 64 * j) + 1);
                const f32x4 x0 = {bflo(w.x), bfhi(w.x), bflo(w.y), bfhi(w.y)}, x1 = {bflo(w.z), bfhi(w.z), bflo(w.w), bfhi(w.w)};
                f32x4* yp = (f32x4*)yr + 2 * (lane + 64 * j); yp[0] = x0 * rs * g0; yp[1] = x1 * rs * g1; }
        }
    }
#if defined(DBG_SCALE_MASK)
    if (IN(15)) { PH_BEGIN
        __syncthreads();
        const size_t obeg[9] = {OY, OYS, OPP, OCP, OMK, OMV, OPS, OCS, 27664384};
        const size_t gt = (size_t)vcu * NTHREADS + tid, NT = (size_t)G * NTHREADS;
#pragma unroll 1
        for (int k = 2; k < 8; ++k) if ((DBG_SCALE_MASK >> k) & 1) for (size_t i = obeg[k] + gt; i < obeg[k + 1]; i += NT) out[i] *= 0.8f;
    }
#endif
    if (ph + 1 < hi) GRID_BAR();
    }
#undef IN
#undef SEAM
#undef GRID_BAR
}

extern "C" void kernel_launch(void* const* d_in, const int* in_sizes, int n_in, void* d_out, int out_size, void* d_ws, size_t ws_size, hipStream_t stream) {
    static int grid = 0;
    if (grid == 0) {
        if (n_in != 22 || ws_size < WS_END) { fprintf(stderr, "kernel_launch: unexpected inputs (n_in %d, ws %zu)\n", n_in, ws_size); grid = -1; return; }
        int dev = 0, cus = 0, per_cu = 0;
        if (hipGetDevice(&dev) != hipSuccess || hipDeviceGetAttribute(&cus, hipDeviceAttributeMultiprocessorCount, dev) != hipSuccess) { grid = -1; return; }
        if (hipFuncSetAttribute((const void*)mk_fwd, hipFuncAttributeMaxDynamicSharedMemorySize, LDS_BYTES) != hipSuccess) { fprintf(stderr, "kernel_launch: hipFuncSetAttribute failed\n"); grid = -1; return; }
        if (hipOccupancyMaxActiveBlocksPerMultiprocessor(&per_cu, (const void*)mk_fwd, NTHREADS, LDS_BYTES) != hipSuccess || per_cu < 1)
            fprintf(stderr, "kernel_launch: note: occupancy query reports %d workgroups per CU\n", per_cu);
        (void)hipGetLastError();
        grid = cus;
    }
    if (grid < 0) return;
    (void)hipMemsetAsync((char*)d_ws + WS_CTL, 0, CTL_ZERO_BYTES, stream);
    Args a{};
    for (int i = 0; i < 22; ++i) a.in[i] = (const float*)d_in[i];
    a.out = (float*)d_out; a.ws = (unsigned char*)d_ws;
#if MK_PER_PHASE
    for (int p = 0; p < NPHASES; ++p) { a.ph_lo = p; a.ph_hi = p + 1; hipLaunchKernelGGL(mk_fwd, dim3(grid), dim3(NTHREADS), LDS_BYTES, stream, a); }
#else
    a.ph_lo = 0; a.ph_hi = NPHASES; hipLaunchKernelGGL(mk_fwd, dim3(grid), dim3(NTHREADS), LDS_BYTES, stream, a);
#endif
}
```

```cpp
#include <hip/hip_runtime.h>
#include <cstdio>
#include <cstdint>

#ifndef SAMPLE_SHIFT
#define SAMPLE_SHIFT 1
#endif
#ifndef MEMBER_FLIP
#define MEMBER_FLIP 1
#endif
#ifndef MEMBER_FLIP_SEL
#define MEMBER_FLIP_SEL (mi & 1)
#endif
#ifndef STAGGER_TICKS
#define STAGGER_TICKS 0
#endif
#ifndef MK_PER_PHASE
#define MK_PER_PHASE 0
#endif

constexpr int D = 1024, BATCH = 8, SEQ = 2048, MP = BATCH * SEQ  , MS = 128  ;
constexpr int NMEM = 256, NH = 4, HD = 256, FF = 4096, MEMROWS = BATCH * NMEM  ;
constexpr float EPS = 1e-6f;
constexpr float QSCALE = 0.0625f * 1.4426950408889634f;

constexpr size_t OY = 0, OYS = 16777216, OPP = 16908288, OCP = 17031168, OMK = 17047552, OMV = 21241856, OPS = 25436160, OCS = 27402240;

__device__ __forceinline__ int lane_id_opaque() { int l; asm volatile("v_mbcnt_lo_u32_b32 %0, -1, 0\n\tv_mbcnt_hi_u32_b32 %0, -1, %0" : "=v"(l)); return l; }
#define SWZ_XOR(v, m) __builtin_bit_cast(float, __builtin_amdgcn_ds_swizzle(__builtin_bit_cast(int, (float)(v)), (((m) << 10) | 0x1f)))
__device__ __forceinline__ void swap32(float& a, float& b) { asm volatile("s_nop 1\n\tv_permlane32_swap_b32 %0, %1\n\ts_nop 1" : "+v"(a), "+v"(b)); }
__device__ __forceinline__ float add_x32(float v) { float a = v, b = v; swap32(a, b); return a + b; }
__device__ __forceinline__ float max_x32(float v) { float a = v, b = v; swap32(a, b); return fmaxf(a, b); }
__device__ __forceinline__ float add_x16_x32(float v) { v += SWZ_XOR(v, 16); return add_x32(v); }
__device__ __forceinline__ float max_x16_x32(float v) { v = fmaxf(v, SWZ_XOR(v, 16)); return max_x32(v); }
__device__ __forceinline__ float wave_sum(float v) { v += SWZ_XOR(v, 1); v += SWZ_XOR(v, 2); v += SWZ_XOR(v, 4); v += SWZ_XOR(v, 8); v += SWZ_XOR(v, 16); return add_x32(v); }
__device__ __forceinline__ float wave_max(float v) { v = fmaxf(v, SWZ_XOR(v, 1)); v = fmaxf(v, SWZ_XOR(v, 2)); v = fmaxf(v, SWZ_XOR(v, 4)); v = fmaxf(v, SWZ_XOR(v, 8)); v = fmaxf(v, SWZ_XOR(v, 16)); return max_x32(v); }

namespace pg8 {
#define PG8_LAS __attribute__((address_space(3)))
typedef unsigned short bf16_t;
typedef short bf16x8 __attribute__((ext_vector_type(8)));
typedef float f32x4 __attribute__((ext_vector_type(4)));
typedef float f32x2 __attribute__((ext_vector_type(2)));
typedef unsigned u32x4 __attribute__((ext_vector_type(4)));
typedef unsigned u32x2 __attribute__((ext_vector_type(2)));
constexpr int BM = 256, BK = 64, HALF = 128, HTB = HALF * BK * 2, STAGE_BYTES = 8 * HTB, NXCD = 8, WGM = 8;

__host__ __device__ __forceinline__ int lds_byte(int r, int c) { const int st = (r >> 4) * 2 + (c >> 5), rr = r & 15, cc = c & 31, ob = rr * 64 + cc * 2; return st * 1024 + (ob ^ (((ob >> 9) & 1) << 5)); }
__host__ __device__ __forceinline__ void stage_rc(int b, int& R, int& C) { const int st = b / 1024, sb = b % 1024, swz = sb ^ (((sb >> 9) & 1) << 5); R = (st >> 1) * 16 + swz / 64; C = (st & 1) * 32 + (swz % 64) / 2; }
__host__ __device__ __forceinline__ int perm32(int rho) { const int n = rho >> 4, i = rho & 15; return 8 * (i >> 2) + 4 * n + (i & 3); }

struct Unit { int pm, pn; };
struct Gemm { int lda, ldb, K; };

__device__ __forceinline__ unsigned cvt_pk_bf16(float lo, float hi) { unsigned r; asm volatile("v_cvt_pk_bf16_f32 %0, %1, %2" : "=v"(r) : "v"(lo), "v"(hi)); return r; }

struct StaticOrder {
    int nM, nN, nwg, G, c, pm0;
    const char* A; const char* B; size_t astep, bstep, apn;
    __device__ void init(int nM_, int nN_, int G_, int c_, int pm0_, const void* A_, size_t astep_, const void* B_, size_t bstep_, size_t apn_ = 0) {
        nM = nM_; nN = nN_; nwg = nM * nN; G = G_; c = c_; pm0 = pm0_; A = (const char*)A_; B = (const char*)B_; astep = astep_; bstep = bstep_; apn = apn_; }
    __device__ bool next(int i, Unit& u) const {
        const long L = (long)i * G + c; if (L >= nwg) return false;
        u.pm = pm0 + (int)(L % nM); u.pn = (int)(L / nM); return true;
    }
    __device__ __forceinline__ const char* aptr(const Unit& u) const { return A + (size_t)u.pm * astep + (size_t)u.pn * apn; }
    __device__ __forceinline__ const char* bptr(const Unit& u) const { return B + (size_t)u.pn * bstep; }
};
struct KvOrder {
    int G, c, batch; const char* A; const char* B;
    __device__ bool next(int i, Unit& u) const { const int L = i * G + c; if (L >= 16) return false; u.pm = (L >> 3) * 8 + batch; u.pn = L & 7; return true; }
    __device__ __forceinline__ const char* aptr(const Unit& u) const { return A + (size_t)u.pm * (256 * 1024 * 2); }
    __device__ __forceinline__ const char* bptr(const Unit& u) const { return B + (size_t)((u.pm >> 3) * 2048 + u.pn * 256) * (1024 * 2); }
};
struct SingleOrder {
    Unit u0; const char* A; const char* B;
    __device__ bool next(int i, Unit& u) const { if (i) return false; u = u0; return true; }
    __device__ __forceinline__ const char* aptr(const Unit&) const { return A; }
    __device__ __forceinline__ const char* bptr(const Unit&) const { return B; }
};


template <bool BASE32> struct EpiRes {
    static constexpr bool PERM = true, AFTER_DRAIN = false;
    const float* base32; bf16_t* x16; float* ssq; const float* cscale;
    __device__ __forceinline__ void operator()(const f32x4 (&acc)[2][2][4][2], const Unit& u, int wr, int wc, int fr, int fq) const {
        const int col0 = u.pn * BM + wc * 32 + 8 * fq;
        f32x4 cs[2][2];
#pragma unroll
        for (int bj = 0; bj < 2; ++bj)
#pragma unroll
            for (int n = 0; n < 2; ++n) cs[bj][n] = cscale ? *(const f32x4*)(cscale + col0 + bj * HALF + n * 4) : (f32x4){1.f, 1.f, 1.f, 1.f};
        constexpr int HSTEP = BASE32 ? 1 : 2;
#pragma unroll
        for (int a0 = 0; a0 < 2; a0 += HSTEP) {
        u32x4 bw[HSTEP][4][2]; f32x4 bf[BASE32 ? 1 : 1][4][2][2];
#pragma unroll
        for (int ah = 0; ah < HSTEP; ++ah)
#pragma unroll
            for (int m = 0; m < 4; ++m) { const int row = u.pm * BM + (a0 + ah) * HALF + wr * 64 + m * 16 + fr; const size_t off = (size_t)row * D + col0;
#pragma unroll
                for (int bj = 0; bj < 2; ++bj) {
                    if (BASE32) { bf[0][m][bj][0] = *(const f32x4*)(base32 + off + bj * HALF); bf[0][m][bj][1] = *(const f32x4*)(base32 + off + bj * HALF + 4); }
                    else bw[ah][m][bj] = *(const u32x4*)(x16 + off + bj * HALF); } }
#pragma unroll
        for (int ah = 0; ah < HSTEP; ++ah) { const int ai = a0 + ah;
#pragma unroll
            for (int m = 0; m < 4; ++m) { const int row = u.pm * BM + ai * HALF + wr * 64 + m * 16 + fr; const size_t off = (size_t)row * D + col0; float ss = 0.f;
#pragma unroll
                for (int bj = 0; bj < 2; ++bj) { f32x4 b0, b1;
                    if (BASE32) { b0 = bf[0][m][bj][0]; b1 = bf[0][m][bj][1]; }
                    else { const u32x4 w = bw[ah][m][bj];
                        b0 = (f32x4){__builtin_bit_cast(float, w.x << 16), __builtin_bit_cast(float, w.x & 0xffff0000u), __builtin_bit_cast(float, w.y << 16), __builtin_bit_cast(float, w.y & 0xffff0000u)};
                        b1 = (f32x4){__builtin_bit_cast(float, w.z << 16), __builtin_bit_cast(float, w.z & 0xffff0000u), __builtin_bit_cast(float, w.w << 16), __builtin_bit_cast(float, w.w & 0xffff0000u)}; }
                    const f32x4 v0 = b0 + acc[ai][bj][m][0] * cs[bj][0], v1 = b1 + acc[ai][bj][m][1] * cs[bj][1];
                    ss += ((v0[0] * v0[0] + v0[1] * v0[1]) + (v0[2] * v0[2] + v0[3] * v0[3])) + ((v1[0] * v1[0] + v1[1] * v1[1]) + (v1[2] * v1[2] + v1[3] * v1[3]));
                    u32x4 o; o.x = cvt_pk_bf16(v0[0], v0[1]); o.y = cvt_pk_bf16(v0[2], v0[3]); o.z = cvt_pk_bf16(v1[0], v1[1]); o.w = cvt_pk_bf16(v1[2], v1[3]);
                    *(u32x4*)(x16 + off + bj * HALF) = o; }
                ss = add_x16_x32(ss);
                if (fq == 0) ssq[(size_t)row * 16 + u.pn * 4 + wc] = ss; }
        }
        }
    }
};
__device__ __forceinline__ float rstd_from_ssq16(const float* ssq, int row) {
    const f32x4* sp = (const f32x4*)(ssq + (size_t)row * 16); const f32x4 s = (sp[0] + sp[1]) + (sp[2] + sp[3]);
    return __builtin_amdgcn_rsqf(((s[0] + s[1]) + (s[2] + s[3])) * (1.0f / D) + EPS);
}
template <int MODE> struct EpiRow {
    static constexpr bool PERM = true, AFTER_DRAIN = false;
    bf16_t* O; int ldc; const float* ssq; float scale; bf16_t* O2; float* convout; const PG8_LAS float* rsd;
    __device__ __forceinline__ void operator()(const f32x4 (&acc)[2][2][4][2], const Unit& u, int wr, int wc, int fr, int fq) const {
        const int colw = wc * 32 + 8 * fq;
        float rsv[2][4];
        if (rsd) {
#pragma unroll
          for (int ai = 0; ai < 2; ++ai)
#pragma unroll
              for (int m = 0; m < 4; ++m) rsv[ai][m] = rsd[ai * HALF + wr * 64 + m * 16 + fr];
        } else { f32x4 qv[2][4];
#pragma unroll
          for (int ai = 0; ai < 2; ++ai)
#pragma unroll
              for (int m = 0; m < 4; ++m) qv[ai][m] = *(const f32x4*)(ssq + (size_t)(u.pm * BM + ai * HALF + wr * 64 + m * 16 + fr) * 16 + 4 * fq);
#pragma unroll
          for (int ai = 0; ai < 2; ++ai)
#pragma unroll
              for (int m = 0; m < 4; ++m) { const f32x4 q = qv[ai][m]; rsv[ai][m] = __builtin_amdgcn_rsqf(add_x16_x32((q[0] + q[1]) + (q[2] + q[3])) * (1.0f / D) + EPS); } }
#pragma unroll
        for (int ai = 0; ai < 2; ++ai)
#pragma unroll
            for (int m = 0; m < 4; ++m) { const int row = u.pm * BM + ai * HALF + wr * 64 + m * 16 + fr; const float rs = rsv[ai][m];
                if (MODE == 2 && u.pn >= 4) {
                    const float r2 = rs * rs; const f32x4 v0 = acc[ai][0][m][0] * acc[ai][1][m][0] * r2, v1 = acc[ai][0][m][1] * acc[ai][1][m][1] * r2;
                    const int ch = (u.pn - 4) * 128 + colw;
                    u32x4 w; w.x = cvt_pk_bf16(v0[0], v0[1]); w.y = cvt_pk_bf16(v0[2], v0[3]); w.z = cvt_pk_bf16(v1[0], v1[1]); w.w = cvt_pk_bf16(v1[2], v1[3]);
                    *(u32x4*)(O2 + (size_t)row * D + ch) = w;
                    const int t = row & (SEQ - 1);
                    if (t >= SEQ - 2) { float* cp = convout + ((size_t)(row >> 11) * 2 + (t - (SEQ - 2))) * D + ch; *(f32x4*)cp = v0; *(f32x4*)(cp + 4) = v1; }
                } else {
                    const float sc = (MODE == 0) ? rs * scale : rs;
#pragma unroll
                    for (int bj = 0; bj < 2; ++bj) { f32x4 v0 = acc[ai][bj][m][0] * sc, v1 = acc[ai][bj][m][1] * sc;
                        if (MODE == 1) {
#pragma unroll
                            for (int j = 0; j < 4; ++j) { const float a = fmaxf(v0[j], 0.f), b = fmaxf(v1[j], 0.f); v0[j] = a * a; v1[j] = b * b; } }
                        u32x4 w; w.x = cvt_pk_bf16(v0[0], v0[1]); w.y = cvt_pk_bf16(v0[2], v0[3]); w.z = cvt_pk_bf16(v1[0], v1[1]); w.w = cvt_pk_bf16(v1[2], v1[3]);
                        *(u32x4*)(O + (size_t)row * ldc + u.pn * BM + bj * HALF + colw) = w; }
                } }
    }
};
struct EpiBf16 {
    static constexpr bool PERM = true, AFTER_DRAIN = false;
    bf16_t* O; int ldc; float scale;
    __device__ __forceinline__ void operator()(const f32x4 (&acc)[2][2][4][2], const Unit& u, int wr, int wc, int fr, int fq) const {
        const int colw = u.pn * BM + wc * 32 + 8 * fq;
#pragma unroll
        for (int ai = 0; ai < 2; ++ai)
#pragma unroll
            for (int m = 0; m < 4; ++m) { const int row = u.pm * BM + ai * HALF + wr * 64 + m * 16 + fr;
#pragma unroll
                for (int bj = 0; bj < 2; ++bj) { const f32x4 v0 = acc[ai][bj][m][0] * scale, v1 = acc[ai][bj][m][1] * scale;
                    u32x4 w; w.x = cvt_pk_bf16(v0[0], v0[1]); w.y = cvt_pk_bf16(v0[2], v0[3]); w.z = cvt_pk_bf16(v1[0], v1[1]); w.w = cvt_pk_bf16(v1[2], v1[3]);
                    *(u32x4*)(O + (size_t)row * ldc + colw + bj * HALF) = w; } }
    }
};
struct EpiKV {
    static constexpr bool PERM = false, AFTER_DRAIN = false;
    float* outk; float* outv; bf16_t* Kb; bf16_t* Vt;
    __device__ __forceinline__ void operator()(const f32x4 (&acc)[2][2][4][2], const Unit& u, int wr, int wc, int fr, int fq) const {
        const int layer = u.pm >> 3; const bool isV = u.pn >= 4; const int col0 = (u.pn & 3) * BM + wc * 32 + 4 * fq;
        float* outp = isV ? outv : outk;
#pragma unroll
        for (int ai = 0; ai < 2; ++ai)
#pragma unroll
            for (int m = 0; m < 4; ++m) { const int rowl = (u.pm & 7) * BM + ai * HALF + wr * 64 + m * 16 + fr; const size_t off = ((size_t)layer * MEMROWS + rowl) * D + col0;
#pragma unroll
                for (int bj = 0; bj < 2; ++bj)
#pragma unroll
                    for (int n = 0; n < 2; ++n) { const f32x4 v = acc[ai][bj][m][n]; *(f32x4*)(outp + off + bj * HALF + n * 16) = v;
                        if (!isV) { u32x2 p; p.x = cvt_pk_bf16(v[0], v[1]); p.y = cvt_pk_bf16(v[2], v[3]); *(u32x2*)(Kb + off + bj * HALF + n * 16) = p; }
                        else { u32x2 p; p.x = cvt_pk_bf16(v[0], v[1]); p.y = cvt_pk_bf16(v[2], v[3]); *(u32x2*)(Vt + off + bj * HALF + n * 16) = p; } } }
    }
};
struct EpiSoftmax {
    static constexpr bool PERM = true, AFTER_DRAIN = true;
    bf16_t* P; int ldp; const float* ssq;
    __device__ __forceinline__ void operator()(const f32x4 (&)[2][2][4][2], const Unit&, int, int, int, int) const {}
    __device__ __forceinline__ void fused(f32x4 (&acc)[2][2][4][2], const Unit& u, int wr, int wc, int fr, int fq, PG8_LAS unsigned char* lds, int wid, int lane) const {
        PG8_LAS float* Pm = (PG8_LAS float*)lds;
        PG8_LAS float* Ps = (PG8_LAS float*)(lds + 4096);
        float rsv[2][4];
        { f32x4 qv[2][4];
#pragma unroll
          for (int ai = 0; ai < 2; ++ai)
#pragma unroll
              for (int m = 0; m < 4; ++m) qv[ai][m] = *(const f32x4*)(ssq + (size_t)(u.pm * BM + ai * HALF + wr * 64 + m * 16 + fr) * 16 + 4 * fq);
#pragma unroll
          for (int ai = 0; ai < 2; ++ai)
#pragma unroll
              for (int m = 0; m < 4; ++m) { const f32x4 q = qv[ai][m]; rsv[ai][m] = __builtin_amdgcn_rsqf(add_x16_x32((q[0] + q[1]) + (q[2] + q[3])) * (1.0f / D) + EPS); } }
#pragma unroll
        for (int ai = 0; ai < 2; ++ai)
#pragma unroll
            for (int m = 0; m < 4; ++m) { float mx = -3.0e38f; const float rs = rsv[ai][m];
#pragma unroll
                for (int bj = 0; bj < 2; ++bj)
#pragma unroll
                    for (int n = 0; n < 2; ++n) { const f32x4 x = acc[ai][bj][m][n] * rs; acc[ai][bj][m][n] = x; mx = fmaxf(mx, fmaxf(fmaxf(x[0], x[1]), fmaxf(x[2], x[3]))); }
                mx = max_x16_x32(mx);
                if (fq == 0) Pm[(ai * HALF + wr * 64 + m * 16 + fr) * 4 + wc] = mx; }
        asm volatile("s_waitcnt lgkmcnt(0)" ::: "memory"); __builtin_amdgcn_s_barrier(); asm volatile("" ::: "memory");
#pragma unroll
        for (int ai = 0; ai < 2; ++ai)
#pragma unroll
            for (int m = 0; m < 4; ++m) { const int r = ai * HALF + wr * 64 + m * 16 + fr; const f32x4 q = *(const PG8_LAS f32x4*)(Pm + r * 4);
                const float mx = fmaxf(fmaxf(q[0], q[1]), fmaxf(q[2], q[3])); float s = 0.f;
#pragma unroll
                for (int bj = 0; bj < 2; ++bj)
#pragma unroll
                    for (int n = 0; n < 2; ++n) { f32x4 x = acc[ai][bj][m][n];
#pragma unroll
                        for (int j = 0; j < 4; ++j) { x[j] = __builtin_amdgcn_exp2f(x[j] - mx); s += x[j]; }
                        acc[ai][bj][m][n] = x; }
                s = add_x16_x32(s);
                if (fq == 0) Ps[r * 4 + wc] = s; }
        asm volatile("s_waitcnt lgkmcnt(0)" ::: "memory"); __builtin_amdgcn_s_barrier(); asm volatile("" ::: "memory");
        const int colw = u.pn * BM + wc * 32 + 8 * fq;
#pragma unroll
        for (int ai = 0; ai < 2; ++ai)
#pragma unroll
            for (int m = 0; m < 4; ++m) { const int r = ai * HALF + wr * 64 + m * 16 + fr; const f32x4 q = *(const PG8_LAS f32x4*)(Ps + r * 4);
                const float inv = __builtin_amdgcn_rcpf((q[0] + q[1]) + (q[2] + q[3]));
#pragma unroll
                for (int bj = 0; bj < 2; ++bj) { const f32x4 v0 = acc[ai][bj][m][0] * inv, v1 = acc[ai][bj][m][1] * inv;
                    u32x4 w; w.x = cvt_pk_bf16(v0[0], v0[1]); w.y = cvt_pk_bf16(v0[2], v0[3]); w.z = cvt_pk_bf16(v1[0], v1[1]); w.w = cvt_pk_bf16(v1[2], v1[3]);
                    *(u32x4*)(P + (size_t)(u.pm * BM + r) * ldp + bj * HALF + colw) = w; } }
    }
};

template <class Epi, class Sched, bool ALIGN_EPI>
__device__ __forceinline__ void gemm_phase(PG8_LAS unsigned char* lds, const Gemm g, const Sched& S, const Epi& E, int tid) {
    asm volatile("" : "+v"(tid));
    const int wid = __builtin_amdgcn_readfirstlane(tid >> 6), lane = tid & 63, wr = wid >> 2, wc = wid & 3, fr = lane & 15, fq = lane >> 4;
    const int nt = g.K / BK;
    unsigned voffA[2], voffB[2];
#pragma unroll
    for (int i = 0; i < 2; ++i) { int R, C; stage_rc(tid * 16 + i * 8192, R, C); const int Rb = Epi::PERM ? ((R & ~31) + perm32(R & 31)) : R;
        voffA[i] = (unsigned)(R * g.lda + C) * 2u; voffB[i] = (unsigned)(Rb * g.ldb + C) * 2u; }
    const size_t kstep = (size_t)(BK * 2);
    const size_t hstepA = (size_t)HALF * g.lda * 2, hstepB = (size_t)HALF * g.ldb * 2;
    const unsigned ldsw = (unsigned)wid * 1024u;
    const int aoff = lds_byte(wr * 64 + fr, fq * 8), boff = lds_byte(wc * 32 + fr, fq * 8);
#define PG8_SA(b, h) (((b) * 2 + (h)) * HTB)
#define PG8_SB(b, h) ((4 + (b) * 2 + (h)) * HTB)
#define PG8_STAGE(bufoff, gbase, voff) do { const char* _gb = (const char*)(gbase); asm volatile("" : "+s"(_gb));   \
        _Pragma("unroll") for (int _i = 0; _i < 2; ++_i) \
        __builtin_amdgcn_global_load_lds((const unsigned*)(_gb + (voff)[_i]), (PG8_LAS unsigned*)(lds + (bufoff) + ldsw + _i * 8192), 16, 0, 0); } while (0)
#define PG8_LDA(dst, b, h) do { _Pragma("unroll") for (int m = 0; m < 4; ++m) _Pragma("unroll") for (int k = 0; k < 2; ++k) dst[m][k] = *(const PG8_LAS bf16x8*)(lds + PG8_SA(b, h) + aoff + m * 2048 + k * 1024); } while (0)
#define PG8_LDB(dst, b, h) do { _Pragma("unroll") for (int n = 0; n < 2; ++n) _Pragma("unroll") for (int k = 0; k < 2; ++k) dst[n][k] = *(const PG8_LAS bf16x8*)(lds + PG8_SB(b, h) + boff + n * 2048 + k * 1024); } while (0)
#define PG8_MMA(ai, bj, At, Bt) do { __builtin_amdgcn_s_setprio(1); _Pragma("unroll") for (int m = 0; m < 4; ++m) _Pragma("unroll") for (int n = 0; n < 2; ++n) _Pragma("unroll") for (int k = 0; k < 2; ++k) \
        acc[ai][bj][m][n] = __builtin_amdgcn_mfma_f32_16x16x32_bf16(Bt[n][k], At[m][k], acc[ai][bj][m][n], 0, 0, 0); __builtin_amdgcn_s_setprio(0); } while (0)
#define PG8_WAIT_V(n) asm volatile("s_waitcnt vmcnt(" #n ")" ::: "memory")
#define PG8_WAIT_L(n) asm volatile("s_waitcnt lgkmcnt(" #n ")" ::: "memory")
#define PG8_BAR __builtin_amdgcn_s_barrier()
#define PG8_SCHED __builtin_amdgcn_sched_barrier(0)
    Unit cur, nxt; int ui = 0;
    if (!S.next(0, cur)) return;
    f32x4 acc[2][2][4][2];
#pragma unroll
    for (int a = 0; a < 2; ++a)
#pragma unroll
        for (int b = 0; b < 2; ++b)
#pragma unroll
            for (int m = 0; m < 4; ++m)
#pragma unroll
                for (int n = 0; n < 2; ++n) acc[a][b][m][n] = (f32x4){0.f, 0.f, 0.f, 0.f};
    bf16x8 At[4][2], B0[2][2], B1[2][2];
    const char* cA = S.aptr(cur); const char* cB = S.bptr(cur);
    PG8_STAGE(PG8_SB(0, 0), cB, voffB); PG8_STAGE(PG8_SB(0, 1), cB + hstepB, voffB); PG8_STAGE(PG8_SA(0, 0), cA, voffA); PG8_STAGE(PG8_SA(0, 1), cA + hstepA, voffA);
    if (wr == 1) PG8_BAR;
    PG8_WAIT_V(2); PG8_BAR;
    PG8_STAGE(PG8_SB(1, 0), cB + kstep, voffB); PG8_STAGE(PG8_SA(1, 0), cA + kstep, voffA); PG8_STAGE(PG8_SB(1, 1), cB + hstepB + kstep, voffB);
    PG8_WAIT_V(6); PG8_BAR;
    for (;;) {
        const bool has_next = S.next(ui + 1, nxt);
        const char* nA = has_next ? S.aptr(nxt) : cA; const char* nB = has_next ? S.bptr(nxt) : cB;
        for (int t = 0; t < nt; t += 2) {
            const bool last = (t == nt - 2);
            const char* a1 = cA + (size_t)(t + 1) * kstep;
            const char* a2 = last ? nA : cA + (size_t)(t + 2) * kstep; const char* b2 = last ? nB : cB + (size_t)(t + 2) * kstep;
            const char* a3 = a2 + kstep; const char* b3 = b2 + kstep;
            PG8_LDB(B0, 0, 0); PG8_LDB(B1, 0, 1); PG8_SCHED; PG8_LDA(At, 0, 0); PG8_STAGE(PG8_SA(1, 1), a1 + hstepA, voffA);
            PG8_WAIT_V(8); PG8_WAIT_L(0); PG8_BAR; PG8_MMA(0, 0, At, B0); PG8_MMA(0, 1, At, B1); PG8_BAR; PG8_SCHED;
            PG8_LDA(At, 0, 1); PG8_STAGE(PG8_SB(0, 0), b2, voffB); PG8_STAGE(PG8_SB(0, 1), b2 + hstepB, voffB); PG8_STAGE(PG8_SA(0, 0), a2, voffA);
            PG8_WAIT_V(8); PG8_WAIT_L(0); PG8_BAR; PG8_MMA(1, 0, At, B0); PG8_MMA(1, 1, At, B1); PG8_BAR; PG8_SCHED;
            PG8_LDB(B0, 1, 0); PG8_LDB(B1, 1, 1); PG8_SCHED; PG8_LDA(At, 1, 0); PG8_STAGE(PG8_SA(0, 1), a2 + hstepA, voffA);
            PG8_WAIT_V(8); PG8_WAIT_L(0); PG8_BAR; PG8_MMA(0, 0, At, B0); PG8_MMA(0, 1, At, B1); PG8_BAR; PG8_SCHED;
            PG8_LDA(At, 1, 1); PG8_STAGE(PG8_SB(1, 0), b3, voffB); PG8_STAGE(PG8_SB(1, 1), b3 + hstepB, voffB); PG8_STAGE(PG8_SA(1, 0), a3, voffA);
            PG8_WAIT_V(8); PG8_WAIT_L(0); PG8_BAR; PG8_MMA(1, 0, At, B0); PG8_MMA(1, 1, At, B1); PG8_BAR; PG8_SCHED;
        }
        if constexpr (ALIGN_EPI) { if (wr == 0) PG8_BAR; }
        if constexpr (!Epi::AFTER_DRAIN) { const int l2 = lane_id_opaque(); E(acc, cur, wr, wc, l2 & 15, l2 >> 4); }
        if (!has_next) break;
#pragma unroll
        for (int a = 0; a < 2; ++a)
#pragma unroll
            for (int b = 0; b < 2; ++b)
#pragma unroll
                for (int m = 0; m < 4; ++m)
#pragma unroll
                    for (int n = 0; n < 2; ++n) acc[a][b][m][n] = (f32x4){0.f, 0.f, 0.f, 0.f};
        cur = nxt; cA = nA; cB = nB; ++ui;
        if constexpr (ALIGN_EPI) { if (wr == 1) PG8_BAR; }
    }
    PG8_WAIT_V(0);
    if constexpr (!ALIGN_EPI) { if (wr == 0) PG8_BAR; }
    PG8_BAR;
    if constexpr (Epi::AFTER_DRAIN) { const int l2 = lane_id_opaque(); E.fused(acc, cur, wr, wc, l2 & 15, l2 >> 4, lds, wid, l2); }
#undef PG8_SA
#undef PG8_SB
#undef PG8_STAGE
#undef PG8_LDA
#undef PG8_LDB
#undef PG8_MMA
#undef PG8_WAIT_V
#undef PG8_WAIT_L
#undef PG8_BAR
#undef PG8_SCHED
}
}

constexpr int NWAVES = 8, NTHREADS = 512;
constexpr size_t MiB = 1u << 20;
constexpr size_t WS_CTL = 0, CTL_ZERO_BYTES = 256 * 1024;
constexpr size_t WS_WPOOL = 1 * MiB;
constexpr size_t WS_WQ = 2 * MiB;
constexpr size_t WS_WO = 6 * MiB;
constexpr size_t WS_WKV = 10 * MiB;
constexpr size_t WS_WUP = 18 * MiB;
constexpr size_t WS_WDN = 34 * MiB;
constexpr size_t WS_WIN = 50 * MiB;
constexpr size_t WS_WOUT = 56 * MiB;
constexpr size_t WS_MN = 58 * MiB;
constexpr size_t WS_KB = 66 * MiB;
constexpr size_t WS_VT = 74 * MiB;
constexpr size_t WS_SSQ = 82 * MiB;
constexpr size_t WS_SMALL = 84 * MiB;
constexpr size_t WS_X = 96 * MiB;
constexpr size_t WS_XG = 160 * MiB;
constexpr size_t WS_P0 = 192 * MiB;
constexpr size_t WS_O = 224 * MiB;
constexpr size_t WS_CH = 256 * MiB;
constexpr size_t WS_PS = 288 * MiB;
constexpr size_t WS_H = 320 * MiB;
constexpr size_t WS_WQN = 448 * MiB;
constexpr size_t WS_MT = 452 * MiB;
constexpr size_t WS_VW = 484 * MiB;
constexpr size_t WS_END = 516 * MiB;
constexpr size_t SS_X = WS_SMALL;
constexpr size_t SS_XG = SS_X + 512 * 1024;
constexpr size_t SS_SSQ = SS_XG + 256 * 1024;
constexpr size_t SS_P0 = SS_SSQ + 32 * 1024;
constexpr size_t SS_O = SS_P0 + 256 * 1024;
constexpr size_t SS_CH = SS_O + 256 * 1024;
constexpr size_t SS_H = SS_CH + 512 * 1024;
constexpr size_t SS_Q = SS_H + 1024 * 1024;
static_assert(SS_Q + 512 * 1024 <= WS_X, "sample buffers");
constexpr int CW_BAR = 4096, CW_BAR_STRIDE = 4096;

constexpr int RING_OFF = 0, RING_BYTES = 131072;
constexpr int LDSCTL_OFF = RING_BYTES, MISC_OFF = LDSCTL_OFF + 320;
constexpr int RSD_OFF = RING_BYTES + 1024;
constexpr int LDS_BYTES = 147456;

#define GAS __attribute__((address_space(1)))
#define LAS __attribute__((address_space(3)))
typedef unsigned short bf16;
typedef unsigned v4u __attribute__((ext_vector_type(4)));
typedef unsigned v2u __attribute__((ext_vector_type(2)));
typedef float f32x4 __attribute__((ext_vector_type(4)));
typedef short bf16x8 __attribute__((ext_vector_type(8)));
#define LDS_WAIT() asm volatile("s_waitcnt lgkmcnt(0)" ::: "memory")
#define VM_WAIT() asm volatile("s_waitcnt vmcnt(0)" ::: "memory")
__device__ __forceinline__ unsigned f2bf(float f) { unsigned u = __builtin_bit_cast(unsigned, f); return (u + 0x7fffu + ((u >> 16) & 1u)) >> 16; }
__device__ __forceinline__ unsigned pk2(float lo, float hi) { return f2bf(lo) | (f2bf(hi) << 16); }
__device__ __forceinline__ float bf2f(unsigned short h) { return __builtin_bit_cast(float, (unsigned)h << 16); }
__device__ __forceinline__ float bflo(unsigned w) { return __builtin_bit_cast(float, w << 16); }
__device__ __forceinline__ float bfhi(unsigned w) { return __builtin_bit_cast(float, w & 0xffff0000u); }

#define XB_TMO      128
#define XB_XCNT(j)  (256  + 64 * (j))
#define XB_XSUB(j)  (1280 + 64 * (j))
#define XB_XGEN(j)  (2304 + 64 * (j))
#define XB_TOP      3328
#define XB_TOPGEN   3392
#define XCD_BAR_WORDS 3456
#define XB_SPIN_CAP (1u << 18)
__device__ __forceinline__ unsigned xb_ld(unsigned* p)              { return __hip_atomic_load(p, __ATOMIC_RELAXED, __HIP_MEMORY_SCOPE_AGENT); }
__device__ __forceinline__ unsigned xb_add(unsigned* p, unsigned v) { return __hip_atomic_fetch_add(p, v, __ATOMIC_RELAXED, __HIP_MEMORY_SCOPE_AGENT); }
__device__ __forceinline__ unsigned xb_xcc_id() { return (unsigned)__builtin_amdgcn_s_getreg((3 << 11) | 20) & 0xFu; }
#define XB_SPIN(cond, bar) do { unsigned _sp = 0; while (cond) { __builtin_amdgcn_s_sleep(1); \
    if ((++_sp & 255u) == 0u) { if (xb_ld(&(bar)[XB_TMO])) break; if (_sp > XB_SPIN_CAP) { atomicAdd(&(bar)[XB_TMO], 1u); break; } } } } while (0)
struct XcdBarrier { unsigned* bar; unsigned x; volatile LAS unsigned* st; unsigned gsize; };
__device__ __forceinline__ XcdBarrier xcd_barrier_post(unsigned* bar, volatile LAS unsigned* st, unsigned gsize) {
    XcdBarrier b; b.bar = bar; b.x = xb_xcc_id(); b.st = st; b.gsize = gsize;
    if (threadIdx.x == 0) (void)xb_add(&bar[XB_XCNT(b.x)], 1u);
    return b;
}
__device__ __forceinline__ void xcd_barrier_complete(unsigned* bar, unsigned x, unsigned G, unsigned& nloc, unsigned& nx) {
    unsigned sum, cnt, mine, sp = 0u;
    for (;;) {
        sum = 0u; cnt = 0u; mine = 0u;
#pragma unroll
        for (unsigned j = 0; j < 16; ++j) { const unsigned c = xb_ld(&bar[XB_XCNT(j)]); sum += c; cnt += (c > 0u) ? 1u : 0u; mine = (j == x) ? c : mine; }
        if (sum == G) break;
        __builtin_amdgcn_s_sleep(1);
        if ((++sp & 255u) == 0u) { if (xb_ld(&bar[XB_TMO])) break; if (sp > XB_SPIN_CAP) { atomicAdd(&bar[XB_TMO], 1u); break; } }
    }
    nloc = mine > 0u ? mine : 1u; nx = cnt > 0u ? cnt : 1u;
}
__device__ __forceinline__ void xcd_barrier(const XcdBarrier& b, const int tid) {
    asm volatile("s_waitcnt vmcnt(0)" ::: "memory");
    __syncthreads();
    if (tid == 0) {
        unsigned* bar = b.bar; asm volatile("" : "+s"(bar));
        __builtin_amdgcn_s_waitcnt(0);
        unsigned nloc = b.st[0], nx = b.st[1];
        if (nloc == 0u) { xcd_barrier_complete(bar, b.x, b.gsize, nloc, nx); b.st[0] = nloc; b.st[1] = nx; }
        const unsigned old = xb_add(&bar[XB_XSUB(b.x)], 1u);
        const unsigned gen = old / nloc;
        if (old + 1u == (gen + 1u) * nloc) {
            if (nx > 1u) {
                __builtin_amdgcn_fence(__ATOMIC_RELEASE, "agent");
                asm volatile("s_waitcnt vmcnt(0)" ::: "memory");
                const unsigned og = xb_add(&bar[XB_TOP], 1u);
                const unsigned tg = og / nx;
                if (og + 1u == (tg + 1u) * nx) xb_add(&bar[XB_TOPGEN], 1u);
                else XB_SPIN(xb_ld(&bar[XB_TOPGEN]) == tg, bar);
            }
            xb_add(&bar[XB_XGEN(b.x)], 1u);
            __builtin_amdgcn_fence(__ATOMIC_ACQUIRE, "agent");
            asm volatile("s_waitcnt vmcnt(0)" ::: "memory");
        } else {
            XB_SPIN(xb_ld(&bar[XB_XGEN(b.x)]) == gen, bar);
            __builtin_amdgcn_fence(__ATOMIC_ACQUIRE, "agent");
            asm volatile("s_waitcnt vmcnt(0)" ::: "memory");
        }
    }
    __syncthreads();
}

__device__ __forceinline__ int opq_v(int x) { asm volatile("" : "+v"(x)); return x; }
struct Args { const float* in[22]; float* out; unsigned char* ws; int ph_lo, ph_hi; };


__device__ __forceinline__ void p0_transpose_item(const float* W, int K, int N, bf16* WT, int k0, int n0, int drow0, LAS float* scr, int lane, const float* gk = nullptr) {
    float v[32];
#pragma unroll
    for (int i = 0; i < 32; ++i) { const int kk = 2 * i + (lane >> 5); v[i] = W[(size_t)(k0 + kk) * N + n0 + (lane & 31)]; }
    if (gk) {
#pragma unroll
        for (int i = 0; i < 32; ++i) v[i] *= gk[k0 + 2 * i + (lane >> 5)]; }
#pragma unroll
    for (int i = 0; i < 32; ++i) scr[(2 * i + (lane >> 5)) * 33 + (lane & 31)] = v[i];
    LDS_WAIT(); asm volatile("" ::: "memory");
    const int c = lane & 7;
#pragma unroll
    for (int j = 0; j < 4; ++j) { const int n = (lane >> 3) + 8 * j; const LAS float* s = scr + (8 * c) * 33 + n;
        v4u o; o.x = pg8::cvt_pk_bf16(s[0 * 33], s[1 * 33]); o.y = pg8::cvt_pk_bf16(s[2 * 33], s[3 * 33]); o.z = pg8::cvt_pk_bf16(s[4 * 33], s[5 * 33]); o.w = pg8::cvt_pk_bf16(s[6 * 33], s[7 * 33]);
        *(GAS v4u*)(WT + (size_t)(drow0 + n) * K + k0 + 8 * c) = o; }
    LDS_WAIT(); asm volatile("" ::: "memory");
}
__device__ __forceinline__ int win_dest_row(int n) {
    if (n < 1024) return n;
    if (n < 2048) { const int ch = n - 1024; return 1024 + (ch >> 7) * 256 + (ch & 127); }
    const int ch = n - 2048; return 1024 + (ch >> 7) * 256 + 128 + (ch & 127);
}

template <int W>
__device__ __forceinline__ void pool_wave(const float* xb  , const LAS float* rs, f32x4 g4, int tA, bf16* pout  , float* poolout  ) {
    f32x4 xv[15 + W];
#pragma unroll
    for (int i = 16 - W; i < 31; ++i) { const int t = tA - 15 + i; xv[i - (16 - W)] = *(const f32x4*)(xb + (size_t)(t >= 0 ? t : 0) * D); }
    f32x4 ring[16]; f32x4 S = {0.f, 0.f, 0.f, 0.f};
#pragma unroll
    for (int i = 16 - W; i < 31; ++i) {
        const int t = tA - 15 + i;
        f32x4 u = {0.f, 0.f, 0.f, 0.f};
        if (t >= 0) u = xv[i - (16 - W)] * rs[i] * g4;
        S += u; if (i - W >= 16 - W) S -= ring[(i - W) & 15];
        ring[i & 15] = u;
        if (i >= 15) {
            const int cnt = (t + 1 < W) ? (t + 1) : W; const float ic = 1.0f / (float)cnt;
            const f32x4 p = S * ic - u; v2u o; o.x = pk2(p[0], p[1]); o.y = pk2(p[2], p[3]);
            *(v2u*)(pout + (size_t)t * D) = o;
            if (t >= SEQ - 15) *(f32x4*)(poolout + (size_t)(t - (SEQ - 15)) * D) = u;
        }
    }
}

template <int RT, int CT, int GR, int KS, class F>
__device__ __forceinline__ void sgemm2(const bf16* A, int lda, int row0, const bf16* Bt, int ldb, const int (&brow)[CT], int K, LAS unsigned char* red, int wave, int lane, const F& f) {
    const int fr = lane & 15, fq = lane >> 4, kw = K >> 3;
    const bf16* ap = A + (size_t)(row0 + fr) * lda + wave * kw + fq * 8;
    const bf16* bp[CT];
#pragma unroll
    for (int ct = 0; ct < CT; ++ct) bp[ct] = Bt + (size_t)(brow[ct] + fr) * ldb + wave * kw + fq * 8;
    f32x4 acc[RT][CT];
#pragma unroll
    for (int rt = 0; rt < RT; ++rt)
#pragma unroll
        for (int ct = 0; ct < CT; ++ct) acc[rt][ct] = (f32x4){0.f, 0.f, 0.f, 0.f};
#pragma unroll 1
    for (int k0 = 0; k0 < kw; k0 += 32 * KS) {
        bf16x8 a[KS][RT], b[KS][CT];
#pragma unroll
        for (int ks = 0; ks < KS; ++ks) {
#pragma unroll
            for (int rt = 0; rt < RT; ++rt) a[ks][rt] = *(const bf16x8*)(ap + (size_t)rt * 16 * lda + k0 + 32 * ks);
#pragma unroll
            for (int ct = 0; ct < CT; ++ct) b[ks][ct] = *(const bf16x8*)(bp[ct] + k0 + 32 * ks); }
#pragma unroll
        for (int ks = 0; ks < KS; ++ks)
#pragma unroll
            for (int rt = 0; rt < RT; ++rt)
#pragma unroll
                for (int ct = 0; ct < CT; ++ct) acc[rt][ct] = __builtin_amdgcn_mfma_f32_16x16x32_bf16(b[ks][ct], a[ks][rt], acc[rt][ct], 0, 0, 0);
    }
#pragma unroll
    for (int rt = 0; rt < RT; ++rt)
#pragma unroll
        for (int ct = 0; ct < CT; ++ct) *(LAS f32x4*)(red + ((((wave * RT + rt) * CT + ct) * 64 + lane) << 4)) = acc[rt][ct];
    LDS_WAIT(); __syncthreads();
    constexpr int NCG = CT / GR, NTASK = RT * NCG;
    for (int t = wave; t < NTASK; t += 8) {
        const int rt = t / NCG, cg = t % NCG;
        f32x4 sacc[GR];
#pragma unroll
        for (int g = 0; g < GR; ++g) { f32x4 tt = {0.f, 0.f, 0.f, 0.f};
#pragma unroll
            for (int w = 0; w < 8; ++w) tt += *(const LAS f32x4*)(red + ((((w * RT + rt) * CT + cg * GR + g) * 64 + lane) << 4));
            sacc[g] = tt; }
        f(sacc, row0 + 16 * rt + fr, cg * GR, fq);
    }
    __syncthreads();
}
__device__ __forceinline__ float srstd(const float* ssq, int row, int fq) {
    const f32x4* sp = (const f32x4*)(ssq + row * 64 + fq * 16); const f32x4 s = (sp[0] + sp[1]) + (sp[2] + sp[3]); float t = (s[0] + s[1]) + (s[2] + s[3]);
    t = add_x16_x32(t);
    return __builtin_amdgcn_rsqf(t * (1.0f / D) + EPS);
}
template <int KS> __device__ __forceinline__ void s_res_unit(const bf16* A, int lda, const bf16* Bt, int ldb, int K, int cp, int row0, const float* base32, bf16* xs16, float* ssq, const float* cscale, LAS unsigned char* red, int wave, int lane) {
    const int brow[2] = {32 * cp, 32 * cp + 16};
    const int myct = wave & 1, prow = row0 + (lane & 15), pc0 = 16 * (2 * cp + myct) + 4 * (lane >> 4); const size_t poff = (size_t)prow * D + pc0;
    f32x4 cs = {1.f, 1.f, 1.f, 1.f}; if (cscale) cs = *(const f32x4*)(cscale + pc0);
    f32x4 bpre; if (base32) bpre = *(const f32x4*)(base32 + poff); else { const v2u w = *(const v2u*)(xs16 + poff); bpre = (f32x4){bflo(w.x), bfhi(w.x), bflo(w.y), bfhi(w.y)}; }
    sgemm2<1, 2, 1, KS>(A, lda, row0, Bt, ldb, brow, K, red, wave, lane, [&](f32x4 (&a)[1], int row, int ct0, int fq) {
        const int ctile = 2 * cp + ct0, c0 = 16 * ctile + 4 * fq; const size_t off = (size_t)row * D + c0;
        const f32x4 v = bpre + a[0] * cs;
        float ss = (v[0] * v[0] + v[1] * v[1]) + (v[2] * v[2] + v[3] * v[3]);
        ss = add_x16_x32(ss);
        if (fq == 0) ssq[row * 64 + ctile] = ss;
        v2u p; p.x = pk2(v[0], v[1]); p.y = pk2(v[2], v[3]); *(v2u*)(xs16 + off) = p; });
}
__device__ __forceinline__ void s_q_unit(const bf16* xs16, const bf16* wq, int cp, int row0, const float* ssq, float* qs, LAS unsigned char* red, int wave, int lane) {
    const int brow[2] = {32 * cp, 32 * cp + 16};
    const float rs = srstd(ssq, row0 + (lane & 15), lane >> 4) * QSCALE;
    sgemm2<1, 2, 1, 4>(xs16, D, row0, wq, D, brow, D, red, wave, lane, [&](f32x4 (&a)[1], int row, int ct0, int fq) {
        *(f32x4*)(qs + (size_t)row * D + 32 * cp + 16 * ct0 + 4 * fq) = a[0] * rs; });
}
__device__ __forceinline__ f32x4 relu2(f32x4 v) {
#pragma unroll
    for (int j = 0; j < 4; ++j) { const float a = fmaxf(v[j], 0.f); v[j] = a * a; }
    return v;
}

__device__ __forceinline__ void rstd_table(const float* ssq, int pm, LAS float* rsd, int tid) {
    if (tid < 256) { const f32x4* sp = (const f32x4*)(ssq + (size_t)(pm * 256 + tid) * 16); const f32x4 q = (sp[0] + sp[1]) + (sp[2] + sp[3]);
        rsd[tid] = __builtin_amdgcn_rsqf(((q[0] + q[1]) + (q[2] + q[3])) * (1.0f / D) + EPS); }
}
__device__ __forceinline__ void treduce32(float (&p)[32], int lane) {
#pragma unroll
    for (int i = 0; i < 16; ++i) { swap32(p[i], p[i + 16]); p[i] += p[i + 16]; }
    { const bool b4 = (lane & 16) != 0;
#pragma unroll
      for (int i = 0; i < 8; ++i) { const float keep = b4 ? p[i + 8] : p[i], send = b4 ? p[i] : p[i + 8]; p[i] = keep + SWZ_XOR(send, 16); } }
    { const bool b3 = (lane & 8) != 0;
#pragma unroll
      for (int i = 0; i < 4; ++i) { const float keep = b3 ? p[i + 4] : p[i], send = b3 ? p[i] : p[i + 4]; p[i] = keep + SWZ_XOR(send, 8); } }
    { const bool b2 = (lane & 4) != 0;
#pragma unroll
      for (int i = 0; i < 2; ++i) { const float keep = b2 ? p[i + 2] : p[i], send = b2 ? p[i] : p[i + 2]; p[i] = keep + SWZ_XOR(send, 4); } }
    { const bool b1 = (lane & 2) != 0; const float keep = b1 ? p[1] : p[0], send = b1 ? p[0] : p[1]; p[0] = keep + SWZ_XOR(send, 2); }
    p[0] += SWZ_XOR(p[0], 1);
}
__device__ __forceinline__ void unpack16(const v4u a, const v4u b, float (&x)[16]) {
    x[0] = bflo(a.x); x[1] = bfhi(a.x); x[2] = bflo(a.y); x[3] = bfhi(a.y); x[4] = bflo(a.z); x[5] = bfhi(a.z); x[6] = bflo(a.w); x[7] = bfhi(a.w);
    x[8] = bflo(b.x); x[9] = bfhi(b.x); x[10] = bflo(b.y); x[11] = bfhi(b.y); x[12] = bflo(b.z); x[13] = bfhi(b.z); x[14] = bflo(b.w); x[15] = bfhi(b.w);
}

constexpr int NPHASES = 15;
__global__ void __launch_bounds__(NTHREADS, 2) mk_fwd(Args args) {
    extern __shared__ __attribute__((aligned(16))) unsigned char lds[];
    LAS unsigned char* L = (LAS unsigned char*)lds;
    volatile LAS unsigned* MISC = (volatile LAS unsigned*)(L + MISC_OFF);
    const int wave0 = __builtin_amdgcn_readfirstlane((int)threadIdx.x >> 6);
    const int G = gridDim.x; const int bx = blockIdx.x; const int vcu = (G % 8 == 0) ? (bx % 8) * (G / 8) + bx / 8 : bx;
    const int grp = bx & 7, mi = bx >> 3, GS = (G - grp + 7) >> 3;
    for (int u = threadIdx.x; u < (LDS_BYTES - LDSCTL_OFF) / 4; u += NTHREADS) ((LAS unsigned*)(L + LDSCTL_OFF))[u] = 0u;
    __syncthreads();
#if MK_PER_PHASE
#define GRID_BAR() do { } while (0)
#define GROUP_BAR() do { } while (0)
#else
    XcdBarrier bar = xcd_barrier_post((unsigned*)(args.ws + WS_CTL) + CW_BAR, MISC + 8, (unsigned)G);
    XcdBarrier gbar = xcd_barrier_post((unsigned*)(args.ws + WS_CTL) + CW_BAR + (1 + grp) * CW_BAR_STRIDE, MISC + 10, (unsigned)GS);
#define GRID_BAR() xcd_barrier(bar, wave0 * 64 + lane_id_opaque())
#define GROUP_BAR() xcd_barrier(gbar, wave0 * 64 + lane_id_opaque())
#endif
    const int lo = args.ph_lo, hi = args.ph_hi;
#define IN(k) (st == (k))
#define SEAM(k) do { } while (0)
    const int NGW = G * NWAVES;
#define TID_NOW (wave0 * 64 + lane_id_opaque())
#define RELANE const int tid = wave0 * 64 + lane_id_opaque(), lane = tid & 63; (void)tid; (void)lane;
#define KA_PTR(T, off) (*(T const __attribute__((address_space(4)))*)(ka + (off)))
#define PH_BEGIN const int tid = wave0 * 64 + lane_id_opaque(), lane = tid & 63, wave = wave0, gw = vcu * NWAVES + wave; (void)lane; (void)gw; \
    const __attribute__((address_space(4))) char* ka = (const __attribute__((address_space(4))) char*)__builtin_amdgcn_kernarg_segment_ptr(); asm volatile("" : "+s"(ka)); \
    unsigned char* const ws = KA_PTR(unsigned char*, 184); float* const out = KA_PTR(float*, 176); (void)ws; (void)out; \
    const float* const x_prompt = KA_PTR(const float*, 0); const float* const x_sample = KA_PTR(const float*, 8); const float* const state_pool = KA_PTR(const float*, 16); const float* const state_conv = KA_PTR(const float*, 24); \
    const float* const cache_k = KA_PTR(const float*, 32); const float* const cache_v = KA_PTR(const float*, 40); const float* const mem_prompt = KA_PTR(const float*, 48); \
    const float* const g_mix = KA_PTR(const float*, 56); const float* const g_attn = KA_PTR(const float*, 64); const float* const g_mem = KA_PTR(const float*, 72); const float* const g_ffn = KA_PTR(const float*, 80); const float* const g_final = KA_PTR(const float*, 88); \
    const float* const w_pool = KA_PTR(const float*, 96); const float* const pool_scale = KA_PTR(const float*, 104); const float* const w_conv_in = KA_PTR(const float*, 112); const float* const w_conv = KA_PTR(const float*, 120); const float* const w_conv_out = KA_PTR(const float*, 128); \
    const float* const w_q = KA_PTR(const float*, 136); const float* const w_kv = KA_PTR(const float*, 144); const float* const w_o = KA_PTR(const float*, 152); const float* const w_up = KA_PTR(const float*, 160); const float* const w_down = KA_PTR(const float*, 168); \
    (void)x_prompt; (void)x_sample; (void)state_pool; (void)state_conv; (void)cache_k; (void)cache_v; (void)mem_prompt; (void)g_mix; (void)g_attn; (void)g_mem; (void)g_ffn; (void)g_final; (void)w_pool; (void)pool_scale; (void)w_conv_in; (void)w_conv; (void)w_conv_out; (void)w_q; (void)w_kv; (void)w_o; (void)w_up; (void)w_down; \
    bf16* const WPOOL = (bf16*)(ws + WS_WPOOL); bf16* const WQ = (bf16*)(ws + WS_WQ); bf16* const WO = (bf16*)(ws + WS_WO); bf16* const WKV = (bf16*)(ws + WS_WKV); \
    bf16* const WUP = (bf16*)(ws + WS_WUP); bf16* const WDN = (bf16*)(ws + WS_WDN); bf16* const WIN = (bf16*)(ws + WS_WIN); bf16* const WOUT = (bf16*)(ws + WS_WOUT); \
    bf16* const MN = (bf16*)(ws + WS_MN); bf16* const KB = (bf16*)(ws + WS_KB); bf16* const VT = (bf16*)(ws + WS_VT); float* const SSQ = (float*)(ws + WS_SSQ); \
    bf16* const X16 = (bf16*)(ws + WS_X); bf16* const P0 = (bf16*)(ws + WS_P0); bf16* const OB = (bf16*)(ws + WS_O); bf16* const CH = (bf16*)(ws + WS_CH); \
    bf16* const WQN = (bf16*)(ws + WS_WQN); bf16* const MT = (bf16*)(ws + WS_MT); bf16* const VW = (bf16*)(ws + WS_VW); bf16* const HB = (bf16*)(ws + WS_H); \
    bf16* const XS16 = (bf16*)(ws + SS_X); float* const SSQS = (float*)(ws + SS_SSQ); bf16* const P0S = (bf16*)(ws + SS_P0); bf16* const OS = (bf16*)(ws + SS_O); \
    float* const CHS = (float*)(ws + SS_CH); bf16* const HS = (bf16*)(ws + SS_H); float* const QS = (float*)(ws + SS_Q); \
    (void)WPOOL; (void)WQ; (void)WO; (void)WKV; (void)WUP; (void)WDN; (void)WIN; (void)WOUT; (void)MN; (void)KB; (void)VT; (void)SSQ; (void)X16; (void)P0; (void)OB; (void)CH; (void)WQN; (void)MT; (void)VW; (void)HB; (void)XS16; (void)SSQS; (void)P0S; (void)OS; (void)CHS; (void)HS; (void)QS;

#if MK_PER_PHASE
    const int soff = 0; const bool sfirst = false;
#else
    const int soff = SAMPLE_SHIFT ? (grp & 1) : 0;
    const bool sfirst = false;
#endif
    const int mflip = (MEMBER_FLIP && !MK_PER_PHASE) ? (MEMBER_FLIP_SEL) : 0;
#pragma unroll 1
    for (int ph = lo; ph < hi + soff; ++ph) {
#pragma unroll 1
    for (int pp = 0; pp < 2; ++pp) {
    const int which = pp ^ mflip;
    const int st = which ? ph - soff : ph;
    const bool doP = (which == 0), doS = (which == 1) || (st == 0);
    if (st < 0 || st >= NPHASES || (which == 1 && st == 0)) continue;
    if (IN(0)) { PH_BEGIN
        LAS float* scr = (LAS float*)(L + RING_OFF + wave * 16384);
        {
            constexpr int I_POOL = 4 * 4 * 8, I_Q = 16 * 32, I_KV = 16 * 64, I_UP = 16 * 128, I_DN = 64 * 32, I_IN = 16 * 96;
            constexpr int NITEMS = I_POOL + 2 * (I_Q + I_KV + I_Q + I_UP + I_DN) + I_IN + I_Q;
            for (int it = gw; it < NITEMS; it += NGW) {
                int r = it;
                if (r < I_POOL) { const int g = r >> 5, rr = r & 31, kb = rr >> 3, nb = rr & 7; p0_transpose_item(w_pool + g * 65536, 256, 256, WPOOL + g * 65536, 64 * kb, 32 * nb, 32 * nb, scr, lane); continue; } r -= I_POOL;
                bool done = false;
#pragma unroll 1
                for (int l = 0; l < 2 && !done; ++l) {
                    if (r < I_Q) { const int kb = r >> 5, nb = r & 31; p0_transpose_item(w_q + (size_t)l * D * D, D, D, WQ + (size_t)l * D * D, 64 * kb, 32 * nb, 32 * nb, scr, lane, g_attn + l * D); done = true; break; } r -= I_Q;
                    if (r < I_KV) { const int kb = r >> 6, nb = r & 63; p0_transpose_item(w_kv + (size_t)l * D * 2048, D, 2048, WKV + (size_t)l * 2048 * D, 64 * kb, 32 * nb, 32 * nb, scr, lane); done = true; break; } r -= I_KV;
                    if (r < I_Q) { const int kb = r >> 5, nb = r & 31; p0_transpose_item(w_o + (size_t)l * D * D, D, D, WO + (size_t)l * D * D, 64 * kb, 32 * nb, 32 * nb, scr, lane); done = true; break; } r -= I_Q;
                    if (r < I_UP) { const int kb = r >> 7, nb = r & 127; p0_transpose_item(w_up + (size_t)l * D * FF, D, FF, WUP + (size_t)l * FF * D, 64 * kb, 32 * nb, 32 * nb, scr, lane, g_ffn + l * D); done = true; break; } r -= I_UP;
                    if (r < I_DN) { const int kb = r >> 5, nb = r & 31; p0_transpose_item(w_down + (size_t)l * FF * D, FF, D, WDN + (size_t)l * D * FF, 64 * kb, 32 * nb, 32 * nb, scr, lane); done = true; break; } r -= I_DN;
                }
                if (done) continue;
                if (r < I_IN) { const int kb = r / 96, nb = r % 96; p0_transpose_item(w_conv_in, D, 3072, WIN, 64 * kb, 32 * nb, win_dest_row(32 * nb), scr, lane, g_mix + D); continue; } r -= I_IN;
                { const int kb = r >> 5, nb = r & 31; p0_transpose_item(w_conv_out, D, D, WOUT, 64 * kb, 32 * nb, 32 * nb, scr, lane); }
            }
        }
        for (int m = gw; m < MEMROWS; m += NGW) {
            const f32x4* xr = (const f32x4*)(mem_prompt + (size_t)m * D) + lane; f32x4 v[4]; float s = 0.f;
#pragma unroll
            for (int j = 0; j < 4; ++j) { v[j] = xr[64 * j]; s += (v[j][0] * v[j][0] + v[j][1] * v[j][1]) + (v[j][2] * v[j][2] + v[j][3] * v[j][3]); }
            const float rstd = __builtin_amdgcn_rsqf(wave_sum(s) * (1.f / D) + EPS);
#pragma unroll
            for (int l = 0; l < 2; ++l) { v2u* o8 = (v2u*)(MN + ((size_t)l * MEMROWS + m) * D) + lane;
#pragma unroll
                for (int j = 0; j < 4; ++j) { const f32x4 gg = *((const f32x4*)(g_mem + l * D) + lane + 64 * j); const f32x4 w = v[j] * rstd * gg; v2u o; o.x = pk2(w[0], w[1]); o.y = pk2(w[2], w[3]); o8[64 * j] = o; } }
        }
        for (int m = gw; m < 2 * D; m += NGW) {
            const float gk = g_attn[m]; const f32x4* xr = (const f32x4*)(w_q + (size_t)m * D) + lane; v2u* o8 = (v2u*)(WQN + (size_t)m * D) + lane;
            f32x4 v[4];
#pragma unroll
            for (int j = 0; j < 4; ++j) v[j] = xr[64 * j];
#pragma unroll
            for (int j = 0; j < 4; ++j) { const f32x4 w = v[j] * gk; v2u o; o.x = pk2(w[0], w[1]); o.y = pk2(w[2], w[3]); o8[64 * j] = o; }
        }
        for (int it = gw; it < MS * 4; it += NGW) {
            const int b = it >> 2, g = it & 3, c4 = g * 256 + lane * 4;
            const f32x4* xr = (const f32x4*)(x_sample + (size_t)b * D) + lane; float s = 0.f;
#pragma unroll
            for (int j = 0; j < 4; ++j) { const f32x4 v = xr[64 * j]; s += (v[0] * v[0] + v[1] * v[1]) + (v[2] * v[2] + v[3] * v[3]); }
            const float rstd = __builtin_amdgcn_rsqf(wave_sum(s) * (1.f / D) + EPS);
            const f32x4 u = *(const f32x4*)(x_sample + (size_t)b * D + c4) * rstd * *(const f32x4*)(g_mix + c4);
            const int W = 2 << g; f32x4 S = u;
            const float* sp = state_pool + (size_t)b * 15 * D + c4;
            float* po = out + OPS + (size_t)b * 15 * D + c4;
            f32x4 sv[15];
#pragma unroll
            for (int r = 0; r < 15; ++r) sv[r] = *(const f32x4*)(sp + (size_t)r * D);
#pragma unroll
            for (int r = 0; r < 15; ++r) { if (r >= 16 - W) S += sv[r]; if (r >= 1) *(f32x4*)(po + (size_t)(r - 1) * D) = sv[r]; }
            *(f32x4*)(po + (size_t)14 * D) = u;
            const f32x4 p = S * (1.0f / (float)W) - u; v2u o; o.x = pk2(p[0], p[1]); o.y = pk2(p[2], p[3]); *(v2u*)(P0S + (size_t)b * D + c4) = o;
        }
        __syncthreads();
        {
            LAS float* rs = (LAS float*)(L + RING_OFF);
            for (int it = vcu; it < BATCH * (SEQ / 32); it += G) {
                const int b = it >> 6, t0 = (it & 63) * 32;
                { f32x4 xv[6][4];
#pragma unroll
                  for (int j = 0; j < 6; ++j) { const int r = wave + 8 * j, t = t0 - 15 + r; const bool ok = (r < 47) && (t >= 0);
                      const f32x4* xr = (const f32x4*)(x_prompt + ((size_t)b * SEQ + (ok ? t : t0)) * D) + lane;
#pragma unroll
                      for (int q = 0; q < 4; ++q) xv[j][q] = xr[64 * q]; }
#pragma unroll
                  for (int j = 0; j < 6; ++j) { const int r = wave + 8 * j, t = t0 - 15 + r; float s = 0.f;
#pragma unroll
                      for (int q = 0; q < 4; ++q) { const f32x4 v = xv[j][q]; s += (v[0] * v[0] + v[1] * v[1]) + (v[2] * v[2] + v[3] * v[3]); }
                      const float rv = (t >= 0) ? __builtin_amdgcn_rsqf(wave_sum(s) * (1.f / D) + EPS) : 0.f;
                      if (lane == 0 && r < 47) rs[r] = rv; } }
                LDS_WAIT(); __syncthreads();
                const int g = wave & 3, tA = t0 + (wave >> 2) * 16, c4 = g * 256 + lane * 4;
                const float* xb = x_prompt + (size_t)b * SEQ * D + c4; const f32x4 g4 = *(const f32x4*)(g_mix + c4);
                bf16* pout = P0 + (size_t)b * SEQ * D + c4; float* poolout = out + OPP + (size_t)b * 15 * D + c4;
                const LAS float* rsw = rs + (wave >> 2) * 16;
                if (g == 0) pool_wave<2>(xb, rsw, g4, tA, pout, poolout); else if (g == 1) pool_wave<4>(xb, rsw, g4, tA, pout, poolout);
                else if (g == 2) pool_wave<8>(xb, rsw, g4, tA, pout, poolout); else pool_wave<16>(xb, rsw, g4, tA, pout, poolout);
                __syncthreads();
            }
        }
    }
    SEAM(0);

    if (IN(1)) { PH_BEGIN
        if (doP) { pg8::Gemm g{D, D, D}; pg8::KvOrder S{GS == 32 ? 16 : GS, (GS == 32 && mi >= 16) ? (1 << 20) : mi, grp, (const char*)MN, (const char*)WKV};
          pg8::EpiKV E{out + OMK, out + OMV, KB, VT};
          pg8::gemm_phase<pg8::EpiKV, pg8::KvOrder, true>(L + RING_OFF, g, S, E, TID_NOW); }
        if (doP) { pg8::Gemm g{D, 256, 256}; pg8::StaticOrder S;
          if (GS == 32) S.init(8, 4, 16, mi >= 16 ? mi - 16 : 1 << 20, grp * 8, P0, (size_t)256 * D * 2, WPOOL, (size_t)65536 * 2, (size_t)256 * 2);
          else S.init(8, 4, GS, mi, grp * 8, P0, (size_t)256 * D * 2, WPOOL, (size_t)65536 * 2, (size_t)256 * 2);
          pg8::EpiRes<true> E{x_prompt, X16, SSQ, pool_scale};
          pg8::gemm_phase<pg8::EpiRes<true>, pg8::StaticOrder, true>(L + RING_OFF, g, S, E, TID_NOW); }
        if (doS) { RELANE for (int cp = mi; cp < 32; cp += GS) s_res_unit<1>(P0S + (cp >> 3) * 256, D, WPOOL, 256, 256, cp, 16 * grp, x_sample, XS16, SSQS, pool_scale, L + RING_OFF, wave, lane); }
    }
    SEAM(1);

    if (IN(2)) { PH_BEGIN
        if (doS) { RELANE for (int cp = mi; cp < 32; cp += GS) s_q_unit(XS16, WQ, cp, 16 * grp, SSQS, QS, L + RING_OFF, wave, lane); }
        if (doP) for (int idx = mi; idx < 64; idx += GS) {
            const int ly = idx >> 5, kind = (idx >> 4) & 1, a = (idx >> 2) & 3, q = idx & 3;
            const bf16* Ap; const bf16* Bp; bf16* Op; pg8::Unit u; float sc;
            if (kind == 0) {
                Ap = KB + ((size_t)ly * MEMROWS + grp * 256) * D + a * 256; Bp = WQN + ((size_t)ly * D + 256 * q) * D + a * 256;
                Op = MT + (size_t)((ly * BATCH + grp) * NH + a) * 256 * D; u = pg8::Unit{0, q}; sc = QSCALE;
            } else {
                Ap = WO + ((size_t)ly * D + 256 * a) * D + q * 256; Bp = VT + ((size_t)ly * MEMROWS + grp * 256) * D + q * 256;
                Op = VW + (size_t)(ly * BATCH + grp) * D * D; u = pg8::Unit{a, q}; sc = 1.f;
            }
            pg8::Gemm g{D, D, 256}; pg8::SingleOrder S{u, (const char*)Ap, (const char*)Bp};
            pg8::EpiBf16 E{Op, D, sc};
            pg8::gemm_phase<pg8::EpiBf16, pg8::SingleOrder, true>(L + RING_OFF, g, S, E, TID_NOW);
            __syncthreads();
        }
    }
    {
        const int l = (st >= 7) ? 1 : 0, pb = l ? 10 : 3;
        {
            if (IN(7)) { PH_BEGIN
                const LAS float* rsdp = nullptr;
                if (doP && (GS & 7) == 0) { LAS float* t_ = (LAS float*)(L + RSD_OFF); rstd_table(SSQ, grp * 8 + (mi & 7), t_, tid); LDS_WAIT(); __syncthreads(); rsdp = t_; }
                if (doP) { pg8::Gemm g{D, D, D}; pg8::StaticOrder S; S.init(8, 12, GS, mi, grp * 8, X16, (size_t)256 * D * 2, WIN, (size_t)256 * D * 2);
                  pg8::EpiRow<2> E{OB, D, SSQ, 1.f, CH, out + OCP, rsdp};
                  pg8::gemm_phase<pg8::EpiRow<2>, pg8::StaticOrder, true>(L + RING_OFF, g, S, E, TID_NOW); }
                if (doS) { RELANE
                for (int c2 = mi; c2 < 32; c2 += GS) {
                    const int ca = 32 * c2, cb = ca + 16; const int ra = 1024 + (ca >> 7) * 256 + (ca & 127), rb = 1024 + (cb >> 7) * 256 + (cb & 127);
                    const int brow[6] = {ca, ra, ra + 128, cb, rb, rb + 128};
                    const float rs = srstd(SSQS, 16 * grp + (lane & 15), lane >> 4);
                    const int prow = 16 * grp + (lane & 15), pc = ((wave & 1) ? cb : ca) + 4 * (lane >> 4);
                    const f32x4 s0 = *(const f32x4*)(state_conv + ((size_t)prow * 2 + 0) * D + pc), s1 = *(const f32x4*)(state_conv + ((size_t)prow * 2 + 1) * D + pc);
                    const f32x4 w0 = *(const f32x4*)(w_conv + pc), w1 = *(const f32x4*)(w_conv + D + pc), w2 = *(const f32x4*)(w_conv + 2 * D + pc);
                    sgemm2<1, 6, 3, 4>(XS16, D, 16 * grp, WIN, D, brow, D, L + RING_OFF, wave, lane, [&](f32x4 (&a)[3], int row, int ct0, int fq) {
                        const int c0 = (ct0 == 0 ? ca : cb) + 4 * fq;
                        const f32x4 gb = a[0] * rs, chv = a[1] * a[2] * (rs * rs);
                        const f32x4 cv = s0 * w0 + s1 * w1 + chv * w2;
                        const unsigned g01 = pk2(gb[0], gb[1]), g23 = pk2(gb[2], gb[3]);
                        v2u o; o.x = pk2(bflo(g01) * cv[0], bfhi(g01) * cv[1]); o.y = pk2(bflo(g23) * cv[2], bfhi(g23) * cv[3]);
                        *(v2u*)(P0S + (size_t)row * D + c0) = o;
                        *(f32x4*)(out + OCS + ((size_t)row * 2 + 0) * D + c0) = s1; *(f32x4*)(out + OCS + ((size_t)row * 2 + 1) * D + c0) = chv; }); }
                }
            }
            SEAM(7);
            if (IN(8)) { PH_BEGIN
                const int gt = mi * NTHREADS + tid, NT = GS * NTHREADS;
                if (doP) for (int idx0 = gt; idx0 < SEQ * 128; idx0 += 4 * NT) {
                    v4u gb[4], c2[4], c1[4], c0[4];
#pragma unroll
                    for (int q = 0; q < 4; ++q) { const int idx = idx0 + q * NT; const bool ok = idx < SEQ * 128; const int t = ok ? (idx >> 7) : 0, row = grp * SEQ + t, c8 = (idx & 127) * 8;
                        gb[q] = *(const v4u*)(OB + (size_t)row * D + c8); c2[q] = *(const v4u*)(CH + (size_t)row * D + c8);
                        c1[q] = *(const v4u*)(CH + (size_t)(row - (t >= 1 ? 1 : 0)) * D + c8); c0[q] = *(const v4u*)(CH + (size_t)(row - (t >= 2 ? 2 : 0)) * D + c8); }
#pragma unroll
                    for (int q = 0; q < 4; ++q) { const int idx = idx0 + q * NT; if (idx >= SEQ * 128) break; const int t = idx >> 7, row = grp * SEQ + t, c8 = (idx & 127) * 8;
                        if (t < 1) c1[q] = (v4u){0u, 0u, 0u, 0u};
                        if (t < 2) c0[q] = (v4u){0u, 0u, 0u, 0u};
                        const f32x4 w0a = *(const f32x4*)(w_conv + c8), w0b = *(const f32x4*)(w_conv + c8 + 4), w1a = *(const f32x4*)(w_conv + D + c8), w1b = *(const f32x4*)(w_conv + D + c8 + 4),
                                    w2a = *(const f32x4*)(w_conv + 2 * D + c8), w2b = *(const f32x4*)(w_conv + 2 * D + c8 + 4);
                        v4u o;
#pragma unroll
                        for (int j = 0; j < 4; ++j) { const float wl0 = (j < 2) ? w0a[2 * j] : w0b[2 * j - 4], wh0 = (j < 2) ? w0a[2 * j + 1] : w0b[2 * j - 3];
                            const float wl1 = (j < 2) ? w1a[2 * j] : w1b[2 * j - 4], wh1 = (j < 2) ? w1a[2 * j + 1] : w1b[2 * j - 3];
                            const float wl2 = (j < 2) ? w2a[2 * j] : w2b[2 * j - 4], wh2 = (j < 2) ? w2a[2 * j + 1] : w2b[2 * j - 3];
                            const float lo_ = bflo(gb[q][j]) * (bflo(c0[q][j]) * wl0 + bflo(c1[q][j]) * wl1 + bflo(c2[q][j]) * wl2);
                            const float hi_ = bfhi(gb[q][j]) * (bfhi(c0[q][j]) * wh0 + bfhi(c1[q][j]) * wh1 + bfhi(c2[q][j]) * wh2);
                            o[j] = pk2(lo_, hi_); }
                        *(v4u*)(P0 + (size_t)row * D + c8) = o; }
                }
                if (doS) { for (int cp = mi; cp < 32; cp += GS) s_res_unit<4>(P0S, D, WOUT, D, D, cp, 16 * grp, nullptr, XS16, SSQS, nullptr, L + RING_OFF, wave, lane); }
            }
            SEAM(8);
            if (IN(9)) { PH_BEGIN
                if (doP) { pg8::Gemm g{D, D, D}; pg8::StaticOrder S; S.init(8, 4, GS, mi, grp * 8, P0, (size_t)256 * D * 2, WOUT, (size_t)256 * D * 2);
                  pg8::EpiRes<false> E{nullptr, X16, SSQ, nullptr};
                  pg8::gemm_phase<pg8::EpiRes<false>, pg8::StaticOrder, true>(L + RING_OFF, g, S, E, TID_NOW); }
                if (doS) { RELANE for (int cp = mi; cp < 32; cp += GS) s_q_unit(XS16, WQ + (size_t)D * D, cp, 16 * grp, SSQS, QS, L + RING_OFF, wave, lane); }
            }
            SEAM(9);
        }
#define LAYER_W const bf16* WQl = WQ + (size_t)l * D * D; const bf16* WOl = WO + (size_t)l * D * D; const bf16* WUPl = WUP + (size_t)l * FF * D; const bf16* WDNl = WDN + (size_t)l * D * FF; (void)WQl; (void)WOl; (void)WUPl; (void)WDNl;
        if (IN(pb)) { PH_BEGIN LAYER_W
#pragma unroll 1
            for (int half = 0; half < 2; ++half) {
            const bool sampleHalf = ((half == 0) == sfirst);
            if (doP && !sampleHalf) for (int itl = mi; itl < 32; itl += GS) {
                const int pm = grp * 8 + (itl >> 2), h = itl & 3;
                pg8::Gemm g{D, D, D}; pg8::SingleOrder S{{pm, h}, (const char*)(X16 + (size_t)pm * 256 * D), (const char*)(MT + (size_t)((l * BATCH + grp) * NH + h) * 256 * D)};
                pg8::EpiSoftmax E{OB, D, SSQ};
                pg8::gemm_phase<pg8::EpiSoftmax, pg8::SingleOrder, false>(L + RING_OFF, g, S, E, TID_NOW);
                LDS_WAIT(); __builtin_amdgcn_s_barrier(); asm volatile("" ::: "memory");
            }
            if (doS && sampleHalf) { RELANE
                LAS float* sc = (LAS float*)(L + RING_OFF);
                LAS float* po = (LAS float*)(L + RING_OFF + 1024);
                for (int it0 = mi; it0 < 64; it0 += 2 * GS) {
                    const bool pair = (it0 + GS < 64);
#pragma unroll 1
                    for (int iu = 0; iu < 2; ++iu) {
                        if (iu == 1 && !pair) break;
                        const int it = it0 + iu * GS, b = 16 * grp + (it >> 2), h = it & 3;
                        const f32x4 q4 = *(const f32x4*)(QS + (size_t)b * D + h * 256 + lane * 4);
                        const float* kp = cache_k + (((size_t)l * MS + b) * NMEM + wave * 32) * D + h * 256 + lane * 4;
                        const float* vp = cache_v + (((size_t)l * MS + b) * NMEM + wave * 32) * D + h * 256 + lane * 4;
                        f32x4 kv[32]; float p[32];
#pragma unroll
                        for (int n = 0; n < 32; ++n) kv[n] = *(const f32x4*)(kp + (size_t)n * D);
#pragma unroll
                        for (int n = 0; n < 32; ++n) { p[n] = (q4[0] * kv[n][0] + q4[1] * kv[n][1]) + (q4[2] * kv[n][2] + q4[3] * kv[n][3]); kv[n] = *(const f32x4*)(vp + (size_t)n * D); }
                        treduce32(p, lane);
                        if ((lane & 1) == 0) sc[wave * 32 + (lane >> 1)] = p[0];
                        LDS_WAIT(); __builtin_amdgcn_s_barrier(); asm volatile("" ::: "memory");
                        float mx, sm = 0.f; const f32x4 sv = *(const LAS f32x4*)(sc + lane * 4);
                        mx = fmaxf(fmaxf(sv[0], sv[1]), fmaxf(sv[2], sv[3]));
                        mx = wave_max(mx);
#pragma unroll
                        for (int j = 0; j < 4; ++j) sm += __builtin_amdgcn_exp2f(sv[j] - mx);
                        sm = wave_sum(sm);
                        f32x4 acc = {0.f, 0.f, 0.f, 0.f};
#pragma unroll
                        for (int n = 0; n < 32; ++n) { const float pn_ = __builtin_amdgcn_exp2f(sc[wave * 32 + n] - mx); acc += kv[n] * pn_; }
                        *(LAS f32x4*)(po + wave * 256 + lane * 4) = acc;
                        LDS_WAIT(); __builtin_amdgcn_s_barrier(); asm volatile("" ::: "memory");
                        if (tid < 256) { float o = 0.f;
#pragma unroll
                            for (int w = 0; w < 8; ++w) o += po[w * 256 + tid];
                            OS[(size_t)b * D + h * 256 + tid] = (bf16)f2bf(o / sm); }
                        LDS_WAIT(); __builtin_amdgcn_s_barrier(); asm volatile("" ::: "memory");
                    }
                }
            }
            }
        }
        SEAM(pb);
        if (IN(pb + 1)) { PH_BEGIN LAYER_W
            if (doP) { pg8::Gemm g{D, D, D}; pg8::StaticOrder S; S.init(8, 4, GS, mi, grp * 8, OB, (size_t)256 * D * 2, VW + (size_t)(l * BATCH + grp) * D * D, (size_t)256 * D * 2);
              pg8::EpiRes<false> E{nullptr, X16, SSQ, nullptr};
              pg8::gemm_phase<pg8::EpiRes<false>, pg8::StaticOrder, true>(L + RING_OFF, g, S, E, TID_NOW); }
            if (doS) { RELANE for (int cp = mi; cp < 32; cp += GS) s_res_unit<4>(OS, D, WOl, D, D, cp, 16 * grp, nullptr, XS16, SSQS, nullptr, L + RING_OFF, wave, lane); }
        }
        SEAM(pb + 2);
        if (IN(pb + 2)) { PH_BEGIN LAYER_W
            const LAS float* rsdp = nullptr;
            if (doP && (GS & 7) == 0) { LAS float* t_ = (LAS float*)(L + RSD_OFF); rstd_table(SSQ, grp * 8 + (mi & 7), t_, tid); LDS_WAIT(); __syncthreads(); rsdp = t_; }
            if (doP) { pg8::Gemm g{D, D, D}; pg8::StaticOrder S; S.init(8, 16, GS, mi, grp * 8, X16, (size_t)256 * D * 2, WUPl, (size_t)256 * D * 2);
              pg8::EpiRow<1> E{HB, FF, SSQ, 1.f, nullptr, nullptr, rsdp};
              pg8::gemm_phase<pg8::EpiRow<1>, pg8::StaticOrder, true>(L + RING_OFF, g, S, E, TID_NOW); }
            if (doS) { RELANE for (int c8 = mi; c8 < 32; c8 += GS) { const int brow[8] = {128 * c8, 128 * c8 + 16, 128 * c8 + 32, 128 * c8 + 48, 128 * c8 + 64, 128 * c8 + 80, 128 * c8 + 96, 128 * c8 + 112};
                const float rs = srstd(SSQS, 16 * grp + (lane & 15), lane >> 4);
                sgemm2<1, 8, 1, 4>(XS16, D, 16 * grp, WUPl, D, brow, D, L + RING_OFF, wave, lane, [&](f32x4 (&a)[1], int row, int ct0, int fq) {
                    const f32x4 v0 = relu2(a[0] * rs);
                    v2u p0; p0.x = pk2(v0[0], v0[1]); p0.y = pk2(v0[2], v0[3]);
                    *(v2u*)(HS + (size_t)row * FF + 128 * c8 + 16 * ct0 + 4 * fq) = p0; }); } }
        }
        SEAM(pb + 3);
        if (IN(pb + 3)) { PH_BEGIN LAYER_W
            if (doP) { pg8::Gemm g{FF, FF, FF}; pg8::StaticOrder S; S.init(8, 4, GS, mi, grp * 8, HB, (size_t)256 * FF * 2, WDNl, (size_t)256 * FF * 2);
              pg8::EpiRes<false> E{nullptr, X16, SSQ, nullptr};
              pg8::gemm_phase<pg8::EpiRes<false>, pg8::StaticOrder, true>(L + RING_OFF, g, S, E, TID_NOW); }
            if (doS) { RELANE for (int cp = mi; cp < 32; cp += GS) s_res_unit<8>(HS, FF, WDNl, FF, FF, cp, 16 * grp, nullptr, XS16, SSQS, nullptr, L + RING_OFF, wave, lane); }
        }
        SEAM(pb + 4);
    }
    if (IN(14)) { PH_BEGIN
        const int mlo = doP ? 0 : SEQ, mhi = doS ? SEQ + 16 : SEQ;
        for (int ml0 = mlo + mi * NWAVES + wave; ml0 < mhi; ml0 += 4 * GS * NWAVES) {
            float sv[4]; v4u xw[4][2];
#pragma unroll
            for (int q = 0; q < 4; ++q) { const int ml = ml0 + q * GS * NWAVES; const bool ok = ml < mhi; const int mlc = ok ? ml : ml0;
                const bf16* xr;
                if (mlc < SEQ) { const int m = grp * SEQ + mlc; sv[q] = (lane < 16) ? SSQ[(size_t)m * 16 + lane] : 0.f; xr = X16 + (size_t)m * D; }
                else { const int r = 16 * grp + (mlc - SEQ); sv[q] = SSQS[r * 64 + lane]; xr = XS16 + (size_t)r * D; }
                xw[q][0] = *((const v4u*)xr + lane); xw[q][1] = *((const v4u*)xr + lane + 64); }
#pragma unroll
            for (int q = 0; q < 4; ++q) { const int ml = ml0 + q * GS * NWAVES; if (ml >= mhi) break;
                const float rs = __builtin_amdgcn_rsqf(wave_sum(sv[q]) * (1.f / D) + EPS);
                float* yr = (ml < SEQ) ? out + OY + (size_t)(grp * SEQ + ml) * D : out + OYS + (size_t)(16 * grp + (ml - SEQ)) * D;
#pragma unroll
                for (int j = 0; j < 2; ++j) { const v4u w = xw[q][j]; const f32x4 g0 = *((const f32x4*)g_final + 2 * (lane + 64 * j)), g1 = *((const f32x4*)g_final + 2 * (lane + 64 * j) + 1);
                    const f32x4 x0 = {bflo(w.x), bfhi(w.x), bflo(w.y), bfhi(w.y)}, x1 = {bflo(w.z), bfhi(w.z), bflo(w.w), bfhi(w.w)};
                    f32x4* yp = (f32x4*)yr + 2 * (lane + 64 * j); yp[0] = x0 * rs * g0; yp[1] = x1 * rs * g1; } }
        }
    }
    }
    if (ph + 1 < hi + soff) { if (ph == 0) { GRID_BAR();
#if STAGGER_TICKS > 0
            { const unsigned long long t0 = __builtin_amdgcn_s_memrealtime(); const unsigned long long dt = (unsigned long long)grp * STAGGER_TICKS;
              while (__builtin_amdgcn_s_memrealtime() - t0 < dt) __builtin_amdgcn_s_sleep(4); }
#endif
        } else GROUP_BAR(); }
    }
#undef IN
#undef SEAM
#undef GRID_BAR
}

extern "C" void kernel_launch(void* const* d_in, const int* in_sizes, int n_in, void* d_out, int out_size, void* d_ws, size_t ws_size, hipStream_t stream) {
    static int grid = 0;
    if (grid == 0) {
        if (n_in != 22 || ws_size < WS_END) { fprintf(stderr, "kernel_launch: unexpected inputs (n_in %d, ws %zu)\n", n_in, ws_size); grid = -1; return; }
        int dev = 0, cus = 0, per_cu = 0;
        if (hipGetDevice(&dev) != hipSuccess || hipDeviceGetAttribute(&cus, hipDeviceAttributeMultiprocessorCount, dev) != hipSuccess) { grid = -1; return; }
        if (hipFuncSetAttribute((const void*)mk_fwd, hipFuncAttributeMaxDynamicSharedMemorySize, LDS_BYTES) != hipSuccess) { fprintf(stderr, "kernel_launch: hipFuncSetAttribute failed\n"); grid = -1; return; }
        if (hipOccupancyMaxActiveBlocksPerMultiprocessor(&per_cu, (const void*)mk_fwd, NTHREADS, LDS_BYTES) != hipSuccess || per_cu < 1)
            fprintf(stderr, "kernel_launch: note: occupancy query reports %d workgroups per CU\n", per_cu);
        (void)hipGetLastError();
        grid = cus;
    }
    if (grid < 0) return;
    (void)hipMemsetAsync((char*)d_ws + WS_CTL, 0, CTL_ZERO_BYTES, stream);
    Args a{};
    for (int i = 0; i < 22; ++i) a.in[i] = (const float*)d_in[i];
    a.out = (float*)d_out; a.ws = (unsigned char*)d_ws;
#if MK_PER_PHASE
    for (int p = 0; p < NPHASES; ++p) { a.ph_lo = p; a.ph_hi = p + 1; hipLaunchKernelGGL(mk_fwd, dim3(grid), dim3(NTHREADS), LDS_BYTES, stream, a); }
#else
    a.ph_lo = 0; a.ph_hi = NPHASES; hipLaunchKernelGGL(mk_fwd, dim3(grid), dim3(NTHREADS), LDS_BYTES, stream, a);
#endif
}
```

```cpp
#include <hip/hip_runtime.h>
#include <cstdio>
#include <cstdint>

#ifndef SAMPLE_SHIFT
#define SAMPLE_SHIFT 1
#endif
#ifndef MEMBER_FLIP
#define MEMBER_FLIP 1
#endif
#ifndef MEMBER_FLIP_SEL
#define MEMBER_FLIP_SEL (mi & 1)
#endif
#ifndef STAGGER_TICKS
#define STAGGER_TICKS 0
#endif
#ifndef MK_PER_PHASE
#define MK_PER_PHASE 0
#endif

constexpr int D = 1024, BATCH = 8, SEQ = 2048, MP = BATCH * SEQ  , MS = 128  ;
constexpr int NMEM = 256, NH = 4, HD = 256, FF = 4096, MEMROWS = BATCH * NMEM  ;
constexpr float EPS = 1e-6f;
constexpr float QSCALE = 0.0625f * 1.4426950408889634f;

constexpr size_t OY = 0, OYS = 16777216, OPP = 16908288, OCP = 17031168, OMK = 17047552, OMV = 21241856, OPS = 25436160, OCS = 27402240;

__device__ __forceinline__ int lane_id_opaque() { int l; asm volatile("v_mbcnt_lo_u32_b32 %0, -1, 0\n\tv_mbcnt_hi_u32_b32 %0, -1, %0" : "=v"(l)); return l; }
#define SWZ_XOR(v, m) __builtin_bit_cast(float, __builtin_amdgcn_ds_swizzle(__builtin_bit_cast(int, (float)(v)), (((m) << 10) | 0x1f)))
__device__ __forceinline__ void swap32(float& a, float& b) { asm volatile("s_nop 1\n\tv_permlane32_swap_b32 %0, %1\n\ts_nop 1" : "+v"(a), "+v"(b)); }
__device__ __forceinline__ float add_x32(float v) { float a = v, b = v; swap32(a, b); return a + b; }
__device__ __forceinline__ float max_x32(float v) { float a = v, b = v; swap32(a, b); return fmaxf(a, b); }
__device__ __forceinline__ float add_x16_x32(float v) { v += SWZ_XOR(v, 16); return add_x32(v); }
__device__ __forceinline__ float max_x16_x32(float v) { v = fmaxf(v, SWZ_XOR(v, 16)); return max_x32(v); }
__device__ __forceinline__ float wave_sum(float v) { v += SWZ_XOR(v, 1); v += SWZ_XOR(v, 2); v += SWZ_XOR(v, 4); v += SWZ_XOR(v, 8); v += SWZ_XOR(v, 16); return add_x32(v); }
__device__ __forceinline__ float wave_max(float v) { v = fmaxf(v, SWZ_XOR(v, 1)); v = fmaxf(v, SWZ_XOR(v, 2)); v = fmaxf(v, SWZ_XOR(v, 4)); v = fmaxf(v, SWZ_XOR(v, 8)); v = fmaxf(v, SWZ_XOR(v, 16)); return max_x32(v); }

namespace pg8 {
#define PG8_LAS __attribute__((address_space(3)))
typedef unsigned short bf16_t;
typedef short bf16x8 __attribute__((ext_vector_type(8)));
typedef float f32x4 __attribute__((ext_vector_type(4)));
typedef float f32x2 __attribute__((ext_vector_type(2)));
typedef unsigned u32x4 __attribute__((ext_vector_type(4)));
typedef unsigned u32x2 __attribute__((ext_vector_type(2)));
constexpr int BM = 256, BK = 64, HALF = 128, HTB = HALF * BK * 2, STAGE_BYTES = 8 * HTB, NXCD = 8, WGM = 8;

__host__ __device__ __forceinline__ int lds_byte(int r, int c) { const int st = (r >> 4) * 2 + (c >> 5), rr = r & 15, cc = c & 31, ob = rr * 64 + cc * 2; return st * 1024 + (ob ^ (((ob >> 9) & 1) << 5)); }
__host__ __device__ __forceinline__ void stage_rc(int b, int& R, int& C) { const int st = b / 1024, sb = b % 1024, swz = sb ^ (((sb >> 9) & 1) << 5); R = (st >> 1) * 16 + swz / 64; C = (st & 1) * 32 + (swz % 64) / 2; }
__host__ __device__ __forceinline__ int perm32(int rho) { const int n = rho >> 4, i = rho & 15; return 8 * (i >> 2) + 4 * n + (i & 3); }

struct Unit { int pm, pn; };
struct Gemm { int lda, ldb, K; };

__device__ __forceinline__ unsigned cvt_pk_bf16(float lo, float hi) { unsigned r; asm volatile("v_cvt_pk_bf16_f32 %0, %1, %2" : "=v"(r) : "v"(lo), "v"(hi)); return r; }

struct StaticOrder {
    int nM, nN, nwg, G, c, pm0;
    const char* A; const char* B; size_t astep, bstep, apn;
    __device__ void init(int nM_, int nN_, int G_, int c_, int pm0_, const void* A_, size_t astep_, const void* B_, size_t bstep_, size_t apn_ = 0) {
        nM = nM_; nN = nN_; nwg = nM * nN; G = G_; c = c_; pm0 = pm0_; A = (const char*)A_; B = (const char*)B_; astep = astep_; bstep = bstep_; apn = apn_; }
    __device__ bool next(int i, Unit& u) const {
        const long L = (long)i * G + c; if (L >= nwg) return false;
        u.pm = pm0 + (int)(L % nM); u.pn = (int)(L / nM); return true;
    }
    __device__ __forceinline__ const char* aptr(const Unit& u) const { return A + (size_t)u.pm * astep + (size_t)u.pn * apn; }
    __device__ __forceinline__ const char* bptr(const Unit& u) const { return B + (size_t)u.pn * bstep; }
};
struct KvOrder {
    int G, c, batch; const char* A; const char* B;
    __device__ bool next(int i, Unit& u) const { const int L = i * G + c; if (L >= 16) return false; u.pm = (L >> 3) * 8 + batch; u.pn = L & 7; return true; }
    __device__ __forceinline__ const char* aptr(const Unit& u) const { return A + (size_t)u.pm * (256 * 1024 * 2); }
    __device__ __forceinline__ const char* bptr(const Unit& u) const { return B + (size_t)((u.pm >> 3) * 2048 + u.pn * 256) * (1024 * 2); }
};
struct SingleOrder {
    Unit u0; const char* A; const char* B;
    __device__ bool next(int i, Unit& u) const { if (i) return false; u = u0; return true; }
    __device__ __forceinline__ const char* aptr(const Unit&) const { return A; }
    __device__ __forceinline__ const char* bptr(const Unit&) const { return B; }
};


template <bool BASE32> struct EpiRes {
    static constexpr bool PERM = true, AFTER_DRAIN = false;
    const float* base32; bf16_t* x16; float* ssq; const float* cscale;
    __device__ __forceinline__ void operator()(const f32x4 (&acc)[2][2][4][2], const Unit& u, int wr, int wc, int fr, int fq) const {
        const int col0 = u.pn * BM + wc * 32 + 8 * fq;
        f32x4 cs[2][2];
#pragma unroll
        for (int bj = 0; bj < 2; ++bj)
#pragma unroll
            for (int n = 0; n < 2; ++n) cs[bj][n] = cscale ? *(const f32x4*)(cscale + col0 + bj * HALF + n * 4) : (f32x4){1.f, 1.f, 1.f, 1.f};
        constexpr int HSTEP = BASE32 ? 1 : 2;
#pragma unroll
        for (int a0 = 0; a0 < 2; a0 += HSTEP) {
        u32x4 bw[HSTEP][4][2]; f32x4 bf[BASE32 ? 1 : 1][4][2][2];
#pragma unroll
        for (int ah = 0; ah < HSTEP; ++ah)
#pragma unroll
            for (int m = 0; m < 4; ++m) { const int row = u.pm * BM + (a0 + ah) * HALF + wr * 64 + m * 16 + fr; const size_t off = (size_t)row * D + col0;
#pragma unroll
                for (int bj = 0; bj < 2; ++bj) {
                    if (BASE32) { bf[0][m][bj][0] = *(const f32x4*)(base32 + off + bj * HALF); bf[0][m][bj][1] = *(const f32x4*)(base32 + off + bj * HALF + 4); }
                    else bw[ah][m][bj] = *(const u32x4*)(x16 + off + bj * HALF); } }
#pragma unroll
        for (int ah = 0; ah < HSTEP; ++ah) { const int ai = a0 + ah;
#pragma unroll
            for (int m = 0; m < 4; ++m) { const int row = u.pm * BM + ai * HALF + wr * 64 + m * 16 + fr; const size_t off = (size_t)row * D + col0; float ss = 0.f;
#pragma unroll
                for (int bj = 0; bj < 2; ++bj) { f32x4 b0, b1;
                    if (BASE32) { b0 = bf[0][m][bj][0]; b1 = bf[0][m][bj][1]; }
                    else { const u32x4 w = bw[ah][m][bj];
                        b0 = (f32x4){__builtin_bit_cast(float, w.x << 16), __builtin_bit_cast(float, w.x & 0xffff0000u), __builtin_bit_cast(float, w.y << 16), __builtin_bit_cast(float, w.y & 0xffff0000u)};
                        b1 = (f32x4){__builtin_bit_cast(float, w.z << 16), __builtin_bit_cast(float, w.z & 0xffff0000u), __builtin_bit_cast(float, w.w << 16), __builtin_bit_cast(float, w.w & 0xffff0000u)}; }
                    const f32x4 v0 = b0 + acc[ai][bj][m][0] * cs[bj][0], v1 = b1 + acc[ai][bj][m][1] * cs[bj][1];
                    ss += ((v0[0] * v0[0] + v0[1] * v0[1]) + (v0[2] * v0[2] + v0[3] * v0[3])) + ((v1[0] * v1[0] + v1[1] * v1[1]) + (v1[2] * v1[2] + v1[3] * v1[3]));
                    u32x4 o; o.x = cvt_pk_bf16(v0[0], v0[1]); o.y = cvt_pk_bf16(v0[2], v0[3]); o.z = cvt_pk_bf16(v1[0], v1[1]); o.w = cvt_pk_bf16(v1[2], v1[3]);
                    *(u32x4*)(x16 + off + bj * HALF) = o; }
                ss = add_x16_x32(ss);
                if (fq == 0) ssq[(size_t)row * 16 + u.pn * 4 + wc] = ss; }
        }
        }
    }
};
__device__ __forceinline__ float rstd_from_ssq16(const float* ssq, int row) {
    const f32x4* sp = (const f32x4*)(ssq + (size_t)row * 16); const f32x4 s = (sp[0] + sp[1]) + (sp[2] + sp[3]);
    return __builtin_amdgcn_rsqf(((s[0] + s[1]) + (s[2] + s[3])) * (1.0f / D) + EPS);
}
template <int MODE> struct EpiRow {
    static constexpr bool PERM = true, AFTER_DRAIN = false;
    bf16_t* O; int ldc; const float* ssq; float scale; bf16_t* O2; float* convout; const PG8_LAS float* rsd;
    __device__ __forceinline__ void operator()(const f32x4 (&acc)[2][2][4][2], const Unit& u, int wr, int wc, int fr, int fq) const {
        const int colw = wc * 32 + 8 * fq;
        float rsv[2][4];
        if (rsd) {
#pragma unroll
          for (int ai = 0; ai < 2; ++ai)
#pragma unroll
              for (int m = 0; m < 4; ++m) rsv[ai][m] = rsd[ai * HALF + wr * 64 + m * 16 + fr];
        } else { f32x4 qv[2][4];
#pragma unroll
          for (int ai = 0; ai < 2; ++ai)
#pragma unroll
              for (int m = 0; m < 4; ++m) qv[ai][m] = *(const f32x4*)(ssq + (size_t)(u.pm * BM + ai * HALF + wr * 64 + m * 16 + fr) * 16 + 4 * fq);
#pragma unroll
          for (int ai = 0; ai < 2; ++ai)
#pragma unroll
              for (int m = 0; m < 4; ++m) { const f32x4 q = qv[ai][m]; rsv[ai][m] = __builtin_amdgcn_rsqf(add_x16_x32((q[0] + q[1]) + (q[2] + q[3])) * (1.0f / D) + EPS); } }
#pragma unroll
        for (int ai = 0; ai < 2; ++ai)
#pragma unroll
            for (int m = 0; m < 4; ++m) { const int row = u.pm * BM + ai * HALF + wr * 64 + m * 16 + fr; const float rs = rsv[ai][m];
                if (MODE == 2 && u.pn >= 4) {
                    const float r2 = rs * rs; const f32x4 v0 = acc[ai][0][m][0] * acc[ai][1][m][0] * r2, v1 = acc[ai][0][m][1] * acc[ai][1][m][1] * r2;
                    const int ch = (u.pn - 4) * 128 + colw;
                    u32x4 w; w.x = cvt_pk_bf16(v0[0], v0[1]); w.y = cvt_pk_bf16(v0[2], v0[3]); w.z = cvt_pk_bf16(v1[0], v1[1]); w.w = cvt_pk_bf16(v1[2], v1[3]);
                    *(u32x4*)(O2 + (size_t)row * D + ch) = w;
                    const int t = row & (SEQ - 1);
                    if (t >= SEQ - 2) { float* cp = convout + ((size_t)(row >> 11) * 2 + (t - (SEQ - 2))) * D + ch; *(f32x4*)cp = v0; *(f32x4*)(cp + 4) = v1; }
                } else {
                    const float sc = (MODE == 0) ? rs * scale : rs;
#pragma unroll
                    for (int bj = 0; bj < 2; ++bj) { f32x4 v0 = acc[ai][bj][m][0] * sc, v1 = acc[ai][bj][m][1] * sc;
                        if (MODE == 1) {
#pragma unroll
                            for (int j = 0; j < 4; ++j) { const float a = fmaxf(v0[j], 0.f), b = fmaxf(v1[j], 0.f); v0[j] = a * a; v1[j] = b * b; } }
                        u32x4 w; w.x = cvt_pk_bf16(v0[0], v0[1]); w.y = cvt_pk_bf16(v0[2], v0[3]); w.z = cvt_pk_bf16(v1[0], v1[1]); w.w = cvt_pk_bf16(v1[2], v1[3]);
                        *(u32x4*)(O + (size_t)row * ldc + u.pn * BM + bj * HALF + colw) = w; }
                } }
    }
};
struct EpiBf16 {
    static constexpr bool PERM = true, AFTER_DRAIN = false;
    bf16_t* O; int ldc; float scale;
    __device__ __forceinline__ void operator()(const f32x4 (&acc)[2][2][4][2], const Unit& u, int wr, int wc, int fr, int fq) const {
        const int colw = u.pn * BM + wc * 32 + 8 * fq;
#pragma unroll
        for (int ai = 0; ai < 2; ++ai)
#pragma unroll
            for (int m = 0; m < 4; ++m) { const int row = u.pm * BM + ai * HALF + wr * 64 + m * 16 + fr;
#pragma unroll
                for (int bj = 0; bj < 2; ++bj) { const f32x4 v0 = acc[ai][bj][m][0] * scale, v1 = acc[ai][bj][m][1] * scale;
                    u32x4 w; w.x = cvt_pk_bf16(v0[0], v0[1]); w.y = cvt_pk_bf16(v0[2], v0[3]); w.z = cvt_pk_bf16(v1[0], v1[1]); w.w = cvt_pk_bf16(v1[2], v1[3]);
                    *(u32x4*)(O + (size_t)row * ldc + colw + bj * HALF) = w; } }
    }
};
struct EpiKV {
    static constexpr bool PERM = false, AFTER_DRAIN = false;
    float* outk; float* outv; bf16_t* Kb; bf16_t* Vt;
    __device__ __forceinline__ void operator()(const f32x4 (&acc)[2][2][4][2], const Unit& u, int wr, int wc, int fr, int fq) const {
        const int layer = u.pm >> 3; const bool isV = u.pn >= 4; const int col0 = (u.pn & 3) * BM + wc * 32 + 4 * fq;
        float* outp = isV ? outv : outk;
#pragma unroll
        for (int ai = 0; ai < 2; ++ai)
#pragma unroll
            for (int m = 0; m < 4; ++m) { const int rowl = (u.pm & 7) * BM + ai * HALF + wr * 64 + m * 16 + fr; const size_t off = ((size_t)layer * MEMROWS + rowl) * D + col0;
#pragma unroll
                for (int bj = 0; bj < 2; ++bj)
#pragma unroll
                    for (int n = 0; n < 2; ++n) { const f32x4 v = acc[ai][bj][m][n]; *(f32x4*)(outp + off + bj * HALF + n * 16) = v;
                        if (!isV) { u32x2 p; p.x = cvt_pk_bf16(v[0], v[1]); p.y = cvt_pk_bf16(v[2], v[3]); *(u32x2*)(Kb + off + bj * HALF + n * 16) = p; }
                        else { u32x2 p; p.x = cvt_pk_bf16(v[0], v[1]); p.y = cvt_pk_bf16(v[2], v[3]); *(u32x2*)(Vt + off + bj * HALF + n * 16) = p; } } }
    }
};
struct EpiSoftmax {
    static constexpr bool PERM = true, AFTER_DRAIN = true;
    bf16_t* P; int ldp; const float* ssq;
    __device__ __forceinline__ void operator()(const f32x4 (&)[2][2][4][2], const Unit&, int, int, int, int) const {}
    __device__ __forceinline__ void fused(f32x4 (&acc)[2][2][4][2], const Unit& u, int wr, int wc, int fr, int fq, PG8_LAS unsigned char* lds, int wid, int lane) const {
        PG8_LAS float* Pm = (PG8_LAS float*)lds;
        PG8_LAS float* Ps = (PG8_LAS float*)(lds + 4096);
        float rsv[2][4];
        { f32x4 qv[2][4];
#pragma unroll
          for (int ai = 0; ai < 2; ++ai)
#pragma unroll
              for (int m = 0; m < 4; ++m) qv[ai][m] = *(const f32x4*)(ssq + (size_t)(u.pm * BM + ai * HALF + wr * 64 + m * 16 + fr) * 16 + 4 * fq);
#pragma unroll
          for (int ai = 0; ai < 2; ++ai)
#pragma unroll
              for (int m = 0; m < 4; ++m) { const f32x4 q = qv[ai][m]; rsv[ai][m] = __builtin_amdgcn_rsqf(add_x16_x32((q[0] + q[1]) + (q[2] + q[3])) * (1.0f / D) + EPS); } }
#pragma unroll
        for (int ai = 0; ai < 2; ++ai)
#pragma unroll
            for (int m = 0; m < 4; ++m) { float mx = -3.0e38f; const float rs = rsv[ai][m];
#pragma unroll
                for (int bj = 0; bj < 2; ++bj)
#pragma unroll
                    for (int n = 0; n < 2; ++n) { const f32x4 x = acc[ai][bj][m][n] * rs; acc[ai][bj][m][n] = x; mx = fmaxf(mx, fmaxf(fmaxf(x[0], x[1]), fmaxf(x[2], x[3]))); }
                mx = max_x16_x32(mx);
                if (fq == 0) Pm[(ai * HALF + wr * 64 + m * 16 + fr) * 4 + wc] = mx; }
        asm volatile("s_waitcnt lgkmcnt(0)" ::: "memory"); __builtin_amdgcn_s_barrier(); asm volatile("" ::: "memory");
#pragma unroll
        for (int ai = 0; ai < 2; ++ai)
#pragma unroll
            for (int m = 0; m < 4; ++m) { const int r = ai * HALF + wr * 64 + m * 16 + fr; const f32x4 q = *(const PG8_LAS f32x4*)(Pm + r * 4);
                const float mx = fmaxf(fmaxf(q[0], q[1]), fmaxf(q[2], q[3])); float s = 0.f;
#pragma unroll
                for (int bj = 0; bj < 2; ++bj)
#pragma unroll
                    for (int n = 0; n < 2; ++n) { f32x4 x = acc[ai][bj][m][n];
#pragma unroll
                        for (int j = 0; j < 4; ++j) { x[j] = __builtin_amdgcn_exp2f(x[j] - mx); s += x[j]; }
                        acc[ai][bj][m][n] = x; }
                s = add_x16_x32(s);
                if (fq == 0) Ps[r * 4 + wc] = s; }
        asm volatile("s_waitcnt lgkmcnt(0)" ::: "memory"); __builtin_amdgcn_s_barrier(); asm volatile("" ::: "memory");
        const int colw = u.pn * BM + wc * 32 + 8 * fq;
#pragma unroll
        for (int ai = 0; ai < 2; ++ai)
#pragma unroll
            for (int m = 0; m < 4; ++m) { const int r = ai * HALF + wr * 64 + m * 16 + fr; const f32x4 q = *(const PG8_LAS f32x4*)(Ps + r * 4);
                const float inv = __builtin_amdgcn_rcpf((q[0] + q[1]) + (q[2] + q[3]));
#pragma unroll
                for (int bj = 0; bj < 2; ++bj) { const f32x4 v0 = acc[ai][bj][m][0] * inv, v1 = acc[ai][bj][m][1] * inv;
                    u32x4 w; w.x = cvt_pk_bf16(v0[0], v0[1]); w.y = cvt_pk_bf16(v0[2], v0[3]); w.z = cvt_pk_bf16(v1[0], v1[1]); w.w = cvt_pk_bf16(v1[2], v1[3]);
                    *(u32x4*)(P + (size_t)(u.pm * BM + r) * ldp + bj * HALF + colw) = w; } }
    }
};

template <class Epi, class Sched, bool ALIGN_EPI>
__device__ __forceinline__ void gemm_phase(PG8_LAS unsigned char* lds, const Gemm g, const Sched& S, const Epi& E, int tid) {
    asm volatile("" : "+v"(tid));
    const int wid = __builtin_amdgcn_readfirstlane(tid >> 6), lane = tid & 63, wr = wid >> 2, wc = wid & 3, fr = lane & 15, fq = lane >> 4;
    const int nt = g.K / BK;
    unsigned voffA[2], voffB[2];
#pragma unroll
    for (int i = 0; i < 2; ++i) { int R, C; stage_rc(tid * 16 + i * 8192, R, C); const int Rb = Epi::PERM ? ((R & ~31) + perm32(R & 31)) : R;
        voffA[i] = (unsigned)(R * g.lda + C) * 2u; voffB[i] = (unsigned)(Rb * g.ldb + C) * 2u; }
    const size_t kstep = (size_t)(BK * 2);
    const size_t hstepA = (size_t)HALF * g.lda * 2, hstepB = (size_t)HALF * g.ldb * 2;
    const unsigned ldsw = (unsigned)wid * 1024u;
    const int aoff = lds_byte(wr * 64 + fr, fq * 8), boff = lds_byte(wc * 32 + fr, fq * 8);
#define PG8_SA(b, h) (((b) * 2 + (h)) * HTB)
#define PG8_SB(b, h) ((4 + (b) * 2 + (h)) * HTB)
#define PG8_STAGE(bufoff, gbase, voff) do { const char* _gb = (const char*)(gbase); asm volatile("" : "+s"(_gb));   \
        _Pragma("unroll") for (int _i = 0; _i < 2; ++_i) \
        __builtin_amdgcn_global_load_lds((const unsigned*)(_gb + (voff)[_i]), (PG8_LAS unsigned*)(lds + (bufoff) + ldsw + _i * 8192), 16, 0, 0); } while (0)
#define PG8_LDA(dst, b, h) do { _Pragma("unroll") for (int m = 0; m < 4; ++m) _Pragma("unroll") for (int k = 0; k < 2; ++k) dst[m][k] = *(const PG8_LAS bf16x8*)(lds + PG8_SA(b, h) + aoff + m * 2048 + k * 1024); } while (0)
#define PG8_LDB(dst, b, h) do { _Pragma("unroll") for (int n = 0; n < 2; ++n) _Pragma("unroll") for (int k = 0; k < 2; ++k) dst[n][k] = *(const PG8_LAS bf16x8*)(lds + PG8_SB(b, h) + boff + n * 2048 + k * 1024); } while (0)
#define PG8_MMA(ai, bj, At, Bt) do { __builtin_amdgcn_s_setprio(1); _Pragma("unroll") for (int m = 0; m < 4; ++m) _Pragma("unroll") for (int n = 0; n < 2; ++n) _Pragma("unroll") for (int k = 0; k < 2; ++k) \
        acc[ai][bj][m][n] = __builtin_amdgcn_mfma_f32_16x16x32_bf16(Bt[n][k], At[m][k], acc[ai][bj][m][n], 0, 0, 0); __builtin_amdgcn_s_setprio(0); } while (0)
#define PG8_WAIT_V(n) asm volatile("s_waitcnt vmcnt(" #n ")" ::: "memory")
#define PG8_WAIT_L(n) asm volatile("s_waitcnt lgkmcnt(" #n ")" ::: "memory")
#define PG8_BAR __builtin_amdgcn_s_barrier()
#define PG8_SCHED __builtin_amdgcn_sched_barrier(0)
    Unit cur, nxt; int ui = 0;
    if (!S.next(0, cur)) return;
    f32x4 acc[2][2][4][2];
#pragma unroll
    for (int a = 0; a < 2; ++a)
#pragma unroll
        for (int b = 0; b < 2; ++b)
#pragma unroll
            for (int m = 0; m < 4; ++m)
#pragma unroll
                for (int n = 0; n < 2; ++n) acc[a][b][m][n] = (f32x4){0.f, 0.f, 0.f, 0.f};
    bf16x8 At[4][2], B0[2][2], B1[2][2];
    const char* cA = S.aptr(cur); const char* cB = S.bptr(cur);
    PG8_STAGE(PG8_SB(0, 0), cB, voffB); PG8_STAGE(PG8_SB(0, 1), cB + hstepB, voffB); PG8_STAGE(PG8_SA(0, 0), cA, voffA); PG8_STAGE(PG8_SA(0, 1), cA + hstepA, voffA);
    if (wr == 1) PG8_BAR;
    PG8_WAIT_V(2); PG8_BAR;
    PG8_STAGE(PG8_SB(1, 0), cB + kstep, voffB); PG8_STAGE(PG8_SA(1, 0), cA + kstep, voffA); PG8_STAGE(PG8_SB(1, 1), cB + hstepB + kstep, voffB);
    PG8_WAIT_V(6); PG8_BAR;
    for (;;) {
        const bool has_next = S.next(ui + 1, nxt);
        const char* nA = has_next ? S.aptr(nxt) : cA; const char* nB = has_next ? S.bptr(nxt) : cB;
        for (int t = 0; t < nt; t += 2) {
            const bool last = (t == nt - 2);
            const char* a1 = cA + (size_t)(t + 1) * kstep;
            const char* a2 = last ? nA : cA + (size_t)(t + 2) * kstep; const char* b2 = last ? nB : cB + (size_t)(t + 2) * kstep;
            const char* a3 = a2 + kstep; const char* b3 = b2 + kstep;
            PG8_LDB(B0, 0, 0); PG8_LDB(B1, 0, 1); PG8_SCHED; PG8_LDA(At, 0, 0); PG8_STAGE(PG8_SA(1, 1), a1 + hstepA, voffA);
            PG8_WAIT_V(8); PG8_WAIT_L(0); PG8_BAR; PG8_MMA(0, 0, At, B0); PG8_MMA(0, 1, At, B1); PG8_BAR; PG8_SCHED;
            PG8_LDA(At, 0, 1); PG8_STAGE(PG8_SB(0, 0), b2, voffB); PG8_STAGE(PG8_SB(0, 1), b2 + hstepB, voffB); PG8_STAGE(PG8_SA(0, 0), a2, voffA);
            PG8_WAIT_V(8); PG8_WAIT_L(0); PG8_BAR; PG8_MMA(1, 0, At, B0); PG8_MMA(1, 1, At, B1); PG8_BAR; PG8_SCHED;
            PG8_LDB(B0, 1, 0); PG8_LDB(B1, 1, 1); PG8_SCHED; PG8_LDA(At, 1, 0); PG8_STAGE(PG8_SA(0, 1), a2 + hstepA, voffA);
            PG8_WAIT_V(8); PG8_WAIT_L(0); PG8_BAR; PG8_MMA(0, 0, At, B0); PG8_MMA(0, 1, At, B1); PG8_BAR; PG8_SCHED;
            PG8_LDA(At, 1, 1); PG8_STAGE(PG8_SB(1, 0), b3, voffB); PG8_STAGE(PG8_SB(1, 1), b3 + hstepB, voffB); PG8_STAGE(PG8_SA(1, 0), a3, voffA);
            PG8_WAIT_V(8); PG8_WAIT_L(0); PG8_BAR; PG8_MMA(1, 0, At, B0); PG8_MMA(1, 1, At, B1); PG8_BAR; PG8_SCHED;
        }
        if constexpr (ALIGN_EPI) { if (wr == 0) PG8_BAR; }
        if constexpr (!Epi::AFTER_DRAIN) { const int l2 = lane_id_opaque(); E(acc, cur, wr, wc, l2 & 15, l2 >> 4); }
        if (!has_next) break;
#pragma unroll
        for (int a = 0; a < 2; ++a)
#pragma unroll
            for (int b = 0; b < 2; ++b)
#pragma unroll
                for (int m = 0; m < 4; ++m)
#pragma unroll
                    for (int n = 0; n < 2; ++n) acc[a][b][m][n] = (f32x4){0.f, 0.f, 0.f, 0.f};
        cur = nxt; cA = nA; cB = nB; ++ui;
        if constexpr (ALIGN_EPI) { if (wr == 1) PG8_BAR; }
    }
    PG8_WAIT_V(0);
    if constexpr (!ALIGN_EPI) { if (wr == 0) PG8_BAR; }
    PG8_BAR;
    if constexpr (Epi::AFTER_DRAIN) { const int l2 = lane_id_opaque(); E.fused(acc, cur, wr, wc, l2 & 15, l2 >> 4, lds, wid, l2); }
#undef PG8_SA
#undef PG8_SB
#undef PG8_STAGE
#undef PG8_LDA
#undef PG8_LDB
#undef PG8_MMA
#undef PG8_WAIT_V
#undef PG8_WAIT_L
#undef PG8_BAR
#undef PG8_SCHED
}
}

constexpr int NWAVES = 8, NTHREADS = 512;
constexpr size_t MiB = 1u << 20;
constexpr size_t WS_CTL = 0, CTL_ZERO_BYTES = 256 * 1024;
constexpr size_t WS_WPOOL = 1 * MiB;
constexpr size_t WS_WQ = 2 * MiB;
constexpr size_t WS_WO = 6 * MiB;
constexpr size_t WS_WKV = 10 * MiB;
constexpr size_t WS_WUP = 18 * MiB;
constexpr size_t WS_WDN = 34 * MiB;
constexpr size_t WS_WIN = 50 * MiB;
constexpr size_t WS_WOUT = 56 * MiB;
constexpr size_t WS_MN = 58 * MiB;
constexpr size_t WS_KB = 66 * MiB;
constexpr size_t WS_VT = 74 * MiB;
constexpr size_t WS_SSQ = 82 * MiB;
constexpr size_t WS_SMALL = 84 * MiB;
constexpr size_t WS_X = 96 * MiB;
constexpr size_t WS_XG = 160 * MiB;
constexpr size_t WS_P0 = 192 * MiB;
constexpr size_t WS_O = 224 * MiB;
constexpr size_t WS_CH = 256 * MiB;
constexpr size_t WS_PS = 288 * MiB;
constexpr size_t WS_H = 320 * MiB;
constexpr size_t WS_WQN = 448 * MiB;
constexpr size_t WS_MT = 452 * MiB;
constexpr size_t WS_VW = 484 * MiB;
constexpr size_t WS_END = 516 * MiB;
constexpr size_t SS_X = WS_SMALL;
constexpr size_t SS_XG = SS_X + 512 * 1024;
constexpr size_t SS_SSQ = SS_XG + 256 * 1024;
constexpr size_t SS_P0 = SS_SSQ + 32 * 1024;
constexpr size_t SS_O = SS_P0 + 256 * 1024;
constexpr size_t SS_CH = SS_O + 256 * 1024;
constexpr size_t SS_H = SS_CH + 512 * 1024;
constexpr size_t SS_Q = SS_H + 1024 * 1024;
static_assert(SS_Q + 512 * 1024 <= WS_X, "sample buffers");
constexpr int CW_BAR = 4096, CW_BAR_STRIDE = 4096;

constexpr int RING_OFF = 0, RING_BYTES = 131072;
constexpr int LDSCTL_OFF = RING_BYTES, MISC_OFF = LDSCTL_OFF + 320;
constexpr int RSD_OFF = RING_BYTES + 1024;
constexpr int LDS_BYTES = 147456;

#define GAS __attribute__((address_space(1)))
#define LAS __attribute__((address_space(3)))
typedef unsigned short bf16;
typedef unsigned v4u __attribute__((ext_vector_type(4)));
typedef unsigned v2u __attribute__((ext_vector_type(2)));
typedef float f32x4 __attribute__((ext_vector_type(4)));
typedef short bf16x8 __attribute__((ext_vector_type(8)));
#define LDS_WAIT() asm volatile("s_waitcnt lgkmcnt(0)" ::: "memory")
#define VM_WAIT() asm volatile("s_waitcnt vmcnt(0)" ::: "memory")
__device__ __forceinline__ unsigned f2bf(float f) { unsigned u = __builtin_bit_cast(unsigned, f); return (u + 0x7fffu + ((u >> 16) & 1u)) >> 16; }
__device__ __forceinline__ unsigned pk2(float lo, float hi) { return f2bf(lo) | (f2bf(hi) << 16); }
__device__ __forceinline__ float bf2f(unsigned short h) { return __builtin_bit_cast(float, (unsigned)h << 16); }
__device__ __forceinline__ float bflo(unsigned w) { return __builtin_bit_cast(float, w << 16); }
__device__ __forceinline__ float bfhi(unsigned w) { return __builtin_bit_cast(float, w & 0xffff0000u); }

#define XB_TMO      128
#define XB_XCNT(j)  (256  + 64 * (j))
#define XB_XSUB(j)  (1280 + 64 * (j))
#define XB_XGEN(j)  (2304 + 64 * (j))
#define XB_TOP      3328
#define XB_TOPGEN   3392
#define XCD_BAR_WORDS 3456
#define XB_SPIN_CAP (1u << 18)
__device__ __forceinline__ unsigned xb_ld(unsigned* p)              { return __hip_atomic_load(p, __ATOMIC_RELAXED, __HIP_MEMORY_SCOPE_AGENT); }
__device__ __forceinline__ unsigned xb_add(unsigned* p, unsigned v) { return __hip_atomic_fetch_add(p, v, __ATOMIC_RELAXED, __HIP_MEMORY_SCOPE_AGENT); }
__device__ __forceinline__ unsigned xb_xcc_id() { return (unsigned)__builtin_amdgcn_s_getreg((3 << 11) | 20) & 0xFu; }
#define XB_SPIN(cond, bar) do { unsigned _sp = 0; while (cond) { __builtin_amdgcn_s_sleep(1); \
    if ((++_sp & 255u) == 0u) { if (xb_ld(&(bar)[XB_TMO])) break; if (_sp > XB_SPIN_CAP) { atomicAdd(&(bar)[XB_TMO], 1u); break; } } } } while (0)
struct XcdBarrier { unsigned* bar; unsigned x; volatile LAS unsigned* st; unsigned gsize; };
__device__ __forceinline__ XcdBarrier xcd_barrier_post(unsigned* bar, volatile LAS unsigned* st, unsigned gsize) {
    XcdBarrier b; b.bar = bar; b.x = xb_xcc_id(); b.st = st; b.gsize = gsize;
    if (threadIdx.x == 0) (void)xb_add(&bar[XB_XCNT(b.x)], 1u);
    return b;
}
__device__ __forceinline__ void xcd_barrier_complete(unsigned* bar, unsigned x, unsigned G, unsigned& nloc, unsigned& nx) {
    unsigned sum, cnt, mine, sp = 0u;
    for (;;) {
        sum = 0u; cnt = 0u; mine = 0u;
#pragma unroll
        for (unsigned j = 0; j < 16; ++j) { const unsigned c = xb_ld(&bar[XB_XCNT(j)]); sum += c; cnt += (c > 0u) ? 1u : 0u; mine = (j == x) ? c : mine; }
        if (sum == G) break;
        __builtin_amdgcn_s_sleep(1);
        if ((++sp & 255u) == 0u) { if (xb_ld(&bar[XB_TMO])) break; if (sp > XB_SPIN_CAP) { atomicAdd(&bar[XB_TMO], 1u); break; } }
    }
    nloc = mine > 0u ? mine : 1u; nx = cnt > 0u ? cnt : 1u;
}
__device__ __forceinline__ void xcd_barrier(const XcdBarrier& b, const int tid) {
    asm volatile("s_waitcnt vmcnt(0)" ::: "memory");
    __syncthreads();
    if (tid == 0) {
        unsigned* bar = b.bar; asm volatile("" : "+s"(bar));
        __builtin_amdgcn_s_waitcnt(0);
        unsigned nloc = b.st[0], nx = b.st[1];
        if (nloc == 0u) { xcd_barrier_complete(bar, b.x, b.gsize, nloc, nx); b.st[0] = nloc; b.st[1] = nx; }
        const unsigned old = xb_add(&bar[XB_XSUB(b.x)], 1u);
        const unsigned gen = old / nloc;
        if (old + 1u == (gen + 1u) * nloc) {
            if (nx > 1u) {
                __builtin_amdgcn_fence(__ATOMIC_RELEASE, "agent");
                asm volatile("s_waitcnt vmcnt(0)" ::: "memory");
                const unsigned og = xb_add(&bar[XB_TOP], 1u);
                const unsigned tg = og / nx;
                if (og + 1u == (tg + 1u) * nx) xb_add(&bar[XB_TOPGEN], 1u);
                else XB_SPIN(xb_ld(&bar[XB_TOPGEN]) == tg, bar);
            }
            xb_add(&bar[XB_XGEN(b.x)], 1u);
            __builtin_amdgcn_fence(__ATOMIC_ACQUIRE, "agent");
            asm volatile("s_waitcnt vmcnt(0)" ::: "memory");
        } else {
            XB_SPIN(xb_ld(&bar[XB_XGEN(b.x)]) == gen, bar);
            __builtin_amdgcn_fence(__ATOMIC_ACQUIRE, "agent");
            asm volatile("s_waitcnt vmcnt(0)" ::: "memory");
        }
    }
    __syncthreads();
}

__device__ __forceinline__ int opq_v(int x) { asm volatile("" : "+v"(x)); return x; }
struct Args { const float* in[22]; float* out; unsigned char* ws; int ph_lo, ph_hi; };


__device__ __forceinline__ void p0_transpose_item(const float* W, int K, int N, bf16* WT, int k0, int n0, int drow0, LAS float* scr, int lane, const float* gk = nullptr) {
    float v[32];
#pragma unroll
    for (int i = 0; i < 32; ++i) { const int kk = 2 * i + (lane >> 5); v[i] = W[(size_t)(k0 + kk) * N + n0 + (lane & 31)]; }
    if (gk) {
#pragma unroll
        for (int i = 0; i < 32; ++i) v[i] *= gk[k0 + 2 * i + (lane >> 5)]; }
#pragma unroll
    for (int i = 0; i < 32; ++i) scr[(2 * i + (lane >> 5)) * 33 + (lane & 31)] = v[i];
    LDS_WAIT(); asm volatile("" ::: "memory");
    const int c = lane & 7;
#pragma unroll
    for (int j = 0; j < 4; ++j) { const int n = (lane >> 3) + 8 * j; const LAS float* s = scr + (8 * c) * 33 + n;
        v4u o; o.x = pg8::cvt_pk_bf16(s[0 * 33], s[1 * 33]); o.y = pg8::cvt_pk_bf16(s[2 * 33], s[3 * 33]); o.z = pg8::cvt_pk_bf16(s[4 * 33], s[5 * 33]); o.w = pg8::cvt_pk_bf16(s[6 * 33], s[7 * 33]);
        *(GAS v4u*)(WT + (size_t)(drow0 + n) * K + k0 + 8 * c) = o; }
    LDS_WAIT(); asm volatile("" ::: "memory");
}
__device__ __forceinline__ int win_dest_row(int n) {
    if (n < 1024) return n;
    if (n < 2048) { const int ch = n - 1024; return 1024 + (ch >> 7) * 256 + (ch & 127); }
    const int ch = n - 2048; return 1024 + (ch >> 7) * 256 + 128 + (ch & 127);
}

template <int W>
__device__ __forceinline__ void pool_wave(const float* xb  , const LAS float* rs, f32x4 g4, int tA, bf16* pout  , float* poolout  ) {
    f32x4 xv[15 + W];
#pragma unroll
    for (int i = 16 - W; i < 31; ++i) { const int t = tA - 15 + i; xv[i - (16 - W)] = *(const f32x4*)(xb + (size_t)(t >= 0 ? t : 0) * D); }
    f32x4 ring[16]; f32x4 S = {0.f, 0.f, 0.f, 0.f};
#pragma unroll
    for (int i = 16 - W; i < 31; ++i) {
        const int t = tA - 15 + i;
        f32x4 u = {0.f, 0.f, 0.f, 0.f};
        if (t >= 0) u = xv[i - (16 - W)] * rs[i] * g4;
        S += u; if (i - W >= 16 - W) S -= ring[(i - W) & 15];
        ring[i & 15] = u;
        if (i >= 15) {
            const int cnt = (t + 1 < W) ? (t + 1) : W; const float ic = 1.0f / (float)cnt;
            const f32x4 p = S * ic - u; v2u o; o.x = pk2(p[0], p[1]); o.y = pk2(p[2], p[3]);
            *(v2u*)(pout + (size_t)t * D) = o;
            if (t >= SEQ - 15) *(f32x4*)(poolout + (size_t)(t - (SEQ - 15)) * D) = u;
        }
    }
}

template <int RT, int CT, int GR, int KS, class F>
__device__ __forceinline__ void sgemm2(const bf16* A, int lda, int row0, const bf16* Bt, int ldb, const int (&brow)[CT], int K, LAS unsigned char* red, int wave, int lane, const F& f) {
    const int fr = lane & 15, fq = lane >> 4, kw = K >> 3;
    const bf16* ap = A + (size_t)(row0 + fr) * lda + wave * kw + fq * 8;
    const bf16* bp[CT];
#pragma unroll
    for (int ct = 0; ct < CT; ++ct) bp[ct] = Bt + (size_t)(brow[ct] + fr) * ldb + wave * kw + fq * 8;
    f32x4 acc[RT][CT];
#pragma unroll
    for (int rt = 0; rt < RT; ++rt)
#pragma unroll
        for (int ct = 0; ct < CT; ++ct) acc[rt][ct] = (f32x4){0.f, 0.f, 0.f, 0.f};
#pragma unroll 1
    for (int k0 = 0; k0 < kw; k0 += 32 * KS) {
        bf16x8 a[KS][RT], b[KS][CT];
#pragma unroll
        for (int ks = 0; ks < KS; ++ks) {
#pragma unroll
            for (int rt = 0; rt < RT; ++rt) a[ks][rt] = *(const bf16x8*)(ap + (size_t)rt * 16 * lda + k0 + 32 * ks);
#pragma unroll
            for (int ct = 0; ct < CT; ++ct) b[ks][ct] = *(const bf16x8*)(bp[ct] + k0 + 32 * ks); }
#pragma unroll
        for (int ks = 0; ks < KS; ++ks)
#pragma unroll
            for (int rt = 0; rt < RT; ++rt)
#pragma unroll
                for (int ct = 0; ct < CT; ++ct) acc[rt][ct] = __builtin_amdgcn_mfma_f32_16x16x32_bf16(b[ks][ct], a[ks][rt], acc[rt][ct], 0, 0, 0);
    }
#pragma unroll
    for (int rt = 0; rt < RT; ++rt)
#pragma unroll
        for (int ct = 0; ct < CT; ++ct) *(LAS f32x4*)(red + ((((wave * RT + rt) * CT + ct) * 64 + lane) << 4)) = acc[rt][ct];
    LDS_WAIT(); __syncthreads();
    constexpr int NCG = CT / GR, NTASK = RT * NCG;
    for (int t = wave; t < NTASK; t += 8) {
        const int rt = t / NCG, cg = t % NCG;
        f32x4 sacc[GR];
#pragma unroll
        for (int g = 0; g < GR; ++g) { f32x4 tt = {0.f, 0.f, 0.f, 0.f};
#pragma unroll
            for (int w = 0; w < 8; ++w) tt += *(const LAS f32x4*)(red + ((((w * RT + rt) * CT + cg * GR + g) * 64 + lane) << 4));
            sacc[g] = tt; }
        f(sacc, row0 + 16 * rt + fr, cg * GR, fq);
    }
    __syncthreads();
}
__device__ __forceinline__ float srstd(const float* ssq, int row, int fq) {
    const f32x4* sp = (const f32x4*)(ssq + row * 64 + fq * 16); const f32x4 s = (sp[0] + sp[1]) + (sp[2] + sp[3]); float t = (s[0] + s[1]) + (s[2] + s[3]);
    t = add_x16_x32(t);
    return __builtin_amdgcn_rsqf(t * (1.0f / D) + EPS);
}
template <int KS> __device__ __forceinline__ void s_res_unit(const bf16* A, int lda, const bf16* Bt, int ldb, int K, int cp, int row0, const float* base32, bf16* xs16, float* ssq, const float* cscale, LAS unsigned char* red, int wave, int lane) {
    const int brow[2] = {32 * cp, 32 * cp + 16};
    const int myct = wave & 1, prow = row0 + (lane & 15), pc0 = 16 * (2 * cp + myct) + 4 * (lane >> 4); const size_t poff = (size_t)prow * D + pc0;
    f32x4 cs = {1.f, 1.f, 1.f, 1.f}; if (cscale) cs = *(const f32x4*)(cscale + pc0);
    f32x4 bpre; if (base32) bpre = *(const f32x4*)(base32 + poff); else { const v2u w = *(const v2u*)(xs16 + poff); bpre = (f32x4){bflo(w.x), bfhi(w.x), bflo(w.y), bfhi(w.y)}; }
    sgemm2<1, 2, 1, KS>(A, lda, row0, Bt, ldb, brow, K, red, wave, lane, [&](f32x4 (&a)[1], int row, int ct0, int fq) {
        const int ctile = 2 * cp + ct0, c0 = 16 * ctile + 4 * fq; const size_t off = (size_t)row * D + c0;
        const f32x4 v = bpre + a[0] * cs;
        float ss = (v[0] * v[0] + v[1] * v[1]) + (v[2] * v[2] + v[3] * v[3]);
        ss = add_x16_x32(ss);
        if (fq == 0) ssq[row * 64 + ctile] = ss;
        v2u p; p.x = pk2(v[0], v[1]); p.y = pk2(v[2], v[3]); *(v2u*)(xs16 + off) = p; });
}
__device__ __forceinline__ void s_q_unit(const bf16* xs16, const bf16* wq, int cp, int row0, const float* ssq, float* qs, LAS unsigned char* red, int wave, int lane) {
    const int brow[2] = {32 * cp, 32 * cp + 16};
    const float rs = srstd(ssq, row0 + (lane & 15), lane >> 4) * QSCALE;
    sgemm2<1, 2, 1, 4>(xs16, D, row0, wq, D, brow, D, red, wave, lane, [&](f32x4 (&a)[1], int row, int ct0, int fq) {
        *(f32x4*)(qs + (size_t)row * D + 32 * cp + 16 * ct0 + 4 * fq) = a[0] * rs; });
}
__device__ __forceinline__ f32x4 relu2(f32x4 v) {
#pragma unroll
    for (int j = 0; j < 4; ++j) { const float a = fmaxf(v[j], 0.f); v[j] = a * a; }
    return v;
}

__device__ __forceinline__ void rstd_table(const float* ssq, int pm, LAS float* rsd, int tid) {
    if (tid < 256) { const f32x4* sp = (const f32x4*)(ssq + (size_t)(pm * 256 + tid) * 16); const f32x4 q = (sp[0] + sp[1]) + (sp[2] + sp[3]);
        rsd[tid] = __builtin_amdgcn_rsqf(((q[0] + q[1]) + (q[2] + q[3])) * (1.0f / D) + EPS); }
}
__device__ __forceinline__ void treduce32(float (&p)[32], int lane) {
#pragma unroll
    for (int i = 0; i < 16; ++i) { swap32(p[i], p[i + 16]); p[i] += p[i + 16]; }
    { const bool b4 = (lane & 16) != 0;
#pragma unroll
      for (int i = 0; i < 8; ++i) { const float keep = b4 ? p[i + 8] : p[i], send = b4 ? p[i] : p[i + 8]; p[i] = keep + SWZ_XOR(send, 16); } }
    { const bool b3 = (lane & 8) != 0;
#pragma unroll
      for (int i = 0; i < 4; ++i) { const float keep = b3 ? p[i + 4] : p[i], send = b3 ? p[i] : p[i + 4]; p[i] = keep + SWZ_XOR(send, 8); } }
    { const bool b2 = (lane & 4) != 0;
#pragma unroll
      for (int i = 0; i < 2; ++i) { const float keep = b2 ? p[i + 2] : p[i], send = b2 ? p[i] : p[i + 2]; p[i] = keep + SWZ_XOR(send, 4); } }
    { const bool b1 = (lane & 2) != 0; const float keep = b1 ? p[1] : p[0], send = b1 ? p[0] : p[1]; p[0] = keep + SWZ_XOR(send, 2); }
    p[0] += SWZ_XOR(p[0], 1);
}
__device__ __forceinline__ void unpack16(const v4u a, const v4u b, float (&x)[16]) {
    x[0] = bflo(a.x); x[1] = bfhi(a.x); x[2] = bflo(a.y); x[3] = bfhi(a.y); x[4] = bflo(a.z); x[5] = bfhi(a.z); x[6] = bflo(a.w); x[7] = bfhi(a.w);
    x[8] = bflo(b.x); x[9] = bfhi(b.x); x[10] = bflo(b.y); x[11] = bfhi(b.y); x[12] = bflo(b.z); x[13] = bfhi(b.z); x[14] = bflo(b.w); x[15] = bfhi(b.w);
}

constexpr int NPHASES = 15;
__global__ void __launch_bounds__(NTHREADS, 2) mk_fwd(Args args) {
    extern __shared__ __attribute__((aligned(16))) unsigned char lds[];
    LAS unsigned char* L = (LAS unsigned char*)lds;
    volatile LAS unsigned* MISC = (volatile LAS unsigned*)(L + MISC_OFF);
    const int wave0 = __builtin_amdgcn_readfirstlane((int)threadIdx.x >> 6);
    const int G = gridDim.x; const int bx = blockIdx.x; const int vcu = (G % 8 == 0) ? (bx % 8) * (G / 8) + bx / 8 : bx;
    const int grp = bx & 7, mi = bx >> 3, GS = (G - grp + 7) >> 3;
    for (int u = threadIdx.x; u < (LDS_BYTES - LDSCTL_OFF) / 4; u += NTHREADS) ((LAS unsigned*)(L + LDSCTL_OFF))[u] = 0u;
    __syncthreads();
#if MK_PER_PHASE
#define GRID_BAR() do { } while (0)
#define GROUP_BAR() do { } while (0)
#else
    XcdBarrier bar = xcd_barrier_post((unsigned*)(args.ws + WS_CTL) + CW_BAR, MISC + 8, (unsigned)G);
    XcdBarrier gbar = xcd_barrier_post((unsigned*)(args.ws + WS_CTL) + CW_BAR + (1 + grp) * CW_BAR_STRIDE, MISC + 10, (unsigned)GS);
#define GRID_BAR() xcd_barrier(bar, wave0 * 64 + lane_id_opaque())
#define GROUP_BAR() xcd_barrier(gbar, wave0 * 64 + lane_id_opaque())
#endif
    const int lo = args.ph_lo, hi = args.ph_hi;
#define IN(k) (st == (k))
#define SEAM(k) do { } while (0)
    const int NGW = G * NWAVES;
#define TID_NOW (wave0 * 64 + lane_id_opaque())
#define RELANE const int tid = wave0 * 64 + lane_id_opaque(), lane = tid & 63; (void)tid; (void)lane;
#define KA_PTR(T, off) (*(T const __attribute__((address_space(4)))*)(ka + (off)))
#define PH_BEGIN const int tid = wave0 * 64 + lane_id_opaque(), lane = tid & 63, wave = wave0, gw = vcu * NWAVES + wave; (void)lane; (void)gw; \
    const __attribute__((address_space(4))) char* ka = (const __attribute__((address_space(4))) char*)__builtin_amdgcn_kernarg_segment_ptr(); asm volatile("" : "+s"(ka)); \
    unsigned char* const ws = KA_PTR(unsigned char*, 184); float* const out = KA_PTR(float*, 176); (void)ws; (void)out; \
    const float* const x_prompt = KA_PTR(const float*, 0); const float* const x_sample = KA_PTR(const float*, 8); const float* const state_pool = KA_PTR(const float*, 16); const float* const state_conv = KA_PTR(const float*, 24); \
    const float* const cache_k = KA_PTR(const float*, 32); const float* const cache_v = KA_PTR(const float*, 40); const float* const mem_prompt = KA_PTR(const float*, 48); \
    const float* const g_mix = KA_PTR(const float*, 56); const float* const g_attn = KA_PTR(const float*, 64); const float* const g_mem = KA_PTR(const float*, 72); const float* const g_ffn = KA_PTR(const float*, 80); const float* const g_final = KA_PTR(const float*, 88); \
    const float* const w_pool = KA_PTR(const float*, 96); const float* const pool_scale = KA_PTR(const float*, 104); const float* const w_conv_in = KA_PTR(const float*, 112); const float* const w_conv = KA_PTR(const float*, 120); const float* const w_conv_out = KA_PTR(const float*, 128); \
    const float* const w_q = KA_PTR(const float*, 136); const float* const w_kv = KA_PTR(const float*, 144); const float* const w_o = KA_PTR(const float*, 152); const float* const w_up = KA_PTR(const float*, 160); const float* const w_down = KA_PTR(const float*, 168); \
    (void)x_prompt; (void)x_sample; (void)state_pool; (void)state_conv; (void)cache_k; (void)cache_v; (void)mem_prompt; (void)g_mix; (void)g_attn; (void)g_mem; (void)g_ffn; (void)g_final; (void)w_pool; (void)pool_scale; (void)w_conv_in; (void)w_conv; (void)w_conv_out; (void)w_q; (void)w_kv; (void)w_o; (void)w_up; (void)w_down; \
    bf16* const WPOOL = (bf16*)(ws + WS_WPOOL); bf16* const WQ = (bf16*)(ws + WS_WQ); bf16* const WO = (bf16*)(ws + WS_WO); bf16* const WKV = (bf16*)(ws + WS_WKV); \
    bf16* const WUP = (bf16*)(ws + WS_WUP); bf16* const WDN = (bf16*)(ws + WS_WDN); bf16* const WIN = (bf16*)(ws + WS_WIN); bf16* const WOUT = (bf16*)(ws + WS_WOUT); \
    bf16* const MN = (bf16*)(ws + WS_MN); bf16* const KB = (bf16*)(ws + WS_KB); bf16* const VT = (bf16*)(ws + WS_VT); float* const SSQ = (float*)(ws + WS_SSQ); \
    bf16* const X16 = (bf16*)(ws + WS_X); bf16* const P0 = (bf16*)(ws + WS_P0); bf16* const OB = (bf16*)(ws + WS_O); bf16* const CH = (bf16*)(ws + WS_CH); \
    bf16* const WQN = (bf16*)(ws + WS_WQN); bf16* const MT = (bf16*)(ws + WS_MT); bf16* const VW = (bf16*)(ws + WS_VW); bf16* const HB = (bf16*)(ws + WS_H); \
    bf16* const XS16 = (bf16*)(ws + SS_X); float* const SSQS = (float*)(ws + SS_SSQ); bf16* const P0S = (bf16*)(ws + SS_P0); bf16* const OS = (bf16*)(ws + SS_O); \
    float* const CHS = (float*)(ws + SS_CH); bf16* const HS = (bf16*)(ws + SS_H); float* const QS = (float*)(ws + SS_Q); \
    (void)WPOOL; (void)WQ; (void)WO; (void)WKV; (void)WUP; (void)WDN; (void)WIN; (void)WOUT; (void)MN; (void)KB; (void)VT; (void)SSQ; (void)X16; (void)P0; (void)OB; (void)CH; (void)WQN; (void)MT; (void)VW; (void)HB; (void)XS16; (void)SSQS; (void)P0S; (void)OS; (void)CHS; (void)HS; (void)QS;

#if MK_PER_PHASE
    const int soff = 0; const bool sfirst = false;
#else
    const int soff = SAMPLE_SHIFT ? (grp & 1) : 0;
    const bool sfirst = false;
#endif
    const int mflip = (MEMBER_FLIP && !MK_PER_PHASE) ? (MEMBER_FLIP_SEL) : 0;
#pragma unroll 1
    for (int ph = lo; ph < hi + soff; ++ph) {
#pragma unroll 1
    for (int pp = 0; pp < 2; ++pp) {
    const int which = pp ^ mflip;
    const int st = which ? ph - soff : ph;
    const bool doP = (which == 0), doS = (which == 1) || (st == 0);
    if (st < 0 || st >= NPHASES || (which == 1 && st == 0)) continue;
    if (IN(0)) { PH_BEGIN
        LAS float* scr = (LAS float*)(L + RING_OFF + wave * 16384);
        {
            constexpr int I_POOL = 4 * 4 * 8, I_Q = 16 * 32, I_KV = 16 * 64, I_UP = 16 * 128, I_DN = 64 * 32, I_IN = 16 * 96;
            constexpr int NITEMS = I_POOL + 2 * (I_Q + I_KV + I_Q + I_UP + I_DN) + I_IN + I_Q;
            for (int it = gw; it < NITEMS; it += NGW) {
                int r = it;
                if (r < I_POOL) { const int g = r >> 5, rr = r & 31, kb = rr >> 3, nb = rr & 7; p0_transpose_item(w_pool + g * 65536, 256, 256, WPOOL + g * 65536, 64 * kb, 32 * nb, 32 * nb, scr, lane); continue; } r -= I_POOL;
                bool done = false;
#pragma unroll 1
                for (int l = 0; l < 2 && !done; ++l) {
                    if (r < I_Q) { const int kb = r >> 5, nb = r & 31; p0_transpose_item(w_q + (size_t)l * D * D, D, D, WQ + (size_t)l * D * D, 64 * kb, 32 * nb, 32 * nb, scr, lane, g_attn + l * D); done = true; break; } r -= I_Q;
                    if (r < I_KV) { const int kb = r >> 6, nb = r & 63; p0_transpose_item(w_kv + (size_t)l * D * 2048, D, 2048, WKV + (size_t)l * 2048 * D, 64 * kb, 32 * nb, 32 * nb, scr, lane); done = true; break; } r -= I_KV;
                    if (r < I_Q) { const int kb = r >> 5, nb = r & 31; p0_transpose_item(w_o + (size_t)l * D * D, D, D, WO + (size_t)l * D * D, 64 * kb, 32 * nb, 32 * nb, scr, lane); done = true; break; } r -= I_Q;
                    if (r < I_UP) { const int kb = r >> 7, nb = r & 127; p0_transpose_item(w_up + (size_t)l * D * FF, D, FF, WUP + (size_t)l * FF * D, 64 * kb, 32 * nb, 32 * nb, scr, lane, g_ffn + l * D); done = true; break; } r -= I_UP;
                    if (r < I_DN) { const int kb = r >> 5, nb = r & 31; p0_transpose_item(w_down + (size_t)l * FF * D, FF, D, WDN + (size_t)l * D * FF, 64 * kb, 32 * nb, 32 * nb, scr, lane); done = true; break; } r -= I_DN;
                }
                if (done) continue;
                if (r < I_IN) { const int kb = r / 96, nb = r % 96; p0_transpose_item(w_conv_in, D, 3072, WIN, 64 * kb, 32 * nb, win_dest_row(32 * nb), scr, lane, g_mix + D); continue; } r -= I_IN;
                { const int kb = r >> 5, nb = r & 31; p0_transpose_item(w_conv_out, D, D, WOUT, 64 * kb, 32 * nb, 32 * nb, scr, lane); }
            }
        }
        for (int m = gw; m < MEMROWS; m += NGW) {
            const f32x4* xr = (const f32x4*)(mem_prompt + (size_t)m * D) + lane; f32x4 v[4]; float s = 0.f;
#pragma unroll
            for (int j = 0; j < 4; ++j) { v[j] = xr[64 * j]; s += (v[j][0] * v[j][0] + v[j][1] * v[j][1]) + (v[j][2] * v[j][2] + v[j][3] * v[j][3]); }
            const float rstd = __builtin_amdgcn_rsqf(wave_sum(s) * (1.f / D) + EPS);
#pragma unroll
            for (int l = 0; l < 2; ++l) { v2u* o8 = (v2u*)(MN + ((size_t)l * MEMROWS + m) * D) + lane;
#pragma unroll
                for (int j = 0; j < 4; ++j) { const f32x4 gg = *((const f32x4*)(g_mem + l * D) + lane + 64 * j); const f32x4 w = v[j] * rstd * gg; v2u o; o.x = pk2(w[0], w[1]); o.y = pk2(w[2], w[3]); o8[64 * j] = o; } }
        }
        for (int m = gw; m < 2 * D; m += NGW) {
            const float gk = g_attn[m]; const f32x4* xr = (const f32x4*)(w_q + (size_t)m * D) + lane; v2u* o8 = (v2u*)(WQN + (size_t)m * D) + lane;
            f32x4 v[4];
#pragma unroll
            for (int j = 0; j < 4; ++j) v[j] = xr[64 * j];
#pragma unroll
            for (int j = 0; j < 4; ++j) { const f32x4 w = v[j] * gk; v2u o; o.x = pk2(w[0], w[1]); o.y = pk2(w[2], w[3]); o8[64 * j] = o; }
        }
        for (int it = gw; it < MS * 4; it += NGW) {
            const int b = it >> 2, g = it & 3, c4 = g * 256 + lane * 4;
            const f32x4* xr = (const f32x4*)(x_sample + (size_t)b * D) + lane; float s = 0.f;
#pragma unroll
            for (int j = 0; j < 4; ++j) { const f32x4 v = xr[64 * j]; s += (v[0] * v[0] + v[1] * v[1]) + (v[2] * v[2] + v[3] * v[3]); }
            const float rstd = __builtin_amdgcn_rsqf(wave_sum(s) * (1.f / D) + EPS);
            const f32x4 u = *(const f32x4*)(x_sample + (size_t)b * D + c4) * rstd * *(const f32x4*)(g_mix + c4);
            const int W = 2 << g; f32x4 S = u;
            const float* sp = state_pool + (size_t)b * 15 * D + c4;
            float* po = out + OPS + (size_t)b * 15 * D + c4;
            f32x4 sv[15];
#pragma unroll
            for (int r = 0; r < 15; ++r) sv[r] = *(const f32x4*)(sp + (size_t)r * D);
#pragma unroll
            for (int r = 0; r < 15; ++r) { if (r >= 16 - W) S += sv[r]; if (r >= 1) *(f32x4*)(po + (size_t)(r - 1) * D) = sv[r]; }
            *(f32x4*)(po + (size_t)14 * D) = u;
            const f32x4 p = S * (1.0f / (float)W) - u; v2u o; o.x = pk2(p[0], p[1]); o.y = pk2(p[2], p[3]); *(v2u*)(P0S + (size_t)b * D + c4) = o;
        }
        __syncthreads();
        {
            LAS float* rs = (LAS float*)(L + RING_OFF);
            for (int it = vcu; it < BATCH * (SEQ / 32); it += G) {
                const int b = it >> 6, t0 = (it & 63) * 32;
                { f32x4 xv[6][4];
#pragma unroll
                  for (int j = 0; j < 6; ++j) { const int r = wave + 8 * j, t = t0 - 15 + r; const bool ok = (r < 47) && (t >= 0);
                      const f32x4* xr = (const f32x4*)(x_prompt + ((size_t)b * SEQ + (ok ? t : t0)) * D) + lane;
#pragma unroll
                      for (int q = 0; q < 4; ++q) xv[j][q] = xr[64 * q]; }
#pragma unroll
                  for (int j = 0; j < 6; ++j) { const int r = wave + 8 * j, t = t0 - 15 + r; float s = 0.f;
#pragma unroll
                      for (int q = 0; q < 4; ++q) { const f32x4 v = xv[j][q]; s += (v[0] * v[0] + v[1] * v[1]) + (v[2] * v[2] + v[3] * v[3]); }
                      const float rv = (t >= 0) ? __builtin_amdgcn_rsqf(wave_sum(s) * (1.f / D) + EPS) : 0.f;
                      if (lane == 0 && r < 47) rs[r] = rv; } }
                LDS_WAIT(); __syncthreads();
                const int g = wave & 3, tA = t0 + (wave >> 2) * 16, c4 = g * 256 + lane * 4;
                const float* xb = x_prompt + (size_t)b * SEQ * D + c4; const f32x4 g4 = *(const f32x4*)(g_mix + c4);
                bf16* pout = P0 + (size_t)b * SEQ * D + c4; float* poolout = out + OPP + (size_t)b * 15 * D + c4;
                const LAS float* rsw = rs + (wave >> 2) * 16;
                if (g == 0) pool_wave<2>(xb, rsw, g4, tA, pout, poolout); else if (g == 1) pool_wave<4>(xb, rsw, g4, tA, pout, poolout);
                else if (g == 2) pool_wave<8>(xb, rsw, g4, tA, pout, poolout); else pool_wave<16>(xb, rsw, g4, tA, pout, poolout);
                __syncthreads();
            }
        }
    }
    SEAM(0);

    if (IN(1)) { PH_BEGIN
        if (doP) { pg8::Gemm g{D, D, D}; pg8::KvOrder S{GS == 32 ? 16 : GS, (GS == 32 && mi >= 16) ? (1 << 20) : mi, grp, (const char*)MN, (const char*)WKV};
          pg8::EpiKV E{out + OMK, out + OMV, KB, VT};
          pg8::gemm_phase<pg8::EpiKV, pg8::KvOrder, true>(L + RING_OFF, g, S, E, TID_NOW); }
        if (doP) { pg8::Gemm g{D, 256, 256}; pg8::StaticOrder S;
          if (GS == 32) S.init(8, 4, 16, mi >= 16 ? mi - 16 : 1 << 20, grp * 8, P0, (size_t)256 * D * 2, WPOOL, (size_t)65536 * 2, (size_t)256 * 2);
          else S.init(8, 4, GS, mi, grp * 8, P0, (size_t)256 * D * 2, WPOOL, (size_t)65536 * 2, (size_t)256 * 2);
          pg8::EpiRes<true> E{x_prompt, X16, SSQ, pool_scale};
          pg8::gemm_phase<pg8::EpiRes<true>, pg8::StaticOrder, true>(L + RING_OFF, g, S, E, TID_NOW); }
        if (doS) { RELANE for (int cp = mi; cp < 32; cp += GS) s_res_unit<1>(P0S + (cp >> 3) * 256, D, WPOOL, 256, 256, cp, 16 * grp, x_sample, XS16, SSQS, pool_scale, L + RING_OFF, wave, lane); }
    }
    SEAM(1);

    if (IN(2)) { PH_BEGIN
        if (doS) { RELANE for (int cp = mi; cp < 32; cp += GS) s_q_unit(XS16, WQ, cp, 16 * grp, SSQS, QS, L + RING_OFF, wave, lane); }
        if (doP) for (int idx = mi; idx < 64; idx += GS) {
            const int ly = idx >> 5, kind = (idx >> 4) & 1, a = (idx >> 2) & 3, q = idx & 3;
            const bf16* Ap; const bf16* Bp; bf16* Op; pg8::Unit u; float sc;
            if (kind == 0) {
                Ap = KB + ((size_t)ly * MEMROWS + grp * 256) * D + a * 256; Bp = WQN + ((size_t)ly * D + 256 * q) * D + a * 256;
                Op = MT + (size_t)((ly * BATCH + grp) * NH + a) * 256 * D; u = pg8::Unit{0, q}; sc = QSCALE;
            } else {
                Ap = WO + ((size_t)ly * D + 256 * a) * D + q * 256; Bp = VT + ((size_t)ly * MEMROWS + grp * 256) * D + q * 256;
                Op = VW + (size_t)(ly * BATCH + grp) * D * D; u = pg8::Unit{a, q}; sc = 1.f;
            }
            pg8::Gemm g{D, D, 256}; pg8::SingleOrder S{u, (const char*)Ap, (const char*)Bp};
            pg8::EpiBf16 E{Op, D, sc};
            pg8::gemm_phase<pg8::EpiBf16, pg8::SingleOrder, true>(L + RING_OFF, g, S, E, TID_NOW);
            __syncthreads();
        }
    }
    {
        const int l = (st >= 7) ? 1 : 0, pb = l ? 10 : 3;
        {
            if (IN(7)) { PH_BEGIN
                const LAS float* rsdp = nullptr;
                if (doP && (GS & 7) == 0) { LAS float* t_ = (LAS float*)(L + RSD_OFF); rstd_table(SSQ, grp * 8 + (mi & 7), t_, tid); LDS_WAIT(); __syncthreads(); rsdp = t_; }
                if (doP) { pg8::Gemm g{D, D, D}; pg8::StaticOrder S; S.init(8, 12, GS, mi, grp * 8, X16, (size_t)256 * D * 2, WIN, (size_t)256 * D * 2);
                  pg8::EpiRow<2> E{OB, D, SSQ, 1.f, CH, out + OCP, rsdp};
                  pg8::gemm_phase<pg8::EpiRow<2>, pg8::StaticOrder, true>(L + RING_OFF, g, S, E, TID_NOW); }
                if (doS) { RELANE
                for (int c2 = mi; c2 < 32; c2 += GS) {
                    const int ca = 32 * c2, cb = ca + 16; const int ra = 1024 + (ca >> 7) * 256 + (ca & 127), rb = 1024 + (cb >> 7) * 256 + (cb & 127);
                    const int brow[6] = {ca, ra, ra + 128, cb, rb, rb + 128};
                    const float rs = srstd(SSQS, 16 * grp + (lane & 15), lane >> 4);
                    const int prow = 16 * grp + (lane & 15), pc = ((wave & 1) ? cb : ca) + 4 * (lane >> 4);
                    const f32x4 s0 = *(const f32x4*)(state_conv + ((size_t)prow * 2 + 0) * D + pc), s1 = *(const f32x4*)(state_conv + ((size_t)prow * 2 + 1) * D + pc);
                    const f32x4 w0 = *(const f32x4*)(w_conv + pc), w1 = *(const f32x4*)(w_conv + D + pc), w2 = *(const f32x4*)(w_conv + 2 * D + pc);
                    sgemm2<1, 6, 3, 4>(XS16, D, 16 * grp, WIN, D, brow, D, L + RING_OFF, wave, lane, [&](f32x4 (&a)[3], int row, int ct0, int fq) {
                        const int c0 = (ct0 == 0 ? ca : cb) + 4 * fq;
                        const f32x4 gb = a[0] * rs, chv = a[1] * a[2] * (rs * rs);
                        const f32x4 cv = s0 * w0 + s1 * w1 + chv * w2;
                        const unsigned g01 = pk2(gb[0], gb[1]), g23 = pk2(gb[2], gb[3]);
                        v2u o; o.x = pk2(bflo(g01) * cv[0], bfhi(g01) * cv[1]); o.y = pk2(bflo(g23) * cv[2], bfhi(g23) * cv[3]);
                        *(v2u*)(P0S + (size_t)row * D + c0) = o;
                        *(f32x4*)(out + OCS + ((size_t)row * 2 + 0) * D + c0) = s1; *(f32x4*)(out + OCS + ((size_t)row * 2 + 1) * D + c0) = chv; }); }
                }
            }
            SEAM(7);
            if (IN(8)) { PH_BEGIN
                const int gt = mi * NTHREADS + tid, NT = GS * NTHREADS;
                if (doP) for (int idx0 = gt; idx0 < SEQ * 128; idx0 += 4 * NT) {
                    v4u gb[4], c2[4], c1[4], c0[4];
#pragma unroll
                    for (int q = 0; q < 4; ++q) { const int idx = idx0 + q * NT; const bool ok = idx < SEQ * 128; const int t = ok ? (idx >> 7) : 0, row = grp * SEQ + t, c8 = (idx & 127) * 8;
                        gb[q] = *(const v4u*)(OB + (size_t)row * D + c8); c2[q] = *(const v4u*)(CH + (size_t)row * D + c8);
                        c1[q] = *(const v4u*)(CH + (size_t)(row - (t >= 1 ? 1 : 0)) * D + c8); c0[q] = *(const v4u*)(CH + (size_t)(row - (t >= 2 ? 2 : 0)) * D + c8); }
#pragma unroll
                    for (int q = 0; q < 4; ++q) { const int idx = idx0 + q * NT; if (idx >= SEQ * 128) break; const int t = idx >> 7, row = grp * SEQ + t, c8 = (idx & 127) * 8;
                        if (t < 1) c1[q] = (v4u){0u, 0u, 0u, 0u};
                        if (t < 2) c0[q] = (v4u){0u, 0u, 0u, 0u};
                        const f32x4 w0a = *(const f32x4*)(w_conv + c8), w0b = *(const f32x4*)(w_conv + c8 + 4), w1a = *(const f32x4*)(w_conv + D + c8), w1b = *(const f32x4*)(w_conv + D + c8 + 4),
                                    w2a = *(const f32x4*)(w_conv + 2 * D + c8), w2b = *(const f32x4*)(w_conv + 2 * D + c8 + 4);
                        v4u o;
#pragma unroll
                        for (int j = 0; j < 4; ++j) { const float wl0 = (j < 2) ? w0a[2 * j] : w0b[2 * j - 4], wh0 = (j < 2) ? w0a[2 * j + 1] : w0b[2 * j - 3];
                            const float wl1 = (j < 2) ? w1a[2 * j] : w1b[2 * j - 4], wh1 = (j < 2) ? w1a[2 * j + 1] : w1b[2 * j - 3];
                            const float wl2 = (j < 2) ? w2a[2 * j] : w2b[2 * j - 4], wh2 = (j < 2) ? w2a[2 * j + 1] : w2b[2 * j - 3];
                            const float lo_ = bflo(gb[q][j]) * (bflo(c0[q][j]) * wl0 + bflo(c1[q][j]) * wl1 + bflo(c2[q][j]) * wl2);
                            const float hi_ = bfhi(gb[q][j]) * (bfhi(c0[q][j]) * wh0 + bfhi(c1[q][j]) * wh1 + bfhi(c2[q][j]) * wh2);
                            o[j] = pk2(lo_, hi_); }
                        *(v4u*)(P0 + (size_t)row * D + c8) = o; }
                }
                if (doS) { for (int cp = mi; cp < 32; cp += GS) s_res_unit<4>(P0S, D, WOUT, D, D, cp, 16 * grp, nullptr, XS16, SSQS, nullptr, L + RING_OFF, wave, lane); }
            }
            SEAM(8);
            if (IN(9)) { PH_BEGIN
                if (doP) { pg8::Gemm g{D, D, D}; pg8::StaticOrder S; S.init(8, 4, GS, mi, grp * 8, P0, (size_t)256 * D * 2, WOUT, (size_t)256 * D * 2);
                  pg8::EpiRes<false> E{nullptr, X16, SSQ, nullptr};
                  pg8::gemm_phase<pg8::EpiRes<false>, pg8::StaticOrder, true>(L + RING_OFF, g, S, E, TID_NOW); }
                if (doS) { RELANE for (int cp = mi; cp < 32; cp += GS) s_q_unit(XS16, WQ + (size_t)D * D, cp, 16 * grp, SSQS, QS, L + RING_OFF, wave, lane); }
            }
            SEAM(9);
        }
#define LAYER_W const bf16* WQl = WQ + (size_t)l * D * D; const bf16* WOl = WO + (size_t)l * D * D; const bf16* WUPl = WUP + (size_t)l * FF * D; const bf16* WDNl = WDN + (size_t)l * D * FF; (void)WQl; (void)WOl; (void)WUPl; (void)WDNl;
        if (IN(pb)) { PH_BEGIN LAYER_W
#pragma unroll 1
            for (int half = 0; half < 2; ++half) {
            const bool sampleHalf = ((half == 0) == sfirst);
            if (doP && !sampleHalf) for (int itl = mi; itl < 32; itl += GS) {
                const int pm = grp * 8 + (itl >> 2), h = itl & 3;
                pg8::Gemm g{D, D, D}; pg8::SingleOrder S{{pm, h}, (const char*)(X16 + (size_t)pm * 256 * D), (const char*)(MT + (size_t)((l * BATCH + grp) * NH + h) * 256 * D)};
                pg8::EpiSoftmax E{OB, D, SSQ};
                pg8::gemm_phase<pg8::EpiSoftmax, pg8::SingleOrder, false>(L + RING_OFF, g, S, E, TID_NOW);
                LDS_WAIT(); __builtin_amdgcn_s_barrier(); asm volatile("" ::: "memory");
            }
            if (doS && sampleHalf) { RELANE
                LAS float* sc = (LAS float*)(L + RING_OFF);
                LAS float* po = (LAS float*)(L + RING_OFF + 1024);
                for (int it0 = mi; it0 < 64; it0 += 2 * GS) {
                    const bool pair = (it0 + GS < 64);
#pragma unroll 1
                    for (int iu = 0; iu < 2; ++iu) {
                        if (iu == 1 && !pair) break;
                        const int it = it0 + iu * GS, b = 16 * grp + (it >> 2), h = it & 3;
                        const f32x4 q4 = *(const f32x4*)(QS + (size_t)b * D + h * 256 + lane * 4);
                        const float* kp = cache_k + (((size_t)l * MS + b) * NMEM + wave * 32) * D + h * 256 + lane * 4;
                        const float* vp = cache_v + (((size_t)l * MS + b) * NMEM + wave * 32) * D + h * 256 + lane * 4;
                        f32x4 kv[32]; float p[32];
#pragma unroll
                        for (int n = 0; n < 32; ++n) kv[n] = __builtin_nontemporal_load((const f32x4*)(kp + (size_t)n * D));
#pragma unroll
                        for (int n = 0; n < 32; ++n) { p[n] = (q4[0] * kv[n][0] + q4[1] * kv[n][1]) + (q4[2] * kv[n][2] + q4[3] * kv[n][3]); kv[n] = __builtin_nontemporal_load((const f32x4*)(vp + (size_t)n * D)); }
                        treduce32(p, lane);
                        if ((lane & 1) == 0) sc[wave * 32 + (lane >> 1)] = p[0];
                        LDS_WAIT(); __builtin_amdgcn_s_barrier(); asm volatile("" ::: "memory");
                        float mx, sm = 0.f; const f32x4 sv = *(const LAS f32x4*)(sc + lane * 4);
                        mx = fmaxf(fmaxf(sv[0], sv[1]), fmaxf(sv[2], sv[3]));
                        mx = wave_max(mx);
#pragma unroll
                        for (int j = 0; j < 4; ++j) sm += __builtin_amdgcn_exp2f(sv[j] - mx);
                        sm = wave_sum(sm);
                        f32x4 acc = {0.f, 0.f, 0.f, 0.f};
#pragma unroll
                        for (int n = 0; n < 32; ++n) { const float pn_ = __builtin_amdgcn_exp2f(sc[wave * 32 + n] - mx); acc += kv[n] * pn_; }
                        *(LAS f32x4*)(po + wave * 256 + lane * 4) = acc;
                        LDS_WAIT(); __builtin_amdgcn_s_barrier(); asm volatile("" ::: "memory");
                        if (tid < 256) { float o = 0.f;
#pragma unroll
                            for (int w = 0; w < 8; ++w) o += po[w * 256 + tid];
                            OS[(size_t)b * D + h * 256 + tid] = (bf16)f2bf(o / sm); }
                        LDS_WAIT(); __builtin_amdgcn_s_barrier(); asm volatile("" ::: "memory");
                    }
                }
            }
            }
        }
        SEAM(pb);
        if (IN(pb + 1)) { PH_BEGIN LAYER_W
            if (doP) { pg8::Gemm g{D, D, D}; pg8::StaticOrder S; S.init(8, 4, GS, mi, grp * 8, OB, (size_t)256 * D * 2, VW + (size_t)(l * BATCH + grp) * D * D, (size_t)256 * D * 2);
              pg8::EpiRes<false> E{nullptr, X16, SSQ, nullptr};
              pg8::gemm_phase<pg8::EpiRes<false>, pg8::StaticOrder, true>(L + RING_OFF, g, S, E, TID_NOW); }
            if (doS) { RELANE for (int cp = mi; cp < 32; cp += GS) s_res_unit<4>(OS, D, WOl, D, D, cp, 16 * grp, nullptr, XS16, SSQS, nullptr, L + RING_OFF, wave, lane); }
        }
        SEAM(pb + 2);
        if (IN(pb + 2)) { PH_BEGIN LAYER_W
            const LAS float* rsdp = nullptr;
            if (doP && (GS & 7) == 0) { LAS float* t_ = (LAS float*)(L + RSD_OFF); rstd_table(SSQ, grp * 8 + (mi & 7), t_, tid); LDS_WAIT(); __syncthreads(); rsdp = t_; }
            if (doP) { pg8::Gemm g{D, D, D}; pg8::StaticOrder S; S.init(8, 16, GS, mi, grp * 8, X16, (size_t)256 * D * 2, WUPl, (size_t)256 * D * 2);
              pg8::EpiRow<1> E{HB, FF, SSQ, 1.f, nullptr, nullptr, rsdp};
              pg8::gemm_phase<pg8::EpiRow<1>, pg8::StaticOrder, true>(L + RING_OFF, g, S, E, TID_NOW); }
            if (doS) { RELANE for (int c8 = mi; c8 < 32; c8 += GS) { const int brow[8] = {128 * c8, 128 * c8 + 16, 128 * c8 + 32, 128 * c8 + 48, 128 * c8 + 64, 128 * c8 + 80, 128 * c8 + 96, 128 * c8 + 112};
                const float rs = srstd(SSQS, 16 * grp + (lane & 15), lane >> 4);
                sgemm2<1, 8, 1, 4>(XS16, D, 16 * grp, WUPl, D, brow, D, L + RING_OFF, wave, lane, [&](f32x4 (&a)[1], int row, int ct0, int fq) {
                    const f32x4 v0 = relu2(a[0] * rs);
                    v2u p0; p0.x = pk2(v0[0], v0[1]); p0.y = pk2(v0[2], v0[3]);
                    *(v2u*)(HS + (size_t)row * FF + 128 * c8 + 16 * ct0 + 4 * fq) = p0; }); } }
        }
        SEAM(pb + 3);
        if (IN(pb + 3)) { PH_BEGIN LAYER_W
            if (doP) { pg8::Gemm g{FF, FF, FF}; pg8::StaticOrder S; S.init(8, 4, GS, mi, grp * 8, HB, (size_t)256 * FF * 2, WDNl, (size_t)256 * FF * 2);
              pg8::EpiRes<false> E{nullptr, X16, SSQ, nullptr};
              pg8::gemm_phase<pg8::EpiRes<false>, pg8::StaticOrder, true>(L + RING_OFF, g, S, E, TID_NOW); }
            if (doS) { RELANE for (int cp = mi; cp < 32; cp += GS) s_res_unit<8>(HS, FF, WDNl, FF, FF, cp, 16 * grp, nullptr, XS16, SSQS, nullptr, L + RING_OFF, wave, lane); }
        }
        SEAM(pb + 4);
    }
    if (IN(14)) { PH_BEGIN
        const int mlo = doP ? 0 : SEQ, mhi = doS ? SEQ + 16 : SEQ;
        for (int ml0 = mlo + mi * NWAVES + wave; ml0 < mhi; ml0 += 4 * GS * NWAVES) {
            float sv[4]; v4u xw[4][2];
#pragma unroll
            for (int q = 0; q < 4; ++q) { const int ml = ml0 + q * GS * NWAVES; const bool ok = ml < mhi; const int mlc = ok ? ml : ml0;
                const bf16* xr;
                if (mlc < SEQ) { const int m = grp * SEQ + mlc; sv[q] = (lane < 16) ? SSQ[(size_t)m * 16 + lane] : 0.f; xr = X16 + (size_t)m * D; }
                else { const int r = 16 * grp + (mlc - SEQ); sv[q] = SSQS[r * 64 + lane]; xr = XS16 + (size_t)r * D; }
                xw[q][0] = *((const v4u*)xr + lane); xw[q][1] = *((const v4u*)xr + lane + 64); }
#pragma unroll
            for (int q = 0; q < 4; ++q) { const int ml = ml0 + q * GS * NWAVES; if (ml >= mhi) break;
                const float rs = __builtin_amdgcn_rsqf(wave_sum(sv[q]) * (1.f / D) + EPS);
                float* yr = (ml < SEQ) ? out + OY + (size_t)(grp * SEQ + ml) * D : out + OYS + (size_t)(16 * grp + (ml - SEQ)) * D;
#pragma unroll
                for (int j = 0; j < 2; ++j) { const v4u w = xw[q][j]; const f32x4 g0 = *((const f32x4*)g_final + 2 * (lane + 64 * j)), g1 = *((const f32x4*)g_final + 2 * (lane + 64 * j) + 1);
                    const f32x4 x0 = {bflo(w.x), bfhi(w.x), bflo(w.y), bfhi(w.y)}, x1 = {bflo(w.z), bfhi(w.z), bflo(w.w), bfhi(w.w)};
                    f32x4* yp = (f32x4*)yr + 2 * (lane + 64 * j); yp[0] = x0 * rs * g0; yp[1] = x1 * rs * g1; } }
        }
    }
    }
    if (ph + 1 < hi + soff) { if (ph == 0) { GRID_BAR();
#if STAGGER_TICKS > 0
            { const unsigned long long t0 = __builtin_amdgcn_s_memrealtime(); const unsigned long long dt = (unsigned long long)grp * STAGGER_TICKS;
              while (__builtin_amdgcn_s_memrealtime() - t0 < dt) __builtin_amdgcn_s_sleep(4); }
#endif
        } else GROUP_BAR(); }
    }
#undef IN
#undef SEAM
#undef GRID_BAR
}

extern "C" void kernel_launch(void* const* d_in, const int* in_sizes, int n_in, void* d_out, int out_size, void* d_ws, size_t ws_size, hipStream_t stream) {
    static int grid = 0;
    if (grid == 0) {
        if (n_in != 22 || ws_size < WS_END) { fprintf(stderr, "kernel_launch: unexpected inputs (n_in %d, ws %zu)\n", n_in, ws_size); grid = -1; return; }
        int dev = 0, cus = 0, per_cu = 0;
        if (hipGetDevice(&dev) != hipSuccess || hipDeviceGetAttribute(&cus, hipDeviceAttributeMultiprocessorCount, dev) != hipSuccess) { grid = -1; return; }
        if (hipFuncSetAttribute((const void*)mk_fwd, hipFuncAttributeMaxDynamicSharedMemorySize, LDS_BYTES) != hipSuccess) { fprintf(stderr, "kernel_launch: hipFuncSetAttribute failed\n"); grid = -1; return; }
        if (hipOccupancyMaxActiveBlocksPerMultiprocessor(&per_cu, (const void*)mk_fwd, NTHREADS, LDS_BYTES) != hipSuccess || per_cu < 1)
            fprintf(stderr, "kernel_launch: note: occupancy query reports %d workgroups per CU\n", per_cu);
        (void)hipGetLastError();
        grid = cus;
    }
    if (grid < 0) return;
    (void)hipMemsetAsync((char*)d_ws + WS_CTL, 0, CTL_ZERO_BYTES, stream);
    Args a{};
    for (int i = 0; i < 22; ++i) a.in[i] = (const float*)d_in[i];
    a.out = (float*)d_out; a.ws = (unsigned char*)d_ws;
#if MK_PER_PHASE
    for (int p = 0; p < NPHASES; ++p) { a.ph_lo = p; a.ph_hi = p + 1; hipLaunchKernelGGL(mk_fwd, dim3(grid), dim3(NTHREADS), LDS_BYTES, stream, a); }
#else
    a.ph_lo = 0; a.ph_hi = NPHASES; hipLaunchKernelGGL(mk_fwd, dim3(grid), dim3(NTHREADS), LDS_BYTES, stream, a);
#endif
}
```

```cpp
#include <hip/hip_runtime.h>
#include <cstdio>
#include <cstdint>

#ifndef SAMPLE_SHIFT
#define SAMPLE_SHIFT 1
#endif
#ifndef MEMBER_FLIP
#define MEMBER_FLIP 1
#endif
#ifndef MEMBER_FLIP_SEL
#define MEMBER_FLIP_SEL (mi & 1)
#endif
#ifndef STAGGER_TICKS
#define STAGGER_TICKS 0
#endif
#ifndef MK_PER_PHASE
#define MK_PER_PHASE 0
#endif

constexpr int D = 1024, BATCH = 8, SEQ = 2048, MP = BATCH * SEQ  , MS = 128  ;
constexpr int NMEM = 256, NH = 4, HD = 256, FF = 4096, MEMROWS = BATCH * NMEM  ;
constexpr float EPS = 1e-6f;
constexpr float QSCALE = 0.0625f * 1.4426950408889634f;

constexpr size_t OY = 0, OYS = 16777216, OPP = 16908288, OCP = 17031168, OMK = 17047552, OMV = 21241856, OPS = 25436160, OCS = 27402240;

__device__ __forceinline__ int lane_id_opaque() { int l; asm volatile("v_mbcnt_lo_u32_b32 %0, -1, 0\n\tv_mbcnt_hi_u32_b32 %0, -1, %0" : "=v"(l)); return l; }
#define SWZ_XOR(v, m) __builtin_bit_cast(float, __builtin_amdgcn_ds_swizzle(__builtin_bit_cast(int, (float)(v)), (((m) << 10) | 0x1f)))
__device__ __forceinline__ void swap32(float& a, float& b) { asm volatile("s_nop 1\n\tv_permlane32_swap_b32 %0, %1\n\ts_nop 1" : "+v"(a), "+v"(b)); }
__device__ __forceinline__ float add_x32(float v) { float a = v, b = v; swap32(a, b); return a + b; }
__device__ __forceinline__ float max_x32(float v) { float a = v, b = v; swap32(a, b); return fmaxf(a, b); }
__device__ __forceinline__ float add_x16_x32(float v) { v += SWZ_XOR(v, 16); return add_x32(v); }
__device__ __forceinline__ float max_x16_x32(float v) { v = fmaxf(v, SWZ_XOR(v, 16)); return max_x32(v); }
__device__ __forceinline__ float wave_sum(float v) { v += SWZ_XOR(v, 1); v += SWZ_XOR(v, 2); v += SWZ_XOR(v, 4); v += SWZ_XOR(v, 8); v += SWZ_XOR(v, 16); return add_x32(v); }
__device__ __forceinline__ float wave_max(float v) { v = fmaxf(v, SWZ_XOR(v, 1)); v = fmaxf(v, SWZ_XOR(v, 2)); v = fmaxf(v, SWZ_XOR(v, 4)); v = fmaxf(v, SWZ_XOR(v, 8)); v = fmaxf(v, SWZ_XOR(v, 16)); return max_x32(v); }

namespace pg8 {
#define PG8_LAS __attribute__((address_space(3)))
typedef unsigned short bf16_t;
typedef short bf16x8 __attribute__((ext_vector_type(8)));
typedef float f32x4 __attribute__((ext_vector_type(4)));
typedef float f32x2 __attribute__((ext_vector_type(2)));
typedef unsigned u32x4 __attribute__((ext_vector_type(4)));
typedef unsigned u32x2 __attribute__((ext_vector_type(2)));
constexpr int BM = 256, BK = 64, HALF = 128, HTB = HALF * BK * 2, STAGE_BYTES = 8 * HTB, NXCD = 8, WGM = 8;

__host__ __device__ __forceinline__ int lds_byte(int r, int c) { const int st = (r >> 4) * 2 + (c >> 5), rr = r & 15, cc = c & 31, ob = rr * 64 + cc * 2; return st * 1024 + (ob ^ (((ob >> 9) & 1) << 5)); }
__host__ __device__ __forceinline__ void stage_rc(int b, int& R, int& C) { const int st = b / 1024, sb = b % 1024, swz = sb ^ (((sb >> 9) & 1) << 5); R = (st >> 1) * 16 + swz / 64; C = (st & 1) * 32 + (swz % 64) / 2; }
__host__ __device__ __forceinline__ int perm32(int rho) { const int n = rho >> 4, i = rho & 15; return 8 * (i >> 2) + 4 * n + (i & 3); }

struct Unit { int pm, pn; };
struct Gemm { int lda, ldb, K; };

__device__ __forceinline__ unsigned cvt_pk_bf16(float lo, float hi) { unsigned r; asm volatile("v_cvt_pk_bf16_f32 %0, %1, %2" : "=v"(r) : "v"(lo), "v"(hi)); return r; }

struct StaticOrder {
    int nM, nN, nwg, G, c, pm0;
    const char* A; const char* B; size_t astep, bstep, apn;
    __device__ void init(int nM_, int nN_, int G_, int c_, int pm0_, const void* A_, size_t astep_, const void* B_, size_t bstep_, size_t apn_ = 0) {
        nM = nM_; nN = nN_; nwg = nM * nN; G = G_; c = c_; pm0 = pm0_; A = (const char*)A_; B = (const char*)B_; astep = astep_; bstep = bstep_; apn = apn_; }
    __device__ bool next(int i, Unit& u) const {
        const long L = (long)i * G + c; if (L >= nwg) return false;
        u.pm = pm0 + (int)(L % nM); u.pn = (int)(L / nM); return true;
    }
    __device__ __forceinline__ const char* aptr(const Unit& u) const { return A + (size_t)u.pm * astep + (size_t)u.pn * apn; }
    __device__ __forceinline__ const char* bptr(const Unit& u) const { return B + (size_t)u.pn * bstep; }
};
struct KvOrder {
    int G, c, batch; const char* A; const char* B;
    __device__ bool next(int i, Unit& u) const { const int L = i * G + c; if (L >= 16) return false; u.pm = (L >> 3) * 8 + batch; u.pn = L & 7; return true; }
    __device__ __forceinline__ const char* aptr(const Unit& u) const { return A + (size_t)u.pm * (256 * 1024 * 2); }
    __device__ __forceinline__ const char* bptr(const Unit& u) const { return B + (size_t)((u.pm >> 3) * 2048 + u.pn * 256) * (1024 * 2); }
};
struct SingleOrder {
    Unit u0; const char* A; const char* B;
    __device__ bool next(int i, Unit& u) const { if (i) return false; u = u0; return true; }
    __device__ __forceinline__ const char* aptr(const Unit&) const { return A; }
    __device__ __forceinline__ const char* bptr(const Unit&) const { return B; }
};


template <bool BASE32> struct EpiRes {
    static constexpr bool PERM = true, AFTER_DRAIN = false;
    const float* base32; bf16_t* x16; float* ssq; const float* cscale;
    __device__ __forceinline__ void operator()(const f32x4 (&acc)[2][2][4][2], const Unit& u, int wr, int wc, int fr, int fq) const {
        const int col0 = u.pn * BM + wc * 32 + 8 * fq;
        f32x4 cs[2][2];
#pragma unroll
        for (int bj = 0; bj < 2; ++bj)
#pragma unroll
            for (int n = 0; n < 2; ++n) cs[bj][n] = cscale ? *(const f32x4*)(cscale + col0 + bj * HALF + n * 4) : (f32x4){1.f, 1.f, 1.f, 1.f};
        constexpr int HSTEP = BASE32 ? 1 : 2;
#pragma unroll
        for (int a0 = 0; a0 < 2; a0 += HSTEP) {
        u32x4 bw[HSTEP][4][2]; f32x4 bf[BASE32 ? 1 : 1][4][2][2];
#pragma unroll
        for (int ah = 0; ah < HSTEP; ++ah)
#pragma unroll
            for (int m = 0; m < 4; ++m) { const int row = u.pm * BM + (a0 + ah) * HALF + wr * 64 + m * 16 + fr; const size_t off = (size_t)row * D + col0;
#pragma unroll
                for (int bj = 0; bj < 2; ++bj) {
                    if (BASE32) { bf[0][m][bj][0] = __builtin_nontemporal_load((const f32x4*)(base32 + off + bj * HALF)); bf[0][m][bj][1] = __builtin_nontemporal_load((const f32x4*)(base32 + off + bj * HALF + 4)); }
                    else bw[ah][m][bj] = *(const u32x4*)(x16 + off + bj * HALF); } }
#pragma unroll
        for (int ah = 0; ah < HSTEP; ++ah) { const int ai = a0 + ah;
#pragma unroll
            for (int m = 0; m < 4; ++m) { const int row = u.pm * BM + ai * HALF + wr * 64 + m * 16 + fr; const size_t off = (size_t)row * D + col0; float ss = 0.f;
#pragma unroll
                for (int bj = 0; bj < 2; ++bj) { f32x4 b0, b1;
                    if (BASE32) { b0 = bf[0][m][bj][0]; b1 = bf[0][m][bj][1]; }
                    else { const u32x4 w = bw[ah][m][bj];
                        b0 = (f32x4){__builtin_bit_cast(float, w.x << 16), __builtin_bit_cast(float, w.x & 0xffff0000u), __builtin_bit_cast(float, w.y << 16), __builtin_bit_cast(float, w.y & 0xffff0000u)};
                        b1 = (f32x4){__builtin_bit_cast(float, w.z << 16), __builtin_bit_cast(float, w.z & 0xffff0000u), __builtin_bit_cast(float, w.w << 16), __builtin_bit_cast(float, w.w & 0xffff0000u)}; }
                    const f32x4 v0 = b0 + acc[ai][bj][m][0] * cs[bj][0], v1 = b1 + acc[ai][bj][m][1] * cs[bj][1];
                    ss += ((v0[0] * v0[0] + v0[1] * v0[1]) + (v0[2] * v0[2] + v0[3] * v0[3])) + ((v1[0] * v1[0] + v1[1] * v1[1]) + (v1[2] * v1[2] + v1[3] * v1[3]));
                    u32x4 o; o.x = cvt_pk_bf16(v0[0], v0[1]); o.y = cvt_pk_bf16(v0[2], v0[3]); o.z = cvt_pk_bf16(v1[0], v1[1]); o.w = cvt_pk_bf16(v1[2], v1[3]);
                    *(u32x4*)(x16 + off + bj * HALF) = o; }
                ss = add_x16_x32(ss);
                if (fq == 0) ssq[(size_t)row * 16 + u.pn * 4 + wc] = ss; }
        }
        }
    }
};
__device__ __forceinline__ float rstd_from_ssq16(const float* ssq, int row) {
    const f32x4* sp = (const f32x4*)(ssq + (size_t)row * 16); const f32x4 s = (sp[0] + sp[1]) + (sp[2] + sp[3]);
    return __builtin_amdgcn_rsqf(((s[0] + s[1]) + (s[2] + s[3])) * (1.0f / D) + EPS);
}
template <int MODE> struct EpiRow {
    static constexpr bool PERM = true, AFTER_DRAIN = false;
    bf16_t* O; int ldc; const float* ssq; float scale; bf16_t* O2; float* convout; const PG8_LAS float* rsd;
    __device__ __forceinline__ void operator()(const f32x4 (&acc)[2][2][4][2], const Unit& u, int wr, int wc, int fr, int fq) const {
        const int colw = wc * 32 + 8 * fq;
        float rsv[2][4];
        if (rsd) {
#pragma unroll
          for (int ai = 0; ai < 2; ++ai)
#pragma unroll
              for (int m = 0; m < 4; ++m) rsv[ai][m] = rsd[ai * HALF + wr * 64 + m * 16 + fr];
        } else { f32x4 qv[2][4];
#pragma unroll
          for (int ai = 0; ai < 2; ++ai)
#pragma unroll
              for (int m = 0; m < 4; ++m) qv[ai][m] = *(const f32x4*)(ssq + (size_t)(u.pm * BM + ai * HALF + wr * 64 + m * 16 + fr) * 16 + 4 * fq);
#pragma unroll
          for (int ai = 0; ai < 2; ++ai)
#pragma unroll
              for (int m = 0; m < 4; ++m) { const f32x4 q = qv[ai][m]; rsv[ai][m] = __builtin_amdgcn_rsqf(add_x16_x32((q[0] + q[1]) + (q[2] + q[3])) * (1.0f / D) + EPS); } }
#pragma unroll
        for (int ai = 0; ai < 2; ++ai)
#pragma unroll
            for (int m = 0; m < 4; ++m) { const int row = u.pm * BM + ai * HALF + wr * 64 + m * 16 + fr; const float rs = rsv[ai][m];
                if (MODE == 2 && u.pn >= 4) {
                    const float r2 = rs * rs; const f32x4 v0 = acc[ai][0][m][0] * acc[ai][1][m][0] * r2, v1 = acc[ai][0][m][1] * acc[ai][1][m][1] * r2;
                    const int ch = (u.pn - 4) * 128 + colw;
                    u32x4 w; w.x = cvt_pk_bf16(v0[0], v0[1]); w.y = cvt_pk_bf16(v0[2], v0[3]); w.z = cvt_pk_bf16(v1[0], v1[1]); w.w = cvt_pk_bf16(v1[2], v1[3]);
                    *(u32x4*)(O2 + (size_t)row * D + ch) = w;
                    const int t = row & (SEQ - 1);
                    if (t >= SEQ - 2) { float* cp = convout + ((size_t)(row >> 11) * 2 + (t - (SEQ - 2))) * D + ch; *(f32x4*)cp = v0; *(f32x4*)(cp + 4) = v1; }
                } else {
                    const float sc = (MODE == 0) ? rs * scale : rs;
#pragma unroll
                    for (int bj = 0; bj < 2; ++bj) { f32x4 v0 = acc[ai][bj][m][0] * sc, v1 = acc[ai][bj][m][1] * sc;
                        if (MODE == 1) {
#pragma unroll
                            for (int j = 0; j < 4; ++j) { const float a = fmaxf(v0[j], 0.f), b = fmaxf(v1[j], 0.f); v0[j] = a * a; v1[j] = b * b; } }
                        u32x4 w; w.x = cvt_pk_bf16(v0[0], v0[1]); w.y = cvt_pk_bf16(v0[2], v0[3]); w.z = cvt_pk_bf16(v1[0], v1[1]); w.w = cvt_pk_bf16(v1[2], v1[3]);
                        *(u32x4*)(O + (size_t)row * ldc + u.pn * BM + bj * HALF + colw) = w; }
                } }
    }
};
struct EpiBf16 {
    static constexpr bool PERM = true, AFTER_DRAIN = false;
    bf16_t* O; int ldc; float scale;
    __device__ __forceinline__ void operator()(const f32x4 (&acc)[2][2][4][2], const Unit& u, int wr, int wc, int fr, int fq) const {
        const int colw = u.pn * BM + wc * 32 + 8 * fq;
#pragma unroll
        for (int ai = 0; ai < 2; ++ai)
#pragma unroll
            for (int m = 0; m < 4; ++m) { const int row = u.pm * BM + ai * HALF + wr * 64 + m * 16 + fr;
#pragma unroll
                for (int bj = 0; bj < 2; ++bj) { const f32x4 v0 = acc[ai][bj][m][0] * scale, v1 = acc[ai][bj][m][1] * scale;
                    u32x4 w; w.x = cvt_pk_bf16(v0[0], v0[1]); w.y = cvt_pk_bf16(v0[2], v0[3]); w.z = cvt_pk_bf16(v1[0], v1[1]); w.w = cvt_pk_bf16(v1[2], v1[3]);
                    *(u32x4*)(O + (size_t)row * ldc + colw + bj * HALF) = w; } }
    }
};
struct EpiKV {
    static constexpr bool PERM = false, AFTER_DRAIN = false;
    float* outk; float* outv; bf16_t* Kb; bf16_t* Vt;
    __device__ __forceinline__ void operator()(const f32x4 (&acc)[2][2][4][2], const Unit& u, int wr, int wc, int fr, int fq) const {
        const int layer = u.pm >> 3; const bool isV = u.pn >= 4; const int col0 = (u.pn & 3) * BM + wc * 32 + 4 * fq;
        float* outp = isV ? outv : outk;
#pragma unroll
        for (int ai = 0; ai < 2; ++ai)
#pragma unroll
            for (int m = 0; m < 4; ++m) { const int rowl = (u.pm & 7) * BM + ai * HALF + wr * 64 + m * 16 + fr; const size_t off = ((size_t)layer * MEMROWS + rowl) * D + col0;
#pragma unroll
                for (int bj = 0; bj < 2; ++bj)
#pragma unroll
                    for (int n = 0; n < 2; ++n) { const f32x4 v = acc[ai][bj][m][n]; *(f32x4*)(outp + off + bj * HALF + n * 16) = v;
                        if (!isV) { u32x2 p; p.x = cvt_pk_bf16(v[0], v[1]); p.y = cvt_pk_bf16(v[2], v[3]); *(u32x2*)(Kb + off + bj * HALF + n * 16) = p; }
                        else { u32x2 p; p.x = cvt_pk_bf16(v[0], v[1]); p.y = cvt_pk_bf16(v[2], v[3]); *(u32x2*)(Vt + off + bj * HALF + n * 16) = p; } } }
    }
};
struct EpiSoftmax {
    static constexpr bool PERM = true, AFTER_DRAIN = true;
    bf16_t* P; int ldp; const float* ssq;
    __device__ __forceinline__ void operator()(const f32x4 (&)[2][2][4][2], const Unit&, int, int, int, int) const {}
    __device__ __forceinline__ void fused(f32x4 (&acc)[2][2][4][2], const Unit& u, int wr, int wc, int fr, int fq, PG8_LAS unsigned char* lds, int wid, int lane) const {
        PG8_LAS float* Pm = (PG8_LAS float*)lds;
        PG8_LAS float* Ps = (PG8_LAS float*)(lds + 4096);
        float rsv[2][4];
        { f32x4 qv[2][4];
#pragma unroll
          for (int ai = 0; ai < 2; ++ai)
#pragma unroll
              for (int m = 0; m < 4; ++m) qv[ai][m] = *(const f32x4*)(ssq + (size_t)(u.pm * BM + ai * HALF + wr * 64 + m * 16 + fr) * 16 + 4 * fq);
#pragma unroll
          for (int ai = 0; ai < 2; ++ai)
#pragma unroll
              for (int m = 0; m < 4; ++m) { const f32x4 q = qv[ai][m]; rsv[ai][m] = __builtin_amdgcn_rsqf(add_x16_x32((q[0] + q[1]) + (q[2] + q[3])) * (1.0f / D) + EPS); } }
#pragma unroll
        for (int ai = 0; ai < 2; ++ai)
#pragma unroll
            for (int m = 0; m < 4; ++m) { float mx = -3.0e38f; const float rs = rsv[ai][m];
#pragma unroll
                for (int bj = 0; bj < 2; ++bj)
#pragma unroll
                    for (int n = 0; n < 2; ++n) { const f32x4 x = acc[ai][bj][m][n] * rs; acc[ai][bj][m][n] = x; mx = fmaxf(mx, fmaxf(fmaxf(x[0], x[1]), fmaxf(x[2], x[3]))); }
                mx = max_x16_x32(mx);
                if (fq == 0) Pm[(ai * HALF + wr * 64 + m * 16 + fr) * 4 + wc] = mx; }
        asm volatile("s_waitcnt lgkmcnt(0)" ::: "memory"); __builtin_amdgcn_s_barrier(); asm volatile("" ::: "memory");
#pragma unroll
        for (int ai = 0; ai < 2; ++ai)
#pragma unroll
            for (int m = 0; m < 4; ++m) { const int r = ai * HALF + wr * 64 + m * 16 + fr; const f32x4 q = *(const PG8_LAS f32x4*)(Pm + r * 4);
                const float mx = fmaxf(fmaxf(q[0], q[1]), fmaxf(q[2], q[3])); float s = 0.f;
#pragma unroll
                for (int bj = 0; bj < 2; ++bj)
#pragma unroll
                    for (int n = 0; n < 2; ++n) { f32x4 x = acc[ai][bj][m][n];
#pragma unroll
                        for (int j = 0; j < 4; ++j) { x[j] = __builtin_amdgcn_exp2f(x[j] - mx); s += x[j]; }
                        acc[ai][bj][m][n] = x; }
                s = add_x16_x32(s);
                if (fq == 0) Ps[r * 4 + wc] = s; }
        asm volatile("s_waitcnt lgkmcnt(0)" ::: "memory"); __builtin_amdgcn_s_barrier(); asm volatile("" ::: "memory");
        const int colw = u.pn * BM + wc * 32 + 8 * fq;
#pragma unroll
        for (int ai = 0; ai < 2; ++ai)
#pragma unroll
            for (int m = 0; m < 4; ++m) { const int r = ai * HALF + wr * 64 + m * 16 + fr; const f32x4 q = *(const PG8_LAS f32x4*)(Ps + r * 4);
                const float inv = __builtin_amdgcn_rcpf((q[0] + q[1]) + (q[2] + q[3]));
#pragma unroll
                for (int bj = 0; bj < 2; ++bj) { const f32x4 v0 = acc[ai][bj][m][0] * inv, v1 = acc[ai][bj][m][1] * inv;
                    u32x4 w; w.x = cvt_pk_bf16(v0[0], v0[1]); w.y = cvt_pk_bf16(v0[2], v0[3]); w.z = cvt_pk_bf16(v1[0], v1[1]); w.w = cvt_pk_bf16(v1[2], v1[3]);
                    *(u32x4*)(P + (size_t)(u.pm * BM + r) * ldp + bj * HALF + colw) = w; } }
    }
};

template <class Epi, class Sched, bool ALIGN_EPI>
__device__ __forceinline__ void gemm_phase(PG8_LAS unsigned char* lds, const Gemm g, const Sched& S, const Epi& E, int tid) {
    asm volatile("" : "+v"(tid));
    const int wid = __builtin_amdgcn_readfirstlane(tid >> 6), lane = tid & 63, wr = wid >> 2, wc = wid & 3, fr = lane & 15, fq = lane >> 4;
    const int nt = g.K / BK;
    unsigned voffA[2], voffB[2];
#pragma unroll
    for (int i = 0; i < 2; ++i) { int R, C; stage_rc(tid * 16 + i * 8192, R, C); const int Rb = Epi::PERM ? ((R & ~31) + perm32(R & 31)) : R;
        voffA[i] = (unsigned)(R * g.lda + C) * 2u; voffB[i] = (unsigned)(Rb * g.ldb + C) * 2u; }
    const size_t kstep = (size_t)(BK * 2);
    const size_t hstepA = (size_t)HALF * g.lda * 2, hstepB = (size_t)HALF * g.ldb * 2;
    const unsigned ldsw = (unsigned)wid * 1024u;
    const int aoff = lds_byte(wr * 64 + fr, fq * 8), boff = lds_byte(wc * 32 + fr, fq * 8);
#define PG8_SA(b, h) (((b) * 2 + (h)) * HTB)
#define PG8_SB(b, h) ((4 + (b) * 2 + (h)) * HTB)
#define PG8_STAGE(bufoff, gbase, voff) do { const char* _gb = (const char*)(gbase); asm volatile("" : "+s"(_gb));   \
        _Pragma("unroll") for (int _i = 0; _i < 2; ++_i) \
        __builtin_amdgcn_global_load_lds((const unsigned*)(_gb + (voff)[_i]), (PG8_LAS unsigned*)(lds + (bufoff) + ldsw + _i * 8192), 16, 0, 0); } while (0)
#define PG8_LDA(dst, b, h) do { _Pragma("unroll") for (int m = 0; m < 4; ++m) _Pragma("unroll") for (int k = 0; k < 2; ++k) dst[m][k] = *(const PG8_LAS bf16x8*)(lds + PG8_SA(b, h) + aoff + m * 2048 + k * 1024); } while (0)
#define PG8_LDB(dst, b, h) do { _Pragma("unroll") for (int n = 0; n < 2; ++n) _Pragma("unroll") for (int k = 0; k < 2; ++k) dst[n][k] = *(const PG8_LAS bf16x8*)(lds + PG8_SB(b, h) + boff + n * 2048 + k * 1024); } while (0)
#define PG8_MMA(ai, bj, At, Bt) do { __builtin_amdgcn_s_setprio(1); _Pragma("unroll") for (int m = 0; m < 4; ++m) _Pragma("unroll") for (int n = 0; n < 2; ++n) _Pragma("unroll") for (int k = 0; k < 2; ++k) \
        acc[ai][bj][m][n] = __builtin_amdgcn_mfma_f32_16x16x32_bf16(Bt[n][k], At[m][k], acc[ai][bj][m][n], 0, 0, 0); __builtin_amdgcn_s_setprio(0); } while (0)
#define PG8_WAIT_V(n) asm volatile("s_waitcnt vmcnt(" #n ")" ::: "memory")
#define PG8_WAIT_L(n) asm volatile("s_waitcnt lgkmcnt(" #n ")" ::: "memory")
#define PG8_BAR __builtin_amdgcn_s_barrier()
#define PG8_SCHED __builtin_amdgcn_sched_barrier(0)
    Unit cur, nxt; int ui = 0;
    if (!S.next(0, cur)) return;
    f32x4 acc[2][2][4][2];
#pragma unroll
    for (int a = 0; a < 2; ++a)
#pragma unroll
        for (int b = 0; b < 2; ++b)
#pragma unroll
            for (int m = 0; m < 4; ++m)
#pragma unroll
                for (int n = 0; n < 2; ++n) acc[a][b][m][n] = (f32x4){0.f, 0.f, 0.f, 0.f};
    bf16x8 At[4][2], B0[2][2], B1[2][2];
    const char* cA = S.aptr(cur); const char* cB = S.bptr(cur);
    PG8_STAGE(PG8_SB(0, 0), cB, voffB); PG8_STAGE(PG8_SB(0, 1), cB + hstepB, voffB); PG8_STAGE(PG8_SA(0, 0), cA, voffA); PG8_STAGE(PG8_SA(0, 1), cA + hstepA, voffA);
    if (wr == 1) PG8_BAR;
    PG8_WAIT_V(2); PG8_BAR;
    PG8_STAGE(PG8_SB(1, 0), cB + kstep, voffB); PG8_STAGE(PG8_SA(1, 0), cA + kstep, voffA); PG8_STAGE(PG8_SB(1, 1), cB + hstepB + kstep, voffB);
    PG8_WAIT_V(6); PG8_BAR;
    for (;;) {
        const bool has_next = S.next(ui + 1, nxt);
        const char* nA = has_next ? S.aptr(nxt) : cA; const char* nB = has_next ? S.bptr(nxt) : cB;
        for (int t = 0; t < nt; t += 2) {
            const bool last = (t == nt - 2);
            const char* a1 = cA + (size_t)(t + 1) * kstep;
            const char* a2 = last ? nA : cA + (size_t)(t + 2) * kstep; const char* b2 = last ? nB : cB + (size_t)(t + 2) * kstep;
            const char* a3 = a2 + kstep; const char* b3 = b2 + kstep;
            PG8_LDB(B0, 0, 0); PG8_LDB(B1, 0, 1); PG8_SCHED; PG8_LDA(At, 0, 0); PG8_STAGE(PG8_SA(1, 1), a1 + hstepA, voffA);
            PG8_WAIT_V(8); PG8_WAIT_L(0); PG8_BAR; PG8_MMA(0, 0, At, B0); PG8_MMA(0, 1, At, B1); PG8_BAR; PG8_SCHED;
            PG8_LDA(At, 0, 1); PG8_STAGE(PG8_SB(0, 0), b2, voffB); PG8_STAGE(PG8_SB(0, 1), b2 + hstepB, voffB); PG8_STAGE(PG8_SA(0, 0), a2, voffA);
            PG8_WAIT_V(8); PG8_WAIT_L(0); PG8_BAR; PG8_MMA(1, 0, At, B0); PG8_MMA(1, 1, At, B1); PG8_BAR; PG8_SCHED;
            PG8_LDB(B0, 1, 0); PG8_LDB(B1, 1, 1); PG8_SCHED; PG8_LDA(At, 1, 0); PG8_STAGE(PG8_SA(0, 1), a2 + hstepA, voffA);
            PG8_WAIT_V(8); PG8_WAIT_L(0); PG8_BAR; PG8_MMA(0, 0, At, B0); PG8_MMA(0, 1, At, B1); PG8_BAR; PG8_SCHED;
            PG8_LDA(At, 1, 1); PG8_STAGE(PG8_SB(1, 0), b3, voffB); PG8_STAGE(PG8_SB(1, 1), b3 + hstepB, voffB); PG8_STAGE(PG8_SA(1, 0), a3, voffA);
            PG8_WAIT_V(8); PG8_WAIT_L(0); PG8_BAR; PG8_MMA(1, 0, At, B0); PG8_MMA(1, 1, At, B1); PG8_BAR; PG8_SCHED;
        }
        if constexpr (ALIGN_EPI) { if (wr == 0) PG8_BAR; }
        if constexpr (!Epi::AFTER_DRAIN) { const int l2 = lane_id_opaque(); E(acc, cur, wr, wc, l2 & 15, l2 >> 4); }
        if (!has_next) break;
#pragma unroll
        for (int a = 0; a < 2; ++a)
#pragma unroll
            for (int b = 0; b < 2; ++b)
#pragma unroll
                for (int m = 0; m < 4; ++m)
#pragma unroll
                    for (int n = 0; n < 2; ++n) acc[a][b][m][n] = (f32x4){0.f, 0.f, 0.f, 0.f};
        cur = nxt; cA = nA; cB = nB; ++ui;
        if constexpr (ALIGN_EPI) { if (wr == 1) PG8_BAR; }
    }
    PG8_WAIT_V(0);
    if constexpr (!ALIGN_EPI) { if (wr == 0) PG8_BAR; }
    PG8_BAR;
    if constexpr (Epi::AFTER_DRAIN) { const int l2 = lane_id_opaque(); E.fused(acc, cur, wr, wc, l2 & 15, l2 >> 4, lds, wid, l2); }
#undef PG8_SA
#undef PG8_SB
#undef PG8_STAGE
#undef PG8_LDA
#undef PG8_LDB
#undef PG8_MMA
#undef PG8_WAIT_V
#undef PG8_WAIT_L
#undef PG8_BAR
#undef PG8_SCHED
}
}

constexpr int NWAVES = 8, NTHREADS = 512;
constexpr size_t MiB = 1u << 20;
constexpr size_t WS_CTL = 0, CTL_ZERO_BYTES = 256 * 1024;
constexpr size_t WS_WPOOL = 1 * MiB;
constexpr size_t WS_WQ = 2 * MiB;
constexpr size_t WS_WO = 6 * MiB;
constexpr size_t WS_WKV = 10 * MiB;
constexpr size_t WS_WUP = 18 * MiB;
constexpr size_t WS_WDN = 34 * MiB;
constexpr size_t WS_WIN = 50 * MiB;
constexpr size_t WS_WOUT = 56 * MiB;
constexpr size_t WS_MN = 58 * MiB;
constexpr size_t WS_KB = 66 * MiB;
constexpr size_t WS_VT = 74 * MiB;
constexpr size_t WS_SSQ = 82 * MiB;
constexpr size_t WS_SMALL = 84 * MiB;
constexpr size_t WS_X = 96 * MiB;
constexpr size_t WS_XG = 160 * MiB;
constexpr size_t WS_P0 = 192 * MiB;
constexpr size_t WS_O = 224 * MiB;
constexpr size_t WS_CH = 256 * MiB;
constexpr size_t WS_PS = 288 * MiB;
constexpr size_t WS_H = 320 * MiB;
constexpr size_t WS_WQN = 448 * MiB;
constexpr size_t WS_MT = 452 * MiB;
constexpr size_t WS_VW = 484 * MiB;
constexpr size_t WS_END = 516 * MiB;
constexpr size_t SS_X = WS_SMALL;
constexpr size_t SS_XG = SS_X + 512 * 1024;
constexpr size_t SS_SSQ = SS_XG + 256 * 1024;
constexpr size_t SS_P0 = SS_SSQ + 32 * 1024;
constexpr size_t SS_O = SS_P0 + 256 * 1024;
constexpr size_t SS_CH = SS_O + 256 * 1024;
constexpr size_t SS_H = SS_CH + 512 * 1024;
constexpr size_t SS_Q = SS_H + 1024 * 1024;
static_assert(SS_Q + 512 * 1024 <= WS_X, "sample buffers");
constexpr int CW_BAR = 4096, CW_BAR_STRIDE = 4096;

constexpr int RING_OFF = 0, RING_BYTES = 131072;
constexpr int LDSCTL_OFF = RING_BYTES, MISC_OFF = LDSCTL_OFF + 320;
constexpr int RSD_OFF = RING_BYTES + 1024;
constexpr int LDS_BYTES = 147456;

#define GAS __attribute__((address_space(1)))
#define LAS __attribute__((address_space(3)))
typedef unsigned short bf16;
typedef unsigned v4u __attribute__((ext_vector_type(4)));
typedef unsigned v2u __attribute__((ext_vector_type(2)));
typedef float f32x4 __attribute__((ext_vector_type(4)));
typedef short bf16x8 __attribute__((ext_vector_type(8)));
#define LDS_WAIT() asm volatile("s_waitcnt lgkmcnt(0)" ::: "memory")
#define VM_WAIT() asm volatile("s_waitcnt vmcnt(0)" ::: "memory")
__device__ __forceinline__ unsigned f2bf(float f) { unsigned u = __builtin_bit_cast(unsigned, f); return (u + 0x7fffu + ((u >> 16) & 1u)) >> 16; }
__device__ __forceinline__ unsigned pk2(float lo, float hi) { return f2bf(lo) | (f2bf(hi) << 16); }
__device__ __forceinline__ float bf2f(unsigned short h) { return __builtin_bit_cast(float, (unsigned)h << 16); }
__device__ __forceinline__ float bflo(unsigned w) { return __builtin_bit_cast(float, w << 16); }
__device__ __forceinline__ float bfhi(unsigned w) { return __builtin_bit_cast(float, w & 0xffff0000u); }

#define XB_TMO      128
#define XB_XCNT(j)  (256  + 64 * (j))
#define XB_XSUB(j)  (1280 + 64 * (j))
#define XB_XGEN(j)  (2304 + 64 * (j))
#define XB_TOP      3328
#define XB_TOPGEN   3392
#define XCD_BAR_WORDS 3456
#define XB_SPIN_CAP (1u << 18)
__device__ __forceinline__ unsigned xb_ld(unsigned* p)              { return __hip_atomic_load(p, __ATOMIC_RELAXED, __HIP_MEMORY_SCOPE_AGENT); }
__device__ __forceinline__ unsigned xb_add(unsigned* p, unsigned v) { return __hip_atomic_fetch_add(p, v, __ATOMIC_RELAXED, __HIP_MEMORY_SCOPE_AGENT); }
__device__ __forceinline__ unsigned xb_xcc_id() { return (unsigned)__builtin_amdgcn_s_getreg((3 << 11) | 20) & 0xFu; }
#define XB_SPIN(cond, bar) do { unsigned _sp = 0; while (cond) { __builtin_amdgcn_s_sleep(1); \
    if ((++_sp & 255u) == 0u) { if (xb_ld(&(bar)[XB_TMO])) break; if (_sp > XB_SPIN_CAP) { atomicAdd(&(bar)[XB_TMO], 1u); break; } } } } while (0)
struct XcdBarrier { unsigned* bar; unsigned x; volatile LAS unsigned* st; unsigned gsize; };
__device__ __forceinline__ XcdBarrier xcd_barrier_post(unsigned* bar, volatile LAS unsigned* st, unsigned gsize) {
    XcdBarrier b; b.bar = bar; b.x = xb_xcc_id(); b.st = st; b.gsize = gsize;
    if (threadIdx.x == 0) (void)xb_add(&bar[XB_XCNT(b.x)], 1u);
    return b;
}
__device__ __forceinline__ void xcd_barrier_complete(unsigned* bar, unsigned x, unsigned G, unsigned& nloc, unsigned& nx) {
    unsigned sum, cnt, mine, sp = 0u;
    for (;;) {
        sum = 0u; cnt = 0u; mine = 0u;
#pragma unroll
        for (unsigned j = 0; j < 16; ++j) { const unsigned c = xb_ld(&bar[XB_XCNT(j)]); sum += c; cnt += (c > 0u) ? 1u : 0u; mine = (j == x) ? c : mine; }
        if (sum == G) break;
        __builtin_amdgcn_s_sleep(1);
        if ((++sp & 255u) == 0u) { if (xb_ld(&bar[XB_TMO])) break; if (sp > XB_SPIN_CAP) { atomicAdd(&bar[XB_TMO], 1u); break; } }
    }
    nloc = mine > 0u ? mine : 1u; nx = cnt > 0u ? cnt : 1u;
}
__device__ __forceinline__ void xcd_barrier(const XcdBarrier& b, const int tid) {
    asm volatile("s_waitcnt vmcnt(0)" ::: "memory");
    __syncthreads();
    if (tid == 0) {
        unsigned* bar = b.bar; asm volatile("" : "+s"(bar));
        __builtin_amdgcn_s_waitcnt(0);
        unsigned nloc = b.st[0], nx = b.st[1];
        if (nloc == 0u) { xcd_barrier_complete(bar, b.x, b.gsize, nloc, nx); b.st[0] = nloc; b.st[1] = nx; }
        const unsigned old = xb_add(&bar[XB_XSUB(b.x)], 1u);
        const unsigned gen = old / nloc;
        if (old + 1u == (gen + 1u) * nloc) {
            if (nx > 1u) {
                __builtin_amdgcn_fence(__ATOMIC_RELEASE, "agent");
                asm volatile("s_waitcnt vmcnt(0)" ::: "memory");
                const unsigned og = xb_add(&bar[XB_TOP], 1u);
                const unsigned tg = og / nx;
                if (og + 1u == (tg + 1u) * nx) xb_add(&bar[XB_TOPGEN], 1u);
                else XB_SPIN(xb_ld(&bar[XB_TOPGEN]) == tg, bar);
            }
            xb_add(&bar[XB_XGEN(b.x)], 1u);
            __builtin_amdgcn_fence(__ATOMIC_ACQUIRE, "agent");
            asm volatile("s_waitcnt vmcnt(0)" ::: "memory");
        } else {
            XB_SPIN(xb_ld(&bar[XB_XGEN(b.x)]) == gen, bar);
            __builtin_amdgcn_fence(__ATOMIC_ACQUIRE, "agent");
            asm volatile("s_waitcnt vmcnt(0)" ::: "memory");
        }
    }
    __syncthreads();
}

__device__ __forceinline__ int opq_v(int x) { asm volatile("" : "+v"(x)); return x; }
struct Args { const float* in[22]; float* out; unsigned char* ws; int ph_lo, ph_hi; };


__device__ __forceinline__ void p0_transpose_item(const float* W, int K, int N, bf16* WT, int k0, int n0, int drow0, LAS float* scr, int lane, const float* gk = nullptr) {
    float v[32];
#pragma unroll
    for (int i = 0; i < 32; ++i) { const int kk = 2 * i + (lane >> 5); v[i] = __builtin_nontemporal_load(W + (size_t)(k0 + kk) * N + n0 + (lane & 31)); }
    if (gk) {
#pragma unroll
        for (int i = 0; i < 32; ++i) v[i] *= gk[k0 + 2 * i + (lane >> 5)]; }
#pragma unroll
    for (int i = 0; i < 32; ++i) scr[(2 * i + (lane >> 5)) * 33 + (lane & 31)] = v[i];
    LDS_WAIT(); asm volatile("" ::: "memory");
    const int c = lane & 7;
#pragma unroll
    for (int j = 0; j < 4; ++j) { const int n = (lane >> 3) + 8 * j; const LAS float* s = scr + (8 * c) * 33 + n;
        v4u o; o.x = pg8::cvt_pk_bf16(s[0 * 33], s[1 * 33]); o.y = pg8::cvt_pk_bf16(s[2 * 33], s[3 * 33]); o.z = pg8::cvt_pk_bf16(s[4 * 33], s[5 * 33]); o.w = pg8::cvt_pk_bf16(s[6 * 33], s[7 * 33]);
        *(GAS v4u*)(WT + (size_t)(drow0 + n) * K + k0 + 8 * c) = o; }
    LDS_WAIT(); asm volatile("" ::: "memory");
}
__device__ __forceinline__ int win_dest_row(int n) {
    if (n < 1024) return n;
    if (n < 2048) { const int ch = n - 1024; return 1024 + (ch >> 7) * 256 + (ch & 127); }
    const int ch = n - 2048; return 1024 + (ch >> 7) * 256 + 128 + (ch & 127);
}

template <int W>
__device__ __forceinline__ void pool_wave(const float* xb  , const LAS float* rs, f32x4 g4, int tA, bf16* pout  , float* poolout  ) {
    f32x4 xv[15 + W];
#pragma unroll
    for (int i = 16 - W; i < 31; ++i) { const int t = tA - 15 + i; xv[i - (16 - W)] = *(const f32x4*)(xb + (size_t)(t >= 0 ? t : 0) * D); }
    f32x4 ring[16]; f32x4 S = {0.f, 0.f, 0.f, 0.f};
#pragma unroll
    for (int i = 16 - W; i < 31; ++i) {
        const int t = tA - 15 + i;
        f32x4 u = {0.f, 0.f, 0.f, 0.f};
        if (t >= 0) u = xv[i - (16 - W)] * rs[i] * g4;
        S += u; if (i - W >= 16 - W) S -= ring[(i - W) & 15];
        ring[i & 15] = u;
        if (i >= 15) {
            const int cnt = (t + 1 < W) ? (t + 1) : W; const float ic = 1.0f / (float)cnt;
            const f32x4 p = S * ic - u; v2u o; o.x = pk2(p[0], p[1]); o.y = pk2(p[2], p[3]);
            *(v2u*)(pout + (size_t)t * D) = o;
            if (t >= SEQ - 15) *(f32x4*)(poolout + (size_t)(t - (SEQ - 15)) * D) = u;
        }
    }
}

template <int RT, int CT, int GR, int KS, class F>
__device__ __forceinline__ void sgemm2(const bf16* A, int lda, int row0, const bf16* Bt, int ldb, const int (&brow)[CT], int K, LAS unsigned char* red, int wave, int lane, const F& f) {
    const int fr = lane & 15, fq = lane >> 4, kw = K >> 3;
    const bf16* ap = A + (size_t)(row0 + fr) * lda + wave * kw + fq * 8;
    const bf16* bp[CT];
#pragma unroll
    for (int ct = 0; ct < CT; ++ct) bp[ct] = Bt + (size_t)(brow[ct] + fr) * ldb + wave * kw + fq * 8;
    f32x4 acc[RT][CT];
#pragma unroll
    for (int rt = 0; rt < RT; ++rt)
#pragma unroll
        for (int ct = 0; ct < CT; ++ct) acc[rt][ct] = (f32x4){0.f, 0.f, 0.f, 0.f};
#pragma unroll 1
    for (int k0 = 0; k0 < kw; k0 += 32 * KS) {
        bf16x8 a[KS][RT], b[KS][CT];
#pragma unroll
        for (int ks = 0; ks < KS; ++ks) {
#pragma unroll
            for (int rt = 0; rt < RT; ++rt) a[ks][rt] = *(const bf16x8*)(ap + (size_t)rt * 16 * lda + k0 + 32 * ks);
#pragma unroll
            for (int ct = 0; ct < CT; ++ct) b[ks][ct] = *(const bf16x8*)(bp[ct] + k0 + 32 * ks); }
#pragma unroll
        for (int ks = 0; ks < KS; ++ks)
#pragma unroll
            for (int rt = 0; rt < RT; ++rt)
#pragma unroll
                for (int ct = 0; ct < CT; ++ct) acc[rt][ct] = __builtin_amdgcn_mfma_f32_16x16x32_bf16(b[ks][ct], a[ks][rt], acc[rt][ct], 0, 0, 0);
    }
#pragma unroll
    for (int rt = 0; rt < RT; ++rt)
#pragma unroll
        for (int ct = 0; ct < CT; ++ct) *(LAS f32x4*)(red + ((((wave * RT + rt) * CT + ct) * 64 + lane) << 4)) = acc[rt][ct];
    LDS_WAIT(); __syncthreads();
    constexpr int NCG = CT / GR, NTASK = RT * NCG;
    for (int t = wave; t < NTASK; t += 8) {
        const int rt = t / NCG, cg = t % NCG;
        f32x4 sacc[GR];
#pragma unroll
        for (int g = 0; g < GR; ++g) { f32x4 tt = {0.f, 0.f, 0.f, 0.f};
#pragma unroll
            for (int w = 0; w < 8; ++w) tt += *(const LAS f32x4*)(red + ((((w * RT + rt) * CT + cg * GR + g) * 64 + lane) << 4));
            sacc[g] = tt; }
        f(sacc, row0 + 16 * rt + fr, cg * GR, fq);
    }
    __syncthreads();
}
__device__ __forceinline__ float srstd(const float* ssq, int row, int fq) {
    const f32x4* sp = (const f32x4*)(ssq + row * 64 + fq * 16); const f32x4 s = (sp[0] + sp[1]) + (sp[2] + sp[3]); float t = (s[0] + s[1]) + (s[2] + s[3]);
    t = add_x16_x32(t);
    return __builtin_amdgcn_rsqf(t * (1.0f / D) + EPS);
}
template <int KS> __device__ __forceinline__ void s_res_unit(const bf16* A, int lda, const bf16* Bt, int ldb, int K, int cp, int row0, const float* base32, bf16* xs16, float* ssq, const float* cscale, LAS unsigned char* red, int wave, int lane) {
    const int brow[2] = {32 * cp, 32 * cp + 16};
    const int myct = wave & 1, prow = row0 + (lane & 15), pc0 = 16 * (2 * cp + myct) + 4 * (lane >> 4); const size_t poff = (size_t)prow * D + pc0;
    f32x4 cs = {1.f, 1.f, 1.f, 1.f}; if (cscale) cs = *(const f32x4*)(cscale + pc0);
    f32x4 bpre; if (base32) bpre = *(const f32x4*)(base32 + poff); else { const v2u w = *(const v2u*)(xs16 + poff); bpre = (f32x4){bflo(w.x), bfhi(w.x), bflo(w.y), bfhi(w.y)}; }
    sgemm2<1, 2, 1, KS>(A, lda, row0, Bt, ldb, brow, K, red, wave, lane, [&](f32x4 (&a)[1], int row, int ct0, int fq) {
        const int ctile = 2 * cp + ct0, c0 = 16 * ctile + 4 * fq; const size_t off = (size_t)row * D + c0;
        const f32x4 v = bpre + a[0] * cs;
        float ss = (v[0] * v[0] + v[1] * v[1]) + (v[2] * v[2] + v[3] * v[3]);
        ss = add_x16_x32(ss);
        if (fq == 0) ssq[row * 64 + ctile] = ss;
        v2u p; p.x = pk2(v[0], v[1]); p.y = pk2(v[2], v[3]); *(v2u*)(xs16 + off) = p; });
}
__device__ __forceinline__ void s_q_unit(const bf16* xs16, const bf16* wq, int cp, int row0, const float* ssq, float* qs, LAS unsigned char* red, int wave, int lane) {
    const int brow[2] = {32 * cp, 32 * cp + 16};
    const float rs = srstd(ssq, row0 + (lane & 15), lane >> 4) * QSCALE;
    sgemm2<1, 2, 1, 4>(xs16, D, row0, wq, D, brow, D, red, wave, lane, [&](f32x4 (&a)[1], int row, int ct0, int fq) {
        *(f32x4*)(qs + (size_t)row * D + 32 * cp + 16 * ct0 + 4 * fq) = a[0] * rs; });
}
__device__ __forceinline__ f32x4 relu2(f32x4 v) {
#pragma unroll
    for (int j = 0; j < 4; ++j) { const float a = fmaxf(v[j], 0.f); v[j] = a * a; }
    return v;
}

__device__ __forceinline__ void rstd_table(const float* ssq, int pm, LAS float* rsd, int tid) {
    if (tid < 256) { const f32x4* sp = (const f32x4*)(ssq + (size_t)(pm * 256 + tid) * 16); const f32x4 q = (sp[0] + sp[1]) + (sp[2] + sp[3]);
        rsd[tid] = __builtin_amdgcn_rsqf(((q[0] + q[1]) + (q[2] + q[3])) * (1.0f / D) + EPS); }
}
__device__ __forceinline__ void treduce32(float (&p)[32], int lane) {
#pragma unroll
    for (int i = 0; i < 16; ++i) { swap32(p[i], p[i + 16]); p[i] += p[i + 16]; }
    { const bool b4 = (lane & 16) != 0;
#pragma unroll
      for (int i = 0; i < 8; ++i) { const float keep = b4 ? p[i + 8] : p[i], send = b4 ? p[i] : p[i + 8]; p[i] = keep + SWZ_XOR(send, 16); } }
    { const bool b3 = (lane & 8) != 0;
#pragma unroll
      for (int i = 0; i < 4; ++i) { const float keep = b3 ? p[i + 4] : p[i], send = b3 ? p[i] : p[i + 4]; p[i] = keep + SWZ_XOR(send, 8); } }
    { const bool b2 = (lane & 4) != 0;
#pragma unroll
      for (int i = 0; i < 2; ++i) { const float keep = b2 ? p[i + 2] : p[i], send = b2 ? p[i] : p[i + 2]; p[i] = keep + SWZ_XOR(send, 4); } }
    { const bool b1 = (lane & 2) != 0; const float keep = b1 ? p[1] : p[0], send = b1 ? p[0] : p[1]; p[0] = keep + SWZ_XOR(send, 2); }
    p[0] += SWZ_XOR(p[0], 1);
}
__device__ __forceinline__ void unpack16(const v4u a, const v4u b, float (&x)[16]) {
    x[0] = bflo(a.x); x[1] = bfhi(a.x); x[2] = bflo(a.y); x[3] = bfhi(a.y); x[4] = bflo(a.z); x[5] = bfhi(a.z); x[6] = bflo(a.w); x[7] = bfhi(a.w);
    x[8] = bflo(b.x); x[9] = bfhi(b.x); x[10] = bflo(b.y); x[11] = bfhi(b.y); x[12] = bflo(b.z); x[13] = bfhi(b.z); x[14] = bflo(b.w); x[15] = bfhi(b.w);
}

constexpr int NPHASES = 15;
__global__ void __launch_bounds__(NTHREADS, 2) mk_fwd(Args args) {
    extern __shared__ __attribute__((aligned(16))) unsigned char lds[];
    LAS unsigned char* L = (LAS unsigned char*)lds;
    volatile LAS unsigned* MISC = (volatile LAS unsigned*)(L + MISC_OFF);
    const int wave0 = __builtin_amdgcn_readfirstlane((int)threadIdx.x >> 6);
    const int G = gridDim.x; const int bx = blockIdx.x; const int vcu = (G % 8 == 0) ? (bx % 8) * (G / 8) + bx / 8 : bx;
    const int grp = bx & 7, mi = bx >> 3, GS = (G - grp + 7) >> 3;
    for (int u = threadIdx.x; u < (LDS_BYTES - LDSCTL_OFF) / 4; u += NTHREADS) ((LAS unsigned*)(L + LDSCTL_OFF))[u] = 0u;
    __syncthreads();
#if MK_PER_PHASE
#define GRID_BAR() do { } while (0)
#define GROUP_BAR() do { } while (0)
#else
    XcdBarrier bar = xcd_barrier_post((unsigned*)(args.ws + WS_CTL) + CW_BAR, MISC + 8, (unsigned)G);
    XcdBarrier gbar = xcd_barrier_post((unsigned*)(args.ws + WS_CTL) + CW_BAR + (1 + grp) * CW_BAR_STRIDE, MISC + 10, (unsigned)GS);
#define GRID_BAR() xcd_barrier(bar, wave0 * 64 + lane_id_opaque())
#define GROUP_BAR() xcd_barrier(gbar, wave0 * 64 + lane_id_opaque())
#endif
    const int lo = args.ph_lo, hi = args.ph_hi;
#define IN(k) (st == (k))
#define SEAM(k) do { } while (0)
    const int NGW = G * NWAVES;
#define TID_NOW (wave0 * 64 + lane_id_opaque())
#define RELANE const int tid = wave0 * 64 + lane_id_opaque(), lane = tid & 63; (void)tid; (void)lane;
#define KA_PTR(T, off) (*(T const __attribute__((address_space(4)))*)(ka + (off)))
#define PH_BEGIN const int tid = wave0 * 64 + lane_id_opaque(), lane = tid & 63, wave = wave0, gw = vcu * NWAVES + wave; (void)lane; (void)gw; \
    const __attribute__((address_space(4))) char* ka = (const __attribute__((address_space(4))) char*)__builtin_amdgcn_kernarg_segment_ptr(); asm volatile("" : "+s"(ka)); \
    unsigned char* const ws = KA_PTR(unsigned char*, 184); float* const out = KA_PTR(float*, 176); (void)ws; (void)out; \
    const float* const x_prompt = KA_PTR(const float*, 0); const float* const x_sample = KA_PTR(const float*, 8); const float* const state_pool = KA_PTR(const float*, 16); const float* const state_conv = KA_PTR(const float*, 24); \
    const float* const cache_k = KA_PTR(const float*, 32); const float* const cache_v = KA_PTR(const float*, 40); const float* const mem_prompt = KA_PTR(const float*, 48); \
    const float* const g_mix = KA_PTR(const float*, 56); const float* const g_attn = KA_PTR(const float*, 64); const float* const g_mem = KA_PTR(const float*, 72); const float* const g_ffn = KA_PTR(const float*, 80); const float* const g_final = KA_PTR(const float*, 88); \
    const float* const w_pool = KA_PTR(const float*, 96); const float* const pool_scale = KA_PTR(const float*, 104); const float* const w_conv_in = KA_PTR(const float*, 112); const float* const w_conv = KA_PTR(const float*, 120); const float* const w_conv_out = KA_PTR(const float*, 128); \
    const float* const w_q = KA_PTR(const float*, 136); const float* const w_kv = KA_PTR(const float*, 144); const float* const w_o = KA_PTR(const float*, 152); const float* const w_up = KA_PTR(const float*, 160); const float* const w_down = KA_PTR(const float*, 168); \
    (void)x_prompt; (void)x_sample; (void)state_pool; (void)state_conv; (void)cache_k; (void)cache_v; (void)mem_prompt; (void)g_mix; (void)g_attn; (void)g_mem; (void)g_ffn; (void)g_final; (void)w_pool; (void)pool_scale; (void)w_conv_in; (void)w_conv; (void)w_conv_out; (void)w_q; (void)w_kv; (void)w_o; (void)w_up; (void)w_down; \
    bf16* const WPOOL = (bf16*)(ws + WS_WPOOL); bf16* const WQ = (bf16*)(ws + WS_WQ); bf16* const WO = (bf16*)(ws + WS_WO); bf16* const WKV = (bf16*)(ws + WS_WKV); \
    bf16* const WUP = (bf16*)(ws + WS_WUP); bf16* const WDN = (bf16*)(ws + WS_WDN); bf16* const WIN = (bf16*)(ws + WS_WIN); bf16* const WOUT = (bf16*)(ws + WS_WOUT); \
    bf16* const MN = (bf16*)(ws + WS_MN); bf16* const KB = (bf16*)(ws + WS_KB); bf16* const VT = (bf16*)(ws + WS_VT); float* const SSQ = (float*)(ws + WS_SSQ); \
    bf16* const X16 = (bf16*)(ws + WS_X); bf16* const P0 = (bf16*)(ws + WS_P0); bf16* const OB = (bf16*)(ws + WS_O); bf16* const CH = (bf16*)(ws + WS_CH); \
    bf16* const WQN = (bf16*)(ws + WS_WQN); bf16* const MT = (bf16*)(ws + WS_MT); bf16* const VW = (bf16*)(ws + WS_VW); bf16* const HB = (bf16*)(ws + WS_H); \
    bf16* const XS16 = (bf16*)(ws + SS_X); float* const SSQS = (float*)(ws + SS_SSQ); bf16* const P0S = (bf16*)(ws + SS_P0); bf16* const OS = (bf16*)(ws + SS_O); \
    float* const CHS = (float*)(ws + SS_CH); bf16* const HS = (bf16*)(ws + SS_H); float* const QS = (float*)(ws + SS_Q); \
    (void)WPOOL; (void)WQ; (void)WO; (void)WKV; (void)WUP; (void)WDN; (void)WIN; (void)WOUT; (void)MN; (void)KB; (void)VT; (void)SSQ; (void)X16; (void)P0; (void)OB; (void)CH; (void)WQN; (void)MT; (void)VW; (void)HB; (void)XS16; (void)SSQS; (void)P0S; (void)OS; (void)CHS; (void)HS; (void)QS;

#if MK_PER_PHASE
    const int soff = 0; const bool sfirst = false;
#else
    const int soff = SAMPLE_SHIFT ? (grp & 1) : 0;
    const bool sfirst = false;
#endif
    const int mflip = (MEMBER_FLIP && !MK_PER_PHASE) ? (MEMBER_FLIP_SEL) : 0;
#pragma unroll 1
    for (int ph = lo; ph < hi + soff; ++ph) {
#pragma unroll 1
    for (int pp = 0; pp < 2; ++pp) {
    const int which = pp ^ mflip;
    const int st = which ? ph - soff : ph;
    const bool doP = (which == 0), doS = (which == 1) || (st == 0);
    if (st < 0 || st >= NPHASES || (which == 1 && st == 0)) continue;
    if (IN(0)) { PH_BEGIN
        LAS float* scr = (LAS float*)(L + RING_OFF + wave * 16384);
        {
            constexpr int I_POOL = 4 * 4 * 8, I_Q = 16 * 32, I_KV = 16 * 64, I_UP = 16 * 128, I_DN = 64 * 32, I_IN = 16 * 96;
            constexpr int NITEMS = I_POOL + 2 * (I_Q + I_KV + I_Q + I_UP + I_DN) + I_IN + I_Q;
            for (int it = gw; it < NITEMS; it += NGW) {
                int r = it;
                if (r < I_POOL) { const int g = r >> 5, rr = r & 31, kb = rr >> 3, nb = rr & 7; p0_transpose_item(w_pool + g * 65536, 256, 256, WPOOL + g * 65536, 64 * kb, 32 * nb, 32 * nb, scr, lane); continue; } r -= I_POOL;
                bool done = false;
#pragma unroll 1
                for (int l = 0; l < 2 && !done; ++l) {
                    if (r < I_Q) { const int kb = r >> 5, nb = r & 31; p0_transpose_item(w_q + (size_t)l * D * D, D, D, WQ + (size_t)l * D * D, 64 * kb, 32 * nb, 32 * nb, scr, lane, g_attn + l * D); done = true; break; } r -= I_Q;
                    if (r < I_KV) { const int kb = r >> 6, nb = r & 63; p0_transpose_item(w_kv + (size_t)l * D * 2048, D, 2048, WKV + (size_t)l * 2048 * D, 64 * kb, 32 * nb, 32 * nb, scr, lane); done = true; break; } r -= I_KV;
                    if (r < I_Q) { const int kb = r >> 5, nb = r & 31; p0_transpose_item(w_o + (size_t)l * D * D, D, D, WO + (size_t)l * D * D, 64 * kb, 32 * nb, 32 * nb, scr, lane); done = true; break; } r -= I_Q;
                    if (r < I_UP) { const int kb = r >> 7, nb = r & 127; p0_transpose_item(w_up + (size_t)l * D * FF, D, FF, WUP + (size_t)l * FF * D, 64 * kb, 32 * nb, 32 * nb, scr, lane, g_ffn + l * D); done = true; break; } r -= I_UP;
                    if (r < I_DN) { const int kb = r >> 5, nb = r & 31; p0_transpose_item(w_down + (size_t)l * FF * D, FF, D, WDN + (size_t)l * D * FF, 64 * kb, 32 * nb, 32 * nb, scr, lane); done = true; break; } r -= I_DN;
                }
                if (done) continue;
                if (r < I_IN) { const int kb = r / 96, nb = r % 96; p0_transpose_item(w_conv_in, D, 3072, WIN, 64 * kb, 32 * nb, win_dest_row(32 * nb), scr, lane, g_mix + D); continue; } r -= I_IN;
                { const int kb = r >> 5, nb = r & 31; p0_transpose_item(w_conv_out, D, D, WOUT, 64 * kb, 32 * nb, 32 * nb, scr, lane); }
            }
        }
        for (int m = gw; m < MEMROWS; m += NGW) {
            const f32x4* xr = (const f32x4*)(mem_prompt + (size_t)m * D) + lane; f32x4 v[4]; float s = 0.f;
#pragma unroll
            for (int j = 0; j < 4; ++j) { v[j] = xr[64 * j]; s += (v[j][0] * v[j][0] + v[j][1] * v[j][1]) + (v[j][2] * v[j][2] + v[j][3] * v[j][3]); }
            const float rstd = __builtin_amdgcn_rsqf(wave_sum(s) * (1.f / D) + EPS);
#pragma unroll
            for (int l = 0; l < 2; ++l) { v2u* o8 = (v2u*)(MN + ((size_t)l * MEMROWS + m) * D) + lane;
#pragma unroll
                for (int j = 0; j < 4; ++j) { const f32x4 gg = *((const f32x4*)(g_mem + l * D) + lane + 64 * j); const f32x4 w = v[j] * rstd * gg; v2u o; o.x = pk2(w[0], w[1]); o.y = pk2(w[2], w[3]); o8[64 * j] = o; } }
        }
        for (int m = gw; m < 2 * D; m += NGW) {
            const float gk = g_attn[m]; const f32x4* xr = (const f32x4*)(w_q + (size_t)m * D) + lane; v2u* o8 = (v2u*)(WQN + (size_t)m * D) + lane;
            f32x4 v[4];
#pragma unroll
            for (int j = 0; j < 4; ++j) v[j] = xr[64 * j];
#pragma unroll
            for (int j = 0; j < 4; ++j) { const f32x4 w = v[j] * gk; v2u o; o.x = pk2(w[0], w[1]); o.y = pk2(w[2], w[3]); o8[64 * j] = o; }
        }
        for (int it = gw; it < MS * 4; it += NGW) {
            const int b = it >> 2, g = it & 3, c4 = g * 256 + lane * 4;
            const f32x4* xr = (const f32x4*)(x_sample + (size_t)b * D) + lane; float s = 0.f;
#pragma unroll
            for (int j = 0; j < 4; ++j) { const f32x4 v = xr[64 * j]; s += (v[0] * v[0] + v[1] * v[1]) + (v[2] * v[2] + v[3] * v[3]); }
            const float rstd = __builtin_amdgcn_rsqf(wave_sum(s) * (1.f / D) + EPS);
            const f32x4 u = *(const f32x4*)(x_sample + (size_t)b * D + c4) * rstd * *(const f32x4*)(g_mix + c4);
            const int W = 2 << g; f32x4 S = u;
            const float* sp = state_pool + (size_t)b * 15 * D + c4;
            float* po = out + OPS + (size_t)b * 15 * D + c4;
            f32x4 sv[15];
#pragma unroll
            for (int r = 0; r < 15; ++r) sv[r] = *(const f32x4*)(sp + (size_t)r * D);
#pragma unroll
            for (int r = 0; r < 15; ++r) { if (r >= 16 - W) S += sv[r]; if (r >= 1) *(f32x4*)(po + (size_t)(r - 1) * D) = sv[r]; }
            *(f32x4*)(po + (size_t)14 * D) = u;
            const f32x4 p = S * (1.0f / (float)W) - u; v2u o; o.x = pk2(p[0], p[1]); o.y = pk2(p[2], p[3]); *(v2u*)(P0S + (size_t)b * D + c4) = o;
        }
        __syncthreads();
        {
            LAS float* rs = (LAS float*)(L + RING_OFF);
            for (int it = vcu; it < BATCH * (SEQ / 32); it += G) {
                const int b = it >> 6, t0 = (it & 63) * 32;
                { f32x4 xv[6][4];
#pragma unroll
                  for (int j = 0; j < 6; ++j) { const int r = wave + 8 * j, t = t0 - 15 + r; const bool ok = (r < 47) && (t >= 0);
                      const f32x4* xr = (const f32x4*)(x_prompt + ((size_t)b * SEQ + (ok ? t : t0)) * D) + lane;
#pragma unroll
                      for (int q = 0; q < 4; ++q) xv[j][q] = xr[64 * q]; }
#pragma unroll
                  for (int j = 0; j < 6; ++j) { const int r = wave + 8 * j, t = t0 - 15 + r; float s = 0.f;
#pragma unroll
                      for (int q = 0; q < 4; ++q) { const f32x4 v = xv[j][q]; s += (v[0] * v[0] + v[1] * v[1]) + (v[2] * v[2] + v[3] * v[3]); }
                      const float rv = (t >= 0) ? __builtin_amdgcn_rsqf(wave_sum(s) * (1.f / D) + EPS) : 0.f;
                      if (lane == 0 && r < 47) rs[r] = rv; } }
                LDS_WAIT(); __syncthreads();
                const int g = wave & 3, tA = t0 + (wave >> 2) * 16, c4 = g * 256 + lane * 4;
                const float* xb = x_prompt + (size_t)b * SEQ * D + c4; const f32x4 g4 = *(const f32x4*)(g_mix + c4);
                bf16* pout = P0 + (size_t)b * SEQ * D + c4; float* poolout = out + OPP + (size_t)b * 15 * D + c4;
                const LAS float* rsw = rs + (wave >> 2) * 16;
                if (g == 0) pool_wave<2>(xb, rsw, g4, tA, pout, poolout); else if (g == 1) pool_wave<4>(xb, rsw, g4, tA, pout, poolout);
                else if (g == 2) pool_wave<8>(xb, rsw, g4, tA, pout, poolout); else pool_wave<16>(xb, rsw, g4, tA, pout, poolout);
                __syncthreads();
            }
        }
    }
    SEAM(0);

    if (IN(1)) { PH_BEGIN
        if (doP) { pg8::Gemm g{D, D, D}; pg8::KvOrder S{GS == 32 ? 16 : GS, (GS == 32 && mi >= 16) ? (1 << 20) : mi, grp, (const char*)MN, (const char*)WKV};
          pg8::EpiKV E{out + OMK, out + OMV, KB, VT};
          pg8::gemm_phase<pg8::EpiKV, pg8::KvOrder, true>(L + RING_OFF, g, S, E, TID_NOW); }
        if (doP) { pg8::Gemm g{D, 256, 256}; pg8::StaticOrder S;
          if (GS == 32) S.init(8, 4, 16, mi >= 16 ? mi - 16 : 1 << 20, grp * 8, P0, (size_t)256 * D * 2, WPOOL, (size_t)65536 * 2, (size_t)256 * 2);
          else S.init(8, 4, GS, mi, grp * 8, P0, (size_t)256 * D * 2, WPOOL, (size_t)65536 * 2, (size_t)256 * 2);
          pg8::EpiRes<true> E{x_prompt, X16, SSQ, pool_scale};
          pg8::gemm_phase<pg8::EpiRes<true>, pg8::StaticOrder, true>(L + RING_OFF, g, S, E, TID_NOW); }
        if (doS) { RELANE for (int cp = mi; cp < 32; cp += GS) s_res_unit<1>(P0S + (cp >> 3) * 256, D, WPOOL, 256, 256, cp, 16 * grp, x_sample, XS16, SSQS, pool_scale, L + RING_OFF, wave, lane); }
    }
    SEAM(1);

    if (IN(2)) { PH_BEGIN
        if (doS) { RELANE for (int cp = mi; cp < 32; cp += GS) s_q_unit(XS16, WQ, cp, 16 * grp, SSQS, QS, L + RING_OFF, wave, lane); }
        if (doP) for (int idx = mi; idx < 64; idx += GS) {
            const int ly = idx >> 5, kind = (idx >> 4) & 1, a = (idx >> 2) & 3, q = idx & 3;
            const bf16* Ap; const bf16* Bp; bf16* Op; pg8::Unit u; float sc;
            if (kind == 0) {
                Ap = KB + ((size_t)ly * MEMROWS + grp * 256) * D + a * 256; Bp = WQN + ((size_t)ly * D + 256 * q) * D + a * 256;
                Op = MT + (size_t)((ly * BATCH + grp) * NH + a) * 256 * D; u = pg8::Unit{0, q}; sc = QSCALE;
            } else {
                Ap = WO + ((size_t)ly * D + 256 * a) * D + q * 256; Bp = VT + ((size_t)ly * MEMROWS + grp * 256) * D + q * 256;
                Op = VW + (size_t)(ly * BATCH + grp) * D * D; u = pg8::Unit{a, q}; sc = 1.f;
            }
            pg8::Gemm g{D, D, 256}; pg8::SingleOrder S{u, (const char*)Ap, (const char*)Bp};
            pg8::EpiBf16 E{Op, D, sc};
            pg8::gemm_phase<pg8::EpiBf16, pg8::SingleOrder, true>(L + RING_OFF, g, S, E, TID_NOW);
            __syncthreads();
        }
    }
    {
        const int l = (st >= 7) ? 1 : 0, pb = l ? 10 : 3;
        {
            if (IN(7)) { PH_BEGIN
                const LAS float* rsdp = nullptr;
                if (doP && (GS & 7) == 0) { LAS float* t_ = (LAS float*)(L + RSD_OFF); rstd_table(SSQ, grp * 8 + (mi & 7), t_, tid); LDS_WAIT(); __syncthreads(); rsdp = t_; }
                if (doP) { pg8::Gemm g{D, D, D}; pg8::StaticOrder S; S.init(8, 12, GS, mi, grp * 8, X16, (size_t)256 * D * 2, WIN, (size_t)256 * D * 2);
                  pg8::EpiRow<2> E{OB, D, SSQ, 1.f, CH, out + OCP, rsdp};
                  pg8::gemm_phase<pg8::EpiRow<2>, pg8::StaticOrder, true>(L + RING_OFF, g, S, E, TID_NOW); }
                if (doS) { RELANE
                for (int c2 = mi; c2 < 32; c2 += GS) {
                    const int ca = 32 * c2, cb = ca + 16; const int ra = 1024 + (ca >> 7) * 256 + (ca & 127), rb = 1024 + (cb >> 7) * 256 + (cb & 127);
                    const int brow[6] = {ca, ra, ra + 128, cb, rb, rb + 128};
                    const float rs = srstd(SSQS, 16 * grp + (lane & 15), lane >> 4);
                    const int prow = 16 * grp + (lane & 15), pc = ((wave & 1) ? cb : ca) + 4 * (lane >> 4);
                    const f32x4 s0 = *(const f32x4*)(state_conv + ((size_t)prow * 2 + 0) * D + pc), s1 = *(const f32x4*)(state_conv + ((size_t)prow * 2 + 1) * D + pc);
                    const f32x4 w0 = *(const f32x4*)(w_conv + pc), w1 = *(const f32x4*)(w_conv + D + pc), w2 = *(const f32x4*)(w_conv + 2 * D + pc);
                    sgemm2<1, 6, 3, 4>(XS16, D, 16 * grp, WIN, D, brow, D, L + RING_OFF, wave, lane, [&](f32x4 (&a)[3], int row, int ct0, int fq) {
                        const int c0 = (ct0 == 0 ? ca : cb) + 4 * fq;
                        const f32x4 gb = a[0] * rs, chv = a[1] * a[2] * (rs * rs);
                        const f32x4 cv = s0 * w0 + s1 * w1 + chv * w2;
                        const unsigned g01 = pk2(gb[0], gb[1]), g23 = pk2(gb[2], gb[3]);
                        v2u o; o.x = pk2(bflo(g01) * cv[0], bfhi(g01) * cv[1]); o.y = pk2(bflo(g23) * cv[2], bfhi(g23) * cv[3]);
                        *(v2u*)(P0S + (size_t)row * D + c0) = o;
                        *(f32x4*)(out + OCS + ((size_t)row * 2 + 0) * D + c0) = s1; *(f32x4*)(out + OCS + ((size_t)row * 2 + 1) * D + c0) = chv; }); }
                }
            }
            SEAM(7);
            if (IN(8)) { PH_BEGIN
                const int gt = mi * NTHREADS + tid, NT = GS * NTHREADS;
                if (doP) for (int idx0 = gt; idx0 < SEQ * 128; idx0 += 4 * NT) {
                    v4u gb[4], c2[4], c1[4], c0[4];
#pragma unroll
                    for (int q = 0; q < 4; ++q) { const int idx = idx0 + q * NT; const bool ok = idx < SEQ * 128; const int t = ok ? (idx >> 7) : 0, row = grp * SEQ + t, c8 = (idx & 127) * 8;
                        gb[q] = *(const v4u*)(OB + (size_t)row * D + c8); c2[q] = *(const v4u*)(CH + (size_t)row * D + c8);
                        c1[q] = *(const v4u*)(CH + (size_t)(row - (t >= 1 ? 1 : 0)) * D + c8); c0[q] = *(const v4u*)(CH + (size_t)(row - (t >= 2 ? 2 : 0)) * D + c8); }
#pragma unroll
                    for (int q = 0; q < 4; ++q) { const int idx = idx0 + q * NT; if (idx >= SEQ * 128) break; const int t = idx >> 7, row = grp * SEQ + t, c8 = (idx & 127) * 8;
                        if (t < 1) c1[q] = (v4u){0u, 0u, 0u, 0u};
                        if (t < 2) c0[q] = (v4u){0u, 0u, 0u, 0u};
                        const f32x4 w0a = *(const f32x4*)(w_conv + c8), w0b = *(const f32x4*)(w_conv + c8 + 4), w1a = *(const f32x4*)(w_conv + D + c8), w1b = *(const f32x4*)(w_conv + D + c8 + 4),
                                    w2a = *(const f32x4*)(w_conv + 2 * D + c8), w2b = *(const f32x4*)(w_conv + 2 * D + c8 + 4);
                        v4u o;
#pragma unroll
                        for (int j = 0; j < 4; ++j) { const float wl0 = (j < 2) ? w0a[2 * j] : w0b[2 * j - 4], wh0 = (j < 2) ? w0a[2 * j + 1] : w0b[2 * j - 3];
                            const float wl1 = (j < 2) ? w1a[2 * j] : w1b[2 * j - 4], wh1 = (j < 2) ? w1a[2 * j + 1] : w1b[2 * j - 3];
                            const float wl2 = (j < 2) ? w2a[2 * j] : w2b[2 * j - 4], wh2 = (j < 2) ? w2a[2 * j + 1] : w2b[2 * j - 3];
                            const float lo_ = bflo(gb[q][j]) * (bflo(c0[q][j]) * wl0 + bflo(c1[q][j]) * wl1 + bflo(c2[q][j]) * wl2);
                            const float hi_ = bfhi(gb[q][j]) * (bfhi(c0[q][j]) * wh0 + bfhi(c1[q][j]) * wh1 + bfhi(c2[q][j]) * wh2);
                            o[j] = pk2(lo_, hi_); }
                        *(v4u*)(P0 + (size_t)row * D + c8) = o; }
                }
                if (doS) { for (int cp = mi; cp < 32; cp += GS) s_res_unit<4>(P0S, D, WOUT, D, D, cp, 16 * grp, nullptr, XS16, SSQS, nullptr, L + RING_OFF, wave, lane); }
            }
            SEAM(8);
            if (IN(9)) { PH_BEGIN
                if (doP) { pg8::Gemm g{D, D, D}; pg8::StaticOrder S; S.init(8, 4, GS, mi, grp * 8, P0, (size_t)256 * D * 2, WOUT, (size_t)256 * D * 2);
                  pg8::EpiRes<false> E{nullptr, X16, SSQ, nullptr};
                  pg8::gemm_phase<pg8::EpiRes<false>, pg8::StaticOrder, true>(L + RING_OFF, g, S, E, TID_NOW); }
                if (doS) { RELANE for (int cp = mi; cp < 32; cp += GS) s_q_unit(XS16, WQ + (size_t)D * D, cp, 16 * grp, SSQS, QS, L + RING_OFF, wave, lane); }
            }
            SEAM(9);
        }
#define LAYER_W const bf16* WQl = WQ + (size_t)l * D * D; const bf16* WOl = WO + (size_t)l * D * D; const bf16* WUPl = WUP + (size_t)l * FF * D; const bf16* WDNl = WDN + (size_t)l * D * FF; (void)WQl; (void)WOl; (void)WUPl; (void)WDNl;
        if (IN(pb)) { PH_BEGIN LAYER_W
#pragma unroll 1
            for (int half = 0; half < 2; ++half) {
            const bool sampleHalf = ((half == 0) == sfirst);
            if (doP && !sampleHalf) for (int itl = mi; itl < 32; itl += GS) {
                const int pm = grp * 8 + (itl >> 2), h = itl & 3;
                pg8::Gemm g{D, D, D}; pg8::SingleOrder S{{pm, h}, (const char*)(X16 + (size_t)pm * 256 * D), (const char*)(MT + (size_t)((l * BATCH + grp) * NH + h) * 256 * D)};
                pg8::EpiSoftmax E{OB, D, SSQ};
                pg8::gemm_phase<pg8::EpiSoftmax, pg8::SingleOrder, false>(L + RING_OFF, g, S, E, TID_NOW);
                LDS_WAIT(); __builtin_amdgcn_s_barrier(); asm volatile("" ::: "memory");
            }
            if (doS && sampleHalf) { RELANE
                LAS float* sc = (LAS float*)(L + RING_OFF);
                LAS float* po = (LAS float*)(L + RING_OFF + 1024);
                for (int it0 = mi; it0 < 64; it0 += 2 * GS) {
                    const bool pair = (it0 + GS < 64);
#pragma unroll 1
                    for (int iu = 0; iu < 2; ++iu) {
                        if (iu == 1 && !pair) break;
                        const int it = it0 + iu * GS, b = 16 * grp + (it >> 2), h = it & 3;
                        const f32x4 q4 = *(const f32x4*)(QS + (size_t)b * D + h * 256 + lane * 4);
                        const float* kp = cache_k + (((size_t)l * MS + b) * NMEM + wave * 32) * D + h * 256 + lane * 4;
                        const float* vp = cache_v + (((size_t)l * MS + b) * NMEM + wave * 32) * D + h * 256 + lane * 4;
                        f32x4 kv[32]; float p[32];
#pragma unroll
                        for (int n = 0; n < 32; ++n) kv[n] = __builtin_nontemporal_load((const f32x4*)(kp + (size_t)n * D));
#pragma unroll
                        for (int n = 0; n < 32; ++n) { p[n] = (q4[0] * kv[n][0] + q4[1] * kv[n][1]) + (q4[2] * kv[n][2] + q4[3] * kv[n][3]); kv[n] = __builtin_nontemporal_load((const f32x4*)(vp + (size_t)n * D)); }
                        treduce32(p, lane);
                        if ((lane & 1) == 0) sc[wave * 32 + (lane >> 1)] = p[0];
                        LDS_WAIT(); __builtin_amdgcn_s_barrier(); asm volatile("" ::: "memory");
                        float mx, sm = 0.f; const f32x4 sv = *(const LAS f32x4*)(sc + lane * 4);
                        mx = fmaxf(fmaxf(sv[0], sv[1]), fmaxf(sv[2], sv[3]));
                        mx = wave_max(mx);
#pragma unroll
                        for (int j = 0; j < 4; ++j) sm += __builtin_amdgcn_exp2f(sv[j] - mx);
                        sm = wave_sum(sm);
                        f32x4 acc = {0.f, 0.f, 0.f, 0.f};
#pragma unroll
                        for (int n = 0; n < 32; ++n) { const float pn_ = __builtin_amdgcn_exp2f(sc[wave * 32 + n] - mx); acc += kv[n] * pn_; }
                        *(LAS f32x4*)(po + wave * 256 + lane * 4) = acc;
                        LDS_WAIT(); __builtin_amdgcn_s_barrier(); asm volatile("" ::: "memory");
                        if (tid < 256) { float o = 0.f;
#pragma unroll
                            for (int w = 0; w < 8; ++w) o += po[w * 256 + tid];
                            OS[(size_t)b * D + h * 256 + tid] = (bf16)f2bf(o / sm); }
                        LDS_WAIT(); __builtin_amdgcn_s_barrier(); asm volatile("" ::: "memory");
                    }
                }
            }
            }
        }
        SEAM(pb);
        if (IN(pb + 1)) { PH_BEGIN LAYER_W
            if (doP) { pg8::Gemm g{D, D, D}; pg8::StaticOrder S; S.init(8, 4, GS, mi, grp * 8, OB, (size_t)256 * D * 2, VW + (size_t)(l * BATCH + grp) * D * D, (size_t)256 * D * 2);
              pg8::EpiRes<false> E{nullptr, X16, SSQ, nullptr};
              pg8::gemm_phase<pg8::EpiRes<false>, pg8::StaticOrder, true>(L + RING_OFF, g, S, E, TID_NOW); }
            if (doS) { RELANE for (int cp = mi; cp < 32; cp += GS) s_res_unit<4>(OS, D, WOl, D, D, cp, 16 * grp, nullptr, XS16, SSQS, nullptr, L + RING_OFF, wave, lane); }
        }
        SEAM(pb + 2);
        if (IN(pb + 2)) { PH_BEGIN LAYER_W
            const LAS float* rsdp = nullptr;
            if (doP && (GS & 7) == 0) { LAS float* t_ = (LAS float*)(L + RSD_OFF); rstd_table(SSQ, grp * 8 + (mi & 7), t_, tid); LDS_WAIT(); __syncthreads(); rsdp = t_; }
            if (doP) { pg8::Gemm g{D, D, D}; pg8::StaticOrder S; S.init(8, 16, GS, mi, grp * 8, X16, (size_t)256 * D * 2, WUPl, (size_t)256 * D * 2);
              pg8::EpiRow<1> E{HB, FF, SSQ, 1.f, nullptr, nullptr, rsdp};
              pg8::gemm_phase<pg8::EpiRow<1>, pg8::StaticOrder, true>(L + RING_OFF, g, S, E, TID_NOW); }
            if (doS) { RELANE for (int c8 = mi; c8 < 32; c8 += GS) { const int brow[8] = {128 * c8, 128 * c8 + 16, 128 * c8 + 32, 128 * c8 + 48, 128 * c8 + 64, 128 * c8 + 80, 128 * c8 + 96, 128 * c8 + 112};
                const float rs = srstd(SSQS, 16 * grp + (lane & 15), lane >> 4);
                sgemm2<1, 8, 1, 4>(XS16, D, 16 * grp, WUPl, D, brow, D, L + RING_OFF, wave, lane, [&](f32x4 (&a)[1], int row, int ct0, int fq) {
                    const f32x4 v0 = relu2(a[0] * rs);
                    v2u p0; p0.x = pk2(v0[0], v0[1]); p0.y = pk2(v0[2], v0[3]);
                    *(v2u*)(HS + (size_t)row * FF + 128 * c8 + 16 * ct0 + 4 * fq) = p0; }); } }
        }
        SEAM(pb + 3);
        if (IN(pb + 3)) { PH_BEGIN LAYER_W
            if (doP) { pg8::Gemm g{FF, FF, FF}; pg8::StaticOrder S; S.init(8, 4, GS, mi, grp * 8, HB, (size_t)256 * FF * 2, WDNl, (size_t)256 * FF * 2);
              pg8::EpiRes<false> E{nullptr, X16, SSQ, nullptr};
              pg8::gemm_phase<pg8::EpiRes<false>, pg8::StaticOrder, true>(L + RING_OFF, g, S, E, TID_NOW); }
            if (doS) { RELANE for (int cp = mi; cp < 32; cp += GS) s_res_unit<8>(HS, FF, WDNl, FF, FF, cp, 16 * grp, nullptr, XS16, SSQS, nullptr, L + RING_OFF, wave, lane); }
        }
        SEAM(pb + 4);
    }
    if (IN(14)) { PH_BEGIN
        const int mlo = doP ? 0 : SEQ, mhi = doS ? SEQ + 16 : SEQ;
        for (int ml0 = mlo + mi * NWAVES + wave; ml0 < mhi; ml0 += 4 * GS * NWAVES) {
            float sv[4]; v4u xw[4][2];
#pragma unroll
            for (int q = 0; q < 4; ++q) { const int ml = ml0 + q * GS * NWAVES; const bool ok = ml < mhi; const int mlc = ok ? ml : ml0;
                const bf16* xr;
                if (mlc < SEQ) { const int m = grp * SEQ + mlc; sv[q] = (lane < 16) ? SSQ[(size_t)m * 16 + lane] : 0.f; xr = X16 + (size_t)m * D; }
                else { const int r = 16 * grp + (mlc - SEQ); sv[q] = SSQS[r * 64 + lane]; xr = XS16 + (size_t)r * D; }
                xw[q][0] = *((const v4u*)xr + lane); xw[q][1] = *((const v4u*)xr + lane + 64); }
#pragma unroll
            for (int q = 0; q < 4; ++q) { const int ml = ml0 + q * GS * NWAVES; if (ml >= mhi) break;
                const float rs = __builtin_amdgcn_rsqf(wave_sum(sv[q]) * (1.f / D) + EPS);
                float* yr = (ml < SEQ) ? out + OY + (size_t)(grp * SEQ + ml) * D : out + OYS + (size_t)(16 * grp + (ml - SEQ)) * D;
#pragma unroll
                for (int j = 0; j < 2; ++j) { const v4u w = xw[q][j]; const f32x4 g0 = *((const f32x4*)g_final + 2 * (lane + 64 * j)), g1 = *((const f32x4*)g_final + 2 * (lane + 64 * j) + 1);
                    const f32x4 x0 = {bflo(w.x), bfhi(w.x), bflo(w.y), bfhi(w.y)}, x1 = {bflo(w.z), bfhi(w.z), bflo(w.w), bfhi(w.w)};
                    f32x4* yp = (f32x4*)yr + 2 * (lane + 64 * j); yp[0] = x0 * rs * g0; yp[1] = x1 * rs * g1; } }
        }
    }
    }
    if (ph + 1 < hi + soff) { if (ph == 0) { GRID_BAR();
#if STAGGER_TICKS > 0
            { const unsigned long long t0 = __builtin_amdgcn_s_memrealtime(); const unsigned long long dt = (unsigned long long)grp * STAGGER_TICKS;
              while (__builtin_amdgcn_s_memrealtime() - t0 < dt) __builtin_amdgcn_s_sleep(4); }
#endif
        } else GROUP_BAR(); }
    }
#undef IN
#undef SEAM
#undef GRID_BAR
}

extern "C" void kernel_launch(void* const* d_in, const int* in_sizes, int n_in, void* d_out, int out_size, void* d_ws, size_t ws_size, hipStream_t stream) {
    static int grid = 0;
    if (grid == 0) {
        if (n_in != 22 || ws_size < WS_END) { fprintf(stderr, "kernel_launch: unexpected inputs (n_in %d, ws %zu)\n", n_in, ws_size); grid = -1; return; }
        int dev = 0, cus = 0, per_cu = 0;
        if (hipGetDevice(&dev) != hipSuccess || hipDeviceGetAttribute(&cus, hipDeviceAttributeMultiprocessorCount, dev) != hipSuccess) { grid = -1; return; }
        if (hipFuncSetAttribute((const void*)mk_fwd, hipFuncAttributeMaxDynamicSharedMemorySize, LDS_BYTES) != hipSuccess) { fprintf(stderr, "kernel_launch: hipFuncSetAttribute failed\n"); grid = -1; return; }
        if (hipOccupancyMaxActiveBlocksPerMultiprocessor(&per_cu, (const void*)mk_fwd, NTHREADS, LDS_BYTES) != hipSuccess || per_cu < 1)
            fprintf(stderr, "kernel_launch: note: occupancy query reports %d workgroups per CU\n", per_cu);
        (void)hipGetLastError();
        grid = cus;
    }
    if (grid < 0) return;
    (void)hipMemsetAsync((char*)d_ws + WS_CTL, 0, CTL_ZERO_BYTES, stream);
    Args a{};
    for (int i = 0; i < 22; ++i) a.in[i] = (const float*)d_in[i];
    a.out = (float*)d_out; a.ws = (unsigned char*)d_ws;
#if MK_PER_PHASE
    for (int p = 0; p < NPHASES; ++p) { a.ph_lo = p; a.ph_hi = p + 1; hipLaunchKernelGGL(mk_fwd, dim3(grid), dim3(NTHREADS), LDS_BYTES, stream, a); }
#else
    a.ph_lo = 0; a.ph_hi = NPHASES; hipLaunchKernelGGL(mk_fwd, dim3(grid), dim3(NTHREADS), LDS_BYTES, stream, a);
#endif
}
```

```cpp
#include <hip/hip_runtime.h>
#include <cstdio>
#include <cstdint>

#ifndef SAMPLE_SHIFT
#define SAMPLE_SHIFT 1
#endif
#ifndef MEMBER_FLIP
#define MEMBER_FLIP 1
#endif
#ifndef MEMBER_FLIP_SEL
#define MEMBER_FLIP_SEL (mi & 1)
#endif
#ifndef STAGGER_TICKS
#define STAGGER_TICKS 0
#endif
#ifndef MK_PER_PHASE
#define MK_PER_PHASE 0
#endif

constexpr int D = 1024, BATCH = 8, SEQ = 2048, MP = BATCH * SEQ  , MS = 128  ;
constexpr int NMEM = 256, NH = 4, HD = 256, FF = 4096, MEMROWS = BATCH * NMEM  ;
constexpr float EPS = 1e-6f;
constexpr float QSCALE = 0.0625f * 1.4426950408889634f;

constexpr size_t OY = 0, OYS = 16777216, OPP = 16908288, OCP = 17031168, OMK = 17047552, OMV = 21241856, OPS = 25436160, OCS = 27402240;

__device__ __forceinline__ int lane_id_opaque() { int l; asm volatile("v_mbcnt_lo_u32_b32 %0, -1, 0\n\tv_mbcnt_hi_u32_b32 %0, -1, %0" : "=v"(l)); return l; }
#define SWZ_XOR(v, m) __builtin_bit_cast(float, __builtin_amdgcn_ds_swizzle(__builtin_bit_cast(int, (float)(v)), (((m) << 10) | 0x1f)))
__device__ __forceinline__ void swap32(float& a, float& b) { asm volatile("s_nop 1\n\tv_permlane32_swap_b32 %0, %1\n\ts_nop 1" : "+v"(a), "+v"(b)); }
__device__ __forceinline__ float add_x32(float v) { float a = v, b = v; swap32(a, b); return a + b; }
__device__ __forceinline__ float max_x32(float v) { float a = v, b = v; swap32(a, b); return fmaxf(a, b); }
__device__ __forceinline__ float add_x16_x32(float v) { v += SWZ_XOR(v, 16); return add_x32(v); }
__device__ __forceinline__ float max_x16_x32(float v) { v = fmaxf(v, SWZ_XOR(v, 16)); return max_x32(v); }
__device__ __forceinline__ float wave_sum(float v) { v += SWZ_XOR(v, 1); v += SWZ_XOR(v, 2); v += SWZ_XOR(v, 4); v += SWZ_XOR(v, 8); v += SWZ_XOR(v, 16); return add_x32(v); }
__device__ __forceinline__ float wave_max(float v) { v = fmaxf(v, SWZ_XOR(v, 1)); v = fmaxf(v, SWZ_XOR(v, 2)); v = fmaxf(v, SWZ_XOR(v, 4)); v = fmaxf(v, SWZ_XOR(v, 8)); v = fmaxf(v, SWZ_XOR(v, 16)); return max_x32(v); }

namespace pg8 {
#define PG8_LAS __attribute__((address_space(3)))
typedef unsigned short bf16_t;
typedef short bf16x8 __attribute__((ext_vector_type(8)));
typedef float f32x4 __attribute__((ext_vector_type(4)));
typedef float f32x2 __attribute__((ext_vector_type(2)));
typedef unsigned u32x4 __attribute__((ext_vector_type(4)));
typedef unsigned u32x2 __attribute__((ext_vector_type(2)));
constexpr int BM = 256, BK = 64, HALF = 128, HTB = HALF * BK * 2, STAGE_BYTES = 8 * HTB, NXCD = 8, WGM = 8;

__host__ __device__ __forceinline__ int lds_byte(int r, int c) { const int st = (r >> 4) * 2 + (c >> 5), rr = r & 15, cc = c & 31, ob = rr * 64 + cc * 2; return st * 1024 + (ob ^ (((ob >> 9) & 1) << 5)); }
__host__ __device__ __forceinline__ void stage_rc(int b, int& R, int& C) { const int st = b / 1024, sb = b % 1024, swz = sb ^ (((sb >> 9) & 1) << 5); R = (st >> 1) * 16 + swz / 64; C = (st & 1) * 32 + (swz % 64) / 2; }
__host__ __device__ __forceinline__ int perm32(int rho) { const int n = rho >> 4, i = rho & 15; return 8 * (i >> 2) + 4 * n + (i & 3); }

struct Unit { int pm, pn; };
struct Gemm { int lda, ldb, K; };

__device__ __forceinline__ unsigned cvt_pk_bf16(float lo, float hi) { unsigned r; asm volatile("v_cvt_pk_bf16_f32 %0, %1, %2" : "=v"(r) : "v"(lo), "v"(hi)); return r; }

struct StaticOrder {
    int nM, nN, nwg, G, c, pm0;
    const char* A; const char* B; size_t astep, bstep, apn;
    __device__ void init(int nM_, int nN_, int G_, int c_, int pm0_, const void* A_, size_t astep_, const void* B_, size_t bstep_, size_t apn_ = 0) {
        nM = nM_; nN = nN_; nwg = nM * nN; G = G_; c = c_; pm0 = pm0_; A = (const char*)A_; B = (const char*)B_; astep = astep_; bstep = bstep_; apn = apn_; }
    __device__ bool next(int i, Unit& u) const {
        const long L = (long)i * G + c; if (L >= nwg) return false;
        u.pm = pm0 + (int)(L % nM); u.pn = (int)(L / nM); return true;
    }
    __device__ __forceinline__ const char* aptr(const Unit& u) const { return A + (size_t)u.pm * astep + (size_t)u.pn * apn; }
    __device__ __forceinline__ const char* bptr(const Unit& u) const { return B + (size_t)u.pn * bstep; }
};
struct KvOrder {
    int G, c, batch; const char* A; const char* B;
    __device__ bool next(int i, Unit& u) const { const int L = i * G + c; if (L >= 16) return false; u.pm = (L >> 3) * 8 + batch; u.pn = L & 7; return true; }
    __device__ __forceinline__ const char* aptr(const Unit& u) const { return A + (size_t)u.pm * (256 * 1024 * 2); }
    __device__ __forceinline__ const char* bptr(const Unit& u) const { return B + (size_t)((u.pm >> 3) * 2048 + u.pn * 256) * (1024 * 2); }
};
struct SingleOrder {
    Unit u0; const char* A; const char* B;
    __device__ bool next(int i, Unit& u) const { if (i) return false; u = u0; return true; }
    __device__ __forceinline__ const char* aptr(const Unit&) const { return A; }
    __device__ __forceinline__ const char* bptr(const Unit&) const { return B; }
};


template <bool BASE32> struct EpiRes {
    static constexpr bool PERM = true, AFTER_DRAIN = false;
    const float* base32; bf16_t* x16; float* ssq; const float* cscale;
    __device__ __forceinline__ void operator()(const f32x4 (&acc)[2][2][4][2], const Unit& u, int wr, int wc, int fr, int fq) const {
        const int col0 = u.pn * BM + wc * 32 + 8 * fq;
        f32x4 cs[2][2];
#pragma unroll
        for (int bj = 0; bj < 2; ++bj)
#pragma unroll
            for (int n = 0; n < 2; ++n) cs[bj][n] = cscale ? *(const f32x4*)(cscale + col0 + bj * HALF + n * 4) : (f32x4){1.f, 1.f, 1.f, 1.f};
        constexpr int HSTEP = BASE32 ? 1 : 2;
#pragma unroll
        for (int a0 = 0; a0 < 2; a0 += HSTEP) {
        u32x4 bw[HSTEP][4][2]; f32x4 bf[BASE32 ? 1 : 1][4][2][2];
#pragma unroll
        for (int ah = 0; ah < HSTEP; ++ah)
#pragma unroll
            for (int m = 0; m < 4; ++m) { const int row = u.pm * BM + (a0 + ah) * HALF + wr * 64 + m * 16 + fr; const size_t off = (size_t)row * D + col0;
#pragma unroll
                for (int bj = 0; bj < 2; ++bj) {
                    if (BASE32) { bf[0][m][bj][0] = __builtin_nontemporal_load((const f32x4*)(base32 + off + bj * HALF)); bf[0][m][bj][1] = __builtin_nontemporal_load((const f32x4*)(base32 + off + bj * HALF + 4)); }
                    else bw[ah][m][bj] = *(const u32x4*)(x16 + off + bj * HALF); } }
#pragma unroll
        for (int ah = 0; ah < HSTEP; ++ah) { const int ai = a0 + ah;
#pragma unroll
            for (int m = 0; m < 4; ++m) { const int row = u.pm * BM + ai * HALF + wr * 64 + m * 16 + fr; const size_t off = (size_t)row * D + col0; float ss = 0.f;
#pragma unroll
                for (int bj = 0; bj < 2; ++bj) { f32x4 b0, b1;
                    if (BASE32) { b0 = bf[0][m][bj][0]; b1 = bf[0][m][bj][1]; }
                    else { const u32x4 w = bw[ah][m][bj];
                        b0 = (f32x4){__builtin_bit_cast(float, w.x << 16), __builtin_bit_cast(float, w.x & 0xffff0000u), __builtin_bit_cast(float, w.y << 16), __builtin_bit_cast(float, w.y & 0xffff0000u)};
                        b1 = (f32x4){__builtin_bit_cast(float, w.z << 16), __builtin_bit_cast(float, w.z & 0xffff0000u), __builtin_bit_cast(float, w.w << 16), __builtin_bit_cast(float, w.w & 0xffff0000u)}; }
                    const f32x4 v0 = b0 + acc[ai][bj][m][0] * cs[bj][0], v1 = b1 + acc[ai][bj][m][1] * cs[bj][1];
                    ss += ((v0[0] * v0[0] + v0[1] * v0[1]) + (v0[2] * v0[2] + v0[3] * v0[3])) + ((v1[0] * v1[0] + v1[1] * v1[1]) + (v1[2] * v1[2] + v1[3] * v1[3]));
                    u32x4 o; o.x = cvt_pk_bf16(v0[0], v0[1]); o.y = cvt_pk_bf16(v0[2], v0[3]); o.z = cvt_pk_bf16(v1[0], v1[1]); o.w = cvt_pk_bf16(v1[2], v1[3]);
                    *(u32x4*)(x16 + off + bj * HALF) = o; }
                ss = add_x16_x32(ss);
                if (fq == 0) ssq[(size_t)row * 16 + u.pn * 4 + wc] = ss; }
        }
        }
    }
};
__device__ __forceinline__ float rstd_from_ssq16(const float* ssq, int row) {
    const f32x4* sp = (const f32x4*)(ssq + (size_t)row * 16); const f32x4 s = (sp[0] + sp[1]) + (sp[2] + sp[3]);
    return __builtin_amdgcn_rsqf(((s[0] + s[1]) + (s[2] + s[3])) * (1.0f / D) + EPS);
}
template <int MODE> struct EpiRow {
    static constexpr bool PERM = true, AFTER_DRAIN = false;
    bf16_t* O; int ldc; const float* ssq; float scale; bf16_t* O2; float* convout; const PG8_LAS float* rsd;
    __device__ __forceinline__ void operator()(const f32x4 (&acc)[2][2][4][2], const Unit& u, int wr, int wc, int fr, int fq) const {
        const int colw = wc * 32 + 8 * fq;
        float rsv[2][4];
        if (rsd) {
#pragma unroll
          for (int ai = 0; ai < 2; ++ai)
#pragma unroll
              for (int m = 0; m < 4; ++m) rsv[ai][m] = rsd[ai * HALF + wr * 64 + m * 16 + fr];
        } else { f32x4 qv[2][4];
#pragma unroll
          for (int ai = 0; ai < 2; ++ai)
#pragma unroll
              for (int m = 0; m < 4; ++m) qv[ai][m] = *(const f32x4*)(ssq + (size_t)(u.pm * BM + ai * HALF + wr * 64 + m * 16 + fr) * 16 + 4 * fq);
#pragma unroll
          for (int ai = 0; ai < 2; ++ai)
#pragma unroll
              for (int m = 0; m < 4; ++m) { const f32x4 q = qv[ai][m]; rsv[ai][m] = __builtin_amdgcn_rsqf(add_x16_x32((q[0] + q[1]) + (q[2] + q[3])) * (1.0f / D) + EPS); } }
#pragma unroll
        for (int ai = 0; ai < 2; ++ai)
#pragma unroll
            for (int m = 0; m < 4; ++m) { const int row = u.pm * BM + ai * HALF + wr * 64 + m * 16 + fr; const float rs = rsv[ai][m];
                if (MODE == 2 && u.pn >= 4) {
                    const float r2 = rs * rs; const f32x4 v0 = acc[ai][0][m][0] * acc[ai][1][m][0] * r2, v1 = acc[ai][0][m][1] * acc[ai][1][m][1] * r2;
                    const int ch = (u.pn - 4) * 128 + colw;
                    u32x4 w; w.x = cvt_pk_bf16(v0[0], v0[1]); w.y = cvt_pk_bf16(v0[2], v0[3]); w.z = cvt_pk_bf16(v1[0], v1[1]); w.w = cvt_pk_bf16(v1[2], v1[3]);
                    *(u32x4*)(O2 + (size_t)row * D + ch) = w;
                    const int t = row & (SEQ - 1);
                    if (t >= SEQ - 2) { float* cp = convout + ((size_t)(row >> 11) * 2 + (t - (SEQ - 2))) * D + ch; *(f32x4*)cp = v0; *(f32x4*)(cp + 4) = v1; }
                } else {
                    const float sc = (MODE == 0) ? rs * scale : rs;
#pragma unroll
                    for (int bj = 0; bj < 2; ++bj) { f32x4 v0 = acc[ai][bj][m][0] * sc, v1 = acc[ai][bj][m][1] * sc;
                        if (MODE == 1) {
#pragma unroll
                            for (int j = 0; j < 4; ++j) { const float a = fmaxf(v0[j], 0.f), b = fmaxf(v1[j], 0.f); v0[j] = a * a; v1[j] = b * b; } }
                        u32x4 w; w.x = cvt_pk_bf16(v0[0], v0[1]); w.y = cvt_pk_bf16(v0[2], v0[3]); w.z = cvt_pk_bf16(v1[0], v1[1]); w.w = cvt_pk_bf16(v1[2], v1[3]);
                        *(u32x4*)(O + (size_t)row * ldc + u.pn * BM + bj * HALF + colw) = w; }
                } }
    }
};
struct EpiBf16 {
    static constexpr bool PERM = true, AFTER_DRAIN = false;
    bf16_t* O; int ldc; float scale;
    __device__ __forceinline__ void operator()(const f32x4 (&acc)[2][2][4][2], const Unit& u, int wr, int wc, int fr, int fq) const {
        const int colw = u.pn * BM + wc * 32 + 8 * fq;
#pragma unroll
        for (int ai = 0; ai < 2; ++ai)
#pragma unroll
            for (int m = 0; m < 4; ++m) { const int row = u.pm * BM + ai * HALF + wr * 64 + m * 16 + fr;
#pragma unroll
                for (int bj = 0; bj < 2; ++bj) { const f32x4 v0 = acc[ai][bj][m][0] * scale, v1 = acc[ai][bj][m][1] * scale;
                    u32x4 w; w.x = cvt_pk_bf16(v0[0], v0[1]); w.y = cvt_pk_bf16(v0[2], v0[3]); w.z = cvt_pk_bf16(v1[0], v1[1]); w.w = cvt_pk_bf16(v1[2], v1[3]);
                    *(u32x4*)(O + (size_t)row * ldc + colw + bj * HALF) = w; } }
    }
};
struct EpiKV {
    static constexpr bool PERM = false, AFTER_DRAIN = false;
    float* outk; float* outv; bf16_t* Kb; bf16_t* Vt;
    __device__ __forceinline__ void operator()(const f32x4 (&acc)[2][2][4][2], const Unit& u, int wr, int wc, int fr, int fq) const {
        const int layer = u.pm >> 3; const bool isV = u.pn >= 4; const int col0 = (u.pn & 3) * BM + wc * 32 + 4 * fq;
        float* outp = isV ? outv : outk;
#pragma unroll
        for (int ai = 0; ai < 2; ++ai)
#pragma unroll
            for (int m = 0; m < 4; ++m) { const int rowl = (u.pm & 7) * BM + ai * HALF + wr * 64 + m * 16 + fr; const size_t off = ((size_t)layer * MEMROWS + rowl) * D + col0;
#pragma unroll
                for (int bj = 0; bj < 2; ++bj)
#pragma unroll
                    for (int n = 0; n < 2; ++n) { const f32x4 v = acc[ai][bj][m][n]; *(f32x4*)(outp + off + bj * HALF + n * 16) = v;
                        if (!isV) { u32x2 p; p.x = cvt_pk_bf16(v[0], v[1]); p.y = cvt_pk_bf16(v[2], v[3]); *(u32x2*)(Kb + off + bj * HALF + n * 16) = p; }
                        else { u32x2 p; p.x = cvt_pk_bf16(v[0], v[1]); p.y = cvt_pk_bf16(v[2], v[3]); *(u32x2*)(Vt + off + bj * HALF + n * 16) = p; } } }
    }
};
struct EpiSoftmax {
    static constexpr bool PERM = true, AFTER_DRAIN = true;
    bf16_t* P; int ldp; const float* ssq;
    __device__ __forceinline__ void operator()(const f32x4 (&)[2][2][4][2], const Unit&, int, int, int, int) const {}
    __device__ __forceinline__ void fused(f32x4 (&acc)[2][2][4][2], const Unit& u, int wr, int wc, int fr, int fq, PG8_LAS unsigned char* lds, int wid, int lane) const {
        PG8_LAS float* Pm = (PG8_LAS float*)lds;
        PG8_LAS float* Ps = (PG8_LAS float*)(lds + 4096);
        float rsv[2][4];
        { f32x4 qv[2][4];
#pragma unroll
          for (int ai = 0; ai < 2; ++ai)
#pragma unroll
              for (int m = 0; m < 4; ++m) qv[ai][m] = *(const f32x4*)(ssq + (size_t)(u.pm * BM + ai * HALF + wr * 64 + m * 16 + fr) * 16 + 4 * fq);
#pragma unroll
          for (int ai = 0; ai < 2; ++ai)
#pragma unroll
              for (int m = 0; m < 4; ++m) { const f32x4 q = qv[ai][m]; rsv[ai][m] = __builtin_amdgcn_rsqf(add_x16_x32((q[0] + q[1]) + (q[2] + q[3])) * (1.0f / D) + EPS); } }
#pragma unroll
        for (int ai = 0; ai < 2; ++ai)
#pragma unroll
            for (int m = 0; m < 4; ++m) { float mx = -3.0e38f; const float rs = rsv[ai][m];
#pragma unroll
                for (int bj = 0; bj < 2; ++bj)
#pragma unroll
                    for (int n = 0; n < 2; ++n) { const f32x4 x = acc[ai][bj][m][n] * rs; acc[ai][bj][m][n] = x; mx = fmaxf(mx, fmaxf(fmaxf(x[0], x[1]), fmaxf(x[2], x[3]))); }
                mx = max_x16_x32(mx);
                if (fq == 0) Pm[(ai * HALF + wr * 64 + m * 16 + fr) * 4 + wc] = mx; }
        asm volatile("s_waitcnt lgkmcnt(0)" ::: "memory"); __builtin_amdgcn_s_barrier(); asm volatile("" ::: "memory");
#pragma unroll
        for (int ai = 0; ai < 2; ++ai)
#pragma unroll
            for (int m = 0; m < 4; ++m) { const int r = ai * HALF + wr * 64 + m * 16 + fr; const f32x4 q = *(const PG8_LAS f32x4*)(Pm + r * 4);
                const float mx = fmaxf(fmaxf(q[0], q[1]), fmaxf(q[2], q[3])); float s = 0.f;
#pragma unroll
                for (int bj = 0; bj < 2; ++bj)
#pragma unroll
                    for (int n = 0; n < 2; ++n) { f32x4 x = acc[ai][bj][m][n];
#pragma unroll
                        for (int j = 0; j < 4; ++j) { x[j] = __builtin_amdgcn_exp2f(x[j] - mx); s += x[j]; }
                        acc[ai][bj][m][n] = x; }
                s = add_x16_x32(s);
                if (fq == 0) Ps[r * 4 + wc] = s; }
        asm volatile("s_waitcnt lgkmcnt(0)" ::: "memory"); __builtin_amdgcn_s_barrier(); asm volatile("" ::: "memory");
        const int colw = u.pn * BM + wc * 32 + 8 * fq;
#pragma unroll
        for (int ai = 0; ai < 2; ++ai)
#pragma unroll
            for (int m = 0; m < 4; ++m) { const int r = ai * HALF + wr * 64 + m * 16 + fr; const f32x4 q = *(const PG8_LAS f32x4*)(Ps + r * 4);
                const float inv = __builtin_amdgcn_rcpf((q[0] + q[1]) + (q[2] + q[3]));
#pragma unroll
                for (int bj = 0; bj < 2; ++bj) { const f32x4 v0 = acc[ai][bj][m][0] * inv, v1 = acc[ai][bj][m][1] * inv;
                    u32x4 w; w.x = cvt_pk_bf16(v0[0], v0[1]); w.y = cvt_pk_bf16(v0[2], v0[3]); w.z = cvt_pk_bf16(v1[0], v1[1]); w.w = cvt_pk_bf16(v1[2], v1[3]);
                    *(u32x4*)(P + (size_t)(u.pm * BM + r) * ldp + bj * HALF + colw) = w; } }
    }
};

template <class Epi, class Sched, bool ALIGN_EPI>
__device__ __forceinline__ void gemm_phase(PG8_LAS unsigned char* lds, const Gemm g, const Sched& S, const Epi& E, int tid) {
    asm volatile("" : "+v"(tid));
    const int wid = __builtin_amdgcn_readfirstlane(tid >> 6), lane = tid & 63, wr = wid >> 2, wc = wid & 3, fr = lane & 15, fq = lane >> 4;
    const int nt = g.K / BK;
    unsigned voffA[2], voffB[2];
#pragma unroll
    for (int i = 0; i < 2; ++i) { int R, C; stage_rc(tid * 16 + i * 8192, R, C); const int Rb = Epi::PERM ? ((R & ~31) + perm32(R & 31)) : R;
        voffA[i] = (unsigned)(R * g.lda + C) * 2u; voffB[i] = (unsigned)(Rb * g.ldb + C) * 2u; }
    const size_t kstep = (size_t)(BK * 2);
    const size_t hstepA = (size_t)HALF * g.lda * 2, hstepB = (size_t)HALF * g.ldb * 2;
    const unsigned ldsw = (unsigned)wid * 1024u;
    const int aoff = lds_byte(wr * 64 + fr, fq * 8), boff = lds_byte(wc * 32 + fr, fq * 8);
#define PG8_SA(b, h) (((b) * 2 + (h)) * HTB)
#define PG8_SB(b, h) ((4 + (b) * 2 + (h)) * HTB)
#define PG8_STAGE(bufoff, gbase, voff) do { const char* _gb = (const char*)(gbase); asm volatile("" : "+s"(_gb));   \
        _Pragma("unroll") for (int _i = 0; _i < 2; ++_i) \
        __builtin_amdgcn_global_load_lds((const unsigned*)(_gb + (voff)[_i]), (PG8_LAS unsigned*)(lds + (bufoff) + ldsw + _i * 8192), 16, 0, 0); } while (0)
#define PG8_LDA(dst, b, h) do { _Pragma("unroll") for (int m = 0; m < 4; ++m) _Pragma("unroll") for (int k = 0; k < 2; ++k) dst[m][k] = *(const PG8_LAS bf16x8*)(lds + PG8_SA(b, h) + aoff + m * 2048 + k * 1024); } while (0)
#define PG8_LDB(dst, b, h) do { _Pragma("unroll") for (int n = 0; n < 2; ++n) _Pragma("unroll") for (int k = 0; k < 2; ++k) dst[n][k] = *(const PG8_LAS bf16x8*)(lds + PG8_SB(b, h) + boff + n * 2048 + k * 1024); } while (0)
#define PG8_MMA(ai, bj, At, Bt) do { __builtin_amdgcn_s_setprio(1); _Pragma("unroll") for (int m = 0; m < 4; ++m) _Pragma("unroll") for (int n = 0; n < 2; ++n) _Pragma("unroll") for (int k = 0; k < 2; ++k) \
        acc[ai][bj][m][n] = __builtin_amdgcn_mfma_f32_16x16x32_bf16(Bt[n][k], At[m][k], acc[ai][bj][m][n], 0, 0, 0); __builtin_amdgcn_s_setprio(0); } while (0)
#define PG8_WAIT_V(n) asm volatile("s_waitcnt vmcnt(" #n ")" ::: "memory")
#define PG8_WAIT_L(n) asm volatile("s_waitcnt lgkmcnt(" #n ")" ::: "memory")
#define PG8_BAR __builtin_amdgcn_s_barrier()
#define PG8_SCHED __builtin_amdgcn_sched_barrier(0)
    Unit cur, nxt; int ui = 0;
    if (!S.next(0, cur)) return;
    f32x4 acc[2][2][4][2];
#pragma unroll
    for (int a = 0; a < 2; ++a)
#pragma unroll
        for (int b = 0; b < 2; ++b)
#pragma unroll
            for (int m = 0; m < 4; ++m)
#pragma unroll
                for (int n = 0; n < 2; ++n) acc[a][b][m][n] = (f32x4){0.f, 0.f, 0.f, 0.f};
    bf16x8 At[4][2], B0[2][2], B1[2][2];
    const char* cA = S.aptr(cur); const char* cB = S.bptr(cur);
    PG8_STAGE(PG8_SB(0, 0), cB, voffB); PG8_STAGE(PG8_SB(0, 1), cB + hstepB, voffB); PG8_STAGE(PG8_SA(0, 0), cA, voffA); PG8_STAGE(PG8_SA(0, 1), cA + hstepA, voffA);
    if (wr == 1) PG8_BAR;
    PG8_WAIT_V(2); PG8_BAR;
    PG8_STAGE(PG8_SB(1, 0), cB + kstep, voffB); PG8_STAGE(PG8_SA(1, 0), cA + kstep, voffA); PG8_STAGE(PG8_SB(1, 1), cB + hstepB + kstep, voffB);
    PG8_WAIT_V(6); PG8_BAR;
    for (;;) {
        const bool has_next = S.next(ui + 1, nxt);
        const char* nA = has_next ? S.aptr(nxt) : cA; const char* nB = has_next ? S.bptr(nxt) : cB;
        for (int t = 0; t < nt; t += 2) {
            const bool last = (t == nt - 2);
            const char* a1 = cA + (size_t)(t + 1) * kstep;
            const char* a2 = last ? nA : cA + (size_t)(t + 2) * kstep; const char* b2 = last ? nB : cB + (size_t)(t + 2) * kstep;
            const char* a3 = a2 + kstep; const char* b3 = b2 + kstep;
            PG8_LDB(B0, 0, 0); PG8_LDB(B1, 0, 1); PG8_SCHED; PG8_LDA(At, 0, 0); PG8_STAGE(PG8_SA(1, 1), a1 + hstepA, voffA);
            PG8_WAIT_V(8); PG8_WAIT_L(0); PG8_BAR; PG8_MMA(0, 0, At, B0); PG8_MMA(0, 1, At, B1); PG8_BAR; PG8_SCHED;
            PG8_LDA(At, 0, 1); PG8_STAGE(PG8_SB(0, 0), b2, voffB); PG8_STAGE(PG8_SB(0, 1), b2 + hstepB, voffB); PG8_STAGE(PG8_SA(0, 0), a2, voffA);
            PG8_WAIT_V(8); PG8_WAIT_L(0); PG8_BAR; PG8_MMA(1, 0, At, B0); PG8_MMA(1, 1, At, B1); PG8_BAR; PG8_SCHED;
            PG8_LDB(B0, 1, 0); PG8_LDB(B1, 1, 1); PG8_SCHED; PG8_LDA(At, 1, 0); PG8_STAGE(PG8_SA(0, 1), a2 + hstepA, voffA);
            PG8_WAIT_V(8); PG8_WAIT_L(0); PG8_BAR; PG8_MMA(0, 0, At, B0); PG8_MMA(0, 1, At, B1); PG8_BAR; PG8_SCHED;
            PG8_LDA(At, 1, 1); PG8_STAGE(PG8_SB(1, 0), b3, voffB); PG8_STAGE(PG8_SB(1, 1), b3 + hstepB, voffB); PG8_STAGE(PG8_SA(1, 0), a3, voffA);
            PG8_WAIT_V(8); PG8_WAIT_L(0); PG8_BAR; PG8_MMA(1, 0, At, B0); PG8_MMA(1, 1, At, B1); PG8_BAR; PG8_SCHED;
        }
        if constexpr (ALIGN_EPI) { if (wr == 0) PG8_BAR; }
        if constexpr (!Epi::AFTER_DRAIN) { const int l2 = lane_id_opaque(); E(acc, cur, wr, wc, l2 & 15, l2 >> 4); }
        if (!has_next) break;
#pragma unroll
        for (int a = 0; a < 2; ++a)
#pragma unroll
            for (int b = 0; b < 2; ++b)
#pragma unroll
                for (int m = 0; m < 4; ++m)
#pragma unroll
                    for (int n = 0; n < 2; ++n) acc[a][b][m][n] = (f32x4){0.f, 0.f, 0.f, 0.f};
        cur = nxt; cA = nA; cB = nB; ++ui;
        if constexpr (ALIGN_EPI) { if (wr == 1) PG8_BAR; }
    }
    PG8_WAIT_V(0);
    if constexpr (!ALIGN_EPI) { if (wr == 0) PG8_BAR; }
    PG8_BAR;
    if constexpr (Epi::AFTER_DRAIN) { const int l2 = lane_id_opaque(); E.fused(acc, cur, wr, wc, l2 & 15, l2 >> 4, lds, wid, l2); }
#undef PG8_SA
#undef PG8_SB
#undef PG8_STAGE
#undef PG8_LDA
#undef PG8_LDB
#undef PG8_MMA
#undef PG8_WAIT_V
#undef PG8_WAIT_L
#undef PG8_BAR
#undef PG8_SCHED
}
}

constexpr int NWAVES = 8, NTHREADS = 512;
constexpr size_t MiB = 1u << 20;
constexpr size_t WS_CTL = 0, CTL_ZERO_BYTES = 256 * 1024;
constexpr size_t WS_WPOOL = 1 * MiB;
constexpr size_t WS_WQ = 2 * MiB;
constexpr size_t WS_WO = 6 * MiB;
constexpr size_t WS_WKV = 10 * MiB;
constexpr size_t WS_WUP = 18 * MiB;
constexpr size_t WS_WDN = 34 * MiB;
constexpr size_t WS_WIN = 50 * MiB;
constexpr size_t WS_WOUT = 56 * MiB;
constexpr size_t WS_MN = 58 * MiB;
constexpr size_t WS_KB = 66 * MiB;
constexpr size_t WS_VT = 74 * MiB;
constexpr size_t WS_SSQ = 82 * MiB;
constexpr size_t WS_SMALL = 84 * MiB;
constexpr size_t WS_X = 96 * MiB;
constexpr size_t WS_XG = 160 * MiB;
constexpr size_t WS_P0 = 192 * MiB;
constexpr size_t WS_O = 224 * MiB;
constexpr size_t WS_CH = 256 * MiB;
constexpr size_t WS_PS = 288 * MiB;
constexpr size_t WS_H = 320 * MiB;
constexpr size_t WS_WQN = 448 * MiB;
constexpr size_t WS_MT = 452 * MiB;
constexpr size_t WS_VW = 484 * MiB;
constexpr size_t WS_END = 516 * MiB;
constexpr size_t SS_X = WS_SMALL;
constexpr size_t SS_XG = SS_X + 512 * 1024;
constexpr size_t SS_SSQ = SS_XG + 256 * 1024;
constexpr size_t SS_P0 = SS_SSQ + 32 * 1024;
constexpr size_t SS_O = SS_P0 + 256 * 1024;
constexpr size_t SS_CH = SS_O + 256 * 1024;
constexpr size_t SS_H = SS_CH + 512 * 1024;
constexpr size_t SS_Q = SS_H + 1024 * 1024;
static_assert(SS_Q + 512 * 1024 <= WS_X, "sample buffers");
constexpr int CW_BAR = 4096, CW_BAR_STRIDE = 4096;

constexpr int RING_OFF = 0, RING_BYTES = 131072;
constexpr int LDSCTL_OFF = RING_BYTES, MISC_OFF = LDSCTL_OFF + 320;
constexpr int RSD_OFF = RING_BYTES + 1024;
constexpr int LDS_BYTES = 147456;

#define GAS __attribute__((address_space(1)))
#define LAS __attribute__((address_space(3)))
typedef unsigned short bf16;
typedef unsigned v4u __attribute__((ext_vector_type(4)));
typedef unsigned v2u __attribute__((ext_vector_type(2)));
typedef float f32x4 __attribute__((ext_vector_type(4)));
typedef short bf16x8 __attribute__((ext_vector_type(8)));
#define LDS_WAIT() asm volatile("s_waitcnt lgkmcnt(0)" ::: "memory")
#define VM_WAIT() asm volatile("s_waitcnt vmcnt(0)" ::: "memory")
__device__ __forceinline__ unsigned f2bf(float f) { unsigned u = __builtin_bit_cast(unsigned, f); return (u + 0x7fffu + ((u >> 16) & 1u)) >> 16; }
__device__ __forceinline__ unsigned pk2(float lo, float hi) { return f2bf(lo) | (f2bf(hi) << 16); }
__device__ __forceinline__ float bf2f(unsigned short h) { return __builtin_bit_cast(float, (unsigned)h << 16); }
__device__ __forceinline__ float bflo(unsigned w) { return __builtin_bit_cast(float, w << 16); }
__device__ __forceinline__ float bfhi(unsigned w) { return __builtin_bit_cast(float, w & 0xffff0000u); }

#define XB_TMO      128
#define XB_XCNT(j)  (256  + 64 * (j))
#define XB_XSUB(j)  (1280 + 64 * (j))
#define XB_XGEN(j)  (2304 + 64 * (j))
#define XB_TOP      3328
#define XB_TOPGEN   3392
#define XCD_BAR_WORDS 3456
#define XB_SPIN_CAP (1u << 18)
__device__ __forceinline__ unsigned xb_ld(unsigned* p)              { return __hip_atomic_load(p, __ATOMIC_RELAXED, __HIP_MEMORY_SCOPE_AGENT); }
__device__ __forceinline__ unsigned xb_add(unsigned* p, unsigned v) { return __hip_atomic_fetch_add(p, v, __ATOMIC_RELAXED, __HIP_MEMORY_SCOPE_AGENT); }
__device__ __forceinline__ unsigned xb_xcc_id() { return (unsigned)__builtin_amdgcn_s_getreg((3 << 11) | 20) & 0xFu; }
#define XB_SPIN(cond, bar) do { unsigned _sp = 0; while (cond) { __builtin_amdgcn_s_sleep(1); \
    if ((++_sp & 255u) == 0u) { if (xb_ld(&(bar)[XB_TMO])) break; if (_sp > XB_SPIN_CAP) { atomicAdd(&(bar)[XB_TMO], 1u); break; } } } } while (0)
struct XcdBarrier { unsigned* bar; unsigned x; volatile LAS unsigned* st; unsigned gsize; };
__device__ __forceinline__ XcdBarrier xcd_barrier_post(unsigned* bar, volatile LAS unsigned* st, unsigned gsize) {
    XcdBarrier b; b.bar = bar; b.x = xb_xcc_id(); b.st = st; b.gsize = gsize;
    if (threadIdx.x == 0) (void)xb_add(&bar[XB_XCNT(b.x)], 1u);
    return b;
}
__device__ __forceinline__ void xcd_barrier_complete(unsigned* bar, unsigned x, unsigned G, unsigned& nloc, unsigned& nx) {
    unsigned sum, cnt, mine, sp = 0u;
    for (;;) {
        sum = 0u; cnt = 0u; mine = 0u;
#pragma unroll
        for (unsigned j = 0; j < 16; ++j) { const unsigned c = xb_ld(&bar[XB_XCNT(j)]); sum += c; cnt += (c > 0u) ? 1u : 0u; mine = (j == x) ? c : mine; }
        if (sum == G) break;
        __builtin_amdgcn_s_sleep(1);
        if ((++sp & 255u) == 0u) { if (xb_ld(&bar[XB_TMO])) break; if (sp > XB_SPIN_CAP) { atomicAdd(&bar[XB_TMO], 1u); break; } }
    }
    nloc = mine > 0u ? mine : 1u; nx = cnt > 0u ? cnt : 1u;
}
__device__ __forceinline__ void xcd_barrier(const XcdBarrier& b, const int tid) {
    asm volatile("s_waitcnt vmcnt(0)" ::: "memory");
    __syncthreads();
    if (tid == 0) {
        unsigned* bar = b.bar; asm volatile("" : "+s"(bar));
        __builtin_amdgcn_s_waitcnt(0);
        unsigned nloc = b.st[0], nx = b.st[1];
        if (nloc == 0u) { xcd_barrier_complete(bar, b.x, b.gsize, nloc, nx); b.st[0] = nloc; b.st[1] = nx; }
        const unsigned old = xb_add(&bar[XB_XSUB(b.x)], 1u);
        const unsigned gen = old / nloc;
        if (old + 1u == (gen + 1u) * nloc) {
            if (nx > 1u) {
                __builtin_amdgcn_fence(__ATOMIC_RELEASE, "agent");
                asm volatile("s_waitcnt vmcnt(0)" ::: "memory");
                const unsigned og = xb_add(&bar[XB_TOP], 1u);
                const unsigned tg = og / nx;
                if (og + 1u == (tg + 1u) * nx) xb_add(&bar[XB_TOPGEN], 1u);
                else XB_SPIN(xb_ld(&bar[XB_TOPGEN]) == tg, bar);
            }
            xb_add(&bar[XB_XGEN(b.x)], 1u);
            __builtin_amdgcn_fence(__ATOMIC_ACQUIRE, "agent");
            asm volatile("s_waitcnt vmcnt(0)" ::: "memory");
        } else {
            XB_SPIN(xb_ld(&bar[XB_XGEN(b.x)]) == gen, bar);
            __builtin_amdgcn_fence(__ATOMIC_ACQUIRE, "agent");
            asm volatile("s_waitcnt vmcnt(0)" ::: "memory");
        }
    }
    __syncthreads();
}

__device__ __forceinline__ int opq_v(int x) { asm volatile("" : "+v"(x)); return x; }
struct Args { const float* in[22]; float* out; unsigned char* ws; int ph_lo, ph_hi; };


__device__ __forceinline__ void p0_transpose_item(const float* W, int K, int N, bf16* WT, int k0, int n0, int drow0, LAS float* scr, int lane, const float* gk = nullptr) {
    float v[32];
#pragma unroll
    for (int i = 0; i < 32; ++i) { const int kk = 2 * i + (lane >> 5); v[i] = __builtin_nontemporal_load(W + (size_t)(k0 + kk) * N + n0 + (lane & 31)); }
    if (gk) {
#pragma unroll
        for (int i = 0; i < 32; ++i) v[i] *= gk[k0 + 2 * i + (lane >> 5)]; }
#pragma unroll
    for (int i = 0; i < 32; ++i) scr[(2 * i + (lane >> 5)) * 33 + (lane & 31)] = v[i];
    LDS_WAIT(); asm volatile("" ::: "memory");
    const int c = lane & 7;
#pragma unroll
    for (int j = 0; j < 4; ++j) { const int n = (lane >> 3) + 8 * j; const LAS float* s = scr + (8 * c) * 33 + n;
        v4u o; o.x = pg8::cvt_pk_bf16(s[0 * 33], s[1 * 33]); o.y = pg8::cvt_pk_bf16(s[2 * 33], s[3 * 33]); o.z = pg8::cvt_pk_bf16(s[4 * 33], s[5 * 33]); o.w = pg8::cvt_pk_bf16(s[6 * 33], s[7 * 33]);
        *(GAS v4u*)(WT + (size_t)(drow0 + n) * K + k0 + 8 * c) = o; }
    LDS_WAIT(); asm volatile("" ::: "memory");
}
__device__ __forceinline__ int win_dest_row(int n) {
    if (n < 1024) return n;
    if (n < 2048) { const int ch = n - 1024; return 1024 + (ch >> 7) * 256 + (ch & 127); }
    const int ch = n - 2048; return 1024 + (ch >> 7) * 256 + 128 + (ch & 127);
}

template <int W>
__device__ __forceinline__ void pool_wave(const float* xb  , const LAS float* rs, f32x4 g4, int tA, bf16* pout  , float* poolout  ) {
    f32x4 xv[15 + W];
#pragma unroll
    for (int i = 16 - W; i < 31; ++i) { const int t = tA - 15 + i; xv[i - (16 - W)] = *(const f32x4*)(xb + (size_t)(t >= 0 ? t : 0) * D); }
    f32x4 ring[16]; f32x4 S = {0.f, 0.f, 0.f, 0.f};
#pragma unroll
    for (int i = 16 - W; i < 31; ++i) {
        const int t = tA - 15 + i;
        f32x4 u = {0.f, 0.f, 0.f, 0.f};
        if (t >= 0) u = xv[i - (16 - W)] * rs[i] * g4;
        S += u; if (i - W >= 16 - W) S -= ring[(i - W) & 15];
        ring[i & 15] = u;
        if (i >= 15) {
            const int cnt = (t + 1 < W) ? (t + 1) : W; const float ic = 1.0f / (float)cnt;
            const f32x4 p = S * ic - u; v2u o; o.x = pk2(p[0], p[1]); o.y = pk2(p[2], p[3]);
            *(v2u*)(pout + (size_t)t * D) = o;
            if (t >= SEQ - 15) *(f32x4*)(poolout + (size_t)(t - (SEQ - 15)) * D) = u;
        }
    }
}

template <int RT, int CT, int GR, int KS, class F>
__device__ __forceinline__ void sgemm2(const bf16* A, int lda, int row0, const bf16* Bt, int ldb, const int (&brow)[CT], int K, LAS unsigned char* red, int wave, int lane, const F& f) {
    const int fr = lane & 15, fq = lane >> 4, kw = K >> 3;
    const bf16* ap = A + (size_t)(row0 + fr) * lda + wave * kw + fq * 8;
    const bf16* bp[CT];
#pragma unroll
    for (int ct = 0; ct < CT; ++ct) bp[ct] = Bt + (size_t)(brow[ct] + fr) * ldb + wave * kw + fq * 8;
    f32x4 acc[RT][CT];
#pragma unroll
    for (int rt = 0; rt < RT; ++rt)
#pragma unroll
        for (int ct = 0; ct < CT; ++ct) acc[rt][ct] = (f32x4){0.f, 0.f, 0.f, 0.f};
#pragma unroll 1
    for (int k0 = 0; k0 < kw; k0 += 32 * KS) {
        bf16x8 a[KS][RT], b[KS][CT];
#pragma unroll
        for (int ks = 0; ks < KS; ++ks) {
#pragma unroll
            for (int rt = 0; rt < RT; ++rt) a[ks][rt] = *(const bf16x8*)(ap + (size_t)rt * 16 * lda + k0 + 32 * ks);
#pragma unroll
            for (int ct = 0; ct < CT; ++ct) b[ks][ct] = *(const bf16x8*)(bp[ct] + k0 + 32 * ks); }
#pragma unroll
        for (int ks = 0; ks < KS; ++ks)
#pragma unroll
            for (int rt = 0; rt < RT; ++rt)
#pragma unroll
                for (int ct = 0; ct < CT; ++ct) acc[rt][ct] = __builtin_amdgcn_mfma_f32_16x16x32_bf16(b[ks][ct], a[ks][rt], acc[rt][ct], 0, 0, 0);
    }
#pragma unroll
    for (int rt = 0; rt < RT; ++rt)
#pragma unroll
        for (int ct = 0; ct < CT; ++ct) *(LAS f32x4*)(red + ((((wave * RT + rt) * CT + ct) * 64 + lane) << 4)) = acc[rt][ct];
    LDS_WAIT(); __syncthreads();
    constexpr int NCG = CT / GR, NTASK = RT * NCG;
    for (int t = wave; t < NTASK; t += 8) {
        const int rt = t / NCG, cg = t % NCG;
        f32x4 sacc[GR];
#pragma unroll
        for (int g = 0; g < GR; ++g) { f32x4 tt = {0.f, 0.f, 0.f, 0.f};
#pragma unroll
            for (int w = 0; w < 8; ++w) tt += *(const LAS f32x4*)(red + ((((w * RT + rt) * CT + cg * GR + g) * 64 + lane) << 4));
            sacc[g] = tt; }
        f(sacc, row0 + 16 * rt + fr, cg * GR, fq);
    }
    __syncthreads();
}
__device__ __forceinline__ float srstd(const float* ssq, int row, int fq) {
    const f32x4* sp = (const f32x4*)(ssq + row * 64 + fq * 16); const f32x4 s = (sp[0] + sp[1]) + (sp[2] + sp[3]); float t = (s[0] + s[1]) + (s[2] + s[3]);
    t = add_x16_x32(t);
    return __builtin_amdgcn_rsqf(t * (1.0f / D) + EPS);
}
template <int KS> __device__ __forceinline__ void s_res_unit(const bf16* A, int lda, const bf16* Bt, int ldb, int K, int cp, int row0, const float* base32, bf16* xs16, float* ssq, const float* cscale, LAS unsigned char* red, int wave, int lane) {
    const int brow[2] = {32 * cp, 32 * cp + 16};
    const int myct = wave & 1, prow = row0 + (lane & 15), pc0 = 16 * (2 * cp + myct) + 4 * (lane >> 4); const size_t poff = (size_t)prow * D + pc0;
    f32x4 cs = {1.f, 1.f, 1.f, 1.f}; if (cscale) cs = *(const f32x4*)(cscale + pc0);
    f32x4 bpre; if (base32) bpre = *(const f32x4*)(base32 + poff); else { const v2u w = *(const v2u*)(xs16 + poff); bpre = (f32x4){bflo(w.x), bfhi(w.x), bflo(w.y), bfhi(w.y)}; }
    sgemm2<1, 2, 1, KS>(A, lda, row0, Bt, ldb, brow, K, red, wave, lane, [&](f32x4 (&a)[1], int row, int ct0, int fq) {
        const int ctile = 2 * cp + ct0, c0 = 16 * ctile + 4 * fq; const size_t off = (size_t)row * D + c0;
        const f32x4 v = bpre + a[0] * cs;
        float ss = (v[0] * v[0] + v[1] * v[1]) + (v[2] * v[2] + v[3] * v[3]);
        ss = add_x16_x32(ss);
        if (fq == 0) ssq[row * 64 + ctile] = ss;
        v2u p; p.x = pk2(v[0], v[1]); p.y = pk2(v[2], v[3]); *(v2u*)(xs16 + off) = p; });
}
__device__ __forceinline__ void s_q_unit(const bf16* xs16, const bf16* wq, int cp, int row0, const float* ssq, float* qs, LAS unsigned char* red, int wave, int lane) {
    const int brow[2] = {32 * cp, 32 * cp + 16};
    const float rs = srstd(ssq, row0 + (lane & 15), lane >> 4) * QSCALE;
    sgemm2<1, 2, 1, 4>(xs16, D, row0, wq, D, brow, D, red, wave, lane, [&](f32x4 (&a)[1], int row, int ct0, int fq) {
        *(f32x4*)(qs + (size_t)row * D + 32 * cp + 16 * ct0 + 4 * fq) = a[0] * rs; });
}
__device__ __forceinline__ f32x4 relu2(f32x4 v) {
#pragma unroll
    for (int j = 0; j < 4; ++j) { const float a = fmaxf(v[j], 0.f); v[j] = a * a; }
    return v;
}

__device__ __forceinline__ void rstd_table(const float* ssq, int pm, LAS float* rsd, int tid) {
    if (tid < 256) { const f32x4* sp = (const f32x4*)(ssq + (size_t)(pm * 256 + tid) * 16); const f32x4 q = (sp[0] + sp[1]) + (sp[2] + sp[3]);
        rsd[tid] = __builtin_amdgcn_rsqf(((q[0] + q[1]) + (q[2] + q[3])) * (1.0f / D) + EPS); }
}
__device__ __forceinline__ void treduce32(float (&p)[32], int lane) {
#pragma unroll
    for (int i = 0; i < 16; ++i) { swap32(p[i], p[i + 16]); p[i] += p[i + 16]; }
    { const bool b4 = (lane & 16) != 0;
#pragma unroll
      for (int i = 0; i < 8; ++i) { const float keep = b4 ? p[i + 8] : p[i], send = b4 ? p[i] : p[i + 8]; p[i] = keep + SWZ_XOR(send, 16); } }
    { const bool b3 = (lane & 8) != 0;
#pragma unroll
      for (int i = 0; i < 4; ++i) { const float keep = b3 ? p[i + 4] : p[i], send = b3 ? p[i] : p[i + 4]; p[i] = keep + SWZ_XOR(send, 8); } }
    { const bool b2 = (lane & 4) != 0;
#pragma unroll
      for (int i = 0; i < 2; ++i) { const float keep = b2 ? p[i + 2] : p[i], send = b2 ? p[i] : p[i + 2]; p[i] = keep + SWZ_XOR(send, 4); } }
    { const bool b1 = (lane & 2) != 0; const float keep = b1 ? p[1] : p[0], send = b1 ? p[0] : p[1]; p[0] = keep + SWZ_XOR(send, 2); }
    p[0] += SWZ_XOR(p[0], 1);
}
__device__ __forceinline__ void unpack16(const v4u a, const v4u b, float (&x)[16]) {
    x[0] = bflo(a.x); x[1] = bfhi(a.x); x[2] = bflo(a.y); x[3] = bfhi(a.y); x[4] = bflo(a.z); x[5] = bfhi(a.z); x[6] = bflo(a.w); x[7] = bfhi(a.w);
    x[8] = bflo(b.x); x[9] = bfhi(b.x); x[10] = bflo(b.y); x[11] = bfhi(b.y); x[12] = bflo(b.z); x[13] = bfhi(b.z); x[14] = bflo(b.w); x[15] = bfhi(b.w);
}

constexpr int NPHASES = 15;
__global__ void __launch_bounds__(NTHREADS, 2) mk_fwd(Args args) {
    extern __shared__ __attribute__((aligned(16))) unsigned char lds[];
    LAS unsigned char* L = (LAS unsigned char*)lds;
    volatile LAS unsigned* MISC = (volatile LAS unsigned*)(L + MISC_OFF);
    const int wave0 = __builtin_amdgcn_readfirstlane((int)threadIdx.x >> 6);
    const int G = gridDim.x; const int bx = blockIdx.x; const int vcu = (G % 8 == 0) ? (bx % 8) * (G / 8) + bx / 8 : bx;
    const int grp = bx & 7, mi = bx >> 3, GS = (G - grp + 7) >> 3;
    for (int u = threadIdx.x; u < (LDS_BYTES - LDSCTL_OFF) / 4; u += NTHREADS) ((LAS unsigned*)(L + LDSCTL_OFF))[u] = 0u;
    __syncthreads();
#if MK_PER_PHASE
#define GRID_BAR() do { } while (0)
#define GROUP_BAR() do { } while (0)
#else
    XcdBarrier bar = xcd_barrier_post((unsigned*)(args.ws + WS_CTL) + CW_BAR, MISC + 8, (unsigned)G);
    XcdBarrier gbar = xcd_barrier_post((unsigned*)(args.ws + WS_CTL) + CW_BAR + (1 + grp) * CW_BAR_STRIDE, MISC + 10, (unsigned)GS);
#define GRID_BAR() xcd_barrier(bar, wave0 * 64 + lane_id_opaque())
#define GROUP_BAR() xcd_barrier(gbar, wave0 * 64 + lane_id_opaque())
#endif
    const int lo = args.ph_lo, hi = args.ph_hi;
#define IN(k) (st == (k))
#define SEAM(k) do { } while (0)
    const int NGW = G * NWAVES;
#define TID_NOW (wave0 * 64 + lane_id_opaque())
#define RELANE const int tid = wave0 * 64 + lane_id_opaque(), lane = tid & 63; (void)tid; (void)lane;
#define KA_PTR(T, off) (*(T const __attribute__((address_space(4)))*)(ka + (off)))
#define PH_BEGIN const int tid = wave0 * 64 + lane_id_opaque(), lane = tid & 63, wave = wave0, gw = vcu * NWAVES + wave; (void)lane; (void)gw; \
    const __attribute__((address_space(4))) char* ka = (const __attribute__((address_space(4))) char*)__builtin_amdgcn_kernarg_segment_ptr(); asm volatile("" : "+s"(ka)); \
    unsigned char* const ws = KA_PTR(unsigned char*, 184); float* const out = KA_PTR(float*, 176); (void)ws; (void)out; \
    const float* const x_prompt = KA_PTR(const float*, 0); const float* const x_sample = KA_PTR(const float*, 8); const float* const state_pool = KA_PTR(const float*, 16); const float* const state_conv = KA_PTR(const float*, 24); \
    const float* const cache_k = KA_PTR(const float*, 32); const float* const cache_v = KA_PTR(const float*, 40); const float* const mem_prompt = KA_PTR(const float*, 48); \
    const float* const g_mix = KA_PTR(const float*, 56); const float* const g_attn = KA_PTR(const float*, 64); const float* const g_mem = KA_PTR(const float*, 72); const float* const g_ffn = KA_PTR(const float*, 80); const float* const g_final = KA_PTR(const float*, 88); \
    const float* const w_pool = KA_PTR(const float*, 96); const float* const pool_scale = KA_PTR(const float*, 104); const float* const w_conv_in = KA_PTR(const float*, 112); const float* const w_conv = KA_PTR(const float*, 120); const float* const w_conv_out = KA_PTR(const float*, 128); \
    const float* const w_q = KA_PTR(const float*, 136); const float* const w_kv = KA_PTR(const float*, 144); const float* const w_o = KA_PTR(const float*, 152); const float* const w_up = KA_PTR(const float*, 160); const float* const w_down = KA_PTR(const float*, 168); \
    (void)x_prompt; (void)x_sample; (void)state_pool; (void)state_conv; (void)cache_k; (void)cache_v; (void)mem_prompt; (void)g_mix; (void)g_attn; (void)g_mem; (void)g_ffn; (void)g_final; (void)w_pool; (void)pool_scale; (void)w_conv_in; (void)w_conv; (void)w_conv_out; (void)w_q; (void)w_kv; (void)w_o; (void)w_up; (void)w_down; \
    bf16* const WPOOL = (bf16*)(ws + WS_WPOOL); bf16* const WQ = (bf16*)(ws + WS_WQ); bf16* const WO = (bf16*)(ws + WS_WO); bf16* const WKV = (bf16*)(ws + WS_WKV); \
    bf16* const WUP = (bf16*)(ws + WS_WUP); bf16* const WDN = (bf16*)(ws + WS_WDN); bf16* const WIN = (bf16*)(ws + WS_WIN); bf16* const WOUT = (bf16*)(ws + WS_WOUT); \
    bf16* const MN = (bf16*)(ws + WS_MN); bf16* const KB = (bf16*)(ws + WS_KB); bf16* const VT = (bf16*)(ws + WS_VT); float* const SSQ = (float*)(ws + WS_SSQ); \
    bf16* const X16 = (bf16*)(ws + WS_X); bf16* const P0 = (bf16*)(ws + WS_P0); bf16* const OB = (bf16*)(ws + WS_O); bf16* const CH = (bf16*)(ws + WS_CH); \
    bf16* const WQN = (bf16*)(ws + WS_WQN); bf16* const MT = (bf16*)(ws + WS_MT); bf16* const VW = (bf16*)(ws + WS_VW); bf16* const HB = (bf16*)(ws + WS_H); \
    bf16* const XS16 = (bf16*)(ws + SS_X); float* const SSQS = (float*)(ws + SS_SSQ); bf16* const P0S = (bf16*)(ws + SS_P0); bf16* const OS = (bf16*)(ws + SS_O); \
    float* const CHS = (float*)(ws + SS_CH); bf16* const HS = (bf16*)(ws + SS_H); float* const QS = (float*)(ws + SS_Q); \
    (void)WPOOL; (void)WQ; (void)WO; (void)WKV; (void)WUP; (void)WDN; (void)WIN; (void)WOUT; (void)MN; (void)KB; (void)VT; (void)SSQ; (void)X16; (void)P0; (void)OB; (void)CH; (void)WQN; (void)MT; (void)VW; (void)HB; (void)XS16; (void)SSQS; (void)P0S; (void)OS; (void)CHS; (void)HS; (void)QS;

#if MK_PER_PHASE
    const int soff = 0; const bool sfirst = false;
#else
    const int soff = SAMPLE_SHIFT ? (grp & 1) : 0;
    const bool sfirst = false;
#endif
    const int mflip = (MEMBER_FLIP && !MK_PER_PHASE) ? (MEMBER_FLIP_SEL) : 0;
#pragma unroll 1
    for (int ph = lo; ph < hi + soff; ++ph) {
#pragma unroll 1
    for (int pp = 0; pp < 2; ++pp) {
    const int which = pp ^ mflip;
    const int st = which ? ph - soff : ph;
    const bool doP = (which == 0), doS = (which == 1) || (st == 0);
    if (st < 0 || st >= NPHASES || (which == 1 && st == 0)) continue;
    if (IN(0)) { PH_BEGIN
        LAS float* scr = (LAS float*)(L + RING_OFF + wave * 16384);
        {
            constexpr int I_POOL = 4 * 4 * 8, I_Q = 16 * 32, I_KV = 16 * 64, I_UP = 16 * 128, I_DN = 64 * 32, I_IN = 16 * 96;
            constexpr int NITEMS = I_POOL + 2 * (I_Q + I_KV + I_Q + I_UP + I_DN) + I_IN + I_Q;
            for (int it = gw; it < NITEMS; it += NGW) {
                int r = it;
                if (r < I_POOL) { const int g = r >> 5, rr = r & 31, kb = rr >> 3, nb = rr & 7; p0_transpose_item(w_pool + g * 65536, 256, 256, WPOOL + g * 65536, 64 * kb, 32 * nb, 32 * nb, scr, lane); continue; } r -= I_POOL;
                bool done = false;
#pragma unroll 1
                for (int l = 0; l < 2 && !done; ++l) {
                    if (r < I_Q) { const int kb = r >> 5, nb = r & 31; p0_transpose_item(w_q + (size_t)l * D * D, D, D, WQ + (size_t)l * D * D, 64 * kb, 32 * nb, 32 * nb, scr, lane, g_attn + l * D); done = true; break; } r -= I_Q;
                    if (r < I_KV) { const int kb = r >> 6, nb = r & 63; p0_transpose_item(w_kv + (size_t)l * D * 2048, D, 2048, WKV + (size_t)l * 2048 * D, 64 * kb, 32 * nb, 32 * nb, scr, lane); done = true; break; } r -= I_KV;
                    if (r < I_Q) { const int kb = r >> 5, nb = r & 31; p0_transpose_item(w_o + (size_t)l * D * D, D, D, WO + (size_t)l * D * D, 64 * kb, 32 * nb, 32 * nb, scr, lane); done = true; break; } r -= I_Q;
                    if (r < I_UP) { const int kb = r >> 7, nb = r & 127; p0_transpose_item(w_up + (size_t)l * D * FF, D, FF, WUP + (size_t)l * FF * D, 64 * kb, 32 * nb, 32 * nb, scr, lane, g_ffn + l * D); done = true; break; } r -= I_UP;
                    if (r < I_DN) { const int kb = r >> 5, nb = r & 31; p0_transpose_item(w_down + (size_t)l * FF * D, FF, D, WDN + (size_t)l * D * FF, 64 * kb, 32 * nb, 32 * nb, scr, lane); done = true; break; } r -= I_DN;
                }
                if (done) continue;
                if (r < I_IN) { const int kb = r / 96, nb = r % 96; p0_transpose_item(w_conv_in, D, 3072, WIN, 64 * kb, 32 * nb, win_dest_row(32 * nb), scr, lane, g_mix + D); continue; } r -= I_IN;
                { const int kb = r >> 5, nb = r & 31; p0_transpose_item(w_conv_out, D, D, WOUT, 64 * kb, 32 * nb, 32 * nb, scr, lane); }
            }
        }
        for (int m = gw; m < MEMROWS; m += NGW) {
            const f32x4* xr = (const f32x4*)(mem_prompt + (size_t)m * D) + lane; f32x4 v[4]; float s = 0.f;
#pragma unroll
            for (int j = 0; j < 4; ++j) { v[j] = __builtin_nontemporal_load(xr + 64 * j); s += (v[j][0] * v[j][0] + v[j][1] * v[j][1]) + (v[j][2] * v[j][2] + v[j][3] * v[j][3]); }
            const float rstd = __builtin_amdgcn_rsqf(wave_sum(s) * (1.f / D) + EPS);
#pragma unroll
            for (int l = 0; l < 2; ++l) { v2u* o8 = (v2u*)(MN + ((size_t)l * MEMROWS + m) * D) + lane;
#pragma unroll
                for (int j = 0; j < 4; ++j) { const f32x4 gg = *((const f32x4*)(g_mem + l * D) + lane + 64 * j); const f32x4 w = v[j] * rstd * gg; v2u o; o.x = pk2(w[0], w[1]); o.y = pk2(w[2], w[3]); o8[64 * j] = o; } }
        }
        for (int m = gw; m < 2 * D; m += NGW) {
            const float gk = g_attn[m]; const f32x4* xr = (const f32x4*)(w_q + (size_t)m * D) + lane; v2u* o8 = (v2u*)(WQN + (size_t)m * D) + lane;
            f32x4 v[4];
#pragma unroll
            for (int j = 0; j < 4; ++j) v[j] = __builtin_nontemporal_load(xr + 64 * j);
#pragma unroll
            for (int j = 0; j < 4; ++j) { const f32x4 w = v[j] * gk; v2u o; o.x = pk2(w[0], w[1]); o.y = pk2(w[2], w[3]); o8[64 * j] = o; }
        }
        for (int it = gw; it < MS * 4; it += NGW) {
            const int b = it >> 2, g = it & 3, c4 = g * 256 + lane * 4;
            const f32x4* xr = (const f32x4*)(x_sample + (size_t)b * D) + lane; float s = 0.f;
#pragma unroll
            for (int j = 0; j < 4; ++j) { const f32x4 v = xr[64 * j]; s += (v[0] * v[0] + v[1] * v[1]) + (v[2] * v[2] + v[3] * v[3]); }
            const float rstd = __builtin_amdgcn_rsqf(wave_sum(s) * (1.f / D) + EPS);
            const f32x4 u = *(const f32x4*)(x_sample + (size_t)b * D + c4) * rstd * *(const f32x4*)(g_mix + c4);
            const int W = 2 << g; f32x4 S = u;
            const float* sp = state_pool + (size_t)b * 15 * D + c4;
            float* po = out + OPS + (size_t)b * 15 * D + c4;
            f32x4 sv[15];
#pragma unroll
            for (int r = 0; r < 15; ++r) sv[r] = __builtin_nontemporal_load((const f32x4*)(sp + (size_t)r * D));
#pragma unroll
            for (int r = 0; r < 15; ++r) { if (r >= 16 - W) S += sv[r]; if (r >= 1) *(f32x4*)(po + (size_t)(r - 1) * D) = sv[r]; }
            *(f32x4*)(po + (size_t)14 * D) = u;
            const f32x4 p = S * (1.0f / (float)W) - u; v2u o; o.x = pk2(p[0], p[1]); o.y = pk2(p[2], p[3]); *(v2u*)(P0S + (size_t)b * D + c4) = o;
        }
        __syncthreads();
        {
            LAS float* rs = (LAS float*)(L + RING_OFF);
            for (int it = vcu; it < BATCH * (SEQ / 32); it += G) {
                const int b = it >> 6, t0 = (it & 63) * 32;
                { f32x4 xv[6][4];
#pragma unroll
                  for (int j = 0; j < 6; ++j) { const int r = wave + 8 * j, t = t0 - 15 + r; const bool ok = (r < 47) && (t >= 0);
                      const f32x4* xr = (const f32x4*)(x_prompt + ((size_t)b * SEQ + (ok ? t : t0)) * D) + lane;
#pragma unroll
                      for (int q = 0; q < 4; ++q) xv[j][q] = xr[64 * q]; }
#pragma unroll
                  for (int j = 0; j < 6; ++j) { const int r = wave + 8 * j, t = t0 - 15 + r; float s = 0.f;
#pragma unroll
                      for (int q = 0; q < 4; ++q) { const f32x4 v = xv[j][q]; s += (v[0] * v[0] + v[1] * v[1]) + (v[2] * v[2] + v[3] * v[3]); }
                      const float rv = (t >= 0) ? __builtin_amdgcn_rsqf(wave_sum(s) * (1.f / D) + EPS) : 0.f;
                      if (lane == 0 && r < 47) rs[r] = rv; } }
                LDS_WAIT(); __syncthreads();
                const int g = wave & 3, tA = t0 + (wave >> 2) * 16, c4 = g * 256 + lane * 4;
                const float* xb = x_prompt + (size_t)b * SEQ * D + c4; const f32x4 g4 = *(const f32x4*)(g_mix + c4);
                bf16* pout = P0 + (size_t)b * SEQ * D + c4; float* poolout = out + OPP + (size_t)b * 15 * D + c4;
                const LAS float* rsw = rs + (wave >> 2) * 16;
                if (g == 0) pool_wave<2>(xb, rsw, g4, tA, pout, poolout); else if (g == 1) pool_wave<4>(xb, rsw, g4, tA, pout, poolout);
                else if (g == 2) pool_wave<8>(xb, rsw, g4, tA, pout, poolout); else pool_wave<16>(xb, rsw, g4, tA, pout, poolout);
                __syncthreads();
            }
        }
    }
    SEAM(0);

    if (IN(1)) { PH_BEGIN
        if (doP) { pg8::Gemm g{D, D, D}; pg8::KvOrder S{GS == 32 ? 16 : GS, (GS == 32 && mi >= 16) ? (1 << 20) : mi, grp, (const char*)MN, (const char*)WKV};
          pg8::EpiKV E{out + OMK, out + OMV, KB, VT};
          pg8::gemm_phase<pg8::EpiKV, pg8::KvOrder, true>(L + RING_OFF, g, S, E, TID_NOW); }
        if (doP) { pg8::Gemm g{D, 256, 256}; pg8::StaticOrder S;
          if (GS == 32) S.init(8, 4, 16, mi >= 16 ? mi - 16 : 1 << 20, grp * 8, P0, (size_t)256 * D * 2, WPOOL, (size_t)65536 * 2, (size_t)256 * 2);
          else S.init(8, 4, GS, mi, grp * 8, P0, (size_t)256 * D * 2, WPOOL, (size_t)65536 * 2, (size_t)256 * 2);
          pg8::EpiRes<true> E{x_prompt, X16, SSQ, pool_scale};
          pg8::gemm_phase<pg8::EpiRes<true>, pg8::StaticOrder, true>(L + RING_OFF, g, S, E, TID_NOW); }
        if (doS) { RELANE for (int cp = mi; cp < 32; cp += GS) s_res_unit<1>(P0S + (cp >> 3) * 256, D, WPOOL, 256, 256, cp, 16 * grp, x_sample, XS16, SSQS, pool_scale, L + RING_OFF, wave, lane); }
    }
    SEAM(1);

    if (IN(2)) { PH_BEGIN
        if (doS) { RELANE for (int cp = mi; cp < 32; cp += GS) s_q_unit(XS16, WQ, cp, 16 * grp, SSQS, QS, L + RING_OFF, wave, lane); }
        if (doP) for (int idx = mi; idx < 64; idx += GS) {
            const int ly = idx >> 5, kind = (idx >> 4) & 1, a = (idx >> 2) & 3, q = idx & 3;
            const bf16* Ap; const bf16* Bp; bf16* Op; pg8::Unit u; float sc;
            if (kind == 0) {
                Ap = KB + ((size_t)ly * MEMROWS + grp * 256) * D + a * 256; Bp = WQN + ((size_t)ly * D + 256 * q) * D + a * 256;
                Op = MT + (size_t)((ly * BATCH + grp) * NH + a) * 256 * D; u = pg8::Unit{0, q}; sc = QSCALE;
            } else {
                Ap = WO + ((size_t)ly * D + 256 * a) * D + q * 256; Bp = VT + ((size_t)ly * MEMROWS + grp * 256) * D + q * 256;
                Op = VW + (size_t)(ly * BATCH + grp) * D * D; u = pg8::Unit{a, q}; sc = 1.f;
            }
            pg8::Gemm g{D, D, 256}; pg8::SingleOrder S{u, (const char*)Ap, (const char*)Bp};
            pg8::EpiBf16 E{Op, D, sc};
            pg8::gemm_phase<pg8::EpiBf16, pg8::SingleOrder, true>(L + RING_OFF, g, S, E, TID_NOW);
            __syncthreads();
        }
    }
    {
        const int l = (st >= 7) ? 1 : 0, pb = l ? 10 : 3;
        {
            if (IN(7)) { PH_BEGIN
                const LAS float* rsdp = nullptr;
                if (doP && (GS & 7) == 0) { LAS float* t_ = (LAS float*)(L + RSD_OFF); rstd_table(SSQ, grp * 8 + (mi & 7), t_, tid); LDS_WAIT(); __syncthreads(); rsdp = t_; }
                if (doP) { pg8::Gemm g{D, D, D}; pg8::StaticOrder S; S.init(8, 12, GS, mi, grp * 8, X16, (size_t)256 * D * 2, WIN, (size_t)256 * D * 2);
                  pg8::EpiRow<2> E{OB, D, SSQ, 1.f, CH, out + OCP, rsdp};
                  pg8::gemm_phase<pg8::EpiRow<2>, pg8::StaticOrder, true>(L + RING_OFF, g, S, E, TID_NOW); }
                if (doS) { RELANE
                for (int c2 = mi; c2 < 32; c2 += GS) {
                    const int ca = 32 * c2, cb = ca + 16; const int ra = 1024 + (ca >> 7) * 256 + (ca & 127), rb = 1024 + (cb >> 7) * 256 + (cb & 127);
                    const int brow[6] = {ca, ra, ra + 128, cb, rb, rb + 128};
                    const float rs = srstd(SSQS, 16 * grp + (lane & 15), lane >> 4);
                    const int prow = 16 * grp + (lane & 15), pc = ((wave & 1) ? cb : ca) + 4 * (lane >> 4);
                    const f32x4 s0 = *(const f32x4*)(state_conv + ((size_t)prow * 2 + 0) * D + pc), s1 = *(const f32x4*)(state_conv + ((size_t)prow * 2 + 1) * D + pc);
                    const f32x4 w0 = *(const f32x4*)(w_conv + pc), w1 = *(const f32x4*)(w_conv + D + pc), w2 = *(const f32x4*)(w_conv + 2 * D + pc);
                    sgemm2<1, 6, 3, 4>(XS16, D, 16 * grp, WIN, D, brow, D, L + RING_OFF, wave, lane, [&](f32x4 (&a)[3], int row, int ct0, int fq) {
                        const int c0 = (ct0 == 0 ? ca : cb) + 4 * fq;
                        const f32x4 gb = a[0] * rs, chv = a[1] * a[2] * (rs * rs);
                        const f32x4 cv = s0 * w0 + s1 * w1 + chv * w2;
                        const unsigned g01 = pk2(gb[0], gb[1]), g23 = pk2(gb[2], gb[3]);
                        v2u o; o.x = pk2(bflo(g01) * cv[0], bfhi(g01) * cv[1]); o.y = pk2(bflo(g23) * cv[2], bfhi(g23) * cv[3]);
                        *(v2u*)(P0S + (size_t)row * D + c0) = o;
                        *(f32x4*)(out + OCS + ((size_t)row * 2 + 0) * D + c0) = s1; *(f32x4*)(out + OCS + ((size_t)row * 2 + 1) * D + c0) = chv; }); }
                }
            }
            SEAM(7);
            if (IN(8)) { PH_BEGIN
                const int gt = mi * NTHREADS + tid, NT = GS * NTHREADS;
                if (doP) for (int idx0 = gt; idx0 < SEQ * 128; idx0 += 4 * NT) {
                    v4u gb[4], c2[4], c1[4], c0[4];
#pragma unroll
                    for (int q = 0; q < 4; ++q) { const int idx = idx0 + q * NT; const bool ok = idx < SEQ * 128; const int t = ok ? (idx >> 7) : 0, row = grp * SEQ + t, c8 = (idx & 127) * 8;
                        gb[q] = __builtin_nontemporal_load((const v4u*)(OB + (size_t)row * D + c8)); c2[q] = *(const v4u*)(CH + (size_t)row * D + c8);
                        c1[q] = *(const v4u*)(CH + (size_t)(row - (t >= 1 ? 1 : 0)) * D + c8); c0[q] = *(const v4u*)(CH + (size_t)(row - (t >= 2 ? 2 : 0)) * D + c8); }
#pragma unroll
                    for (int q = 0; q < 4; ++q) { const int idx = idx0 + q * NT; if (idx >= SEQ * 128) break; const int t = idx >> 7, row = grp * SEQ + t, c8 = (idx & 127) * 8;
                        if (t < 1) c1[q] = (v4u){0u, 0u, 0u, 0u};
                        if (t < 2) c0[q] = (v4u){0u, 0u, 0u, 0u};
                        const f32x4 w0a = *(const f32x4*)(w_conv + c8), w0b = *(const f32x4*)(w_conv + c8 + 4), w1a = *(const f32x4*)(w_conv + D + c8), w1b = *(const f32x4*)(w_conv + D + c8 + 4),
                                    w2a = *(const f32x4*)(w_conv + 2 * D + c8), w2b = *(const f32x4*)(w_conv + 2 * D + c8 + 4);
                        v4u o;
#pragma unroll
                        for (int j = 0; j < 4; ++j) { const float wl0 = (j < 2) ? w0a[2 * j] : w0b[2 * j - 4], wh0 = (j < 2) ? w0a[2 * j + 1] : w0b[2 * j - 3];
                            const float wl1 = (j < 2) ? w1a[2 * j] : w1b[2 * j - 4], wh1 = (j < 2) ? w1a[2 * j + 1] : w1b[2 * j - 3];
                            const float wl2 = (j < 2) ? w2a[2 * j] : w2b[2 * j - 4], wh2 = (j < 2) ? w2a[2 * j + 1] : w2b[2 * j - 3];
                            const float lo_ = bflo(gb[q][j]) * (bflo(c0[q][j]) * wl0 + bflo(c1[q][j]) * wl1 + bflo(c2[q][j]) * wl2);
                            const float hi_ = bfhi(gb[q][j]) * (bfhi(c0[q][j]) * wh0 + bfhi(c1[q][j]) * wh1 + bfhi(c2[q][j]) * wh2);
                            o[j] = pk2(lo_, hi_); }
                        *(v4u*)(P0 + (size_t)row * D + c8) = o; }
                }
                if (doS) { for (int cp = mi; cp < 32; cp += GS) s_res_unit<4>(P0S, D, WOUT, D, D, cp, 16 * grp, nullptr, XS16, SSQS, nullptr, L + RING_OFF, wave, lane); }
            }
            SEAM(8);
            if (IN(9)) { PH_BEGIN
                if (doP) { pg8::Gemm g{D, D, D}; pg8::StaticOrder S; S.init(8, 4, GS, mi, grp * 8, P0, (size_t)256 * D * 2, WOUT, (size_t)256 * D * 2);
                  pg8::EpiRes<false> E{nullptr, X16, SSQ, nullptr};
                  pg8::gemm_phase<pg8::EpiRes<false>, pg8::StaticOrder, true>(L + RING_OFF, g, S, E, TID_NOW); }
                if (doS) { RELANE for (int cp = mi; cp < 32; cp += GS) s_q_unit(XS16, WQ + (size_t)D * D, cp, 16 * grp, SSQS, QS, L + RING_OFF, wave, lane); }
            }
            SEAM(9);
        }
#define LAYER_W const bf16* WQl = WQ + (size_t)l * D * D; const bf16* WOl = WO + (size_t)l * D * D; const bf16* WUPl = WUP + (size_t)l * FF * D; const bf16* WDNl = WDN + (size_t)l * D * FF; (void)WQl; (void)WOl; (void)WUPl; (void)WDNl;
        if (IN(pb)) { PH_BEGIN LAYER_W
#pragma unroll 1
            for (int half = 0; half < 2; ++half) {
            const bool sampleHalf = ((half == 0) == sfirst);
            if (doP && !sampleHalf) for (int itl = mi; itl < 32; itl += GS) {
                const int pm = grp * 8 + (itl >> 2), h = itl & 3;
                pg8::Gemm g{D, D, D}; pg8::SingleOrder S{{pm, h}, (const char*)(X16 + (size_t)pm * 256 * D), (const char*)(MT + (size_t)((l * BATCH + grp) * NH + h) * 256 * D)};
                pg8::EpiSoftmax E{OB, D, SSQ};
                pg8::gemm_phase<pg8::EpiSoftmax, pg8::SingleOrder, false>(L + RING_OFF, g, S, E, TID_NOW);
                LDS_WAIT(); __builtin_amdgcn_s_barrier(); asm volatile("" ::: "memory");
            }
            if (doS && sampleHalf) { RELANE
                LAS float* sc = (LAS float*)(L + RING_OFF);
                LAS float* po = (LAS float*)(L + RING_OFF + 1024);
                for (int it0 = mi; it0 < 64; it0 += 2 * GS) {
                    const bool pair = (it0 + GS < 64);
#pragma unroll 1
                    for (int iu = 0; iu < 2; ++iu) {
                        if (iu == 1 && !pair) break;
                        const int it = it0 + iu * GS, b = 16 * grp + (it >> 2), h = it & 3;
                        const f32x4 q4 = *(const f32x4*)(QS + (size_t)b * D + h * 256 + lane * 4);
                        const float* kp = cache_k + (((size_t)l * MS + b) * NMEM + wave * 32) * D + h * 256 + lane * 4;
                        const float* vp = cache_v + (((size_t)l * MS + b) * NMEM + wave * 32) * D + h * 256 + lane * 4;
                        f32x4 kv[32]; float p[32];
#pragma unroll
                        for (int n = 0; n < 32; ++n) kv[n] = __builtin_nontemporal_load((const f32x4*)(kp + (size_t)n * D));
#pragma unroll
                        for (int n = 0; n < 32; ++n) { p[n] = (q4[0] * kv[n][0] + q4[1] * kv[n][1]) + (q4[2] * kv[n][2] + q4[3] * kv[n][3]); kv[n] = __builtin_nontemporal_load((const f32x4*)(vp + (size_t)n * D)); }
                        treduce32(p, lane);
                        if ((lane & 1) == 0) sc[wave * 32 + (lane >> 1)] = p[0];
                        LDS_WAIT(); __builtin_amdgcn_s_barrier(); asm volatile("" ::: "memory");
                        float mx, sm = 0.f; const f32x4 sv = *(const LAS f32x4*)(sc + lane * 4);
                        mx = fmaxf(fmaxf(sv[0], sv[1]), fmaxf(sv[2], sv[3]));
                        mx = wave_max(mx);
#pragma unroll
                        for (int j = 0; j < 4; ++j) sm += __builtin_amdgcn_exp2f(sv[j] - mx);
                        sm = wave_sum(sm);
                        f32x4 acc = {0.f, 0.f, 0.f, 0.f};
#pragma unroll
                        for (int n = 0; n < 32; ++n) { const float pn_ = __builtin_amdgcn_exp2f(sc[wave * 32 + n] - mx); acc += kv[n] * pn_; }
                        *(LAS f32x4*)(po + wave * 256 + lane * 4) = acc;
                        LDS_WAIT(); __builtin_amdgcn_s_barrier(); asm volatile("" ::: "memory");
                        if (tid < 256) { float o = 0.f;
#pragma unroll
                            for (int w = 0; w < 8; ++w) o += po[w * 256 + tid];
                            OS[(size_t)b * D + h * 256 + tid] = (bf16)f2bf(o / sm); }
                        LDS_WAIT(); __builtin_amdgcn_s_barrier(); asm volatile("" ::: "memory");
                    }
                }
            }
            }
        }
        SEAM(pb);
        if (IN(pb + 1)) { PH_BEGIN LAYER_W
            if (doP) { pg8::Gemm g{D, D, D}; pg8::StaticOrder S; S.init(8, 4, GS, mi, grp * 8, OB, (size_t)256 * D * 2, VW + (size_t)(l * BATCH + grp) * D * D, (size_t)256 * D * 2);
              pg8::EpiRes<false> E{nullptr, X16, SSQ, nullptr};
              pg8::gemm_phase<pg8::EpiRes<false>, pg8::StaticOrder, true>(L + RING_OFF, g, S, E, TID_NOW); }
            if (doS) { RELANE for (int cp = mi; cp < 32; cp += GS) s_res_unit<4>(OS, D, WOl, D, D, cp, 16 * grp, nullptr, XS16, SSQS, nullptr, L + RING_OFF, wave, lane); }
        }
        SEAM(pb + 2);
        if (IN(pb + 2)) { PH_BEGIN LAYER_W
            const LAS float* rsdp = nullptr;
            if (doP && (GS & 7) == 0) { LAS float* t_ = (LAS float*)(L + RSD_OFF); rstd_table(SSQ, grp * 8 + (mi & 7), t_, tid); LDS_WAIT(); __syncthreads(); rsdp = t_; }
            if (doP) { pg8::Gemm g{D, D, D}; pg8::StaticOrder S; S.init(8, 16, GS, mi, grp * 8, X16, (size_t)256 * D * 2, WUPl, (size_t)256 * D * 2);
              pg8::EpiRow<1> E{HB, FF, SSQ, 1.f, nullptr, nullptr, rsdp};
              pg8::gemm_phase<pg8::EpiRow<1>, pg8::StaticOrder, true>(L + RING_OFF, g, S, E, TID_NOW); }
            if (doS) { RELANE for (int c8 = mi; c8 < 32; c8 += GS) { const int brow[8] = {128 * c8, 128 * c8 + 16, 128 * c8 + 32, 128 * c8 + 48, 128 * c8 + 64, 128 * c8 + 80, 128 * c8 + 96, 128 * c8 + 112};
                const float rs = srstd(SSQS, 16 * grp + (lane & 15), lane >> 4);
                sgemm2<1, 8, 1, 4>(XS16, D, 16 * grp, WUPl, D, brow, D, L + RING_OFF, wave, lane, [&](f32x4 (&a)[1], int row, int ct0, int fq) {
                    const f32x4 v0 = relu2(a[0] * rs);
                    v2u p0; p0.x = pk2(v0[0], v0[1]); p0.y = pk2(v0[2], v0[3]);
                    *(v2u*)(HS + (size_t)row * FF + 128 * c8 + 16 * ct0 + 4 * fq) = p0; }); } }
        }
        SEAM(pb + 3);
        if (IN(pb + 3)) { PH_BEGIN LAYER_W
            if (doP) { pg8::Gemm g{FF, FF, FF}; pg8::StaticOrder S; S.init(8, 4, GS, mi, grp * 8, HB, (size_t)256 * FF * 2, WDNl, (size_t)256 * FF * 2);
              pg8::EpiRes<false> E{nullptr, X16, SSQ, nullptr};
              pg8::gemm_phase<pg8::EpiRes<false>, pg8::StaticOrder, true>(L + RING_OFF, g, S, E, TID_NOW); }
            if (doS) { RELANE for (int cp = mi; cp < 32; cp += GS) s_res_unit<8>(HS, FF, WDNl, FF, FF, cp, 16 * grp, nullptr, XS16, SSQS, nullptr, L + RING_OFF, wave, lane); }
        }
        SEAM(pb + 4);
    }
    if (IN(14)) { PH_BEGIN
        const int mlo = doP ? 0 : SEQ, mhi = doS ? SEQ + 16 : SEQ;
        for (int ml0 = mlo + mi * NWAVES + wave; ml0 < mhi; ml0 += 4 * GS * NWAVES) {
            float sv[4]; v4u xw[4][2];
#pragma unroll
            for (int q = 0; q < 4; ++q) { const int ml = ml0 + q * GS * NWAVES; const bool ok = ml < mhi; const int mlc = ok ? ml : ml0;
                const bf16* xr;
                if (mlc < SEQ) { const int m = grp * SEQ + mlc; sv[q] = (lane < 16) ? SSQ[(size_t)m * 16 + lane] : 0.f; xr = X16 + (size_t)m * D; }
                else { const int r = 16 * grp + (mlc - SEQ); sv[q] = SSQS[r * 64 + lane]; xr = XS16 + (size_t)r * D; }
                xw[q][0] = __builtin_nontemporal_load((const v4u*)xr + lane); xw[q][1] = __builtin_nontemporal_load((const v4u*)xr + lane + 64); }
#pragma unroll
            for (int q = 0; q < 4; ++q) { const int ml = ml0 + q * GS * NWAVES; if (ml >= mhi) break;
                const float rs = __builtin_amdgcn_rsqf(wave_sum(sv[q]) * (1.f / D) + EPS);
                float* yr = (ml < SEQ) ? out + OY + (size_t)(grp * SEQ + ml) * D : out + OYS + (size_t)(16 * grp + (ml - SEQ)) * D;
#pragma unroll
                for (int j = 0; j < 2; ++j) { const v4u w = xw[q][j]; const f32x4 g0 = *((const f32x4*)g_final + 2 * (lane + 64 * j)), g1 = *((const f32x4*)g_final + 2 * (lane + 64 * j) + 1);
                    const f32x4 x0 = {bflo(w.x), bfhi(w.x), bflo(w.y), bfhi(w.y)}, x1 = {bflo(w.z), bfhi(w.z), bflo(w.w), bfhi(w.w)};
                    f32x4* yp = (f32x4*)yr + 2 * (lane + 64 * j); yp[0] = x0 * rs * g0; yp[1] = x1 * rs * g1; } }
        }
    }
    }
    if (ph + 1 < hi + soff) { if (ph == 0) { GRID_BAR();
#if STAGGER_TICKS > 0
            { const unsigned long long t0 = __builtin_amdgcn_s_memrealtime(); const unsigned long long dt = (unsigned long long)grp * STAGGER_TICKS;
              while (__builtin_amdgcn_s_memrealtime() - t0 < dt) __builtin_amdgcn_s_sleep(4); }
#endif
        } else GROUP_BAR(); }
    }
#undef IN
#undef SEAM
#undef GRID_BAR
}

extern "C" void kernel_launch(void* const* d_in, const int* in_sizes, int n_in, void* d_out, int out_size, void* d_ws, size_t ws_size, hipStream_t stream) {
    static int grid = 0;
    if (grid == 0) {
        if (n_in != 22 || ws_size < WS_END) { fprintf(stderr, "kernel_launch: unexpected inputs (n_in %d, ws %zu)\n", n_in, ws_size); grid = -1; return; }
        int dev = 0, cus = 0, per_cu = 0;
        if (hipGetDevice(&dev) != hipSuccess || hipDeviceGetAttribute(&cus, hipDeviceAttributeMultiprocessorCount, dev) != hipSuccess) { grid = -1; return; }
        if (hipFuncSetAttribute((const void*)mk_fwd, hipFuncAttributeMaxDynamicSharedMemorySize, LDS_BYTES) != hipSuccess) { fprintf(stderr, "kernel_launch: hipFuncSetAttribute failed\n"); grid = -1; return; }
        if (hipOccupancyMaxActiveBlocksPerMultiprocessor(&per_cu, (const void*)mk_fwd, NTHREADS, LDS_BYTES) != hipSuccess || per_cu < 1)
            fprintf(stderr, "kernel_launch: note: occupancy query reports %d workgroups per CU\n", per_cu);
        (void)hipGetLastError();
        grid = cus;
    }
    if (grid < 0) return;
    (void)hipMemsetAsync((char*)d_ws + WS_CTL, 0, CTL_ZERO_BYTES, stream);
    Args a{};
    for (int i = 0; i < 22; ++i) a.in[i] = (const float*)d_in[i];
    a.out = (float*)d_out; a.ws = (unsigned char*)d_ws;
#if MK_PER_PHASE
    for (int p = 0; p < NPHASES; ++p) { a.ph_lo = p; a.ph_hi = p + 1; hipLaunchKernelGGL(mk_fwd, dim3(grid), dim3(NTHREADS), LDS_BYTES, stream, a); }
#else
    a.ph_lo = 0; a.ph_hi = NPHASES; hipLaunchKernelGGL(mk_fwd, dim3(grid), dim3(NTHREADS), LDS_BYTES, stream, a);
#endif
}
```

```cpp
#include <hip/hip_runtime.h>
#include <cstdio>
#include <cstdint>

#ifndef SAMPLE_SHIFT
#define SAMPLE_SHIFT 1
#endif
#ifndef SELF_INIT
#define SELF_INIT 1
#endif
#ifndef MEMBER_FLIP
#define MEMBER_FLIP 1
#endif
#ifndef MEMBER_FLIP_SEL
#define MEMBER_FLIP_SEL (mi & 1)
#endif
#ifndef STAGGER_TICKS
#define STAGGER_TICKS 0
#endif
#ifndef MK_PER_PHASE
#define MK_PER_PHASE 0
#endif

constexpr int D = 1024, BATCH = 8, SEQ = 2048, MP = BATCH * SEQ  , MS = 128  ;
constexpr int NMEM = 256, NH = 4, HD = 256, FF = 4096, MEMROWS = BATCH * NMEM  ;
constexpr float EPS = 1e-6f;
constexpr float QSCALE = 0.0625f * 1.4426950408889634f;

constexpr size_t OY = 0, OYS = 16777216, OPP = 16908288, OCP = 17031168, OMK = 17047552, OMV = 21241856, OPS = 25436160, OCS = 27402240;

__device__ __forceinline__ int lane_id_opaque() { int l; asm volatile("v_mbcnt_lo_u32_b32 %0, -1, 0\n\tv_mbcnt_hi_u32_b32 %0, -1, %0" : "=v"(l)); return l; }
#define SWZ_XOR(v, m) __builtin_bit_cast(float, __builtin_amdgcn_ds_swizzle(__builtin_bit_cast(int, (float)(v)), (((m) << 10) | 0x1f)))
__device__ __forceinline__ void swap32(float& a, float& b) { asm volatile("s_nop 1\n\tv_permlane32_swap_b32 %0, %1\n\ts_nop 1" : "+v"(a), "+v"(b)); }
__device__ __forceinline__ float add_x32(float v) { float a = v, b = v; swap32(a, b); return a + b; }
__device__ __forceinline__ float max_x32(float v) { float a = v, b = v; swap32(a, b); return fmaxf(a, b); }
__device__ __forceinline__ float add_x16_x32(float v) { v += SWZ_XOR(v, 16); return add_x32(v); }
__device__ __forceinline__ float max_x16_x32(float v) { v = fmaxf(v, SWZ_XOR(v, 16)); return max_x32(v); }
__device__ __forceinline__ float wave_sum(float v) { v += SWZ_XOR(v, 1); v += SWZ_XOR(v, 2); v += SWZ_XOR(v, 4); v += SWZ_XOR(v, 8); v += SWZ_XOR(v, 16); return add_x32(v); }
__device__ __forceinline__ float wave_max(float v) { v = fmaxf(v, SWZ_XOR(v, 1)); v = fmaxf(v, SWZ_XOR(v, 2)); v = fmaxf(v, SWZ_XOR(v, 4)); v = fmaxf(v, SWZ_XOR(v, 8)); v = fmaxf(v, SWZ_XOR(v, 16)); return max_x32(v); }

namespace pg8 {
#define PG8_LAS __attribute__((address_space(3)))
typedef unsigned short bf16_t;
typedef short bf16x8 __attribute__((ext_vector_type(8)));
typedef float f32x4 __attribute__((ext_vector_type(4)));
typedef float f32x2 __attribute__((ext_vector_type(2)));
typedef unsigned u32x4 __attribute__((ext_vector_type(4)));
typedef unsigned u32x2 __attribute__((ext_vector_type(2)));
constexpr int BM = 256, BK = 64, HALF = 128, HTB = HALF * BK * 2, STAGE_BYTES = 8 * HTB, NXCD = 8, WGM = 8;

__host__ __device__ __forceinline__ int lds_byte(int r, int c) { const int st = (r >> 4) * 2 + (c >> 5), rr = r & 15, cc = c & 31, ob = rr * 64 + cc * 2; return st * 1024 + (ob ^ (((ob >> 9) & 1) << 5)); }
__host__ __device__ __forceinline__ void stage_rc(int b, int& R, int& C) { const int st = b / 1024, sb = b % 1024, swz = sb ^ (((sb >> 9) & 1) << 5); R = (st >> 1) * 16 + swz / 64; C = (st & 1) * 32 + (swz % 64) / 2; }
__host__ __device__ __forceinline__ int perm32(int rho) { const int n = rho >> 4, i = rho & 15; return 8 * (i >> 2) + 4 * n + (i & 3); }

struct Unit { int pm, pn; };
struct Gemm { int lda, ldb, K; };

__device__ __forceinline__ unsigned cvt_pk_bf16(float lo, float hi) { unsigned r; asm volatile("v_cvt_pk_bf16_f32 %0, %1, %2" : "=v"(r) : "v"(lo), "v"(hi)); return r; }

struct StaticOrder {
    int nM, nN, nwg, G, c, pm0;
    const char* A; const char* B; size_t astep, bstep, apn;
    __device__ void init(int nM_, int nN_, int G_, int c_, int pm0_, const void* A_, size_t astep_, const void* B_, size_t bstep_, size_t apn_ = 0) {
        nM = nM_; nN = nN_; nwg = nM * nN; G = G_; c = c_; pm0 = pm0_; A = (const char*)A_; B = (const char*)B_; astep = astep_; bstep = bstep_; apn = apn_; }
    __device__ bool next(int i, Unit& u) const {
        const long L = (long)i * G + c; if (L >= nwg) return false;
        u.pm = pm0 + (int)(L % nM); u.pn = (int)(L / nM); return true;
    }
    __device__ __forceinline__ const char* aptr(const Unit& u) const { return A + (size_t)u.pm * astep + (size_t)u.pn * apn; }
    __device__ __forceinline__ const char* bptr(const Unit& u) const { return B + (size_t)u.pn * bstep; }
};
struct KvOrder {
    int G, c, batch; const char* A; const char* B;
    __device__ bool next(int i, Unit& u) const { const int L = i * G + c; if (L >= 16) return false; u.pm = (L >> 3) * 8 + batch; u.pn = L & 7; return true; }
    __device__ __forceinline__ const char* aptr(const Unit& u) const { return A + (size_t)u.pm * (256 * 1024 * 2); }
    __device__ __forceinline__ const char* bptr(const Unit& u) const { return B + (size_t)((u.pm >> 3) * 2048 + u.pn * 256) * (1024 * 2); }
};
struct SingleOrder {
    Unit u0; const char* A; const char* B;
    __device__ bool next(int i, Unit& u) const { if (i) return false; u = u0; return true; }
    __device__ __forceinline__ const char* aptr(const Unit&) const { return A; }
    __device__ __forceinline__ const char* bptr(const Unit&) const { return B; }
};


template <bool BASE32> struct EpiRes {
    static constexpr bool PERM = true, AFTER_DRAIN = false;
    const float* base32; bf16_t* x16; float* ssq; const float* cscale;
    __device__ __forceinline__ void operator()(const f32x4 (&acc)[2][2][4][2], const Unit& u, int wr, int wc, int fr, int fq) const {
        const int col0 = u.pn * BM + wc * 32 + 8 * fq;
        f32x4 cs[2][2];
#pragma unroll
        for (int bj = 0; bj < 2; ++bj)
#pragma unroll
            for (int n = 0; n < 2; ++n) cs[bj][n] = cscale ? *(const f32x4*)(cscale + col0 + bj * HALF + n * 4) : (f32x4){1.f, 1.f, 1.f, 1.f};
        constexpr int HSTEP = BASE32 ? 1 : 2;
#pragma unroll
        for (int a0 = 0; a0 < 2; a0 += HSTEP) {
        u32x4 bw[HSTEP][4][2]; f32x4 bf[BASE32 ? 1 : 1][4][2][2];
#pragma unroll
        for (int ah = 0; ah < HSTEP; ++ah)
#pragma unroll
            for (int m = 0; m < 4; ++m) { const int row = u.pm * BM + (a0 + ah) * HALF + wr * 64 + m * 16 + fr; const size_t off = (size_t)row * D + col0;
#pragma unroll
                for (int bj = 0; bj < 2; ++bj) {
                    if (BASE32) { bf[0][m][bj][0] = __builtin_nontemporal_load((const f32x4*)(base32 + off + bj * HALF)); bf[0][m][bj][1] = __builtin_nontemporal_load((const f32x4*)(base32 + off + bj * HALF + 4)); }
                    else bw[ah][m][bj] = *(const u32x4*)(x16 + off + bj * HALF); } }
#pragma unroll
        for (int ah = 0; ah < HSTEP; ++ah) { const int ai = a0 + ah;
#pragma unroll
            for (int m = 0; m < 4; ++m) { const int row = u.pm * BM + ai * HALF + wr * 64 + m * 16 + fr; const size_t off = (size_t)row * D + col0; float ss = 0.f;
#pragma unroll
                for (int bj = 0; bj < 2; ++bj) { f32x4 b0, b1;
                    if (BASE32) { b0 = bf[0][m][bj][0]; b1 = bf[0][m][bj][1]; }
                    else { const u32x4 w = bw[ah][m][bj];
                        b0 = (f32x4){__builtin_bit_cast(float, w.x << 16), __builtin_bit_cast(float, w.x & 0xffff0000u), __builtin_bit_cast(float, w.y << 16), __builtin_bit_cast(float, w.y & 0xffff0000u)};
                        b1 = (f32x4){__builtin_bit_cast(float, w.z << 16), __builtin_bit_cast(float, w.z & 0xffff0000u), __builtin_bit_cast(float, w.w << 16), __builtin_bit_cast(float, w.w & 0xffff0000u)}; }
                    const f32x4 v0 = b0 + acc[ai][bj][m][0] * cs[bj][0], v1 = b1 + acc[ai][bj][m][1] * cs[bj][1];
                    ss += ((v0[0] * v0[0] + v0[1] * v0[1]) + (v0[2] * v0[2] + v0[3] * v0[3])) + ((v1[0] * v1[0] + v1[1] * v1[1]) + (v1[2] * v1[2] + v1[3] * v1[3]));
                    u32x4 o; o.x = cvt_pk_bf16(v0[0], v0[1]); o.y = cvt_pk_bf16(v0[2], v0[3]); o.z = cvt_pk_bf16(v1[0], v1[1]); o.w = cvt_pk_bf16(v1[2], v1[3]);
                    *(u32x4*)(x16 + off + bj * HALF) = o; }
                ss = add_x16_x32(ss);
                if (fq == 0) ssq[(size_t)row * 16 + u.pn * 4 + wc] = ss; }
        }
        }
    }
};
__device__ __forceinline__ float rstd_from_ssq16(const float* ssq, int row) {
    const f32x4* sp = (const f32x4*)(ssq + (size_t)row * 16); const f32x4 s = (sp[0] + sp[1]) + (sp[2] + sp[3]);
    return __builtin_amdgcn_rsqf(((s[0] + s[1]) + (s[2] + s[3])) * (1.0f / D) + EPS);
}
template <int MODE> struct EpiRow {
    static constexpr bool PERM = true, AFTER_DRAIN = false;
    bf16_t* O; int ldc; const float* ssq; float scale; bf16_t* O2; float* convout; const PG8_LAS float* rsd;
    __device__ __forceinline__ void operator()(const f32x4 (&acc)[2][2][4][2], const Unit& u, int wr, int wc, int fr, int fq) const {
        const int colw = wc * 32 + 8 * fq;
        float rsv[2][4];
        if (rsd) {
#pragma unroll
          for (int ai = 0; ai < 2; ++ai)
#pragma unroll
              for (int m = 0; m < 4; ++m) rsv[ai][m] = rsd[ai * HALF + wr * 64 + m * 16 + fr];
        } else { f32x4 qv[2][4];
#pragma unroll
          for (int ai = 0; ai < 2; ++ai)
#pragma unroll
              for (int m = 0; m < 4; ++m) qv[ai][m] = *(const f32x4*)(ssq + (size_t)(u.pm * BM + ai * HALF + wr * 64 + m * 16 + fr) * 16 + 4 * fq);
#pragma unroll
          for (int ai = 0; ai < 2; ++ai)
#pragma unroll
              for (int m = 0; m < 4; ++m) { const f32x4 q = qv[ai][m]; rsv[ai][m] = __builtin_amdgcn_rsqf(add_x16_x32((q[0] + q[1]) + (q[2] + q[3])) * (1.0f / D) + EPS); } }
#pragma unroll
        for (int ai = 0; ai < 2; ++ai)
#pragma unroll
            for (int m = 0; m < 4; ++m) { const int row = u.pm * BM + ai * HALF + wr * 64 + m * 16 + fr; const float rs = rsv[ai][m];
                if (MODE == 2 && u.pn >= 4) {
                    const float r2 = rs * rs; const f32x4 v0 = acc[ai][0][m][0] * acc[ai][1][m][0] * r2, v1 = acc[ai][0][m][1] * acc[ai][1][m][1] * r2;
                    const int ch = (u.pn - 4) * 128 + colw;
                    u32x4 w; w.x = cvt_pk_bf16(v0[0], v0[1]); w.y = cvt_pk_bf16(v0[2], v0[3]); w.z = cvt_pk_bf16(v1[0], v1[1]); w.w = cvt_pk_bf16(v1[2], v1[3]);
                    *(u32x4*)(O2 + (size_t)row * D + ch) = w;
                    const int t = row & (SEQ - 1);
                    if (t >= SEQ - 2) { float* cp = convout + ((size_t)(row >> 11) * 2 + (t - (SEQ - 2))) * D + ch; *(f32x4*)cp = v0; *(f32x4*)(cp + 4) = v1; }
                } else {
                    const float sc = (MODE == 0) ? rs * scale : rs;
#pragma unroll
                    for (int bj = 0; bj < 2; ++bj) { f32x4 v0 = acc[ai][bj][m][0] * sc, v1 = acc[ai][bj][m][1] * sc;
                        if (MODE == 1) {
#pragma unroll
                            for (int j = 0; j < 4; ++j) { const float a = fmaxf(v0[j], 0.f), b = fmaxf(v1[j], 0.f); v0[j] = a * a; v1[j] = b * b; } }
                        u32x4 w; w.x = cvt_pk_bf16(v0[0], v0[1]); w.y = cvt_pk_bf16(v0[2], v0[3]); w.z = cvt_pk_bf16(v1[0], v1[1]); w.w = cvt_pk_bf16(v1[2], v1[3]);
                        *(u32x4*)(O + (size_t)row * ldc + u.pn * BM + bj * HALF + colw) = w; }
                } }
    }
};
struct EpiBf16 {
    static constexpr bool PERM = true, AFTER_DRAIN = false;
    bf16_t* O; int ldc; float scale;
    __device__ __forceinline__ void operator()(const f32x4 (&acc)[2][2][4][2], const Unit& u, int wr, int wc, int fr, int fq) const {
        const int colw = u.pn * BM + wc * 32 + 8 * fq;
#pragma unroll
        for (int ai = 0; ai < 2; ++ai)
#pragma unroll
            for (int m = 0; m < 4; ++m) { const int row = u.pm * BM + ai * HALF + wr * 64 + m * 16 + fr;
#pragma unroll
                for (int bj = 0; bj < 2; ++bj) { const f32x4 v0 = acc[ai][bj][m][0] * scale, v1 = acc[ai][bj][m][1] * scale;
                    u32x4 w; w.x = cvt_pk_bf16(v0[0], v0[1]); w.y = cvt_pk_bf16(v0[2], v0[3]); w.z = cvt_pk_bf16(v1[0], v1[1]); w.w = cvt_pk_bf16(v1[2], v1[3]);
                    *(u32x4*)(O + (size_t)row * ldc + colw + bj * HALF) = w; } }
    }
};
struct EpiKV {
    static constexpr bool PERM = false, AFTER_DRAIN = false;
    float* outk; float* outv; bf16_t* Kb; bf16_t* Vt;
    __device__ __forceinline__ void operator()(const f32x4 (&acc)[2][2][4][2], const Unit& u, int wr, int wc, int fr, int fq) const {
        const int layer = u.pm >> 3; const bool isV = u.pn >= 4; const int col0 = (u.pn & 3) * BM + wc * 32 + 4 * fq;
        float* outp = isV ? outv : outk;
#pragma unroll
        for (int ai = 0; ai < 2; ++ai)
#pragma unroll
            for (int m = 0; m < 4; ++m) { const int rowl = (u.pm & 7) * BM + ai * HALF + wr * 64 + m * 16 + fr; const size_t off = ((size_t)layer * MEMROWS + rowl) * D + col0;
#pragma unroll
                for (int bj = 0; bj < 2; ++bj)
#pragma unroll
                    for (int n = 0; n < 2; ++n) { const f32x4 v = acc[ai][bj][m][n]; *(f32x4*)(outp + off + bj * HALF + n * 16) = v;
                        if (!isV) { u32x2 p; p.x = cvt_pk_bf16(v[0], v[1]); p.y = cvt_pk_bf16(v[2], v[3]); *(u32x2*)(Kb + off + bj * HALF + n * 16) = p; }
                        else { u32x2 p; p.x = cvt_pk_bf16(v[0], v[1]); p.y = cvt_pk_bf16(v[2], v[3]); *(u32x2*)(Vt + off + bj * HALF + n * 16) = p; } } }
    }
};
struct EpiSoftmax {
    static constexpr bool PERM = true, AFTER_DRAIN = true;
    bf16_t* P; int ldp; const float* ssq;
    __device__ __forceinline__ void operator()(const f32x4 (&)[2][2][4][2], const Unit&, int, int, int, int) const {}
    __device__ __forceinline__ void fused(f32x4 (&acc)[2][2][4][2], const Unit& u, int wr, int wc, int fr, int fq, PG8_LAS unsigned char* lds, int wid, int lane) const {
        PG8_LAS float* Pm = (PG8_LAS float*)lds;
        PG8_LAS float* Ps = (PG8_LAS float*)(lds + 4096);
        float rsv[2][4];
        { f32x4 qv[2][4];
#pragma unroll
          for (int ai = 0; ai < 2; ++ai)
#pragma unroll
              for (int m = 0; m < 4; ++m) qv[ai][m] = *(const f32x4*)(ssq + (size_t)(u.pm * BM + ai * HALF + wr * 64 + m * 16 + fr) * 16 + 4 * fq);
#pragma unroll
          for (int ai = 0; ai < 2; ++ai)
#pragma unroll
              for (int m = 0; m < 4; ++m) { const f32x4 q = qv[ai][m]; rsv[ai][m] = __builtin_amdgcn_rsqf(add_x16_x32((q[0] + q[1]) + (q[2] + q[3])) * (1.0f / D) + EPS); } }
#pragma unroll
        for (int ai = 0; ai < 2; ++ai)
#pragma unroll
            for (int m = 0; m < 4; ++m) { float mx = -3.0e38f; const float rs = rsv[ai][m];
#pragma unroll
                for (int bj = 0; bj < 2; ++bj)
#pragma unroll
                    for (int n = 0; n < 2; ++n) { const f32x4 x = acc[ai][bj][m][n] * rs; acc[ai][bj][m][n] = x; mx = fmaxf(mx, fmaxf(fmaxf(x[0], x[1]), fmaxf(x[2], x[3]))); }
                mx = max_x16_x32(mx);
                if (fq == 0) Pm[(ai * HALF + wr * 64 + m * 16 + fr) * 4 + wc] = mx; }
        asm volatile("s_waitcnt lgkmcnt(0)" ::: "memory"); __builtin_amdgcn_s_barrier(); asm volatile("" ::: "memory");
#pragma unroll
        for (int ai = 0; ai < 2; ++ai)
#pragma unroll
            for (int m = 0; m < 4; ++m) { const int r = ai * HALF + wr * 64 + m * 16 + fr; const f32x4 q = *(const PG8_LAS f32x4*)(Pm + r * 4);
                const float mx = fmaxf(fmaxf(q[0], q[1]), fmaxf(q[2], q[3])); float s = 0.f;
#pragma unroll
                for (int bj = 0; bj < 2; ++bj)
#pragma unroll
                    for (int n = 0; n < 2; ++n) { f32x4 x = acc[ai][bj][m][n];
#pragma unroll
                        for (int j = 0; j < 4; ++j) { x[j] = __builtin_amdgcn_exp2f(x[j] - mx); s += x[j]; }
                        acc[ai][bj][m][n] = x; }
                s = add_x16_x32(s);
                if (fq == 0) Ps[r * 4 + wc] = s; }
        asm volatile("s_waitcnt lgkmcnt(0)" ::: "memory"); __builtin_amdgcn_s_barrier(); asm volatile("" ::: "memory");
        const int colw = u.pn * BM + wc * 32 + 8 * fq;
#pragma unroll
        for (int ai = 0; ai < 2; ++ai)
#pragma unroll
            for (int m = 0; m < 4; ++m) { const int r = ai * HALF + wr * 64 + m * 16 + fr; const f32x4 q = *(const PG8_LAS f32x4*)(Ps + r * 4);
                const float inv = __builtin_amdgcn_rcpf((q[0] + q[1]) + (q[2] + q[3]));
#pragma unroll
                for (int bj = 0; bj < 2; ++bj) { const f32x4 v0 = acc[ai][bj][m][0] * inv, v1 = acc[ai][bj][m][1] * inv;
                    u32x4 w; w.x = cvt_pk_bf16(v0[0], v0[1]); w.y = cvt_pk_bf16(v0[2], v0[3]); w.z = cvt_pk_bf16(v1[0], v1[1]); w.w = cvt_pk_bf16(v1[2], v1[3]);
                    *(u32x4*)(P + (size_t)(u.pm * BM + r) * ldp + bj * HALF + colw) = w; } }
    }
};

template <class Epi, class Sched, bool ALIGN_EPI>
__device__ __forceinline__ void gemm_phase(PG8_LAS unsigned char* lds, const Gemm g, const Sched& S, const Epi& E, int tid) {
    asm volatile("" : "+v"(tid));
    const int wid = __builtin_amdgcn_readfirstlane(tid >> 6), lane = tid & 63, wr = wid >> 2, wc = wid & 3, fr = lane & 15, fq = lane >> 4;
    const int nt = g.K / BK;
    unsigned voffA[2], voffB[2];
#pragma unroll
    for (int i = 0; i < 2; ++i) { int R, C; stage_rc(tid * 16 + i * 8192, R, C); const int Rb = Epi::PERM ? ((R & ~31) + perm32(R & 31)) : R;
        voffA[i] = (unsigned)(R * g.lda + C) * 2u; voffB[i] = (unsigned)(Rb * g.ldb + C) * 2u; }
    const size_t kstep = (size_t)(BK * 2);
    const size_t hstepA = (size_t)HALF * g.lda * 2, hstepB = (size_t)HALF * g.ldb * 2;
    const unsigned ldsw = (unsigned)wid * 1024u;
    const int aoff = lds_byte(wr * 64 + fr, fq * 8), boff = lds_byte(wc * 32 + fr, fq * 8);
#define PG8_SA(b, h) (((b) * 2 + (h)) * HTB)
#define PG8_SB(b, h) ((4 + (b) * 2 + (h)) * HTB)
#define PG8_STAGE(bufoff, gbase, voff) do { const char* _gb = (const char*)(gbase); asm volatile("" : "+s"(_gb));   \
        _Pragma("unroll") for (int _i = 0; _i < 2; ++_i) \
        __builtin_amdgcn_global_load_lds((const unsigned*)(_gb + (voff)[_i]), (PG8_LAS unsigned*)(lds + (bufoff) + ldsw + _i * 8192), 16, 0, 0); } while (0)
#define PG8_LDA(dst, b, h) do { _Pragma("unroll") for (int m = 0; m < 4; ++m) _Pragma("unroll") for (int k = 0; k < 2; ++k) dst[m][k] = *(const PG8_LAS bf16x8*)(lds + PG8_SA(b, h) + aoff + m * 2048 + k * 1024); } while (0)
#define PG8_LDB(dst, b, h) do { _Pragma("unroll") for (int n = 0; n < 2; ++n) _Pragma("unroll") for (int k = 0; k < 2; ++k) dst[n][k] = *(const PG8_LAS bf16x8*)(lds + PG8_SB(b, h) + boff + n * 2048 + k * 1024); } while (0)
#define PG8_MMA(ai, bj, At, Bt) do { __builtin_amdgcn_s_setprio(1); _Pragma("unroll") for (int m = 0; m < 4; ++m) _Pragma("unroll") for (int n = 0; n < 2; ++n) _Pragma("unroll") for (int k = 0; k < 2; ++k) \
        acc[ai][bj][m][n] = __builtin_amdgcn_mfma_f32_16x16x32_bf16(Bt[n][k], At[m][k], acc[ai][bj][m][n], 0, 0, 0); __builtin_amdgcn_s_setprio(0); } while (0)
#define PG8_WAIT_V(n) asm volatile("s_waitcnt vmcnt(" #n ")" ::: "memory")
#define PG8_WAIT_L(n) asm volatile("s_waitcnt lgkmcnt(" #n ")" ::: "memory")
#define PG8_BAR __builtin_amdgcn_s_barrier()
#define PG8_SCHED __builtin_amdgcn_sched_barrier(0)
    Unit cur, nxt; int ui = 0;
    if (!S.next(0, cur)) return;
    f32x4 acc[2][2][4][2];
#pragma unroll
    for (int a = 0; a < 2; ++a)
#pragma unroll
        for (int b = 0; b < 2; ++b)
#pragma unroll
            for (int m = 0; m < 4; ++m)
#pragma unroll
                for (int n = 0; n < 2; ++n) acc[a][b][m][n] = (f32x4){0.f, 0.f, 0.f, 0.f};
    bf16x8 At[4][2], B0[2][2], B1[2][2];
    const char* cA = S.aptr(cur); const char* cB = S.bptr(cur);
    PG8_STAGE(PG8_SB(0, 0), cB, voffB); PG8_STAGE(PG8_SB(0, 1), cB + hstepB, voffB); PG8_STAGE(PG8_SA(0, 0), cA, voffA); PG8_STAGE(PG8_SA(0, 1), cA + hstepA, voffA);
    if (wr == 1) PG8_BAR;
    PG8_WAIT_V(2); PG8_BAR;
    PG8_STAGE(PG8_SB(1, 0), cB + kstep, voffB); PG8_STAGE(PG8_SA(1, 0), cA + kstep, voffA); PG8_STAGE(PG8_SB(1, 1), cB + hstepB + kstep, voffB);
    PG8_WAIT_V(6); PG8_BAR;
    for (;;) {
        const bool has_next = S.next(ui + 1, nxt);
        const char* nA = has_next ? S.aptr(nxt) : cA; const char* nB = has_next ? S.bptr(nxt) : cB;
        for (int t = 0; t < nt; t += 2) {
            const bool last = (t == nt - 2);
            const char* a1 = cA + (size_t)(t + 1) * kstep;
            const char* a2 = last ? nA : cA + (size_t)(t + 2) * kstep; const char* b2 = last ? nB : cB + (size_t)(t + 2) * kstep;
            const char* a3 = a2 + kstep; const char* b3 = b2 + kstep;
            PG8_LDB(B0, 0, 0); PG8_LDB(B1, 0, 1); PG8_SCHED; PG8_LDA(At, 0, 0); PG8_STAGE(PG8_SA(1, 1), a1 + hstepA, voffA);
            PG8_WAIT_V(8); PG8_WAIT_L(0); PG8_BAR; PG8_MMA(0, 0, At, B0); PG8_MMA(0, 1, At, B1); PG8_BAR; PG8_SCHED;
            PG8_LDA(At, 0, 1); PG8_STAGE(PG8_SB(0, 0), b2, voffB); PG8_STAGE(PG8_SB(0, 1), b2 + hstepB, voffB); PG8_STAGE(PG8_SA(0, 0), a2, voffA);
            PG8_WAIT_V(8); PG8_WAIT_L(0); PG8_BAR; PG8_MMA(1, 0, At, B0); PG8_MMA(1, 1, At, B1); PG8_BAR; PG8_SCHED;
            PG8_LDB(B0, 1, 0); PG8_LDB(B1, 1, 1); PG8_SCHED; PG8_LDA(At, 1, 0); PG8_STAGE(PG8_SA(0, 1), a2 + hstepA, voffA);
            PG8_WAIT_V(8); PG8_WAIT_L(0); PG8_BAR; PG8_MMA(0, 0, At, B0); PG8_MMA(0, 1, At, B1); PG8_BAR; PG8_SCHED;
            PG8_LDA(At, 1, 1); PG8_STAGE(PG8_SB(1, 0), b3, voffB); PG8_STAGE(PG8_SB(1, 1), b3 + hstepB, voffB); PG8_STAGE(PG8_SA(1, 0), a3, voffA);
            PG8_WAIT_V(8); PG8_WAIT_L(0); PG8_BAR; PG8_MMA(1, 0, At, B0); PG8_MMA(1, 1, At, B1); PG8_BAR; PG8_SCHED;
        }
        if constexpr (ALIGN_EPI) { if (wr == 0) PG8_BAR; }
        if constexpr (!Epi::AFTER_DRAIN) { const int l2 = lane_id_opaque(); E(acc, cur, wr, wc, l2 & 15, l2 >> 4); }
        if (!has_next) break;
#pragma unroll
        for (int a = 0; a < 2; ++a)
#pragma unroll
            for (int b = 0; b < 2; ++b)
#pragma unroll
                for (int m = 0; m < 4; ++m)
#pragma unroll
                    for (int n = 0; n < 2; ++n) acc[a][b][m][n] = (f32x4){0.f, 0.f, 0.f, 0.f};
        cur = nxt; cA = nA; cB = nB; ++ui;
        if constexpr (ALIGN_EPI) { if (wr == 1) PG8_BAR; }
    }
    PG8_WAIT_V(0);
    if constexpr (!ALIGN_EPI) { if (wr == 0) PG8_BAR; }
    PG8_BAR;
    if constexpr (Epi::AFTER_DRAIN) { const int l2 = lane_id_opaque(); E.fused(acc, cur, wr, wc, l2 & 15, l2 >> 4, lds, wid, l2); }
#undef PG8_SA
#undef PG8_SB
#undef PG8_STAGE
#undef PG8_LDA
#undef PG8_LDB
#undef PG8_MMA
#undef PG8_WAIT_V
#undef PG8_WAIT_L
#undef PG8_BAR
#undef PG8_SCHED
}
}

constexpr int NWAVES = 8, NTHREADS = 512;
constexpr size_t MiB = 1u << 20;
constexpr size_t WS_CTL = 0, CTL_ZERO_BYTES = 256 * 1024;
constexpr size_t WS_WPOOL = 1 * MiB;
constexpr size_t WS_WQ = 2 * MiB;
constexpr size_t WS_WO = 6 * MiB;
constexpr size_t WS_WKV = 10 * MiB;
constexpr size_t WS_WUP = 18 * MiB;
constexpr size_t WS_WDN = 34 * MiB;
constexpr size_t WS_WIN = 50 * MiB;
constexpr size_t WS_WOUT = 56 * MiB;
constexpr size_t WS_MN = 58 * MiB;
constexpr size_t WS_KB = 66 * MiB;
constexpr size_t WS_VT = 74 * MiB;
constexpr size_t WS_SSQ = 82 * MiB;
constexpr size_t WS_SMALL = 84 * MiB;
constexpr size_t WS_X = 96 * MiB;
constexpr size_t WS_XG = 160 * MiB;
constexpr size_t WS_P0 = 192 * MiB;
constexpr size_t WS_O = 224 * MiB;
constexpr size_t WS_CH = 256 * MiB;
constexpr size_t WS_PS = 288 * MiB;
constexpr size_t WS_H = 320 * MiB;
constexpr size_t WS_WQN = 448 * MiB;
constexpr size_t WS_MT = 452 * MiB;
constexpr size_t WS_VW = 484 * MiB;
constexpr size_t WS_END = 516 * MiB;
constexpr size_t SS_X = WS_SMALL;
constexpr size_t SS_XG = SS_X + 512 * 1024;
constexpr size_t SS_SSQ = SS_XG + 256 * 1024;
constexpr size_t SS_P0 = SS_SSQ + 32 * 1024;
constexpr size_t SS_O = SS_P0 + 256 * 1024;
constexpr size_t SS_CH = SS_O + 256 * 1024;
constexpr size_t SS_H = SS_CH + 512 * 1024;
constexpr size_t SS_Q = SS_H + 1024 * 1024;
static_assert(SS_Q + 512 * 1024 <= WS_X, "sample buffers");
constexpr int CW_FLAG = 0;
constexpr unsigned INIT_MAGIC = 0x5eed1357u;
constexpr int CW_BAR = 4096, CW_BAR_STRIDE = 4096;

constexpr int RING_OFF = 0, RING_BYTES = 131072;
constexpr int LDSCTL_OFF = RING_BYTES, MISC_OFF = LDSCTL_OFF + 320;
constexpr int RSD_OFF = RING_BYTES + 1024;
constexpr int LDS_BYTES = 147456;

#define GAS __attribute__((address_space(1)))
#define LAS __attribute__((address_space(3)))
typedef unsigned short bf16;
typedef unsigned v4u __attribute__((ext_vector_type(4)));
typedef unsigned v2u __attribute__((ext_vector_type(2)));
typedef float f32x4 __attribute__((ext_vector_type(4)));
typedef short bf16x8 __attribute__((ext_vector_type(8)));
#define LDS_WAIT() asm volatile("s_waitcnt lgkmcnt(0)" ::: "memory")
#define VM_WAIT() asm volatile("s_waitcnt vmcnt(0)" ::: "memory")
__device__ __forceinline__ unsigned f2bf(float f) { unsigned u = __builtin_bit_cast(unsigned, f); return (u + 0x7fffu + ((u >> 16) & 1u)) >> 16; }
__device__ __forceinline__ unsigned pk2(float lo, float hi) { return f2bf(lo) | (f2bf(hi) << 16); }
__device__ __forceinline__ float bf2f(unsigned short h) { return __builtin_bit_cast(float, (unsigned)h << 16); }
__device__ __forceinline__ float bflo(unsigned w) { return __builtin_bit_cast(float, w << 16); }
__device__ __forceinline__ float bfhi(unsigned w) { return __builtin_bit_cast(float, w & 0xffff0000u); }

#define XB_TMO      128
#define XB_XCNT(j)  (256  + 64 * (j))
#define XB_XSUB(j)  (1280 + 64 * (j))
#define XB_XGEN(j)  (2304 + 64 * (j))
#define XB_TOP      3328
#define XB_TOPGEN   3392
#define XCD_BAR_WORDS 3456
#define XB_SPIN_CAP (1u << 18)
__device__ __forceinline__ unsigned xb_ld(unsigned* p)              { return __hip_atomic_load(p, __ATOMIC_RELAXED, __HIP_MEMORY_SCOPE_AGENT); }
__device__ __forceinline__ unsigned xb_add(unsigned* p, unsigned v) { return __hip_atomic_fetch_add(p, v, __ATOMIC_RELAXED, __HIP_MEMORY_SCOPE_AGENT); }
__device__ __forceinline__ unsigned xb_xcc_id() { return (unsigned)__builtin_amdgcn_s_getreg((3 << 11) | 20) & 0xFu; }
#define XB_SPIN(cond, bar) do { unsigned _sp = 0; while (cond) { __builtin_amdgcn_s_sleep(1); \
    if ((++_sp & 255u) == 0u) { if (xb_ld(&(bar)[XB_TMO])) break; if (_sp > XB_SPIN_CAP) { atomicAdd(&(bar)[XB_TMO], 1u); break; } } } } while (0)
struct XcdBarrier { unsigned* bar; unsigned x; volatile LAS unsigned* st; unsigned gsize; };
__device__ __forceinline__ XcdBarrier xcd_barrier_post(unsigned* bar, volatile LAS unsigned* st, unsigned gsize) {
    XcdBarrier b; b.bar = bar; b.x = xb_xcc_id(); b.st = st; b.gsize = gsize;
    if (threadIdx.x == 0) (void)xb_add(&bar[XB_XCNT(b.x)], 1u);
    return b;
}
__device__ __forceinline__ void xcd_barrier_complete(unsigned* bar, unsigned x, unsigned G, unsigned& nloc, unsigned& nx) {
    unsigned sum, cnt, mine, sp = 0u;
    for (;;) {
        sum = 0u; cnt = 0u; mine = 0u;
#pragma unroll
        for (unsigned j = 0; j < 16; ++j) { const unsigned c = xb_ld(&bar[XB_XCNT(j)]); sum += c; cnt += (c > 0u) ? 1u : 0u; mine = (j == x) ? c : mine; }
        if (sum == G) break;
        __builtin_amdgcn_s_sleep(1);
        if ((++sp & 255u) == 0u) { if (xb_ld(&bar[XB_TMO])) break; if (sp > XB_SPIN_CAP) { atomicAdd(&bar[XB_TMO], 1u); break; } }
    }
    nloc = mine > 0u ? mine : 1u; nx = cnt > 0u ? cnt : 1u;
}
__device__ __forceinline__ void xcd_barrier(const XcdBarrier& b, const int tid) {
    asm volatile("s_waitcnt vmcnt(0)" ::: "memory");
    __syncthreads();
    if (tid == 0) {
        unsigned* bar = b.bar; asm volatile("" : "+s"(bar));
        __builtin_amdgcn_s_waitcnt(0);
        unsigned nloc = b.st[0], nx = b.st[1];
        if (nloc == 0u) { xcd_barrier_complete(bar, b.x, b.gsize, nloc, nx); b.st[0] = nloc; b.st[1] = nx; }
        const unsigned old = xb_add(&bar[XB_XSUB(b.x)], 1u);
        const unsigned gen = old / nloc;
        if (old + 1u == (gen + 1u) * nloc) {
            if (nx > 1u) {
                __builtin_amdgcn_fence(__ATOMIC_RELEASE, "agent");
                asm volatile("s_waitcnt vmcnt(0)" ::: "memory");
                const unsigned og = xb_add(&bar[XB_TOP], 1u);
                const unsigned tg = og / nx;
                if (og + 1u == (tg + 1u) * nx) xb_add(&bar[XB_TOPGEN], 1u);
                else XB_SPIN(xb_ld(&bar[XB_TOPGEN]) == tg, bar);
            }
            xb_add(&bar[XB_XGEN(b.x)], 1u);
            __builtin_amdgcn_fence(__ATOMIC_ACQUIRE, "agent");
            asm volatile("s_waitcnt vmcnt(0)" ::: "memory");
        } else {
            XB_SPIN(xb_ld(&bar[XB_XGEN(b.x)]) == gen, bar);
            __builtin_amdgcn_fence(__ATOMIC_ACQUIRE, "agent");
            asm volatile("s_waitcnt vmcnt(0)" ::: "memory");
        }
    }
    __syncthreads();
}

__device__ __forceinline__ int opq_v(int x) { asm volatile("" : "+v"(x)); return x; }
struct Args { const float* in[22]; float* out; unsigned char* ws; int ph_lo, ph_hi; };


__device__ __forceinline__ void p0_transpose_item(const float* W, int K, int N, bf16* WT, int k0, int n0, int drow0, LAS float* scr, int lane, const float* gk = nullptr) {
    float v[32];
#pragma unroll
    for (int i = 0; i < 32; ++i) { const int kk = 2 * i + (lane >> 5); v[i] = __builtin_nontemporal_load(W + (size_t)(k0 + kk) * N + n0 + (lane & 31)); }
    if (gk) {
#pragma unroll
        for (int i = 0; i < 32; ++i) v[i] *= gk[k0 + 2 * i + (lane >> 5)]; }
#pragma unroll
    for (int i = 0; i < 32; ++i) scr[(2 * i + (lane >> 5)) * 33 + (lane & 31)] = v[i];
    LDS_WAIT(); asm volatile("" ::: "memory");
    const int c = lane & 7;
#pragma unroll
    for (int j = 0; j < 4; ++j) { const int n = (lane >> 3) + 8 * j; const LAS float* s = scr + (8 * c) * 33 + n;
        v4u o; o.x = pg8::cvt_pk_bf16(s[0 * 33], s[1 * 33]); o.y = pg8::cvt_pk_bf16(s[2 * 33], s[3 * 33]); o.z = pg8::cvt_pk_bf16(s[4 * 33], s[5 * 33]); o.w = pg8::cvt_pk_bf16(s[6 * 33], s[7 * 33]);
        *(GAS v4u*)(WT + (size_t)(drow0 + n) * K + k0 + 8 * c) = o; }
    LDS_WAIT(); asm volatile("" ::: "memory");
}
__device__ __forceinline__ int win_dest_row(int n) {
    if (n < 1024) return n;
    if (n < 2048) { const int ch = n - 1024; return 1024 + (ch >> 7) * 256 + (ch & 127); }
    const int ch = n - 2048; return 1024 + (ch >> 7) * 256 + 128 + (ch & 127);
}

template <int W>
__device__ __forceinline__ void pool_wave(const float* xb  , const LAS float* rs, f32x4 g4, int tA, bf16* pout  , float* poolout  ) {
    f32x4 xv[15 + W];
#pragma unroll
    for (int i = 16 - W; i < 31; ++i) { const int t = tA - 15 + i; xv[i - (16 - W)] = *(const f32x4*)(xb + (size_t)(t >= 0 ? t : 0) * D); }
    f32x4 ring[16]; f32x4 S = {0.f, 0.f, 0.f, 0.f};
#pragma unroll
    for (int i = 16 - W; i < 31; ++i) {
        const int t = tA - 15 + i;
        f32x4 u = {0.f, 0.f, 0.f, 0.f};
        if (t >= 0) u = xv[i - (16 - W)] * rs[i] * g4;
        S += u; if (i - W >= 16 - W) S -= ring[(i - W) & 15];
        ring[i & 15] = u;
        if (i >= 15) {
            const int cnt = (t + 1 < W) ? (t + 1) : W; const float ic = 1.0f / (float)cnt;
            const f32x4 p = S * ic - u; v2u o; o.x = pk2(p[0], p[1]); o.y = pk2(p[2], p[3]);
            *(v2u*)(pout + (size_t)t * D) = o;
            if (t >= SEQ - 15) *(f32x4*)(poolout + (size_t)(t - (SEQ - 15)) * D) = u;
        }
    }
}

template <int RT, int CT, int GR, int KS, class F>
__device__ __forceinline__ void sgemm2(const bf16* A, int lda, int row0, const bf16* Bt, int ldb, const int (&brow)[CT], int K, LAS unsigned char* red, int wave, int lane, const F& f) {
    const int fr = lane & 15, fq = lane >> 4, kw = K >> 3;
    const bf16* ap = A + (size_t)(row0 + fr) * lda + wave * kw + fq * 8;
    const bf16* bp[CT];
#pragma unroll
    for (int ct = 0; ct < CT; ++ct) bp[ct] = Bt + (size_t)(brow[ct] + fr) * ldb + wave * kw + fq * 8;
    f32x4 acc[RT][CT];
#pragma unroll
    for (int rt = 0; rt < RT; ++rt)
#pragma unroll
        for (int ct = 0; ct < CT; ++ct) acc[rt][ct] = (f32x4){0.f, 0.f, 0.f, 0.f};
#pragma unroll 1
    for (int k0 = 0; k0 < kw; k0 += 32 * KS) {
        bf16x8 a[KS][RT], b[KS][CT];
#pragma unroll
        for (int ks = 0; ks < KS; ++ks) {
#pragma unroll
            for (int rt = 0; rt < RT; ++rt) a[ks][rt] = *(const bf16x8*)(ap + (size_t)rt * 16 * lda + k0 + 32 * ks);
#pragma unroll
            for (int ct = 0; ct < CT; ++ct) b[ks][ct] = *(const bf16x8*)(bp[ct] + k0 + 32 * ks); }
#pragma unroll
        for (int ks = 0; ks < KS; ++ks)
#pragma unroll
            for (int rt = 0; rt < RT; ++rt)
#pragma unroll
                for (int ct = 0; ct < CT; ++ct) acc[rt][ct] = __builtin_amdgcn_mfma_f32_16x16x32_bf16(b[ks][ct], a[ks][rt], acc[rt][ct], 0, 0, 0);
    }
#pragma unroll
    for (int rt = 0; rt < RT; ++rt)
#pragma unroll
        for (int ct = 0; ct < CT; ++ct) *(LAS f32x4*)(red + ((((wave * RT + rt) * CT + ct) * 64 + lane) << 4)) = acc[rt][ct];
    LDS_WAIT(); __syncthreads();
    constexpr int NCG = CT / GR, NTASK = RT * NCG;
    for (int t = wave; t < NTASK; t += 8) {
        const int rt = t / NCG, cg = t % NCG;
        f32x4 sacc[GR];
#pragma unroll
        for (int g = 0; g < GR; ++g) { f32x4 tt = {0.f, 0.f, 0.f, 0.f};
#pragma unroll
            for (int w = 0; w < 8; ++w) tt += *(const LAS f32x4*)(red + ((((w * RT + rt) * CT + cg * GR + g) * 64 + lane) << 4));
            sacc[g] = tt; }
        f(sacc, row0 + 16 * rt + fr, cg * GR, fq);
    }
    __syncthreads();
}
__device__ __forceinline__ float srstd(const float* ssq, int row, int fq) {
    const f32x4* sp = (const f32x4*)(ssq + row * 64 + fq * 16); const f32x4 s = (sp[0] + sp[1]) + (sp[2] + sp[3]); float t = (s[0] + s[1]) + (s[2] + s[3]);
    t = add_x16_x32(t);
    return __builtin_amdgcn_rsqf(t * (1.0f / D) + EPS);
}
template <int KS> __device__ __forceinline__ void s_res_unit(const bf16* A, int lda, const bf16* Bt, int ldb, int K, int cp, int row0, const float* base32, bf16* xs16, float* ssq, const float* cscale, LAS unsigned char* red, int wave, int lane) {
    const int brow[2] = {32 * cp, 32 * cp + 16};
    const int myct = wave & 1, prow = row0 + (lane & 15), pc0 = 16 * (2 * cp + myct) + 4 * (lane >> 4); const size_t poff = (size_t)prow * D + pc0;
    f32x4 cs = {1.f, 1.f, 1.f, 1.f}; if (cscale) cs = *(const f32x4*)(cscale + pc0);
    f32x4 bpre; if (base32) bpre = *(const f32x4*)(base32 + poff); else { const v2u w = *(const v2u*)(xs16 + poff); bpre = (f32x4){bflo(w.x), bfhi(w.x), bflo(w.y), bfhi(w.y)}; }
    sgemm2<1, 2, 1, KS>(A, lda, row0, Bt, ldb, brow, K, red, wave, lane, [&](f32x4 (&a)[1], int row, int ct0, int fq) {
        const int ctile = 2 * cp + ct0, c0 = 16 * ctile + 4 * fq; const size_t off = (size_t)row * D + c0;
        const f32x4 v = bpre + a[0] * cs;
        float ss = (v[0] * v[0] + v[1] * v[1]) + (v[2] * v[2] + v[3] * v[3]);
        ss = add_x16_x32(ss);
        if (fq == 0) ssq[row * 64 + ctile] = ss;
        v2u p; p.x = pk2(v[0], v[1]); p.y = pk2(v[2], v[3]); *(v2u*)(xs16 + off) = p; });
}
__device__ __forceinline__ void s_q_unit(const bf16* xs16, const bf16* wq, int cp, int row0, const float* ssq, float* qs, LAS unsigned char* red, int wave, int lane) {
    const int brow[2] = {32 * cp, 32 * cp + 16};
    const float rs = srstd(ssq, row0 + (lane & 15), lane >> 4) * QSCALE;
    sgemm2<1, 2, 1, 4>(xs16, D, row0, wq, D, brow, D, red, wave, lane, [&](f32x4 (&a)[1], int row, int ct0, int fq) {
        *(f32x4*)(qs + (size_t)row * D + 32 * cp + 16 * ct0 + 4 * fq) = a[0] * rs; });
}
__device__ __forceinline__ f32x4 relu2(f32x4 v) {
#pragma unroll
    for (int j = 0; j < 4; ++j) { const float a = fmaxf(v[j], 0.f); v[j] = a * a; }
    return v;
}

__device__ __forceinline__ void rstd_table(const float* ssq, int pm, LAS float* rsd, int tid) {
    if (tid < 256) { const f32x4* sp = (const f32x4*)(ssq + (size_t)(pm * 256 + tid) * 16); const f32x4 q = (sp[0] + sp[1]) + (sp[2] + sp[3]);
        rsd[tid] = __builtin_amdgcn_rsqf(((q[0] + q[1]) + (q[2] + q[3])) * (1.0f / D) + EPS); }
}
__device__ __forceinline__ void treduce32(float (&p)[32], int lane) {
#pragma unroll
    for (int i = 0; i < 16; ++i) { swap32(p[i], p[i + 16]); p[i] += p[i + 16]; }
    { const bool b4 = (lane & 16) != 0;
#pragma unroll
      for (int i = 0; i < 8; ++i) { const float keep = b4 ? p[i + 8] : p[i], send = b4 ? p[i] : p[i + 8]; p[i] = keep + SWZ_XOR(send, 16); } }
    { const bool b3 = (lane & 8) != 0;
#pragma unroll
      for (int i = 0; i < 4; ++i) { const float keep = b3 ? p[i + 4] : p[i], send = b3 ? p[i] : p[i + 4]; p[i] = keep + SWZ_XOR(send, 8); } }
    { const bool b2 = (lane & 4) != 0;
#pragma unroll
      for (int i = 0; i < 2; ++i) { const float keep = b2 ? p[i + 2] : p[i], send = b2 ? p[i] : p[i + 2]; p[i] = keep + SWZ_XOR(send, 4); } }
    { const bool b1 = (lane & 2) != 0; const float keep = b1 ? p[1] : p[0], send = b1 ? p[0] : p[1]; p[0] = keep + SWZ_XOR(send, 2); }
    p[0] += SWZ_XOR(p[0], 1);
}
__device__ __forceinline__ void unpack16(const v4u a, const v4u b, float (&x)[16]) {
    x[0] = bflo(a.x); x[1] = bfhi(a.x); x[2] = bflo(a.y); x[3] = bfhi(a.y); x[4] = bflo(a.z); x[5] = bfhi(a.z); x[6] = bflo(a.w); x[7] = bfhi(a.w);
    x[8] = bflo(b.x); x[9] = bfhi(b.x); x[10] = bflo(b.y); x[11] = bfhi(b.y); x[12] = bflo(b.z); x[13] = bfhi(b.z); x[14] = bflo(b.w); x[15] = bfhi(b.w);
}

constexpr int NPHASES = 15;
__global__ void __launch_bounds__(NTHREADS, 2) mk_fwd(Args args) {
    extern __shared__ __attribute__((aligned(16))) unsigned char lds[];
    LAS unsigned char* L = (LAS unsigned char*)lds;
    volatile LAS unsigned* MISC = (volatile LAS unsigned*)(L + MISC_OFF);
    const int wave0 = __builtin_amdgcn_readfirstlane((int)threadIdx.x >> 6);
    const int G = gridDim.x; const int bx = blockIdx.x; const int vcu = (G % 8 == 0) ? (bx % 8) * (G / 8) + bx / 8 : bx;
    const int grp = bx & 7, mi = bx >> 3, GS = (G - grp + 7) >> 3;
    for (int u = threadIdx.x; u < (LDS_BYTES - LDSCTL_OFF) / 4; u += NTHREADS) ((LAS unsigned*)(L + LDSCTL_OFF))[u] = 0u;
    __syncthreads();
#if MK_PER_PHASE
#define GRID_BAR() do { } while (0)
#define GROUP_BAR() do { } while (0)
#else
#if SELF_INIT
    unsigned* const ctlw = (unsigned*)(args.ws + WS_CTL);
    XcdBarrier bar, gbar;
    bar.bar = ctlw + CW_BAR; bar.x = xb_xcc_id(); bar.st = MISC + 8; bar.gsize = (unsigned)G;
    gbar.bar = ctlw + CW_BAR + (1 + grp) * CW_BAR_STRIDE; gbar.x = bar.x; gbar.st = MISC + 10; gbar.gsize = (unsigned)GS;
    if (bx == 0) {
        const int t = (int)threadIdx.x;
        if (t < 9 * 51) { const int r = t / 51, k = t % 51;
            const int w = (k == 0) ? XB_TMO : (k <= 16) ? XB_XCNT(k - 1) : (k <= 32) ? XB_XSUB(k - 17) : (k <= 48) ? XB_XGEN(k - 33) : (k == 49) ? XB_TOP : XB_TOPGEN;
            __hip_atomic_store(ctlw + CW_BAR + r * CW_BAR_STRIDE + w, 0u, __ATOMIC_RELAXED, __HIP_MEMORY_SCOPE_AGENT); }
        asm volatile("s_waitcnt vmcnt(0)" ::: "memory");
        __syncthreads();
        if (t == 0) __hip_atomic_store(ctlw + CW_FLAG, INIT_MAGIC, __ATOMIC_RELAXED, __HIP_MEMORY_SCOPE_AGENT);
    }
#else
    XcdBarrier bar = xcd_barrier_post((unsigned*)(args.ws + WS_CTL) + CW_BAR, MISC + 8, (unsigned)G);
    XcdBarrier gbar = xcd_barrier_post((unsigned*)(args.ws + WS_CTL) + CW_BAR + (1 + grp) * CW_BAR_STRIDE, MISC + 10, (unsigned)GS);
#endif
#define GRID_BAR() xcd_barrier(bar, wave0 * 64 + lane_id_opaque())
#define GROUP_BAR() xcd_barrier(gbar, wave0 * 64 + lane_id_opaque())
#endif
    const int lo = args.ph_lo, hi = args.ph_hi;
#define IN(k) (st == (k))
#define SEAM(k) do { } while (0)
    const int NGW = G * NWAVES;
#define TID_NOW (wave0 * 64 + lane_id_opaque())
#define RELANE const int tid = wave0 * 64 + lane_id_opaque(), lane = tid & 63; (void)tid; (void)lane;
#define KA_PTR(T, off) (*(T const __attribute__((address_space(4)))*)(ka + (off)))
#define PH_BEGIN const int tid = wave0 * 64 + lane_id_opaque(), lane = tid & 63, wave = wave0, gw = vcu * NWAVES + wave; (void)lane; (void)gw; \
    const __attribute__((address_space(4))) char* ka = (const __attribute__((address_space(4))) char*)__builtin_amdgcn_kernarg_segment_ptr(); asm volatile("" : "+s"(ka)); \
    unsigned char* const ws = KA_PTR(unsigned char*, 184); float* const out = KA_PTR(float*, 176); (void)ws; (void)out; \
    const float* const x_prompt = KA_PTR(const float*, 0); const float* const x_sample = KA_PTR(const float*, 8); const float* const state_pool = KA_PTR(const float*, 16); const float* const state_conv = KA_PTR(const float*, 24); \
    const float* const cache_k = KA_PTR(const float*, 32); const float* const cache_v = KA_PTR(const float*, 40); const float* const mem_prompt = KA_PTR(const float*, 48); \
    const float* const g_mix = KA_PTR(const float*, 56); const float* const g_attn = KA_PTR(const float*, 64); const float* const g_mem = KA_PTR(const float*, 72); const float* const g_ffn = KA_PTR(const float*, 80); const float* const g_final = KA_PTR(const float*, 88); \
    const float* const w_pool = KA_PTR(const float*, 96); const float* const pool_scale = KA_PTR(const float*, 104); const float* const w_conv_in = KA_PTR(const float*, 112); const float* const w_conv = KA_PTR(const float*, 120); const float* const w_conv_out = KA_PTR(const float*, 128); \
    const float* const w_q = KA_PTR(const float*, 136); const float* const w_kv = KA_PTR(const float*, 144); const float* const w_o = KA_PTR(const float*, 152); const float* const w_up = KA_PTR(const float*, 160); const float* const w_down = KA_PTR(const float*, 168); \
    (void)x_prompt; (void)x_sample; (void)state_pool; (void)state_conv; (void)cache_k; (void)cache_v; (void)mem_prompt; (void)g_mix; (void)g_attn; (void)g_mem; (void)g_ffn; (void)g_final; (void)w_pool; (void)pool_scale; (void)w_conv_in; (void)w_conv; (void)w_conv_out; (void)w_q; (void)w_kv; (void)w_o; (void)w_up; (void)w_down; \
    bf16* const WPOOL = (bf16*)(ws + WS_WPOOL); bf16* const WQ = (bf16*)(ws + WS_WQ); bf16* const WO = (bf16*)(ws + WS_WO); bf16* const WKV = (bf16*)(ws + WS_WKV); \
    bf16* const WUP = (bf16*)(ws + WS_WUP); bf16* const WDN = (bf16*)(ws + WS_WDN); bf16* const WIN = (bf16*)(ws + WS_WIN); bf16* const WOUT = (bf16*)(ws + WS_WOUT); \
    bf16* const MN = (bf16*)(ws + WS_MN); bf16* const KB = (bf16*)(ws + WS_KB); bf16* const VT = (bf16*)(ws + WS_VT); float* const SSQ = (float*)(ws + WS_SSQ); \
    bf16* const X16 = (bf16*)(ws + WS_X); bf16* const P0 = (bf16*)(ws + WS_P0); bf16* const OB = (bf16*)(ws + WS_O); bf16* const CH = (bf16*)(ws + WS_CH); \
    bf16* const WQN = (bf16*)(ws + WS_WQN); bf16* const MT = (bf16*)(ws + WS_MT); bf16* const VW = (bf16*)(ws + WS_VW); bf16* const HB = (bf16*)(ws + WS_H); \
    bf16* const XS16 = (bf16*)(ws + SS_X); float* const SSQS = (float*)(ws + SS_SSQ); bf16* const P0S = (bf16*)(ws + SS_P0); bf16* const OS = (bf16*)(ws + SS_O); \
    float* const CHS = (float*)(ws + SS_CH); bf16* const HS = (bf16*)(ws + SS_H); float* const QS = (float*)(ws + SS_Q); \
    (void)WPOOL; (void)WQ; (void)WO; (void)WKV; (void)WUP; (void)WDN; (void)WIN; (void)WOUT; (void)MN; (void)KB; (void)VT; (void)SSQ; (void)X16; (void)P0; (void)OB; (void)CH; (void)WQN; (void)MT; (void)VW; (void)HB; (void)XS16; (void)SSQS; (void)P0S; (void)OS; (void)CHS; (void)HS; (void)QS;

#if MK_PER_PHASE
    const int soff = 0; const bool sfirst = false;
#else
    const int soff = SAMPLE_SHIFT ? (grp & 1) : 0;
    const bool sfirst = false;
#endif
    const int mflip = (MEMBER_FLIP && !MK_PER_PHASE) ? (MEMBER_FLIP_SEL) : 0;
#pragma unroll 1
    for (int ph = lo; ph < hi + soff; ++ph) {
#pragma unroll 1
    for (int pp = 0; pp < 2; ++pp) {
    const int which = pp ^ mflip;
    const int st = which ? ph - soff : ph;
    const bool doP = (which == 0), doS = (which == 1) || (st == 0);
    if (st < 0 || st >= NPHASES || (which == 1 && st == 0)) continue;
    if (IN(0)) { PH_BEGIN
        LAS float* scr = (LAS float*)(L + RING_OFF + wave * 16384);
        {
            constexpr int I_POOL = 4 * 4 * 8, I_Q = 16 * 32, I_KV = 16 * 64, I_UP = 16 * 128, I_DN = 64 * 32, I_IN = 16 * 96;
            constexpr int NITEMS = I_POOL + 2 * (I_Q + I_KV + I_Q + I_UP + I_DN) + I_IN + I_Q;
            for (int it = gw; it < NITEMS; it += NGW) {
                int r = it;
                if (r < I_POOL) { const int g = r >> 5, rr = r & 31, kb = rr >> 3, nb = rr & 7; p0_transpose_item(w_pool + g * 65536, 256, 256, WPOOL + g * 65536, 64 * kb, 32 * nb, 32 * nb, scr, lane); continue; } r -= I_POOL;
                bool done = false;
#pragma unroll 1
                for (int l = 0; l < 2 && !done; ++l) {
                    if (r < I_Q) { const int kb = r >> 5, nb = r & 31; p0_transpose_item(w_q + (size_t)l * D * D, D, D, WQ + (size_t)l * D * D, 64 * kb, 32 * nb, 32 * nb, scr, lane, g_attn + l * D); done = true; break; } r -= I_Q;
                    if (r < I_KV) { const int kb = r >> 6, nb = r & 63; p0_transpose_item(w_kv + (size_t)l * D * 2048, D, 2048, WKV + (size_t)l * 2048 * D, 64 * kb, 32 * nb, 32 * nb, scr, lane); done = true; break; } r -= I_KV;
                    if (r < I_Q) { const int kb = r >> 5, nb = r & 31; p0_transpose_item(w_o + (size_t)l * D * D, D, D, WO + (size_t)l * D * D, 64 * kb, 32 * nb, 32 * nb, scr, lane); done = true; break; } r -= I_Q;
                    if (r < I_UP) { const int kb = r >> 7, nb = r & 127; p0_transpose_item(w_up + (size_t)l * D * FF, D, FF, WUP + (size_t)l * FF * D, 64 * kb, 32 * nb, 32 * nb, scr, lane, g_ffn + l * D); done = true; break; } r -= I_UP;
                    if (r < I_DN) { const int kb = r >> 5, nb = r & 31; p0_transpose_item(w_down + (size_t)l * FF * D, FF, D, WDN + (size_t)l * D * FF, 64 * kb, 32 * nb, 32 * nb, scr, lane); done = true; break; } r -= I_DN;
                }
                if (done) continue;
                if (r < I_IN) { const int kb = r / 96, nb = r % 96; p0_transpose_item(w_conv_in, D, 3072, WIN, 64 * kb, 32 * nb, win_dest_row(32 * nb), scr, lane, g_mix + D); continue; } r -= I_IN;
                { const int kb = r >> 5, nb = r & 31; p0_transpose_item(w_conv_out, D, D, WOUT, 64 * kb, 32 * nb, 32 * nb, scr, lane); }
            }
        }
        for (int m = gw; m < MEMROWS; m += NGW) {
            const f32x4* xr = (const f32x4*)(mem_prompt + (size_t)m * D) + lane; f32x4 v[4]; float s = 0.f;
#pragma unroll
            for (int j = 0; j < 4; ++j) { v[j] = __builtin_nontemporal_load(xr + 64 * j); s += (v[j][0] * v[j][0] + v[j][1] * v[j][1]) + (v[j][2] * v[j][2] + v[j][3] * v[j][3]); }
            const float rstd = __builtin_amdgcn_rsqf(wave_sum(s) * (1.f / D) + EPS);
#pragma unroll
            for (int l = 0; l < 2; ++l) { v2u* o8 = (v2u*)(MN + ((size_t)l * MEMROWS + m) * D) + lane;
#pragma unroll
                for (int j = 0; j < 4; ++j) { const f32x4 gg = *((const f32x4*)(g_mem + l * D) + lane + 64 * j); const f32x4 w = v[j] * rstd * gg; v2u o; o.x = pk2(w[0], w[1]); o.y = pk2(w[2], w[3]); o8[64 * j] = o; } }
        }
        for (int m = gw; m < 2 * D; m += NGW) {
            const float gk = g_attn[m]; const f32x4* xr = (const f32x4*)(w_q + (size_t)m * D) + lane; v2u* o8 = (v2u*)(WQN + (size_t)m * D) + lane;
            f32x4 v[4];
#pragma unroll
            for (int j = 0; j < 4; ++j) v[j] = __builtin_nontemporal_load(xr + 64 * j);
#pragma unroll
            for (int j = 0; j < 4; ++j) { const f32x4 w = v[j] * gk; v2u o; o.x = pk2(w[0], w[1]); o.y = pk2(w[2], w[3]); o8[64 * j] = o; }
        }
        for (int it = gw; it < MS * 4; it += NGW) {
            const int b = it >> 2, g = it & 3, c4 = g * 256 + lane * 4;
            const f32x4* xr = (const f32x4*)(x_sample + (size_t)b * D) + lane; float s = 0.f;
#pragma unroll
            for (int j = 0; j < 4; ++j) { const f32x4 v = xr[64 * j]; s += (v[0] * v[0] + v[1] * v[1]) + (v[2] * v[2] + v[3] * v[3]); }
            const float rstd = __builtin_amdgcn_rsqf(wave_sum(s) * (1.f / D) + EPS);
            const f32x4 u = *(const f32x4*)(x_sample + (size_t)b * D + c4) * rstd * *(const f32x4*)(g_mix + c4);
            const int W = 2 << g; f32x4 S = u;
            const float* sp = state_pool + (size_t)b * 15 * D + c4;
            float* po = out + OPS + (size_t)b * 15 * D + c4;
            f32x4 sv[15];
#pragma unroll
            for (int r = 0; r < 15; ++r) sv[r] = __builtin_nontemporal_load((const f32x4*)(sp + (size_t)r * D));
#pragma unroll
            for (int r = 0; r < 15; ++r) { if (r >= 16 - W) S += sv[r]; if (r >= 1) *(f32x4*)(po + (size_t)(r - 1) * D) = sv[r]; }
            *(f32x4*)(po + (size_t)14 * D) = u;
            const f32x4 p = S * (1.0f / (float)W) - u; v2u o; o.x = pk2(p[0], p[1]); o.y = pk2(p[2], p[3]); *(v2u*)(P0S + (size_t)b * D + c4) = o;
        }
        __syncthreads();
        {
            LAS float* rs = (LAS float*)(L + RING_OFF);
            for (int it = vcu; it < BATCH * (SEQ / 32); it += G) {
                const int b = it >> 6, t0 = (it & 63) * 32;
                { f32x4 xv[6][4];
#pragma unroll
                  for (int j = 0; j < 6; ++j) { const int r = wave + 8 * j, t = t0 - 15 + r; const bool ok = (r < 47) && (t >= 0);
                      const f32x4* xr = (const f32x4*)(x_prompt + ((size_t)b * SEQ + (ok ? t : t0)) * D) + lane;
#pragma unroll
                      for (int q = 0; q < 4; ++q) xv[j][q] = xr[64 * q]; }
#pragma unroll
                  for (int j = 0; j < 6; ++j) { const int r = wave + 8 * j, t = t0 - 15 + r; float s = 0.f;
#pragma unroll
                      for (int q = 0; q < 4; ++q) { const f32x4 v = xv[j][q]; s += (v[0] * v[0] + v[1] * v[1]) + (v[2] * v[2] + v[3] * v[3]); }
                      const float rv = (t >= 0) ? __builtin_amdgcn_rsqf(wave_sum(s) * (1.f / D) + EPS) : 0.f;
                      if (lane == 0 && r < 47) rs[r] = rv; } }
                LDS_WAIT(); __syncthreads();
                const int g = wave & 3, tA = t0 + (wave >> 2) * 16, c4 = g * 256 + lane * 4;
                const float* xb = x_prompt + (size_t)b * SEQ * D + c4; const f32x4 g4 = *(const f32x4*)(g_mix + c4);
                bf16* pout = P0 + (size_t)b * SEQ * D + c4; float* poolout = out + OPP + (size_t)b * 15 * D + c4;
                const LAS float* rsw = rs + (wave >> 2) * 16;
                if (g == 0) pool_wave<2>(xb, rsw, g4, tA, pout, poolout); else if (g == 1) pool_wave<4>(xb, rsw, g4, tA, pout, poolout);
                else if (g == 2) pool_wave<8>(xb, rsw, g4, tA, pout, poolout); else pool_wave<16>(xb, rsw, g4, tA, pout, poolout);
                __syncthreads();
            }
        }
    }
    SEAM(0);

    if (IN(1)) { PH_BEGIN
        if (doP) { pg8::Gemm g{D, D, D}; pg8::KvOrder S{GS == 32 ? 16 : GS, (GS == 32 && mi >= 16) ? (1 << 20) : mi, grp, (const char*)MN, (const char*)WKV};
          pg8::EpiKV E{out + OMK, out + OMV, KB, VT};
          pg8::gemm_phase<pg8::EpiKV, pg8::KvOrder, true>(L + RING_OFF, g, S, E, TID_NOW); }
        if (doP) { pg8::Gemm g{D, 256, 256}; pg8::StaticOrder S;
          if (GS == 32) S.init(8, 4, 16, mi >= 16 ? mi - 16 : 1 << 20, grp * 8, P0, (size_t)256 * D * 2, WPOOL, (size_t)65536 * 2, (size_t)256 * 2);
          else S.init(8, 4, GS, mi, grp * 8, P0, (size_t)256 * D * 2, WPOOL, (size_t)65536 * 2, (size_t)256 * 2);
          pg8::EpiRes<true> E{x_prompt, X16, SSQ, pool_scale};
          pg8::gemm_phase<pg8::EpiRes<true>, pg8::StaticOrder, true>(L + RING_OFF, g, S, E, TID_NOW); }
        if (doS) { RELANE for (int cp = mi; cp < 32; cp += GS) s_res_unit<1>(P0S + (cp >> 3) * 256, D, WPOOL, 256, 256, cp, 16 * grp, x_sample, XS16, SSQS, pool_scale, L + RING_OFF, wave, lane); }
    }
    SEAM(1);

    if (IN(2)) { PH_BEGIN
        if (doS) { RELANE for (int cp = mi; cp < 32; cp += GS) s_q_unit(XS16, WQ, cp, 16 * grp, SSQS, QS, L + RING_OFF, wave, lane); }
        if (doP) for (int idx = mi; idx < 64; idx += GS) {
            const int ly = idx >> 5, kind = (idx >> 4) & 1, a = (idx >> 2) & 3, q = idx & 3;
            const bf16* Ap; const bf16* Bp; bf16* Op; pg8::Unit u; float sc;
            if (kind == 0) {
                Ap = KB + ((size_t)ly * MEMROWS + grp * 256) * D + a * 256; Bp = WQN + ((size_t)ly * D + 256 * q) * D + a * 256;
                Op = MT + (size_t)((ly * BATCH + grp) * NH + a) * 256 * D; u = pg8::Unit{0, q}; sc = QSCALE;
            } else {
                Ap = WO + ((size_t)ly * D + 256 * a) * D + q * 256; Bp = VT + ((size_t)ly * MEMROWS + grp * 256) * D + q * 256;
                Op = VW + (size_t)(ly * BATCH + grp) * D * D; u = pg8::Unit{a, q}; sc = 1.f;
            }
            pg8::Gemm g{D, D, 256}; pg8::SingleOrder S{u, (const char*)Ap, (const char*)Bp};
            pg8::EpiBf16 E{Op, D, sc};
            pg8::gemm_phase<pg8::EpiBf16, pg8::SingleOrder, true>(L + RING_OFF, g, S, E, TID_NOW);
            __syncthreads();
        }
    }
    {
        const int l = (st >= 7) ? 1 : 0, pb = l ? 10 : 3;
        {
            if (IN(7)) { PH_BEGIN
                const LAS float* rsdp = nullptr;
                if (doP && (GS & 7) == 0) { LAS float* t_ = (LAS float*)(L + RSD_OFF); rstd_table(SSQ, grp * 8 + (mi & 7), t_, tid); LDS_WAIT(); __syncthreads(); rsdp = t_; }
                if (doP) { pg8::Gemm g{D, D, D}; pg8::StaticOrder S; S.init(8, 12, GS, mi, grp * 8, X16, (size_t)256 * D * 2, WIN, (size_t)256 * D * 2);
                  pg8::EpiRow<2> E{OB, D, SSQ, 1.f, CH, out + OCP, rsdp};
                  pg8::gemm_phase<pg8::EpiRow<2>, pg8::StaticOrder, true>(L + RING_OFF, g, S, E, TID_NOW); }
                if (doS) { RELANE
                for (int c2 = mi; c2 < 32; c2 += GS) {
                    const int ca = 32 * c2, cb = ca + 16; const int ra = 1024 + (ca >> 7) * 256 + (ca & 127), rb = 1024 + (cb >> 7) * 256 + (cb & 127);
                    const int brow[6] = {ca, ra, ra + 128, cb, rb, rb + 128};
                    const float rs = srstd(SSQS, 16 * grp + (lane & 15), lane >> 4);
                    const int prow = 16 * grp + (lane & 15), pc = ((wave & 1) ? cb : ca) + 4 * (lane >> 4);
                    const f32x4 s0 = *(const f32x4*)(state_conv + ((size_t)prow * 2 + 0) * D + pc), s1 = *(const f32x4*)(state_conv + ((size_t)prow * 2 + 1) * D + pc);
                    const f32x4 w0 = *(const f32x4*)(w_conv + pc), w1 = *(const f32x4*)(w_conv + D + pc), w2 = *(const f32x4*)(w_conv + 2 * D + pc);
                    sgemm2<1, 6, 3, 4>(XS16, D, 16 * grp, WIN, D, brow, D, L + RING_OFF, wave, lane, [&](f32x4 (&a)[3], int row, int ct0, int fq) {
                        const int c0 = (ct0 == 0 ? ca : cb) + 4 * fq;
                        const f32x4 gb = a[0] * rs, chv = a[1] * a[2] * (rs * rs);
                        const f32x4 cv = s0 * w0 + s1 * w1 + chv * w2;
                        const unsigned g01 = pk2(gb[0], gb[1]), g23 = pk2(gb[2], gb[3]);
                        v2u o; o.x = pk2(bflo(g01) * cv[0], bfhi(g01) * cv[1]); o.y = pk2(bflo(g23) * cv[2], bfhi(g23) * cv[3]);
                        *(v2u*)(P0S + (size_t)row * D + c0) = o;
                        *(f32x4*)(out + OCS + ((size_t)row * 2 + 0) * D + c0) = s1; *(f32x4*)(out + OCS + ((size_t)row * 2 + 1) * D + c0) = chv; }); }
                }
            }
            SEAM(7);
            if (IN(8)) { PH_BEGIN
                const int gt = mi * NTHREADS + tid, NT = GS * NTHREADS;
                if (doP) for (int idx0 = gt; idx0 < SEQ * 128; idx0 += 4 * NT) {
                    v4u gb[4], c2[4], c1[4], c0[4];
#pragma unroll
                    for (int q = 0; q < 4; ++q) { const int idx = idx0 + q * NT; const bool ok = idx < SEQ * 128; const int t = ok ? (idx >> 7) : 0, row = grp * SEQ + t, c8 = (idx & 127) * 8;
                        gb[q] = __builtin_nontemporal_load((const v4u*)(OB + (size_t)row * D + c8)); c2[q] = *(const v4u*)(CH + (size_t)row * D + c8);
                        c1[q] = *(const v4u*)(CH + (size_t)(row - (t >= 1 ? 1 : 0)) * D + c8); c0[q] = *(const v4u*)(CH + (size_t)(row - (t >= 2 ? 2 : 0)) * D + c8); }
#pragma unroll
                    for (int q = 0; q < 4; ++q) { const int idx = idx0 + q * NT; if (idx >= SEQ * 128) break; const int t = idx >> 7, row = grp * SEQ + t, c8 = (idx & 127) * 8;
                        if (t < 1) c1[q] = (v4u){0u, 0u, 0u, 0u};
                        if (t < 2) c0[q] = (v4u){0u, 0u, 0u, 0u};
                        const f32x4 w0a = *(const f32x4*)(w_conv + c8), w0b = *(const f32x4*)(w_conv + c8 + 4), w1a = *(const f32x4*)(w_conv + D + c8), w1b = *(const f32x4*)(w_conv + D + c8 + 4),
                                    w2a = *(const f32x4*)(w_conv + 2 * D + c8), w2b = *(const f32x4*)(w_conv + 2 * D + c8 + 4);
                        v4u o;
#pragma unroll
                        for (int j = 0; j < 4; ++j) { const float wl0 = (j < 2) ? w0a[2 * j] : w0b[2 * j - 4], wh0 = (j < 2) ? w0a[2 * j + 1] : w0b[2 * j - 3];
                            const float wl1 = (j < 2) ? w1a[2 * j] : w1b[2 * j - 4], wh1 = (j < 2) ? w1a[2 * j + 1] : w1b[2 * j - 3];
                            const float wl2 = (j < 2) ? w2a[2 * j] : w2b[2 * j - 4], wh2 = (j < 2) ? w2a[2 * j + 1] : w2b[2 * j - 3];
                            const float lo_ = bflo(gb[q][j]) * (bflo(c0[q][j]) * wl0 + bflo(c1[q][j]) * wl1 + bflo(c2[q][j]) * wl2);
                            const float hi_ = bfhi(gb[q][j]) * (bfhi(c0[q][j]) * wh0 + bfhi(c1[q][j]) * wh1 + bfhi(c2[q][j]) * wh2);
                            o[j] = pk2(lo_, hi_); }
                        *(v4u*)(P0 + (size_t)row * D + c8) = o; }
                }
                if (doS) { for (int cp = mi; cp < 32; cp += GS) s_res_unit<4>(P0S, D, WOUT, D, D, cp, 16 * grp, nullptr, XS16, SSQS, nullptr, L + RING_OFF, wave, lane); }
            }
            SEAM(8);
            if (IN(9)) { PH_BEGIN
                if (doP) { pg8::Gemm g{D, D, D}; pg8::StaticOrder S; S.init(8, 4, GS, mi, grp * 8, P0, (size_t)256 * D * 2, WOUT, (size_t)256 * D * 2);
                  pg8::EpiRes<false> E{nullptr, X16, SSQ, nullptr};
                  pg8::gemm_phase<pg8::EpiRes<false>, pg8::StaticOrder, true>(L + RING_OFF, g, S, E, TID_NOW); }
                if (doS) { RELANE for (int cp = mi; cp < 32; cp += GS) s_q_unit(XS16, WQ + (size_t)D * D, cp, 16 * grp, SSQS, QS, L + RING_OFF, wave, lane); }
            }
            SEAM(9);
        }
#define LAYER_W const bf16* WQl = WQ + (size_t)l * D * D; const bf16* WOl = WO + (size_t)l * D * D; const bf16* WUPl = WUP + (size_t)l * FF * D; const bf16* WDNl = WDN + (size_t)l * D * FF; (void)WQl; (void)WOl; (void)WUPl; (void)WDNl;
        if (IN(pb)) { PH_BEGIN LAYER_W
#pragma unroll 1
            for (int half = 0; half < 2; ++half) {
            const bool sampleHalf = ((half == 0) == sfirst);
            if (doP && !sampleHalf) for (int itl = mi; itl < 32; itl += GS) {
                const int pm = grp * 8 + (itl >> 2), h = itl & 3;
                pg8::Gemm g{D, D, D}; pg8::SingleOrder S{{pm, h}, (const char*)(X16 + (size_t)pm * 256 * D), (const char*)(MT + (size_t)((l * BATCH + grp) * NH + h) * 256 * D)};
                pg8::EpiSoftmax E{OB, D, SSQ};
                pg8::gemm_phase<pg8::EpiSoftmax, pg8::SingleOrder, false>(L + RING_OFF, g, S, E, TID_NOW);
                LDS_WAIT(); __builtin_amdgcn_s_barrier(); asm volatile("" ::: "memory");
            }
            if (doS && sampleHalf) { RELANE
                LAS float* sc = (LAS float*)(L + RING_OFF);
                LAS float* po = (LAS float*)(L + RING_OFF + 1024);
                for (int it0 = mi; it0 < 64; it0 += 2 * GS) {
                    const bool pair = (it0 + GS < 64);
#pragma unroll 1
                    for (int iu = 0; iu < 2; ++iu) {
                        if (iu == 1 && !pair) break;
                        const int it = it0 + iu * GS, b = 16 * grp + (it >> 2), h = it & 3;
                        const f32x4 q4 = *(const f32x4*)(QS + (size_t)b * D + h * 256 + lane * 4);
                        const float* kp = cache_k + (((size_t)l * MS + b) * NMEM + wave * 32) * D + h * 256 + lane * 4;
                        const float* vp = cache_v + (((size_t)l * MS + b) * NMEM + wave * 32) * D + h * 256 + lane * 4;
                        f32x4 kv[32]; float p[32];
#pragma unroll
                        for (int n = 0; n < 32; ++n) kv[n] = __builtin_nontemporal_load((const f32x4*)(kp + (size_t)n * D));
#pragma unroll
                        for (int n = 0; n < 32; ++n) { p[n] = (q4[0] * kv[n][0] + q4[1] * kv[n][1]) + (q4[2] * kv[n][2] + q4[3] * kv[n][3]); kv[n] = __builtin_nontemporal_load((const f32x4*)(vp + (size_t)n * D)); }
                        treduce32(p, lane);
                        if ((lane & 1) == 0) sc[wave * 32 + (lane >> 1)] = p[0];
                        LDS_WAIT(); __builtin_amdgcn_s_barrier(); asm volatile("" ::: "memory");
                        float mx, sm = 0.f; const f32x4 sv = *(const LAS f32x4*)(sc + lane * 4);
                        mx = fmaxf(fmaxf(sv[0], sv[1]), fmaxf(sv[2], sv[3]));
                        mx = wave_max(mx);
#pragma unroll
                        for (int j = 0; j < 4; ++j) sm += __builtin_amdgcn_exp2f(sv[j] - mx);
                        sm = wave_sum(sm);
                        f32x4 acc = {0.f, 0.f, 0.f, 0.f};
#pragma unroll
                        for (int n = 0; n < 32; ++n) { const float pn_ = __builtin_amdgcn_exp2f(sc[wave * 32 + n] - mx); acc += kv[n] * pn_; }
                        *(LAS f32x4*)(po + wave * 256 + lane * 4) = acc;
                        LDS_WAIT(); __builtin_amdgcn_s_barrier(); asm volatile("" ::: "memory");
                        if (tid < 256) { float o = 0.f;
#pragma unroll
                            for (int w = 0; w < 8; ++w) o += po[w * 256 + tid];
                            OS[(size_t)b * D + h * 256 + tid] = (bf16)f2bf(o / sm); }
                        LDS_WAIT(); __builtin_amdgcn_s_barrier(); asm volatile("" ::: "memory");
                    }
                }
            }
            }
        }
        SEAM(pb);
        if (IN(pb + 1)) { PH_BEGIN LAYER_W
            if (doP) { pg8::Gemm g{D, D, D}; pg8::StaticOrder S; S.init(8, 4, GS, mi, grp * 8, OB, (size_t)256 * D * 2, VW + (size_t)(l * BATCH + grp) * D * D, (size_t)256 * D * 2);
              pg8::EpiRes<false> E{nullptr, X16, SSQ, nullptr};
              pg8::gemm_phase<pg8::EpiRes<false>, pg8::StaticOrder, true>(L + RING_OFF, g, S, E, TID_NOW); }
            if (doS) { RELANE for (int cp = mi; cp < 32; cp += GS) s_res_unit<4>(OS, D, WOl, D, D, cp, 16 * grp, nullptr, XS16, SSQS, nullptr, L + RING_OFF, wave, lane); }
        }
        SEAM(pb + 2);
        if (IN(pb + 2)) { PH_BEGIN LAYER_W
            const LAS float* rsdp = nullptr;
            if (doP && (GS & 7) == 0) { LAS float* t_ = (LAS float*)(L + RSD_OFF); rstd_table(SSQ, grp * 8 + (mi & 7), t_, tid); LDS_WAIT(); __syncthreads(); rsdp = t_; }
            if (doP) { pg8::Gemm g{D, D, D}; pg8::StaticOrder S; S.init(8, 16, GS, mi, grp * 8, X16, (size_t)256 * D * 2, WUPl, (size_t)256 * D * 2);
              pg8::EpiRow<1> E{HB, FF, SSQ, 1.f, nullptr, nullptr, rsdp};
              pg8::gemm_phase<pg8::EpiRow<1>, pg8::StaticOrder, true>(L + RING_OFF, g, S, E, TID_NOW); }
            if (doS) { RELANE for (int c8 = mi; c8 < 32; c8 += GS) { const int brow[8] = {128 * c8, 128 * c8 + 16, 128 * c8 + 32, 128 * c8 + 48, 128 * c8 + 64, 128 * c8 + 80, 128 * c8 + 96, 128 * c8 + 112};
                const float rs = srstd(SSQS, 16 * grp + (lane & 15), lane >> 4);
                sgemm2<1, 8, 1, 4>(XS16, D, 16 * grp, WUPl, D, brow, D, L + RING_OFF, wave, lane, [&](f32x4 (&a)[1], int row, int ct0, int fq) {
                    const f32x4 v0 = relu2(a[0] * rs);
                    v2u p0; p0.x = pk2(v0[0], v0[1]); p0.y = pk2(v0[2], v0[3]);
                    *(v2u*)(HS + (size_t)row * FF + 128 * c8 + 16 * ct0 + 4 * fq) = p0; }); } }
        }
        SEAM(pb + 3);
        if (IN(pb + 3)) { PH_BEGIN LAYER_W
            if (doP) { pg8::Gemm g{FF, FF, FF}; pg8::StaticOrder S; S.init(8, 4, GS, mi, grp * 8, HB, (size_t)256 * FF * 2, WDNl, (size_t)256 * FF * 2);
              pg8::EpiRes<false> E{nullptr, X16, SSQ, nullptr};
              pg8::gemm_phase<pg8::EpiRes<false>, pg8::StaticOrder, true>(L + RING_OFF, g, S, E, TID_NOW); }
            if (doS) { RELANE for (int cp = mi; cp < 32; cp += GS) s_res_unit<8>(HS, FF, WDNl, FF, FF, cp, 16 * grp, nullptr, XS16, SSQS, nullptr, L + RING_OFF, wave, lane); }
        }
        SEAM(pb + 4);
    }
    if (IN(14)) { PH_BEGIN
        const int mlo = doP ? 0 : SEQ, mhi = doS ? SEQ + 16 : SEQ;
        for (int ml0 = mlo + mi * NWAVES + wave; ml0 < mhi; ml0 += 4 * GS * NWAVES) {
            float sv[4]; v4u xw[4][2];
#pragma unroll
            for (int q = 0; q < 4; ++q) { const int ml = ml0 + q * GS * NWAVES; const bool ok = ml < mhi; const int mlc = ok ? ml : ml0;
                const bf16* xr;
                if (mlc < SEQ) { const int m = grp * SEQ + mlc; sv[q] = (lane < 16) ? SSQ[(size_t)m * 16 + lane] : 0.f; xr = X16 + (size_t)m * D; }
                else { const int r = 16 * grp + (mlc - SEQ); sv[q] = SSQS[r * 64 + lane]; xr = XS16 + (size_t)r * D; }
                xw[q][0] = __builtin_nontemporal_load((const v4u*)xr + lane); xw[q][1] = __builtin_nontemporal_load((const v4u*)xr + lane + 64); }
#pragma unroll
            for (int q = 0; q < 4; ++q) { const int ml = ml0 + q * GS * NWAVES; if (ml >= mhi) break;
                const float rs = __builtin_amdgcn_rsqf(wave_sum(sv[q]) * (1.f / D) + EPS);
                float* yr = (ml < SEQ) ? out + OY + (size_t)(grp * SEQ + ml) * D : out + OYS + (size_t)(16 * grp + (ml - SEQ)) * D;
#pragma unroll
                for (int j = 0; j < 2; ++j) { const v4u w = xw[q][j]; const f32x4 g0 = *((const f32x4*)g_final + 2 * (lane + 64 * j)), g1 = *((const f32x4*)g_final + 2 * (lane + 64 * j) + 1);
                    const f32x4 x0 = {bflo(w.x), bfhi(w.x), bflo(w.y), bfhi(w.y)}, x1 = {bflo(w.z), bfhi(w.z), bflo(w.w), bfhi(w.w)};
                    f32x4* yp = (f32x4*)yr + 2 * (lane + 64 * j); yp[0] = x0 * rs * g0; yp[1] = x1 * rs * g1; } }
        }
    }
    }
#if SELF_INIT && !MK_PER_PHASE
    if (ph == 0) {
        if (wave0 == 0 && lane_id_opaque() == 0) {
            unsigned sp_ = 0u;
            while (__hip_atomic_load(ctlw + CW_FLAG, __ATOMIC_RELAXED, __HIP_MEMORY_SCOPE_AGENT) != INIT_MAGIC) { __builtin_amdgcn_s_sleep(2); if (++sp_ > (1u << 22)) break; }
            (void)xb_add(&bar.bar[XB_XCNT(bar.x)], 1u); (void)xb_add(&gbar.bar[XB_XCNT(gbar.x)], 1u);
        }
    }
#endif
    if (ph + 1 < hi + soff) { if (ph == 0) { GRID_BAR();
#if STAGGER_TICKS > 0
            { const unsigned long long t0 = __builtin_amdgcn_s_memrealtime(); const unsigned long long dt = (unsigned long long)grp * STAGGER_TICKS;
              while (__builtin_amdgcn_s_memrealtime() - t0 < dt) __builtin_amdgcn_s_sleep(4); }
#endif
        } else GROUP_BAR(); }
    }
#if SELF_INIT && !MK_PER_PHASE
    if (bx == 0 && threadIdx.x == 0) __hip_atomic_store(ctlw + CW_FLAG, 0u, __ATOMIC_RELAXED, __HIP_MEMORY_SCOPE_AGENT);
#endif
#undef IN
#undef SEAM
#undef GRID_BAR
}

extern "C" void kernel_launch(void* const* d_in, const int* in_sizes, int n_in, void* d_out, int out_size, void* d_ws, size_t ws_size, hipStream_t stream) {
    static int grid = 0;
    if (grid == 0) {
        if (n_in != 22 || ws_size < WS_END) { fprintf(stderr, "kernel_launch: unexpected inputs (n_in %d, ws %zu)\n", n_in, ws_size); grid = -1; return; }
        int dev = 0, cus = 0, per_cu = 0;
        if (hipGetDevice(&dev) != hipSuccess || hipDeviceGetAttribute(&cus, hipDeviceAttributeMultiprocessorCount, dev) != hipSuccess) { grid = -1; return; }
        if (hipFuncSetAttribute((const void*)mk_fwd, hipFuncAttributeMaxDynamicSharedMemorySize, LDS_BYTES) != hipSuccess) { fprintf(stderr, "kernel_launch: hipFuncSetAttribute failed\n"); grid = -1; return; }
        if (hipOccupancyMaxActiveBlocksPerMultiprocessor(&per_cu, (const void*)mk_fwd, NTHREADS, LDS_BYTES) != hipSuccess || per_cu < 1)
            fprintf(stderr, "kernel_launch: note: occupancy query reports %d workgroups per CU\n", per_cu);
        (void)hipGetLastError();
        grid = cus;
    }
    if (grid < 0) return;
#if !SELF_INIT || MK_PER_PHASE
    (void)hipMemsetAsync((char*)d_ws + WS_CTL, 0, CTL_ZERO_BYTES, stream);
#endif
    Args a{};
    for (int i = 0; i < 22; ++i) a.in[i] = (const float*)d_in[i];
    a.out = (float*)d_out; a.ws = (unsigned char*)d_ws;
#if MK_PER_PHASE
    for (int p = 0; p < NPHASES; ++p) { a.ph_lo = p; a.ph_hi = p + 1; hipLaunchKernelGGL(mk_fwd, dim3(grid), dim3(NTHREADS), LDS_BYTES, stream, a); }
#else
    a.ph_lo = 0; a.ph_hi = NPHASES; hipLaunchKernelGGL(mk_fwd, dim3(grid), dim3(NTHREADS), LDS_BYTES, stream, a);
#endif
}
```

```cpp
#include <hip/hip_runtime.h>
#include <cstdio>
#include <cstdint>

#ifndef SAMPLE_SHIFT
#define SAMPLE_SHIFT 1
#endif
#ifndef SELF_INIT
#define SELF_INIT 1
#endif
#ifndef MEMBER_FLIP
#define MEMBER_FLIP 1
#endif
#ifndef MEMBER_FLIP_SEL
#define MEMBER_FLIP_SEL (mi & 1)
#endif
#ifndef STAGGER_TICKS
#define STAGGER_TICKS 0
#endif
#ifndef MK_PER_PHASE
#define MK_PER_PHASE 0
#endif

constexpr int D = 1024, BATCH = 8, SEQ = 2048, MP = BATCH * SEQ  , MS = 128  ;
constexpr int NMEM = 256, NH = 4, HD = 256, FF = 4096, MEMROWS = BATCH * NMEM  ;
constexpr float EPS = 1e-6f;
constexpr float QSCALE = 0.0625f * 1.4426950408889634f;

constexpr size_t OY = 0, OYS = 16777216, OPP = 16908288, OCP = 17031168, OMK = 17047552, OMV = 21241856, OPS = 25436160, OCS = 27402240;

__device__ __forceinline__ int lane_id_opaque() { int l; asm volatile("v_mbcnt_lo_u32_b32 %0, -1, 0\n\tv_mbcnt_hi_u32_b32 %0, -1, %0" : "=v"(l)); return l; }
#define SWZ_XOR(v, m) __builtin_bit_cast(float, __builtin_amdgcn_ds_swizzle(__builtin_bit_cast(int, (float)(v)), (((m) << 10) | 0x1f)))
__device__ __forceinline__ void swap32(float& a, float& b) { asm volatile("s_nop 1\n\tv_permlane32_swap_b32 %0, %1\n\ts_nop 1" : "+v"(a), "+v"(b)); }
__device__ __forceinline__ float add_x32(float v) { float a = v, b = v; swap32(a, b); return a + b; }
__device__ __forceinline__ float max_x32(float v) { float a = v, b = v; swap32(a, b); return fmaxf(a, b); }
__device__ __forceinline__ float add_x16_x32(float v) { v += SWZ_XOR(v, 16); return add_x32(v); }
__device__ __forceinline__ float max_x16_x32(float v) { v = fmaxf(v, SWZ_XOR(v, 16)); return max_x32(v); }
__device__ __forceinline__ float wave_sum(float v) { v += SWZ_XOR(v, 1); v += SWZ_XOR(v, 2); v += SWZ_XOR(v, 4); v += SWZ_XOR(v, 8); v += SWZ_XOR(v, 16); return add_x32(v); }
__device__ __forceinline__ float wave_max(float v) { v = fmaxf(v, SWZ_XOR(v, 1)); v = fmaxf(v, SWZ_XOR(v, 2)); v = fmaxf(v, SWZ_XOR(v, 4)); v = fmaxf(v, SWZ_XOR(v, 8)); v = fmaxf(v, SWZ_XOR(v, 16)); return max_x32(v); }

namespace pg8 {
#define PG8_LAS __attribute__((address_space(3)))
typedef unsigned short bf16_t;
typedef short bf16x8 __attribute__((ext_vector_type(8)));
typedef float f32x4 __attribute__((ext_vector_type(4)));
typedef float f32x2 __attribute__((ext_vector_type(2)));
typedef unsigned u32x4 __attribute__((ext_vector_type(4)));
typedef unsigned u32x2 __attribute__((ext_vector_type(2)));
constexpr int BM = 256, BK = 64, HALF = 128, HTB = HALF * BK * 2, STAGE_BYTES = 8 * HTB, NXCD = 8, WGM = 8;

__host__ __device__ __forceinline__ int lds_byte(int r, int c) { const int st = (r >> 4) * 2 + (c >> 5), rr = r & 15, cc = c & 31, ob = rr * 64 + cc * 2; return st * 1024 + (ob ^ (((ob >> 9) & 1) << 5)); }
__host__ __device__ __forceinline__ void stage_rc(int b, int& R, int& C) { const int st = b / 1024, sb = b % 1024, swz = sb ^ (((sb >> 9) & 1) << 5); R = (st >> 1) * 16 + swz / 64; C = (st & 1) * 32 + (swz % 64) / 2; }
__host__ __device__ __forceinline__ int perm32(int rho) { const int n = rho >> 4, i = rho & 15; return 8 * (i >> 2) + 4 * n + (i & 3); }

struct Unit { int pm, pn; };
struct Gemm { int lda, ldb, K; };

__device__ __forceinline__ unsigned cvt_pk_bf16(float lo, float hi) { unsigned r; asm volatile("v_cvt_pk_bf16_f32 %0, %1, %2" : "=v"(r) : "v"(lo), "v"(hi)); return r; }

struct StaticOrder {
    int nM, nN, nwg, G, c, pm0;
    const char* A; const char* B; size_t astep, bstep, apn;
    __device__ void init(int nM_, int nN_, int G_, int c_, int pm0_, const void* A_, size_t astep_, const void* B_, size_t bstep_, size_t apn_ = 0) {
        nM = nM_; nN = nN_; nwg = nM * nN; G = G_; c = c_; pm0 = pm0_; A = (const char*)A_; B = (const char*)B_; astep = astep_; bstep = bstep_; apn = apn_; }
    __device__ bool next(int i, Unit& u) const {
        const long L = (long)i * G + c; if (L >= nwg) return false;
        u.pm = pm0 + (int)(L % nM); u.pn = (int)(L / nM); return true;
    }
    __device__ __forceinline__ const char* aptr(const Unit& u) const { return A + (size_t)u.pm * astep + (size_t)u.pn * apn; }
    __device__ __forceinline__ const char* bptr(const Unit& u) const { return B + (size_t)u.pn * bstep; }
};
struct KvOrder {
    int G, c, batch; const char* A; const char* B;
    __device__ bool next(int i, Unit& u) const { const int L = i * G + c; if (L >= 16) return false; u.pm = (L >> 3) * 8 + batch; u.pn = L & 7; return true; }
    __device__ __forceinline__ const char* aptr(const Unit& u) const { return A + (size_t)u.pm * (256 * 1024 * 2); }
    __device__ __forceinline__ const char* bptr(const Unit& u) const { return B + (size_t)((u.pm >> 3) * 2048 + u.pn * 256) * (1024 * 2); }
};
struct SingleOrder {
    Unit u0; const char* A; const char* B;
    __device__ bool next(int i, Unit& u) const { if (i) return false; u = u0; return true; }
    __device__ __forceinline__ const char* aptr(const Unit&) const { return A; }
    __device__ __forceinline__ const char* bptr(const Unit&) const { return B; }
};


template <bool BASE32> struct EpiRes {
    static constexpr bool PERM = true, AFTER_DRAIN = false;
    const float* base32; bf16_t* x16; float* ssq; const float* cscale;
    __device__ __forceinline__ void operator()(const f32x4 (&acc)[2][2][4][2], const Unit& u, int wr, int wc, int fr, int fq) const {
        const int col0 = u.pn * BM + wc * 32 + 8 * fq;
        f32x4 cs[2][2];
#pragma unroll
        for (int bj = 0; bj < 2; ++bj)
#pragma unroll
            for (int n = 0; n < 2; ++n) cs[bj][n] = cscale ? *(const f32x4*)(cscale + col0 + bj * HALF + n * 4) : (f32x4){1.f, 1.f, 1.f, 1.f};
        constexpr int HSTEP = BASE32 ? 1 : 2;
#pragma unroll
        for (int a0 = 0; a0 < 2; a0 += HSTEP) {
        u32x4 bw[HSTEP][4][2]; f32x4 bf[BASE32 ? 1 : 1][4][2][2];
#pragma unroll
        for (int ah = 0; ah < HSTEP; ++ah)
#pragma unroll
            for (int m = 0; m < 4; ++m) { const int row = u.pm * BM + (a0 + ah) * HALF + wr * 64 + m * 16 + fr; const size_t off = (size_t)row * D + col0;
#pragma unroll
                for (int bj = 0; bj < 2; ++bj) {
                    if (BASE32) { bf[0][m][bj][0] = __builtin_nontemporal_load((const f32x4*)(base32 + off + bj * HALF)); bf[0][m][bj][1] = __builtin_nontemporal_load((const f32x4*)(base32 + off + bj * HALF + 4)); }
                    else bw[ah][m][bj] = *(const u32x4*)(x16 + off + bj * HALF); } }
#pragma unroll
        for (int ah = 0; ah < HSTEP; ++ah) { const int ai = a0 + ah;
#pragma unroll
            for (int m = 0; m < 4; ++m) { const int row = u.pm * BM + ai * HALF + wr * 64 + m * 16 + fr; const size_t off = (size_t)row * D + col0; float ss = 0.f;
#pragma unroll
                for (int bj = 0; bj < 2; ++bj) { f32x4 b0, b1;
                    if (BASE32) { b0 = bf[0][m][bj][0]; b1 = bf[0][m][bj][1]; }
                    else { const u32x4 w = bw[ah][m][bj];
                        b0 = (f32x4){__builtin_bit_cast(float, w.x << 16), __builtin_bit_cast(float, w.x & 0xffff0000u), __builtin_bit_cast(float, w.y << 16), __builtin_bit_cast(float, w.y & 0xffff0000u)};
                        b1 = (f32x4){__builtin_bit_cast(float, w.z << 16), __builtin_bit_cast(float, w.z & 0xffff0000u), __builtin_bit_cast(float, w.w << 16), __builtin_bit_cast(float, w.w & 0xffff0000u)}; }
                    const f32x4 v0 = b0 + acc[ai][bj][m][0] * cs[bj][0], v1 = b1 + acc[ai][bj][m][1] * cs[bj][1];
                    ss += ((v0[0] * v0[0] + v0[1] * v0[1]) + (v0[2] * v0[2] + v0[3] * v0[3])) + ((v1[0] * v1[0] + v1[1] * v1[1]) + (v1[2] * v1[2] + v1[3] * v1[3]));
                    u32x4 o; o.x = cvt_pk_bf16(v0[0], v0[1]); o.y = cvt_pk_bf16(v0[2], v0[3]); o.z = cvt_pk_bf16(v1[0], v1[1]); o.w = cvt_pk_bf16(v1[2], v1[3]);
                    *(u32x4*)(x16 + off + bj * HALF) = o; }
                ss = add_x16_x32(ss);
                if (fq == 0) ssq[(size_t)row * 16 + u.pn * 4 + wc] = ss; }
        }
        }
    }
};
__device__ __forceinline__ float rstd_from_ssq16(const float* ssq, int row) {
    const f32x4* sp = (const f32x4*)(ssq + (size_t)row * 16); const f32x4 s = (sp[0] + sp[1]) + (sp[2] + sp[3]);
    return __builtin_amdgcn_rsqf(((s[0] + s[1]) + (s[2] + s[3])) * (1.0f / D) + EPS);
}
template <int MODE> struct EpiRow {
    static constexpr bool PERM = true, AFTER_DRAIN = false;
    bf16_t* O; int ldc; const float* ssq; float scale; bf16_t* O2; float* convout; const PG8_LAS float* rsd;
    __device__ __forceinline__ void operator()(const f32x4 (&acc)[2][2][4][2], const Unit& u, int wr, int wc, int fr, int fq) const {
        const int colw = wc * 32 + 8 * fq;
        float rsv[2][4];
        if (rsd) {
#pragma unroll
          for (int ai = 0; ai < 2; ++ai)
#pragma unroll
              for (int m = 0; m < 4; ++m) rsv[ai][m] = rsd[ai * HALF + wr * 64 + m * 16 + fr];
        } else { f32x4 qv[2][4];
#pragma unroll
          for (int ai = 0; ai < 2; ++ai)
#pragma unroll
              for (int m = 0; m < 4; ++m) qv[ai][m] = *(const f32x4*)(ssq + (size_t)(u.pm * BM + ai * HALF + wr * 64 + m * 16 + fr) * 16 + 4 * fq);
#pragma unroll
          for (int ai = 0; ai < 2; ++ai)
#pragma unroll
              for (int m = 0; m < 4; ++m) { const f32x4 q = qv[ai][m]; rsv[ai][m] = __builtin_amdgcn_rsqf(add_x16_x32((q[0] + q[1]) + (q[2] + q[3])) * (1.0f / D) + EPS); } }
#pragma unroll
        for (int ai = 0; ai < 2; ++ai)
#pragma unroll
            for (int m = 0; m < 4; ++m) { const int row = u.pm * BM + ai * HALF + wr * 64 + m * 16 + fr; const float rs = rsv[ai][m];
                if (MODE == 2 && u.pn >= 4) {
                    const float r2 = rs * rs; const f32x4 v0 = acc[ai][0][m][0] * acc[ai][1][m][0] * r2, v1 = acc[ai][0][m][1] * acc[ai][1][m][1] * r2;
                    const int ch = (u.pn - 4) * 128 + colw;
                    u32x4 w; w.x = cvt_pk_bf16(v0[0], v0[1]); w.y = cvt_pk_bf16(v0[2], v0[3]); w.z = cvt_pk_bf16(v1[0], v1[1]); w.w = cvt_pk_bf16(v1[2], v1[3]);
                    *(u32x4*)(O2 + (size_t)row * D + ch) = w;
                    const int t = row & (SEQ - 1);
                    if (t >= SEQ - 2) { float* cp = convout + ((size_t)(row >> 11) * 2 + (t - (SEQ - 2))) * D + ch; *(f32x4*)cp = v0; *(f32x4*)(cp + 4) = v1; }
                } else {
                    const float sc = (MODE == 0) ? rs * scale : rs;
#pragma unroll
                    for (int bj = 0; bj < 2; ++bj) { f32x4 v0 = acc[ai][bj][m][0] * sc, v1 = acc[ai][bj][m][1] * sc;
                        if (MODE == 1) {
#pragma unroll
                            for (int j = 0; j < 4; ++j) { const float a = fmaxf(v0[j], 0.f), b = fmaxf(v1[j], 0.f); v0[j] = a * a; v1[j] = b * b; } }
                        u32x4 w; w.x = cvt_pk_bf16(v0[0], v0[1]); w.y = cvt_pk_bf16(v0[2], v0[3]); w.z = cvt_pk_bf16(v1[0], v1[1]); w.w = cvt_pk_bf16(v1[2], v1[3]);
                        *(u32x4*)(O + (size_t)row * ldc + u.pn * BM + bj * HALF + colw) = w; }
                } }
    }
};
struct EpiBf16 {
    static constexpr bool PERM = true, AFTER_DRAIN = false;
    bf16_t* O; int ldc; float scale;
    __device__ __forceinline__ void operator()(const f32x4 (&acc)[2][2][4][2], const Unit& u, int wr, int wc, int fr, int fq) const {
        const int colw = u.pn * BM + wc * 32 + 8 * fq;
#pragma unroll
        for (int ai = 0; ai < 2; ++ai)
#pragma unroll
            for (int m = 0; m < 4; ++m) { const int row = u.pm * BM + ai * HALF + wr * 64 + m * 16 + fr;
#pragma unroll
                for (int bj = 0; bj < 2; ++bj) { const f32x4 v0 = acc[ai][bj][m][0] * scale, v1 = acc[ai][bj][m][1] * scale;
                    u32x4 w; w.x = cvt_pk_bf16(v0[0], v0[1]); w.y = cvt_pk_bf16(v0[2], v0[3]); w.z = cvt_pk_bf16(v1[0], v1[1]); w.w = cvt_pk_bf16(v1[2], v1[3]);
                    *(u32x4*)(O + (size_t)row * ldc + colw + bj * HALF) = w; } }
    }
};
struct EpiKV {
    static constexpr bool PERM = false, AFTER_DRAIN = false;
    float* outk; float* outv; bf16_t* Kb; bf16_t* Vt;
    __device__ __forceinline__ void operator()(const f32x4 (&acc)[2][2][4][2], const Unit& u, int wr, int wc, int fr, int fq) const {
        const int layer = u.pm >> 3; const bool isV = u.pn >= 4; const int col0 = (u.pn & 3) * BM + wc * 32 + 4 * fq;
        float* outp = isV ? outv : outk;
#pragma unroll
        for (int ai = 0; ai < 2; ++ai)
#pragma unroll
            for (int m = 0; m < 4; ++m) { const int rowl = (u.pm & 7) * BM + ai * HALF + wr * 64 + m * 16 + fr; const size_t off = ((size_t)layer * MEMROWS + rowl) * D + col0;
#pragma unroll
                for (int bj = 0; bj < 2; ++bj)
#pragma unroll
                    for (int n = 0; n < 2; ++n) { const f32x4 v = acc[ai][bj][m][n]; *(f32x4*)(outp + off + bj * HALF + n * 16) = v;
                        if (!isV) { u32x2 p; p.x = cvt_pk_bf16(v[0], v[1]); p.y = cvt_pk_bf16(v[2], v[3]); *(u32x2*)(Kb + off + bj * HALF + n * 16) = p; }
                        else { u32x2 p; p.x = cvt_pk_bf16(v[0], v[1]); p.y = cvt_pk_bf16(v[2], v[3]); *(u32x2*)(Vt + off + bj * HALF + n * 16) = p; } } }
    }
};
struct EpiSoftmax {
    static constexpr bool PERM = true, AFTER_DRAIN = true;
    bf16_t* P; int ldp; const float* ssq;
    __device__ __forceinline__ void operator()(const f32x4 (&)[2][2][4][2], const Unit&, int, int, int, int) const {}
    __device__ __forceinline__ void fused(f32x4 (&acc)[2][2][4][2], const Unit& u, int wr, int wc, int fr, int fq, PG8_LAS unsigned char* lds, int wid, int lane) const {
        PG8_LAS float* Pm = (PG8_LAS float*)lds;
        PG8_LAS float* Ps = (PG8_LAS float*)(lds + 4096);
        float rsv[2][4];
        { f32x4 qv[2][4];
#pragma unroll
          for (int ai = 0; ai < 2; ++ai)
#pragma unroll
              for (int m = 0; m < 4; ++m) qv[ai][m] = *(const f32x4*)(ssq + (size_t)(u.pm * BM + ai * HALF + wr * 64 + m * 16 + fr) * 16 + 4 * fq);
#pragma unroll
          for (int ai = 0; ai < 2; ++ai)
#pragma unroll
              for (int m = 0; m < 4; ++m) { const f32x4 q = qv[ai][m]; rsv[ai][m] = __builtin_amdgcn_rsqf(add_x16_x32((q[0] + q[1]) + (q[2] + q[3])) * (1.0f / D) + EPS); } }
#pragma unroll
        for (int ai = 0; ai < 2; ++ai)
#pragma unroll
            for (int m = 0; m < 4; ++m) { float mx = -3.0e38f; const float rs = rsv[ai][m];
#pragma unroll
                for (int bj = 0; bj < 2; ++bj)
#pragma unroll
                    for (int n = 0; n < 2; ++n) { const f32x4 x = acc[ai][bj][m][n] * rs; acc[ai][bj][m][n] = x; mx = fmaxf(mx, fmaxf(fmaxf(x[0], x[1]), fmaxf(x[2], x[3]))); }
                mx = max_x16_x32(mx);
                if (fq == 0) Pm[(ai * HALF + wr * 64 + m * 16 + fr) * 4 + wc] = mx; }
        asm volatile("s_waitcnt lgkmcnt(0)" ::: "memory"); __builtin_amdgcn_s_barrier(); asm volatile("" ::: "memory");
#pragma unroll
        for (int ai = 0; ai < 2; ++ai)
#pragma unroll
            for (int m = 0; m < 4; ++m) { const int r = ai * HALF + wr * 64 + m * 16 + fr; const f32x4 q = *(const PG8_LAS f32x4*)(Pm + r * 4);
                const float mx = fmaxf(fmaxf(q[0], q[1]), fmaxf(q[2], q[3])); float s = 0.f;
#pragma unroll
                for (int bj = 0; bj < 2; ++bj)
#pragma unroll
                    for (int n = 0; n < 2; ++n) { f32x4 x = acc[ai][bj][m][n];
#pragma unroll
                        for (int j = 0; j < 4; ++j) { x[j] = __builtin_amdgcn_exp2f(x[j] - mx); s += x[j]; }
                        acc[ai][bj][m][n] = x; }
                s = add_x16_x32(s);
                if (fq == 0) Ps[r * 4 + wc] = s; }
        asm volatile("s_waitcnt lgkmcnt(0)" ::: "memory"); __builtin_amdgcn_s_barrier(); asm volatile("" ::: "memory");
        const int colw = u.pn * BM + wc * 32 + 8 * fq;
#pragma unroll
        for (int ai = 0; ai < 2; ++ai)
#pragma unroll
            for (int m = 0; m < 4; ++m) { const int r = ai * HALF + wr * 64 + m * 16 + fr; const f32x4 q = *(const PG8_LAS f32x4*)(Ps + r * 4);
                const float inv = __builtin_amdgcn_rcpf((q[0] + q[1]) + (q[2] + q[3]));
#pragma unroll
                for (int bj = 0; bj < 2; ++bj) { const f32x4 v0 = acc[ai][bj][m][0] * inv, v1 = acc[ai][bj][m][1] * inv;
                    u32x4 w; w.x = cvt_pk_bf16(v0[0], v0[1]); w.y = cvt_pk_bf16(v0[2], v0[3]); w.z = cvt_pk_bf16(v1[0], v1[1]); w.w = cvt_pk_bf16(v1[2], v1[3]);
                    *(u32x4*)(P + (size_t)(u.pm * BM + r) * ldp + bj * HALF + colw) = w; } }
    }
};

template <class Epi, class Sched, bool ALIGN_EPI>
__device__ __forceinline__ void gemm_phase(PG8_LAS unsigned char* lds, const Gemm g, const Sched& S, const Epi& E, int tid) {
    asm volatile("" : "+v"(tid));
    const int wid = __builtin_amdgcn_readfirstlane(tid >> 6), lane = tid & 63, wr = wid >> 2, wc = wid & 3, fr = lane & 15, fq = lane >> 4;
    const int nt = g.K / BK;
    unsigned voffA[2], voffB[2];
#pragma unroll
    for (int i = 0; i < 2; ++i) { int R, C; stage_rc(tid * 16 + i * 8192, R, C); const int Rb = Epi::PERM ? ((R & ~31) + perm32(R & 31)) : R;
        voffA[i] = (unsigned)(R * g.lda + C) * 2u; voffB[i] = (unsigned)(Rb * g.ldb + C) * 2u; }
    const size_t kstep = (size_t)(BK * 2);
    const size_t hstepA = (size_t)HALF * g.lda * 2, hstepB = (size_t)HALF * g.ldb * 2;
    const unsigned ldsw = (unsigned)wid * 1024u;
    const int aoff = lds_byte(wr * 64 + fr, fq * 8), boff = lds_byte(wc * 32 + fr, fq * 8);
#define PG8_SA(b, h) (((b) * 2 + (h)) * HTB)
#define PG8_SB(b, h) ((4 + (b) * 2 + (h)) * HTB)
#define PG8_STAGE(bufoff, gbase, voff) do { const char* _gb = (const char*)(gbase); asm volatile("" : "+s"(_gb));   \
        _Pragma("unroll") for (int _i = 0; _i < 2; ++_i) \
        __builtin_amdgcn_global_load_lds((const unsigned*)(_gb + (voff)[_i]), (PG8_LAS unsigned*)(lds + (bufoff) + ldsw + _i * 8192), 16, 0, 0); } while (0)
#define PG8_LDA(dst, b, h) do { _Pragma("unroll") for (int m = 0; m < 4; ++m) _Pragma("unroll") for (int k = 0; k < 2; ++k) dst[m][k] = *(const PG8_LAS bf16x8*)(lds + PG8_SA(b, h) + aoff + m * 2048 + k * 1024); } while (0)
#define PG8_LDB(dst, b, h) do { _Pragma("unroll") for (int n = 0; n < 2; ++n) _Pragma("unroll") for (int k = 0; k < 2; ++k) dst[n][k] = *(const PG8_LAS bf16x8*)(lds + PG8_SB(b, h) + boff + n * 2048 + k * 1024); } while (0)
#define PG8_MMA(ai, bj, At, Bt) do { __builtin_amdgcn_s_setprio(1); _Pragma("unroll") for (int m = 0; m < 4; ++m) _Pragma("unroll") for (int n = 0; n < 2; ++n) _Pragma("unroll") for (int k = 0; k < 2; ++k) \
        acc[ai][bj][m][n] = __builtin_amdgcn_mfma_f32_16x16x32_bf16(Bt[n][k], At[m][k], acc[ai][bj][m][n], 0, 0, 0); __builtin_amdgcn_s_setprio(0); } while (0)
#define PG8_WAIT_V(n) asm volatile("s_waitcnt vmcnt(" #n ")" ::: "memory")
#define PG8_WAIT_L(n) asm volatile("s_waitcnt lgkmcnt(" #n ")" ::: "memory")
#define PG8_BAR __builtin_amdgcn_s_barrier()
#define PG8_SCHED __builtin_amdgcn_sched_barrier(0)
    Unit cur, nxt; int ui = 0;
    if (!S.next(0, cur)) return;
    f32x4 acc[2][2][4][2];
#pragma unroll
    for (int a = 0; a < 2; ++a)
#pragma unroll
        for (int b = 0; b < 2; ++b)
#pragma unroll
            for (int m = 0; m < 4; ++m)
#pragma unroll
                for (int n = 0; n < 2; ++n) acc[a][b][m][n] = (f32x4){0.f, 0.f, 0.f, 0.f};
    bf16x8 At[4][2], B0[2][2], B1[2][2];
    const char* cA = S.aptr(cur); const char* cB = S.bptr(cur);
    PG8_STAGE(PG8_SB(0, 0), cB, voffB); PG8_STAGE(PG8_SB(0, 1), cB + hstepB, voffB); PG8_STAGE(PG8_SA(0, 0), cA, voffA); PG8_STAGE(PG8_SA(0, 1), cA + hstepA, voffA);
    if (wr == 1) PG8_BAR;
    PG8_WAIT_V(2); PG8_BAR;
    PG8_STAGE(PG8_SB(1, 0), cB + kstep, voffB); PG8_STAGE(PG8_SA(1, 0), cA + kstep, voffA); PG8_STAGE(PG8_SB(1, 1), cB + hstepB + kstep, voffB);
    PG8_WAIT_V(6); PG8_BAR;
    for (;;) {
        const bool has_next = S.next(ui + 1, nxt);
        const char* nA = has_next ? S.aptr(nxt) : cA; const char* nB = has_next ? S.bptr(nxt) : cB;
        for (int t = 0; t < nt; t += 2) {
            const bool last = (t == nt - 2);
            const char* a1 = cA + (size_t)(t + 1) * kstep;
            const char* a2 = last ? nA : cA + (size_t)(t + 2) * kstep; const char* b2 = last ? nB : cB + (size_t)(t + 2) * kstep;
            const char* a3 = a2 + kstep; const char* b3 = b2 + kstep;
            PG8_LDB(B0, 0, 0); PG8_LDB(B1, 0, 1); PG8_SCHED; PG8_LDA(At, 0, 0); PG8_STAGE(PG8_SA(1, 1), a1 + hstepA, voffA);
            PG8_WAIT_V(8); PG8_WAIT_L(0); PG8_BAR; PG8_MMA(0, 0, At, B0); PG8_MMA(0, 1, At, B1); PG8_BAR; PG8_SCHED;
            PG8_LDA(At, 0, 1); PG8_STAGE(PG8_SB(0, 0), b2, voffB); PG8_STAGE(PG8_SB(0, 1), b2 + hstepB, voffB); PG8_STAGE(PG8_SA(0, 0), a2, voffA);
            PG8_WAIT_V(8); PG8_WAIT_L(0); PG8_BAR; PG8_MMA(1, 0, At, B0); PG8_MMA(1, 1, At, B1); PG8_BAR; PG8_SCHED;
            PG8_LDB(B0, 1, 0); PG8_LDB(B1, 1, 1); PG8_SCHED; PG8_LDA(At, 1, 0); PG8_STAGE(PG8_SA(0, 1), a2 + hstepA, voffA);
            PG8_WAIT_V(8); PG8_WAIT_L(0); PG8_BAR; PG8_MMA(0, 0, At, B0); PG8_MMA(0, 1, At, B1); PG8_BAR; PG8_SCHED;
            PG8_LDA(At, 1, 1); PG8_STAGE(PG8_SB(1, 0), b3, voffB); PG8_STAGE(PG8_SB(1, 1), b3 + hstepB, voffB); PG8_STAGE(PG8_SA(1, 0), a3, voffA);
            PG8_WAIT_V(8); PG8_WAIT_L(0); PG8_BAR; PG8_MMA(1, 0, At, B0); PG8_MMA(1, 1, At, B1); PG8_BAR; PG8_SCHED;
        }
        if constexpr (ALIGN_EPI) { if (wr == 0) PG8_BAR; }
        if constexpr (!Epi::AFTER_DRAIN) { const int l2 = lane_id_opaque(); E(acc, cur, wr, wc, l2 & 15, l2 >> 4); }
        if (!has_next) break;
#pragma unroll
        for (int a = 0; a < 2; ++a)
#pragma unroll
            for (int b = 0; b < 2; ++b)
#pragma unroll
                for (int m = 0; m < 4; ++m)
#pragma unroll
                    for (int n = 0; n < 2; ++n) acc[a][b][m][n] = (f32x4){0.f, 0.f, 0.f, 0.f};
        cur = nxt; cA = nA; cB = nB; ++ui;
        if constexpr (ALIGN_EPI) { if (wr == 1) PG8_BAR; }
    }
    PG8_WAIT_V(0);
    if constexpr (!ALIGN_EPI) { if (wr == 0) PG8_BAR; }
    PG8_BAR;
    if constexpr (Epi::AFTER_DRAIN) { const int l2 = lane_id_opaque(); E.fused(acc, cur, wr, wc, l2 & 15, l2 >> 4, lds, wid, l2); }
#undef PG8_SA
#undef PG8_SB
#undef PG8_STAGE
#undef PG8_LDA
#undef PG8_LDB
#undef PG8_MMA
#undef PG8_WAIT_V
#undef PG8_WAIT_L
#undef PG8_BAR
#undef PG8_SCHED
}
}

constexpr int NWAVES = 8, NTHREADS = 512;
constexpr size_t MiB = 1u << 20;
constexpr size_t WS_CTL = 0, CTL_ZERO_BYTES = 256 * 1024;
constexpr size_t WS_WPOOL = 1 * MiB;
constexpr size_t WS_WQ = 2 * MiB;
constexpr size_t WS_WO = 6 * MiB;
constexpr size_t WS_WKV = 10 * MiB;
constexpr size_t WS_WUP = 18 * MiB;
constexpr size_t WS_WDN = 34 * MiB;
constexpr size_t WS_WIN = 50 * MiB;
constexpr size_t WS_WOUT = 56 * MiB;
constexpr size_t WS_MN = 58 * MiB;
constexpr size_t WS_KB = 66 * MiB;
constexpr size_t WS_VT = 74 * MiB;
constexpr size_t WS_SSQ = 82 * MiB;
constexpr size_t WS_SMALL = 84 * MiB;
constexpr size_t WS_X = 96 * MiB;
constexpr size_t WS_XG = 160 * MiB;
constexpr size_t WS_P0 = 192 * MiB;
constexpr size_t WS_O = 224 * MiB;
constexpr size_t WS_CH = 256 * MiB;
constexpr size_t WS_PS = 288 * MiB;
constexpr size_t WS_H = 320 * MiB;
constexpr size_t WS_WQN = 448 * MiB;
constexpr size_t WS_MT = 452 * MiB;
constexpr size_t WS_VW = 484 * MiB;
constexpr size_t WS_END = 516 * MiB;
constexpr size_t SS_X = WS_SMALL;
constexpr size_t SS_XG = SS_X + 512 * 1024;
constexpr size_t SS_SSQ = SS_XG + 256 * 1024;
constexpr size_t SS_P0 = SS_SSQ + 32 * 1024;
constexpr size_t SS_O = SS_P0 + 256 * 1024;
constexpr size_t SS_CH = SS_O + 256 * 1024;
constexpr size_t SS_H = SS_CH + 512 * 1024;
constexpr size_t SS_Q = SS_H + 1024 * 1024;
static_assert(SS_Q + 512 * 1024 <= WS_X, "sample buffers");
constexpr int CW_FLAG = 0;
constexpr unsigned INIT_MAGIC = 0x5eed1357u;
constexpr int CW_BAR = 4096, CW_BAR_STRIDE = 4096;

constexpr int RING_OFF = 0, RING_BYTES = 131072;
constexpr int LDSCTL_OFF = RING_BYTES, MISC_OFF = LDSCTL_OFF + 320;
constexpr int RSD_OFF = RING_BYTES + 1024;
constexpr int LDS_BYTES = 147456;

#define GAS __attribute__((address_space(1)))
#define LAS __attribute__((address_space(3)))
typedef unsigned short bf16;
typedef unsigned v4u __attribute__((ext_vector_type(4)));
typedef unsigned v2u __attribute__((ext_vector_type(2)));
typedef float f32x4 __attribute__((ext_vector_type(4)));
typedef short bf16x8 __attribute__((ext_vector_type(8)));
#define LDS_WAIT() asm volatile("s_waitcnt lgkmcnt(0)" ::: "memory")
#define VM_WAIT() asm volatile("s_waitcnt vmcnt(0)" ::: "memory")
__device__ __forceinline__ unsigned f2bf(float f) { unsigned u = __builtin_bit_cast(unsigned, f); return (u + 0x7fffu + ((u >> 16) & 1u)) >> 16; }
__device__ __forceinline__ unsigned pk2(float lo, float hi) { return f2bf(lo) | (f2bf(hi) << 16); }
__device__ __forceinline__ float bf2f(unsigned short h) { return __builtin_bit_cast(float, (unsigned)h << 16); }
__device__ __forceinline__ float bflo(unsigned w) { return __builtin_bit_cast(float, w << 16); }
__device__ __forceinline__ float bfhi(unsigned w) { return __builtin_bit_cast(float, w & 0xffff0000u); }

#define XB_TMO      128
#define XB_XCNT(j)  (256  + 64 * (j))
#define XB_XSUB(j)  (1280 + 64 * (j))
#define XB_XGEN(j)  (2304 + 64 * (j))
#define XB_TOP      3328
#define XB_TOPGEN   3392
#define XCD_BAR_WORDS 3456
#define XB_SPIN_CAP (1u << 18)
__device__ __forceinline__ unsigned xb_ld(unsigned* p)              { return __hip_atomic_load(p, __ATOMIC_RELAXED, __HIP_MEMORY_SCOPE_AGENT); }
__device__ __forceinline__ unsigned xb_add(unsigned* p, unsigned v) { return __hip_atomic_fetch_add(p, v, __ATOMIC_RELAXED, __HIP_MEMORY_SCOPE_AGENT); }
__device__ __forceinline__ unsigned xb_xcc_id() { return (unsigned)__builtin_amdgcn_s_getreg((3 << 11) | 20) & 0xFu; }
#define XB_SPIN(cond, bar) do { unsigned _sp = 0; while (cond) { __builtin_amdgcn_s_sleep(1); \
    if ((++_sp & 255u) == 0u) { if (xb_ld(&(bar)[XB_TMO])) break; if (_sp > XB_SPIN_CAP) { atomicAdd(&(bar)[XB_TMO], 1u); break; } } } } while (0)
struct XcdBarrier { unsigned* bar; unsigned x; volatile LAS unsigned* st; unsigned gsize; };
__device__ __forceinline__ XcdBarrier xcd_barrier_post(unsigned* bar, volatile LAS unsigned* st, unsigned gsize) {
    XcdBarrier b; b.bar = bar; b.x = xb_xcc_id(); b.st = st; b.gsize = gsize;
    if (threadIdx.x == 0) (void)xb_add(&bar[XB_XCNT(b.x)], 1u);
    return b;
}
__device__ __forceinline__ void xcd_barrier_complete(unsigned* bar, unsigned x, unsigned G, unsigned& nloc, unsigned& nx) {
    unsigned sum, cnt, mine, sp = 0u;
    for (;;) {
        sum = 0u; cnt = 0u; mine = 0u;
#pragma unroll
        for (unsigned j = 0; j < 16; ++j) { const unsigned c = xb_ld(&bar[XB_XCNT(j)]); sum += c; cnt += (c > 0u) ? 1u : 0u; mine = (j == x) ? c : mine; }
        if (sum == G) break;
        __builtin_amdgcn_s_sleep(1);
        if ((++sp & 255u) == 0u) { if (xb_ld(&bar[XB_TMO])) break; if (sp > XB_SPIN_CAP) { atomicAdd(&bar[XB_TMO], 1u); break; } }
    }
    nloc = mine > 0u ? mine : 1u; nx = cnt > 0u ? cnt : 1u;
}
__device__ __forceinline__ void xcd_barrier(const XcdBarrier& b, const int tid) {
    asm volatile("s_waitcnt vmcnt(0)" ::: "memory");
    __syncthreads();
    if (tid == 0) {
        unsigned* bar = b.bar; asm volatile("" : "+s"(bar));
        __builtin_amdgcn_s_waitcnt(0);
        unsigned nloc = b.st[0], nx = b.st[1];
        if (nloc == 0u) { xcd_barrier_complete(bar, b.x, b.gsize, nloc, nx); b.st[0] = nloc; b.st[1] = nx; }
        const unsigned old = xb_add(&bar[XB_XSUB(b.x)], 1u);
        const unsigned gen = old / nloc;
        if (old + 1u == (gen + 1u) * nloc) {
            if (nx > 1u) {
                __builtin_amdgcn_fence(__ATOMIC_RELEASE, "agent");
                asm volatile("s_waitcnt vmcnt(0)" ::: "memory");
                const unsigned og = xb_add(&bar[XB_TOP], 1u);
                const unsigned tg = og / nx;
                if (og + 1u == (tg + 1u) * nx) xb_add(&bar[XB_TOPGEN], 1u);
                else XB_SPIN(xb_ld(&bar[XB_TOPGEN]) == tg, bar);
            }
            xb_add(&bar[XB_XGEN(b.x)], 1u);
            __builtin_amdgcn_fence(__ATOMIC_ACQUIRE, "agent");
            asm volatile("s_waitcnt vmcnt(0)" ::: "memory");
        } else {
            XB_SPIN(xb_ld(&bar[XB_XGEN(b.x)]) == gen, bar);
            __builtin_amdgcn_fence(__ATOMIC_ACQUIRE, "agent");
            asm volatile("s_waitcnt vmcnt(0)" ::: "memory");
        }
    }
    __syncthreads();
}

__device__ __forceinline__ int opq_v(int x) { asm volatile("" : "+v"(x)); return x; }
struct Args { const float* in[22]; float* out; unsigned char* ws; int ph_lo, ph_hi; };


__device__ __forceinline__ void p0_transpose_item(const float* W, int K, int N, bf16* WT, int k0, int n0, int drow0, LAS float* scr, int lane, const float* gk = nullptr) {
    float v[32];
#pragma unroll
    for (int i = 0; i < 32; ++i) { const int kk = 2 * i + (lane >> 5); v[i] = __builtin_nontemporal_load(W + (size_t)(k0 + kk) * N + n0 + (lane & 31)); }
    if (gk) {
#pragma unroll
        for (int i = 0; i < 32; ++i) v[i] *= gk[k0 + 2 * i + (lane >> 5)]; }
#pragma unroll
    for (int i = 0; i < 32; ++i) scr[(2 * i + (lane >> 5)) * 33 + (lane & 31)] = v[i];
    LDS_WAIT(); asm volatile("" ::: "memory");
    const int c = lane & 7;
#pragma unroll
    for (int j = 0; j < 4; ++j) { const int n = (lane >> 3) + 8 * j; const LAS float* s = scr + (8 * c) * 33 + n;
        v4u o; o.x = pg8::cvt_pk_bf16(s[0 * 33], s[1 * 33]); o.y = pg8::cvt_pk_bf16(s[2 * 33], s[3 * 33]); o.z = pg8::cvt_pk_bf16(s[4 * 33], s[5 * 33]); o.w = pg8::cvt_pk_bf16(s[6 * 33], s[7 * 33]);
        *(GAS v4u*)(WT + (size_t)(drow0 + n) * K + k0 + 8 * c) = o; }
    LDS_WAIT(); asm volatile("" ::: "memory");
}
__device__ __forceinline__ int win_dest_row(int n) {
    if (n < 1024) return n;
    if (n < 2048) { const int ch = n - 1024; return 1024 + (ch >> 7) * 256 + (ch & 127); }
    const int ch = n - 2048; return 1024 + (ch >> 7) * 256 + 128 + (ch & 127);
}

template <int W>
__device__ __forceinline__ void pool_wave(const float* xb  , const LAS float* rs, f32x4 g4, int tA, bf16* pout  , float* poolout  ) {
    f32x4 xv[15 + W];
#pragma unroll
    for (int i = 16 - W; i < 31; ++i) { const int t = tA - 15 + i; xv[i - (16 - W)] = *(const f32x4*)(xb + (size_t)(t >= 0 ? t : 0) * D); }
    f32x4 ring[16]; f32x4 S = {0.f, 0.f, 0.f, 0.f};
#pragma unroll
    for (int i = 16 - W; i < 31; ++i) {
        const int t = tA - 15 + i;
        f32x4 u = {0.f, 0.f, 0.f, 0.f};
        if (t >= 0) u = xv[i - (16 - W)] * rs[i] * g4;
        S += u; if (i - W >= 16 - W) S -= ring[(i - W) & 15];
        ring[i & 15] = u;
        if (i >= 15) {
            const int cnt = (t + 1 < W) ? (t + 1) : W; const float ic = 1.0f / (float)cnt;
            const f32x4 p = S * ic - u; v2u o; o.x = pk2(p[0], p[1]); o.y = pk2(p[2], p[3]);
            *(v2u*)(pout + (size_t)t * D) = o;
            if (t >= SEQ - 15) *(f32x4*)(poolout + (size_t)(t - (SEQ - 15)) * D) = u;
        }
    }
}

template <int RT, int CT, int GR, int KS, class F>
__device__ __forceinline__ void sgemm2(const bf16* A, int lda, int row0, const bf16* Bt, int ldb, const int (&brow)[CT], int K, LAS unsigned char* red, int wave, int lane, const F& f) {
    const int fr = lane & 15, fq = lane >> 4, kw = K >> 3;
    const bf16* ap = A + (size_t)(row0 + fr) * lda + wave * kw + fq * 8;
    const bf16* bp[CT];
#pragma unroll
    for (int ct = 0; ct < CT; ++ct) bp[ct] = Bt + (size_t)(brow[ct] + fr) * ldb + wave * kw + fq * 8;
    f32x4 acc[RT][CT];
#pragma unroll
    for (int rt = 0; rt < RT; ++rt)
#pragma unroll
        for (int ct = 0; ct < CT; ++ct) acc[rt][ct] = (f32x4){0.f, 0.f, 0.f, 0.f};
#pragma unroll 1
    for (int k0 = 0; k0 < kw; k0 += 32 * KS) {
        bf16x8 a[KS][RT], b[KS][CT];
#pragma unroll
        for (int ks = 0; ks < KS; ++ks) {
#pragma unroll
            for (int rt = 0; rt < RT; ++rt) a[ks][rt] = *(const bf16x8*)(ap + (size_t)rt * 16 * lda + k0 + 32 * ks);
#pragma unroll
            for (int ct = 0; ct < CT; ++ct) b[ks][ct] = *(const bf16x8*)(bp[ct] + k0 + 32 * ks); }
#pragma unroll
        for (int ks = 0; ks < KS; ++ks)
#pragma unroll
            for (int rt = 0; rt < RT; ++rt)
#pragma unroll
                for (int ct = 0; ct < CT; ++ct) acc[rt][ct] = __builtin_amdgcn_mfma_f32_16x16x32_bf16(b[ks][ct], a[ks][rt], acc[rt][ct], 0, 0, 0);
    }
#pragma unroll
    for (int rt = 0; rt < RT; ++rt)
#pragma unroll
        for (int ct = 0; ct < CT; ++ct) *(LAS f32x4*)(red + ((((wave * RT + rt) * CT + ct) * 64 + lane) << 4)) = acc[rt][ct];
    LDS_WAIT(); __syncthreads();
    constexpr int NCG = CT / GR, NTASK = RT * NCG;
    for (int t = wave; t < NTASK; t += 8) {
        const int rt = t / NCG, cg = t % NCG;
        f32x4 sacc[GR];
#pragma unroll
        for (int g = 0; g < GR; ++g) { f32x4 tt = {0.f, 0.f, 0.f, 0.f};
#pragma unroll
            for (int w = 0; w < 8; ++w) tt += *(const LAS f32x4*)(red + ((((w * RT + rt) * CT + cg * GR + g) * 64 + lane) << 4));
            sacc[g] = tt; }
        f(sacc, row0 + 16 * rt + fr, cg * GR, fq);
    }
    __syncthreads();
}
__device__ __forceinline__ float srstd(const float* ssq, int row, int fq) {
    const f32x4* sp = (const f32x4*)(ssq + row * 64 + fq * 16); const f32x4 s = (sp[0] + sp[1]) + (sp[2] + sp[3]); float t = (s[0] + s[1]) + (s[2] + s[3]);
    t = add_x16_x32(t);
    return __builtin_amdgcn_rsqf(t * (1.0f / D) + EPS);
}
template <int KS> __device__ __forceinline__ void s_res_unit(const bf16* A, int lda, const bf16* Bt, int ldb, int K, int cp, int row0, const float* base32, bf16* xs16, float* ssq, const float* cscale, LAS unsigned char* red, int wave, int lane) {
    const int brow[2] = {32 * cp, 32 * cp + 16};
    const int myct = wave & 1, prow = row0 + (lane & 15), pc0 = 16 * (2 * cp + myct) + 4 * (lane >> 4); const size_t poff = (size_t)prow * D + pc0;
    f32x4 cs = {1.f, 1.f, 1.f, 1.f}; if (cscale) cs = *(const f32x4*)(cscale + pc0);
    f32x4 bpre; if (base32) bpre = *(const f32x4*)(base32 + poff); else { const v2u w = *(const v2u*)(xs16 + poff); bpre = (f32x4){bflo(w.x), bfhi(w.x), bflo(w.y), bfhi(w.y)}; }
    sgemm2<1, 2, 1, KS>(A, lda, row0, Bt, ldb, brow, K, red, wave, lane, [&](f32x4 (&a)[1], int row, int ct0, int fq) {
        const int ctile = 2 * cp + ct0, c0 = 16 * ctile + 4 * fq; const size_t off = (size_t)row * D + c0;
        const f32x4 v = bpre + a[0] * cs;
        float ss = (v[0] * v[0] + v[1] * v[1]) + (v[2] * v[2] + v[3] * v[3]);
        ss = add_x16_x32(ss);
        if (fq == 0) ssq[row * 64 + ctile] = ss;
        v2u p; p.x = pk2(v[0], v[1]); p.y = pk2(v[2], v[3]); *(v2u*)(xs16 + off) = p; });
}
__device__ __forceinline__ void s_q_unit(const bf16* xs16, const bf16* wq, int cp, int row0, const float* ssq, float* qs, LAS unsigned char* red, int wave, int lane) {
    const int brow[2] = {32 * cp, 32 * cp + 16};
    const float rs = srstd(ssq, row0 + (lane & 15), lane >> 4) * QSCALE;
    sgemm2<1, 2, 1, 4>(xs16, D, row0, wq, D, brow, D, red, wave, lane, [&](f32x4 (&a)[1], int row, int ct0, int fq) {
        *(f32x4*)(qs + (size_t)row * D + 32 * cp + 16 * ct0 + 4 * fq) = a[0] * rs; });
}
__device__ __forceinline__ f32x4 relu2(f32x4 v) {
#pragma unroll
    for (int j = 0; j < 4; ++j) { const float a = fmaxf(v[j], 0.f); v[j] = a * a; }
    return v;
}

__device__ __forceinline__ void rstd_table(const float* ssq, int pm, LAS float* rsd, int tid) {
    if (tid < 256) { const f32x4* sp = (const f32x4*)(ssq + (size_t)(pm * 256 + tid) * 16); const f32x4 q = (sp[0] + sp[1]) + (sp[2] + sp[3]);
        rsd[tid] = __builtin_amdgcn_rsqf(((q[0] + q[1]) + (q[2] + q[3])) * (1.0f / D) + EPS); }
}
__device__ __forceinline__ void treduce32(float (&p)[32], int lane) {
#pragma unroll
    for (int i = 0; i < 16; ++i) { swap32(p[i], p[i + 16]); p[i] += p[i + 16]; }
    { const bool b4 = (lane & 16) != 0;
#pragma unroll
      for (int i = 0; i < 8; ++i) { const float keep = b4 ? p[i + 8] : p[i], send = b4 ? p[i] : p[i + 8]; p[i] = keep + SWZ_XOR(send, 16); } }
    { const bool b3 = (lane & 8) != 0;
#pragma unroll
      for (int i = 0; i < 4; ++i) { const float keep = b3 ? p[i + 4] : p[i], send = b3 ? p[i] : p[i + 4]; p[i] = keep + SWZ_XOR(send, 8); } }
    { const bool b2 = (lane & 4) != 0;
#pragma unroll
      for (int i = 0; i < 2; ++i) { const float keep = b2 ? p[i + 2] : p[i], send = b2 ? p[i] : p[i + 2]; p[i] = keep + SWZ_XOR(send, 4); } }
    { const bool b1 = (lane & 2) != 0; const float keep = b1 ? p[1] : p[0], send = b1 ? p[0] : p[1]; p[0] = keep + SWZ_XOR(send, 2); }
    p[0] += SWZ_XOR(p[0], 1);
}
__device__ __forceinline__ void unpack16(const v4u a, const v4u b, float (&x)[16]) {
    x[0] = bflo(a.x); x[1] = bfhi(a.x); x[2] = bflo(a.y); x[3] = bfhi(a.y); x[4] = bflo(a.z); x[5] = bfhi(a.z); x[6] = bflo(a.w); x[7] = bfhi(a.w);
    x[8] = bflo(b.x); x[9] = bfhi(b.x); x[10] = bflo(b.y); x[11] = bfhi(b.y); x[12] = bflo(b.z); x[13] = bfhi(b.z); x[14] = bflo(b.w); x[15] = bfhi(b.w);
}

constexpr int NPHASES = 15;
__global__ void __launch_bounds__(NTHREADS, 2) mk_fwd(Args args) {
    extern __shared__ __attribute__((aligned(16))) unsigned char lds[];
    LAS unsigned char* L = (LAS unsigned char*)lds;
    volatile LAS unsigned* MISC = (volatile LAS unsigned*)(L + MISC_OFF);
    const int wave0 = __builtin_amdgcn_readfirstlane((int)threadIdx.x >> 6);
    const int G = gridDim.x; const int bx = blockIdx.x; const int vcu = (G % 8 == 0) ? (bx % 8) * (G / 8) + bx / 8 : bx;
    const int grp = bx & 7, mi = bx >> 3, GS = (G - grp + 7) >> 3;
    for (int u = threadIdx.x; u < (LDS_BYTES - LDSCTL_OFF) / 4; u += NTHREADS) ((LAS unsigned*)(L + LDSCTL_OFF))[u] = 0u;
    __syncthreads();
#if MK_PER_PHASE
#define GRID_BAR() do { } while (0)
#define GROUP_BAR() do { } while (0)
#else
#if SELF_INIT
    unsigned* const ctlw = (unsigned*)(args.ws + WS_CTL);
    XcdBarrier bar, gbar;
    bar.bar = ctlw + CW_BAR; bar.x = xb_xcc_id(); bar.st = MISC + 8; bar.gsize = (unsigned)G;
    gbar.bar = ctlw + CW_BAR + (1 + grp) * CW_BAR_STRIDE; gbar.x = bar.x; gbar.st = MISC + 10; gbar.gsize = (unsigned)GS;
    if (bx == 0) {
        const int t = (int)threadIdx.x;
        if (t < 9 * 51) { const int r = t / 51, k = t % 51;
            const int w = (k == 0) ? XB_TMO : (k <= 16) ? XB_XCNT(k - 1) : (k <= 32) ? XB_XSUB(k - 17) : (k <= 48) ? XB_XGEN(k - 33) : (k == 49) ? XB_TOP : XB_TOPGEN;
            __hip_atomic_store(ctlw + CW_BAR + r * CW_BAR_STRIDE + w, 0u, __ATOMIC_RELAXED, __HIP_MEMORY_SCOPE_AGENT); }
        asm volatile("s_waitcnt vmcnt(0)" ::: "memory");
        __syncthreads();
        if (t == 0) __hip_atomic_store(ctlw + CW_FLAG, INIT_MAGIC, __ATOMIC_RELAXED, __HIP_MEMORY_SCOPE_AGENT);
    }
#else
    XcdBarrier bar = xcd_barrier_post((unsigned*)(args.ws + WS_CTL) + CW_BAR, MISC + 8, (unsigned)G);
    XcdBarrier gbar = xcd_barrier_post((unsigned*)(args.ws + WS_CTL) + CW_BAR + (1 + grp) * CW_BAR_STRIDE, MISC + 10, (unsigned)GS);
#endif
#define GRID_BAR() xcd_barrier(bar, wave0 * 64 + lane_id_opaque())
#define GROUP_BAR() xcd_barrier(gbar, wave0 * 64 + lane_id_opaque())
#endif
    const int lo = args.ph_lo, hi = args.ph_hi;
#define IN(k) (st == (k))
#define SEAM(k) do { } while (0)
    const int NGW = G * NWAVES;
#define TID_NOW (wave0 * 64 + lane_id_opaque())
#define RELANE const int tid = wave0 * 64 + lane_id_opaque(), lane = tid & 63; (void)tid; (void)lane;
#define KA_PTR(T, off) (*(T const __attribute__((address_space(4)))*)(ka + (off)))
#define PH_BEGIN const int tid = wave0 * 64 + lane_id_opaque(), lane = tid & 63, wave = wave0, gw = vcu * NWAVES + wave; (void)lane; (void)gw; \
    const __attribute__((address_space(4))) char* ka = (const __attribute__((address_space(4))) char*)__builtin_amdgcn_kernarg_segment_ptr(); asm volatile("" : "+s"(ka)); \
    unsigned char* const ws = KA_PTR(unsigned char*, 184); float* const out = KA_PTR(float*, 176); (void)ws; (void)out; \
    const float* const x_prompt = KA_PTR(const float*, 0); const float* const x_sample = KA_PTR(const float*, 8); const float* const state_pool = KA_PTR(const float*, 16); const float* const state_conv = KA_PTR(const float*, 24); \
    const float* const cache_k = KA_PTR(const float*, 32); const float* const cache_v = KA_PTR(const float*, 40); const float* const mem_prompt = KA_PTR(const float*, 48); \
    const float* const g_mix = KA_PTR(const float*, 56); const float* const g_attn = KA_PTR(const float*, 64); const float* const g_mem = KA_PTR(const float*, 72); const float* const g_ffn = KA_PTR(const float*, 80); const float* const g_final = KA_PTR(const float*, 88); \
    const float* const w_pool = KA_PTR(const float*, 96); const float* const pool_scale = KA_PTR(const float*, 104); const float* const w_conv_in = KA_PTR(const float*, 112); const float* const w_conv = KA_PTR(const float*, 120); const float* const w_conv_out = KA_PTR(const float*, 128); \
    const float* const w_q = KA_PTR(const float*, 136); const float* const w_kv = KA_PTR(const float*, 144); const float* const w_o = KA_PTR(const float*, 152); const float* const w_up = KA_PTR(const float*, 160); const float* const w_down = KA_PTR(const float*, 168); \
    (void)x_prompt; (void)x_sample; (void)state_pool; (void)state_conv; (void)cache_k; (void)cache_v; (void)mem_prompt; (void)g_mix; (void)g_attn; (void)g_mem; (void)g_ffn; (void)g_final; (void)w_pool; (void)pool_scale; (void)w_conv_in; (void)w_conv; (void)w_conv_out; (void)w_q; (void)w_kv; (void)w_o; (void)w_up; (void)w_down; \
    bf16* const WPOOL = (bf16*)(ws + WS_WPOOL); bf16* const WQ = (bf16*)(ws + WS_WQ); bf16* const WO = (bf16*)(ws + WS_WO); bf16* const WKV = (bf16*)(ws + WS_WKV); \
    bf16* const WUP = (bf16*)(ws + WS_WUP); bf16* const WDN = (bf16*)(ws + WS_WDN); bf16* const WIN = (bf16*)(ws + WS_WIN); bf16* const WOUT = (bf16*)(ws + WS_WOUT); \
    bf16* const MN = (bf16*)(ws + WS_MN); bf16* const KB = (bf16*)(ws + WS_KB); bf16* const VT = (bf16*)(ws + WS_VT); float* const SSQ = (float*)(ws + WS_SSQ); \
    bf16* const X16 = (bf16*)(ws + WS_X); bf16* const P0 = (bf16*)(ws + WS_P0); bf16* const OB = (bf16*)(ws + WS_O); bf16* const CH = (bf16*)(ws + WS_CH); \
    bf16* const WQN = (bf16*)(ws + WS_WQN); bf16* const MT = (bf16*)(ws + WS_MT); bf16* const VW = (bf16*)(ws + WS_VW); bf16* const HB = (bf16*)(ws + WS_H); \
    bf16* const XS16 = (bf16*)(ws + SS_X); float* const SSQS = (float*)(ws + SS_SSQ); bf16* const P0S = (bf16*)(ws + SS_P0); bf16* const OS = (bf16*)(ws + SS_O); \
    float* const CHS = (float*)(ws + SS_CH); bf16* const HS = (bf16*)(ws + SS_H); float* const QS = (float*)(ws + SS_Q); \
    (void)WPOOL; (void)WQ; (void)WO; (void)WKV; (void)WUP; (void)WDN; (void)WIN; (void)WOUT; (void)MN; (void)KB; (void)VT; (void)SSQ; (void)X16; (void)P0; (void)OB; (void)CH; (void)WQN; (void)MT; (void)VW; (void)HB; (void)XS16; (void)SSQS; (void)P0S; (void)OS; (void)CHS; (void)HS; (void)QS;

#if MK_PER_PHASE
    const int soff = 0; const bool sfirst = false;
#else
    const int soff = SAMPLE_SHIFT ? (grp & 1) : 0;
    const bool sfirst = false;
#endif
    const int mflip = (MEMBER_FLIP && !MK_PER_PHASE) ? (MEMBER_FLIP_SEL) : 0;
#pragma unroll 1
    for (int ph = lo; ph < hi + soff; ++ph) {
#pragma unroll 1
    for (int pp = 0; pp < 2; ++pp) {
    const int which = pp ^ mflip;
    const int st = which ? ph - soff : ph;
    const bool doP = (which == 0), doS = (which == 1) || (st == 0);
    if (st < 0 || st >= NPHASES || (which == 1 && st == 0)) continue;
    if (IN(0)) { PH_BEGIN
        LAS float* scr = (LAS float*)(L + RING_OFF + wave * 16384);
        {
            constexpr int I_POOL = 4 * 4 * 8, I_Q = 16 * 32, I_KV = 16 * 64, I_UP = 16 * 128, I_DN = 64 * 32, I_IN = 16 * 96;
            constexpr int NITEMS = I_POOL + 2 * (I_Q + I_KV + I_Q + I_UP + I_DN) + I_IN + I_Q;
            for (int it = gw; it < NITEMS; it += NGW) {
                int r = it;
                if (r < I_POOL) { const int g = r >> 5, rr = r & 31, kb = rr >> 3, nb = rr & 7; p0_transpose_item(w_pool + g * 65536, 256, 256, WPOOL + g * 65536, 64 * kb, 32 * nb, 32 * nb, scr, lane); continue; } r -= I_POOL;
                bool done = false;
#pragma unroll 1
                for (int l = 0; l < 2 && !done; ++l) {
                    if (r < I_Q) { const int kb = r >> 5, nb = r & 31; p0_transpose_item(w_q + (size_t)l * D * D, D, D, WQ + (size_t)l * D * D, 64 * kb, 32 * nb, 32 * nb, scr, lane, g_attn + l * D); done = true; break; } r -= I_Q;
                    if (r < I_KV) { const int kb = r >> 6, nb = r & 63; p0_transpose_item(w_kv + (size_t)l * D * 2048, D, 2048, WKV + (size_t)l * 2048 * D, 64 * kb, 32 * nb, 32 * nb, scr, lane); done = true; break; } r -= I_KV;
                    if (r < I_Q) { const int kb = r >> 5, nb = r & 31; p0_transpose_item(w_o + (size_t)l * D * D, D, D, WO + (size_t)l * D * D, 64 * kb, 32 * nb, 32 * nb, scr, lane); done = true; break; } r -= I_Q;
                    if (r < I_UP) { const int kb = r >> 7, nb = r & 127; p0_transpose_item(w_up + (size_t)l * D * FF, D, FF, WUP + (size_t)l * FF * D, 64 * kb, 32 * nb, 32 * nb, scr, lane, g_ffn + l * D); done = true; break; } r -= I_UP;
                    if (r < I_DN) { const int kb = r >> 5, nb = r & 31; p0_transpose_item(w_down + (size_t)l * FF * D, FF, D, WDN + (size_t)l * D * FF, 64 * kb, 32 * nb, 32 * nb, scr, lane); done = true; break; } r -= I_DN;
                }
                if (done) continue;
                if (r < I_IN) { const int kb = r / 96, nb = r % 96; p0_transpose_item(w_conv_in, D, 3072, WIN, 64 * kb, 32 * nb, win_dest_row(32 * nb), scr, lane, g_mix + D); continue; } r -= I_IN;
                { const int kb = r >> 5, nb = r & 31; p0_transpose_item(w_conv_out, D, D, WOUT, 64 * kb, 32 * nb, 32 * nb, scr, lane); }
            }
        }
        for (int m = gw; m < MEMROWS; m += NGW) {
            const f32x4* xr = (const f32x4*)(mem_prompt + (size_t)m * D) + lane; f32x4 v[4]; float s = 0.f;
#pragma unroll
            for (int j = 0; j < 4; ++j) { v[j] = __builtin_nontemporal_load(xr + 64 * j); s += (v[j][0] * v[j][0] + v[j][1] * v[j][1]) + (v[j][2] * v[j][2] + v[j][3] * v[j][3]); }
            const float rstd = __builtin_amdgcn_rsqf(wave_sum(s) * (1.f / D) + EPS);
#pragma unroll
            for (int l = 0; l < 2; ++l) { v2u* o8 = (v2u*)(MN + ((size_t)l * MEMROWS + m) * D) + lane;
#pragma unroll
                for (int j = 0; j < 4; ++j) { const f32x4 gg = *((const f32x4*)(g_mem + l * D) + lane + 64 * j); const f32x4 w = v[j] * rstd * gg; v2u o; o.x = pk2(w[0], w[1]); o.y = pk2(w[2], w[3]); o8[64 * j] = o; } }
        }
        for (int m = gw; m < 2 * D; m += NGW) {
            const float gk = g_attn[m]; const f32x4* xr = (const f32x4*)(w_q + (size_t)m * D) + lane; v2u* o8 = (v2u*)(WQN + (size_t)m * D) + lane;
            f32x4 v[4];
#pragma unroll
            for (int j = 0; j < 4; ++j) v[j] = __builtin_nontemporal_load(xr + 64 * j);
#pragma unroll
            for (int j = 0; j < 4; ++j) { const f32x4 w = v[j] * gk; v2u o; o.x = pk2(w[0], w[1]); o.y = pk2(w[2], w[3]); o8[64 * j] = o; }
        }
        for (int it = gw; it < MS * 4; it += NGW) {
            const int b = it >> 2, g = it & 3, c4 = g * 256 + lane * 4;
            const f32x4* xr = (const f32x4*)(x_sample + (size_t)b * D) + lane; float s = 0.f;
#pragma unroll
            for (int j = 0; j < 4; ++j) { const f32x4 v = xr[64 * j]; s += (v[0] * v[0] + v[1] * v[1]) + (v[2] * v[2] + v[3] * v[3]); }
            const float rstd = __builtin_amdgcn_rsqf(wave_sum(s) * (1.f / D) + EPS);
            const f32x4 u = *(const f32x4*)(x_sample + (size_t)b * D + c4) * rstd * *(const f32x4*)(g_mix + c4);
            const int W = 2 << g; f32x4 S = u;
            const float* sp = state_pool + (size_t)b * 15 * D + c4;
            float* po = out + OPS + (size_t)b * 15 * D + c4;
            f32x4 sv[15];
#pragma unroll
            for (int r = 0; r < 15; ++r) sv[r] = __builtin_nontemporal_load((const f32x4*)(sp + (size_t)r * D));
#pragma unroll
            for (int r = 0; r < 15; ++r) { if (r >= 16 - W) S += sv[r]; if (r >= 1) *(f32x4*)(po + (size_t)(r - 1) * D) = sv[r]; }
            *(f32x4*)(po + (size_t)14 * D) = u;
            const f32x4 p = S * (1.0f / (float)W) - u; v2u o; o.x = pk2(p[0], p[1]); o.y = pk2(p[2], p[3]); *(v2u*)(P0S + (size_t)b * D + c4) = o;
        }
        __syncthreads();
        {
            LAS float* rs = (LAS float*)(L + RING_OFF);
            for (int it = vcu; it < BATCH * (SEQ / 32); it += G) {
                const int b = it >> 6, t0 = (it & 63) * 32;
                { f32x4 xv[6][4];
#pragma unroll
                  for (int j = 0; j < 6; ++j) { const int r = wave + 8 * j, t = t0 - 15 + r; const bool ok = (r < 47) && (t >= 0);
                      const f32x4* xr = (const f32x4*)(x_prompt + ((size_t)b * SEQ + (ok ? t : t0)) * D) + lane;
#pragma unroll
                      for (int q = 0; q < 4; ++q) xv[j][q] = xr[64 * q]; }
#pragma unroll
                  for (int j = 0; j < 6; ++j) { const int r = wave + 8 * j, t = t0 - 15 + r; float s = 0.f;
#pragma unroll
                      for (int q = 0; q < 4; ++q) { const f32x4 v = xv[j][q]; s += (v[0] * v[0] + v[1] * v[1]) + (v[2] * v[2] + v[3] * v[3]); }
                      const float rv = (t >= 0) ? __builtin_amdgcn_rsqf(wave_sum(s) * (1.f / D) + EPS) : 0.f;
                      if (lane == 0 && r < 47) rs[r] = rv; } }
                LDS_WAIT(); __syncthreads();
                const int g = wave & 3, tA = t0 + (wave >> 2) * 16, c4 = g * 256 + lane * 4;
                const float* xb = x_prompt + (size_t)b * SEQ * D + c4; const f32x4 g4 = *(const f32x4*)(g_mix + c4);
                bf16* pout = P0 + (size_t)b * SEQ * D + c4; float* poolout = out + OPP + (size_t)b * 15 * D + c4;
                const LAS float* rsw = rs + (wave >> 2) * 16;
                if (g == 0) pool_wave<2>(xb, rsw, g4, tA, pout, poolout); else if (g == 1) pool_wave<4>(xb, rsw, g4, tA, pout, poolout);
                else if (g == 2) pool_wave<8>(xb, rsw, g4, tA, pout, poolout); else pool_wave<16>(xb, rsw, g4, tA, pout, poolout);
                __syncthreads();
            }
        }
    }
    SEAM(0);

    if (IN(1)) { PH_BEGIN
        if (doP) { pg8::Gemm g{D, D, D}; pg8::KvOrder S{GS == 32 ? 16 : GS, (GS == 32 && mi >= 16) ? (1 << 20) : mi, grp, (const char*)MN, (const char*)WKV};
          pg8::EpiKV E{out + OMK, out + OMV, KB, VT};
          pg8::gemm_phase<pg8::EpiKV, pg8::KvOrder, true>(L + RING_OFF, g, S, E, TID_NOW); }
        if (doP) { pg8::Gemm g{D, 256, 256}; pg8::StaticOrder S;
          if (GS == 32) S.init(8, 4, 16, mi >= 16 ? mi - 16 : 1 << 20, grp * 8, P0, (size_t)256 * D * 2, WPOOL, (size_t)65536 * 2, (size_t)256 * 2);
          else S.init(8, 4, GS, mi, grp * 8, P0, (size_t)256 * D * 2, WPOOL, (size_t)65536 * 2, (size_t)256 * 2);
          pg8::EpiRes<true> E{x_prompt, X16, SSQ, pool_scale};
          pg8::gemm_phase<pg8::EpiRes<true>, pg8::StaticOrder, true>(L + RING_OFF, g, S, E, TID_NOW); }
        if (doS) { RELANE for (int cp = mi; cp < 32; cp += GS) s_res_unit<1>(P0S + (cp >> 3) * 256, D, WPOOL, 256, 256, cp, 16 * grp, x_sample, XS16, SSQS, pool_scale, L + RING_OFF, wave, lane); }
    }
    SEAM(1);

    if (IN(2)) { PH_BEGIN
        if (doS) { RELANE for (int cp = mi; cp < 32; cp += GS) s_q_unit(XS16, WQ, cp, 16 * grp, SSQS, QS, L + RING_OFF, wave, lane); }
        if (doP) for (int idx = mi; idx < 64; idx += GS) {
            const int ly = idx >> 5, kind = (idx >> 4) & 1, a = (idx >> 2) & 3, q = idx & 3;
            const bf16* Ap; const bf16* Bp; bf16* Op; pg8::Unit u; float sc;
            if (kind == 0) {
                Ap = KB + ((size_t)ly * MEMROWS + grp * 256) * D + a * 256; Bp = WQN + ((size_t)ly * D + 256 * q) * D + a * 256;
                Op = MT + (size_t)((ly * BATCH + grp) * NH + a) * 256 * D; u = pg8::Unit{0, q}; sc = QSCALE;
            } else {
                Ap = WO + ((size_t)ly * D + 256 * a) * D + q * 256; Bp = VT + ((size_t)ly * MEMROWS + grp * 256) * D + q * 256;
                Op = VW + (size_t)(ly * BATCH + grp) * D * D; u = pg8::Unit{a, q}; sc = 1.f;
            }
            pg8::Gemm g{D, D, 256}; pg8::SingleOrder S{u, (const char*)Ap, (const char*)Bp};
            pg8::EpiBf16 E{Op, D, sc};
            pg8::gemm_phase<pg8::EpiBf16, pg8::SingleOrder, true>(L + RING_OFF, g, S, E, TID_NOW);
            __syncthreads();
        }
    }
    {
        const int l = (st >= 7) ? 1 : 0, pb = l ? 10 : 3;
        {
            if (IN(7)) { PH_BEGIN
                const LAS float* rsdp = nullptr;
                if (doP && (GS & 7) == 0) { LAS float* t_ = (LAS float*)(L + RSD_OFF); rstd_table(SSQ, grp * 8 + (mi & 7), t_, tid); LDS_WAIT(); __syncthreads(); rsdp = t_; }
                if (doP) { pg8::Gemm g{D, D, D}; pg8::StaticOrder S; S.init(8, 12, GS, mi, grp * 8, X16, (size_t)256 * D * 2, WIN, (size_t)256 * D * 2);
                  pg8::EpiRow<2> E{OB, D, SSQ, 1.f, CH, out + OCP, rsdp};
                  pg8::gemm_phase<pg8::EpiRow<2>, pg8::StaticOrder, true>(L + RING_OFF, g, S, E, TID_NOW); }
                if (doS) { RELANE
                for (int c2 = mi; c2 < 32; c2 += GS) {
                    const int ca = 32 * c2, cb = ca + 16; const int ra = 1024 + (ca >> 7) * 256 + (ca & 127), rb = 1024 + (cb >> 7) * 256 + (cb & 127);
                    const int brow[6] = {ca, ra, ra + 128, cb, rb, rb + 128};
                    const float rs = srstd(SSQS, 16 * grp + (lane & 15), lane >> 4);
                    const int prow = 16 * grp + (lane & 15), pc = ((wave & 1) ? cb : ca) + 4 * (lane >> 4);
                    const f32x4 s0 = *(const f32x4*)(state_conv + ((size_t)prow * 2 + 0) * D + pc), s1 = *(const f32x4*)(state_conv + ((size_t)prow * 2 + 1) * D + pc);
                    const f32x4 w0 = *(const f32x4*)(w_conv + pc), w1 = *(const f32x4*)(w_conv + D + pc), w2 = *(const f32x4*)(w_conv + 2 * D + pc);
                    sgemm2<1, 6, 3, 4>(XS16, D, 16 * grp, WIN, D, brow, D, L + RING_OFF, wave, lane, [&](f32x4 (&a)[3], int row, int ct0, int fq) {
                        const int c0 = (ct0 == 0 ? ca : cb) + 4 * fq;
                        const f32x4 gb = a[0] * rs, chv = a[1] * a[2] * (rs * rs);
                        const f32x4 cv = s0 * w0 + s1 * w1 + chv * w2;
                        const unsigned g01 = pk2(gb[0], gb[1]), g23 = pk2(gb[2], gb[3]);
                        v2u o; o.x = pk2(bflo(g01) * cv[0], bfhi(g01) * cv[1]); o.y = pk2(bflo(g23) * cv[2], bfhi(g23) * cv[3]);
                        *(v2u*)(P0S + (size_t)row * D + c0) = o;
                        *(f32x4*)(out + OCS + ((size_t)row * 2 + 0) * D + c0) = s1; *(f32x4*)(out + OCS + ((size_t)row * 2 + 1) * D + c0) = chv; }); }
                }
            }
            SEAM(7);
            if (IN(8)) { PH_BEGIN
                const int gt = mi * NTHREADS + tid, NT = GS * NTHREADS;
                if (doP) for (int it0 = gt; it0 < (SEQ / 4) * 128; it0 += 2 * NT) {
                    v4u gb[2][4], cw[2][6];
#pragma unroll
                    for (int q = 0; q < 2; ++q) { const int it = it0 + q * NT; const bool ok = it < (SEQ / 4) * 128; const int t0 = ok ? (it >> 7) * 4 : 0, c8 = (it & 127) * 8; const size_t r0 = (size_t)grp * SEQ + t0;
#pragma unroll
                        for (int j = 0; j < 4; ++j) gb[q][j] = __builtin_nontemporal_load((const v4u*)(OB + (r0 + j) * D + c8));
#pragma unroll
                        for (int j = 0; j < 6; ++j) { const int dt = j - 2; cw[q][j] = *(const v4u*)(CH + (r0 + ((t0 + dt >= 0) ? dt : 0)) * D + c8); } }
#pragma unroll
                    for (int q = 0; q < 2; ++q) { const int it = it0 + q * NT; if (it >= (SEQ / 4) * 128) break; const int t0 = (it >> 7) * 4, c8 = (it & 127) * 8; const size_t r0 = (size_t)grp * SEQ + t0;
                        if (t0 == 0) { cw[q][0] = (v4u){0u, 0u, 0u, 0u}; cw[q][1] = (v4u){0u, 0u, 0u, 0u}; }
                        const f32x4 w0a = *(const f32x4*)(w_conv + c8), w0b = *(const f32x4*)(w_conv + c8 + 4), w1a = *(const f32x4*)(w_conv + D + c8), w1b = *(const f32x4*)(w_conv + D + c8 + 4),
                                    w2a = *(const f32x4*)(w_conv + 2 * D + c8), w2b = *(const f32x4*)(w_conv + 2 * D + c8 + 4);
#pragma unroll
                        for (int r = 0; r < 4; ++r) { v4u o;
#pragma unroll
                            for (int j = 0; j < 4; ++j) { const float wl0 = (j < 2) ? w0a[2 * j] : w0b[2 * j - 4], wh0 = (j < 2) ? w0a[2 * j + 1] : w0b[2 * j - 3];
                                const float wl1 = (j < 2) ? w1a[2 * j] : w1b[2 * j - 4], wh1 = (j < 2) ? w1a[2 * j + 1] : w1b[2 * j - 3];
                                const float wl2 = (j < 2) ? w2a[2 * j] : w2b[2 * j - 4], wh2 = (j < 2) ? w2a[2 * j + 1] : w2b[2 * j - 3];
                                const float lo_ = bflo(gb[q][r][j]) * (bflo(cw[q][r][j]) * wl0 + bflo(cw[q][r + 1][j]) * wl1 + bflo(cw[q][r + 2][j]) * wl2);
                                const float hi_ = bfhi(gb[q][r][j]) * (bfhi(cw[q][r][j]) * wh0 + bfhi(cw[q][r + 1][j]) * wh1 + bfhi(cw[q][r + 2][j]) * wh2);
                                o[j] = pk2(lo_, hi_); }
                            *(v4u*)(P0 + (r0 + r) * D + c8) = o; } }
                }
                if (doS) { for (int cp = mi; cp < 32; cp += GS) s_res_unit<4>(P0S, D, WOUT, D, D, cp, 16 * grp, nullptr, XS16, SSQS, nullptr, L + RING_OFF, wave, lane); }
            }
            SEAM(8);
            if (IN(9)) { PH_BEGIN
                if (doP) { pg8::Gemm g{D, D, D}; pg8::StaticOrder S; S.init(8, 4, GS, mi, grp * 8, P0, (size_t)256 * D * 2, WOUT, (size_t)256 * D * 2);
                  pg8::EpiRes<false> E{nullptr, X16, SSQ, nullptr};
                  pg8::gemm_phase<pg8::EpiRes<false>, pg8::StaticOrder, true>(L + RING_OFF, g, S, E, TID_NOW); }
                if (doS) { RELANE for (int cp = mi; cp < 32; cp += GS) s_q_unit(XS16, WQ + (size_t)D * D, cp, 16 * grp, SSQS, QS, L + RING_OFF, wave, lane); }
            }
            SEAM(9);
        }
#define LAYER_W const bf16* WQl = WQ + (size_t)l * D * D; const bf16* WOl = WO + (size_t)l * D * D; const bf16* WUPl = WUP + (size_t)l * FF * D; const bf16* WDNl = WDN + (size_t)l * D * FF; (void)WQl; (void)WOl; (void)WUPl; (void)WDNl;
        if (IN(pb)) { PH_BEGIN LAYER_W
#pragma unroll 1
            for (int half = 0; half < 2; ++half) {
            const bool sampleHalf = ((half == 0) == sfirst);
            if (doP && !sampleHalf) for (int itl = mi; itl < 32; itl += GS) {
                const int pm = grp * 8 + (itl >> 2), h = itl & 3;
                pg8::Gemm g{D, D, D}; pg8::SingleOrder S{{pm, h}, (const char*)(X16 + (size_t)pm * 256 * D), (const char*)(MT + (size_t)((l * BATCH + grp) * NH + h) * 256 * D)};
                pg8::EpiSoftmax E{OB, D, SSQ};
                pg8::gemm_phase<pg8::EpiSoftmax, pg8::SingleOrder, false>(L + RING_OFF, g, S, E, TID_NOW);
                LDS_WAIT(); __builtin_amdgcn_s_barrier(); asm volatile("" ::: "memory");
            }
            if (doS && sampleHalf) { RELANE
                LAS float* sc = (LAS float*)(L + RING_OFF);
                LAS float* po = (LAS float*)(L + RING_OFF + 1024);
                for (int it0 = mi; it0 < 64; it0 += 2 * GS) {
                    const bool pair = (it0 + GS < 64);
#pragma unroll 1
                    for (int iu = 0; iu < 2; ++iu) {
                        if (iu == 1 && !pair) break;
                        const int it = it0 + iu * GS, b = 16 * grp + (it >> 2), h = it & 3;
                        const f32x4 q4 = *(const f32x4*)(QS + (size_t)b * D + h * 256 + lane * 4);
                        const float* kp = cache_k + (((size_t)l * MS + b) * NMEM + wave * 32) * D + h * 256 + lane * 4;
                        const float* vp = cache_v + (((size_t)l * MS + b) * NMEM + wave * 32) * D + h * 256 + lane * 4;
                        f32x4 kv[32]; float p[32];
#pragma unroll
                        for (int n = 0; n < 32; ++n) kv[n] = __builtin_nontemporal_load((const f32x4*)(kp + (size_t)n * D));
#pragma unroll
                        for (int n = 0; n < 32; ++n) { p[n] = (q4[0] * kv[n][0] + q4[1] * kv[n][1]) + (q4[2] * kv[n][2] + q4[3] * kv[n][3]); kv[n] = __builtin_nontemporal_load((const f32x4*)(vp + (size_t)n * D)); }
                        treduce32(p, lane);
                        if ((lane & 1) == 0) sc[wave * 32 + (lane >> 1)] = p[0];
                        LDS_WAIT(); __builtin_amdgcn_s_barrier(); asm volatile("" ::: "memory");
                        float mx, sm = 0.f; const f32x4 sv = *(const LAS f32x4*)(sc + lane * 4);
                        mx = fmaxf(fmaxf(sv[0], sv[1]), fmaxf(sv[2], sv[3]));
                        mx = wave_max(mx);
#pragma unroll
                        for (int j = 0; j < 4; ++j) sm += __builtin_amdgcn_exp2f(sv[j] - mx);
                        sm = wave_sum(sm);
                        f32x4 acc = {0.f, 0.f, 0.f, 0.f};
#pragma unroll
                        for (int n = 0; n < 32; ++n) { const float pn_ = __builtin_amdgcn_exp2f(sc[wave * 32 + n] - mx); acc += kv[n] * pn_; }
                        *(LAS f32x4*)(po + wave * 256 + lane * 4) = acc;
                        LDS_WAIT(); __builtin_amdgcn_s_barrier(); asm volatile("" ::: "memory");
                        if (tid < 256) { float o = 0.f;
#pragma unroll
                            for (int w = 0; w < 8; ++w) o += po[w * 256 + tid];
                            OS[(size_t)b * D + h * 256 + tid] = (bf16)f2bf(o / sm); }
                        LDS_WAIT(); __builtin_amdgcn_s_barrier(); asm volatile("" ::: "memory");
                    }
                }
            }
            }
        }
        SEAM(pb);
        if (IN(pb + 1)) { PH_BEGIN LAYER_W
            if (doP) { pg8::Gemm g{D, D, D}; pg8::StaticOrder S; S.init(8, 4, GS, mi, grp * 8, OB, (size_t)256 * D * 2, VW + (size_t)(l * BATCH + grp) * D * D, (size_t)256 * D * 2);
              pg8::EpiRes<false> E{nullptr, X16, SSQ, nullptr};
              pg8::gemm_phase<pg8::EpiRes<false>, pg8::StaticOrder, true>(L + RING_OFF, g, S, E, TID_NOW); }
            if (doS) { RELANE for (int cp = mi; cp < 32; cp += GS) s_res_unit<4>(OS, D, WOl, D, D, cp, 16 * grp, nullptr, XS16, SSQS, nullptr, L + RING_OFF, wave, lane); }
        }
        SEAM(pb + 2);
        if (IN(pb + 2)) { PH_BEGIN LAYER_W
            const LAS float* rsdp = nullptr;
            if (doP && (GS & 7) == 0) { LAS float* t_ = (LAS float*)(L + RSD_OFF); rstd_table(SSQ, grp * 8 + (mi & 7), t_, tid); LDS_WAIT(); __syncthreads(); rsdp = t_; }
            if (doP) { pg8::Gemm g{D, D, D}; pg8::StaticOrder S; S.init(8, 16, GS, mi, grp * 8, X16, (size_t)256 * D * 2, WUPl, (size_t)256 * D * 2);
              pg8::EpiRow<1> E{HB, FF, SSQ, 1.f, nullptr, nullptr, rsdp};
              pg8::gemm_phase<pg8::EpiRow<1>, pg8::StaticOrder, true>(L + RING_OFF, g, S, E, TID_NOW); }
            if (doS) { RELANE for (int c8 = mi; c8 < 32; c8 += GS) { const int brow[8] = {128 * c8, 128 * c8 + 16, 128 * c8 + 32, 128 * c8 + 48, 128 * c8 + 64, 128 * c8 + 80, 128 * c8 + 96, 128 * c8 + 112};
                const float rs = srstd(SSQS, 16 * grp + (lane & 15), lane >> 4);
                sgemm2<1, 8, 1, 4>(XS16, D, 16 * grp, WUPl, D, brow, D, L + RING_OFF, wave, lane, [&](f32x4 (&a)[1], int row, int ct0, int fq) {
                    const f32x4 v0 = relu2(a[0] * rs);
                    v2u p0; p0.x = pk2(v0[0], v0[1]); p0.y = pk2(v0[2], v0[3]);
                    *(v2u*)(HS + (size_t)row * FF + 128 * c8 + 16 * ct0 + 4 * fq) = p0; }); } }
        }
        SEAM(pb + 3);
        if (IN(pb + 3)) { PH_BEGIN LAYER_W
            if (doP) { pg8::Gemm g{FF, FF, FF}; pg8::StaticOrder S; S.init(8, 4, GS, mi, grp * 8, HB, (size_t)256 * FF * 2, WDNl, (size_t)256 * FF * 2);
              pg8::EpiRes<false> E{nullptr, X16, SSQ, nullptr};
              pg8::gemm_phase<pg8::EpiRes<false>, pg8::StaticOrder, true>(L + RING_OFF, g, S, E, TID_NOW); }
            if (doS) { RELANE for (int cp = mi; cp < 32; cp += GS) s_res_unit<8>(HS, FF, WDNl, FF, FF, cp, 16 * grp, nullptr, XS16, SSQS, nullptr, L + RING_OFF, wave, lane); }
        }
        SEAM(pb + 4);
    }
    if (IN(14)) { PH_BEGIN
        const int mlo = doP ? 0 : SEQ, mhi = doS ? SEQ + 16 : SEQ;
        for (int ml0 = mlo + mi * NWAVES + wave; ml0 < mhi; ml0 += 4 * GS * NWAVES) {
            float sv[4]; v4u xw[4][2];
#pragma unroll
            for (int q = 0; q < 4; ++q) { const int ml = ml0 + q * GS * NWAVES; const bool ok = ml < mhi; const int mlc = ok ? ml : ml0;
                const bf16* xr;
                if (mlc < SEQ) { const int m = grp * SEQ + mlc; sv[q] = (lane < 16) ? SSQ[(size_t)m * 16 + lane] : 0.f; xr = X16 + (size_t)m * D; }
                else { const int r = 16 * grp + (mlc - SEQ); sv[q] = SSQS[r * 64 + lane]; xr = XS16 + (size_t)r * D; }
                xw[q][0] = __builtin_nontemporal_load((const v4u*)xr + lane); xw[q][1] = __builtin_nontemporal_load((const v4u*)xr + lane + 64); }
#pragma unroll
            for (int q = 0; q < 4; ++q) { const int ml = ml0 + q * GS * NWAVES; if (ml >= mhi) break;
                const float rs = __builtin_amdgcn_rsqf(wave_sum(sv[q]) * (1.f / D) + EPS);
                float* yr = (ml < SEQ) ? out + OY + (size_t)(grp * SEQ + ml) * D : out + OYS + (size_t)(16 * grp + (ml - SEQ)) * D;
#pragma unroll
                for (int j = 0; j < 2; ++j) { const v4u w = xw[q][j]; const f32x4 g0 = *((const f32x4*)g_final + 2 * (lane + 64 * j)), g1 = *((const f32x4*)g_final + 2 * (lane + 64 * j) + 1);
                    const f32x4 x0 = {bflo(w.x), bfhi(w.x), bflo(w.y), bfhi(w.y)}, x1 = {bflo(w.z), bfhi(w.z), bflo(w.w), bfhi(w.w)};
                    f32x4* yp = (f32x4*)yr + 2 * (lane + 64 * j); yp[0] = x0 * rs * g0; yp[1] = x1 * rs * g1; } }
        }
    }
    }
#if SELF_INIT && !MK_PER_PHASE
    if (ph == 0) {
        if (wave0 == 0 && lane_id_opaque() == 0) {
            unsigned sp_ = 0u;
            while (__hip_atomic_load(ctlw + CW_FLAG, __ATOMIC_RELAXED, __HIP_MEMORY_SCOPE_AGENT) != INIT_MAGIC) { __builtin_amdgcn_s_sleep(2); if (++sp_ > (1u << 22)) break; }
            (void)xb_add(&bar.bar[XB_XCNT(bar.x)], 1u); (void)xb_add(&gbar.bar[XB_XCNT(gbar.x)], 1u);
        }
    }
#endif
    if (ph + 1 < hi + soff) { if (ph == 0) { GRID_BAR();
#if STAGGER_TICKS > 0
            { const unsigned long long t0 = __builtin_amdgcn_s_memrealtime(); const unsigned long long dt = (unsigned long long)grp * STAGGER_TICKS;
              while (__builtin_amdgcn_s_memrealtime() - t0 < dt) __builtin_amdgcn_s_sleep(4); }
#endif
        } else GROUP_BAR(); }
    }
#if SELF_INIT && !MK_PER_PHASE
    if (bx == 0 && threadIdx.x == 0) __hip_atomic_store(ctlw + CW_FLAG, 0u, __ATOMIC_RELAXED, __HIP_MEMORY_SCOPE_AGENT);
#endif
#undef IN
#undef SEAM
#undef GRID_BAR
}

extern "C" void kernel_launch(void* const* d_in, const int* in_sizes, int n_in, void* d_out, int out_size, void* d_ws, size_t ws_size, hipStream_t stream) {
    static int grid = 0;
    if (grid == 0) {
        if (n_in != 22 || ws_size < WS_END) { fprintf(stderr, "kernel_launch: unexpected inputs (n_in %d, ws %zu)\n", n_in, ws_size); grid = -1; return; }
        int dev = 0, cus = 0, per_cu = 0;
        if (hipGetDevice(&dev) != hipSuccess || hipDeviceGetAttribute(&cus, hipDeviceAttributeMultiprocessorCount, dev) != hipSuccess) { grid = -1; return; }
        if (hipFuncSetAttribute((const void*)mk_fwd, hipFuncAttributeMaxDynamicSharedMemorySize, LDS_BYTES) != hipSuccess) { fprintf(stderr, "kernel_launch: hipFuncSetAttribute failed\n"); grid = -1; return; }
        if (hipOccupancyMaxActiveBlocksPerMultiprocessor(&per_cu, (const void*)mk_fwd, NTHREADS, LDS_BYTES) != hipSuccess || per_cu < 1)
            fprintf(stderr, "kernel_launch: note: occupancy query reports %d workgroups per CU\n", per_cu);
        (void)hipGetLastError();
        grid = cus;
    }
    if (grid < 0) return;
#if !SELF_INIT || MK_PER_PHASE
    (void)hipMemsetAsync((char*)d_ws + WS_CTL, 0, CTL_ZERO_BYTES, stream);
#endif
    Args a{};
    for (int i = 0; i < 22; ++i) a.in[i] = (const float*)d_in[i];
    a.out = (float*)d_out; a.ws = (unsigned char*)d_ws;
#if MK_PER_PHASE
    for (int p = 0; p < NPHASES; ++p) { a.ph_lo = p; a.ph_hi = p + 1; hipLaunchKernelGGL(mk_fwd, dim3(grid), dim3(NTHREADS), LDS_BYTES, stream, a); }
#else
    a.ph_lo = 0; a.ph_hi = NPHASES; hipLaunchKernelGGL(mk_fwd, dim3(grid), dim3(NTHREADS), LDS_BYTES, stream, a);
#endif
}
```

```cpp
#include <hip/hip_runtime.h>
#include <cstdio>
#include <cstdint>

#ifndef SAMPLE_SHIFT
#define SAMPLE_SHIFT 1
#endif
#ifndef SELF_INIT
#define SELF_INIT 1
#endif
#ifndef MEMBER_FLIP
#define MEMBER_FLIP 1
#endif
#ifndef MEMBER_FLIP_SEL
#define MEMBER_FLIP_SEL (mi & 1)
#endif
#ifndef STAGGER_TICKS
#define STAGGER_TICKS 0
#endif
#ifndef MK_PER_PHASE
#define MK_PER_PHASE 0
#endif

constexpr int D = 1024, BATCH = 8, SEQ = 2048, MP = BATCH * SEQ  , MS = 128  ;
constexpr int NMEM = 256, NH = 4, HD = 256, FF = 4096, MEMROWS = BATCH * NMEM  ;
constexpr float EPS = 1e-6f;
constexpr float QSCALE = 0.0625f * 1.4426950408889634f;

constexpr size_t OY = 0, OYS = 16777216, OPP = 16908288, OCP = 17031168, OMK = 17047552, OMV = 21241856, OPS = 25436160, OCS = 27402240;

__device__ __forceinline__ int lane_id_opaque() { int l; asm volatile("v_mbcnt_lo_u32_b32 %0, -1, 0\n\tv_mbcnt_hi_u32_b32 %0, -1, %0" : "=v"(l)); return l; }
#define SWZ_XOR(v, m) __builtin_bit_cast(float, __builtin_amdgcn_ds_swizzle(__builtin_bit_cast(int, (float)(v)), (((m) << 10) | 0x1f)))
__device__ __forceinline__ void swap32(float& a, float& b) { asm volatile("s_nop 1\n\tv_permlane32_swap_b32 %0, %1\n\ts_nop 1" : "+v"(a), "+v"(b)); }
__device__ __forceinline__ float add_x32(float v) { float a = v, b = v; swap32(a, b); return a + b; }
__device__ __forceinline__ float max_x32(float v) { float a = v, b = v; swap32(a, b); return fmaxf(a, b); }
__device__ __forceinline__ float add_x16_x32(float v) { v += SWZ_XOR(v, 16); return add_x32(v); }
__device__ __forceinline__ float max_x16_x32(float v) { v = fmaxf(v, SWZ_XOR(v, 16)); return max_x32(v); }
__device__ __forceinline__ float wave_sum(float v) { v += SWZ_XOR(v, 1); v += SWZ_XOR(v, 2); v += SWZ_XOR(v, 4); v += SWZ_XOR(v, 8); v += SWZ_XOR(v, 16); return add_x32(v); }
__device__ __forceinline__ float wave_max(float v) { v = fmaxf(v, SWZ_XOR(v, 1)); v = fmaxf(v, SWZ_XOR(v, 2)); v = fmaxf(v, SWZ_XOR(v, 4)); v = fmaxf(v, SWZ_XOR(v, 8)); v = fmaxf(v, SWZ_XOR(v, 16)); return max_x32(v); }

namespace pg8 {
#define PG8_LAS __attribute__((address_space(3)))
typedef unsigned short bf16_t;
typedef short bf16x8 __attribute__((ext_vector_type(8)));
typedef float f32x4 __attribute__((ext_vector_type(4)));
typedef float f32x2 __attribute__((ext_vector_type(2)));
typedef unsigned u32x4 __attribute__((ext_vector_type(4)));
typedef unsigned u32x2 __attribute__((ext_vector_type(2)));
constexpr int BM = 256, BK = 64, HALF = 128, HTB = HALF * BK * 2, STAGE_BYTES = 8 * HTB, NXCD = 8, WGM = 8;

__host__ __device__ __forceinline__ int lds_byte(int r, int c) { const int st = (r >> 4) * 2 + (c >> 5), rr = r & 15, cc = c & 31, ob = rr * 64 + cc * 2; return st * 1024 + (ob ^ (((ob >> 9) & 1) << 5)); }
__host__ __device__ __forceinline__ void stage_rc(int b, int& R, int& C) { const int st = b / 1024, sb = b % 1024, swz = sb ^ (((sb >> 9) & 1) << 5); R = (st >> 1) * 16 + swz / 64; C = (st & 1) * 32 + (swz % 64) / 2; }
__host__ __device__ __forceinline__ int perm32(int rho) { const int n = rho >> 4, i = rho & 15; return 8 * (i >> 2) + 4 * n + (i & 3); }

struct Unit { int pm, pn; };
struct Gemm { int lda, ldb, K; };

__device__ __forceinline__ unsigned cvt_pk_bf16(float lo, float hi) { unsigned r; asm volatile("v_cvt_pk_bf16_f32 %0, %1, %2" : "=v"(r) : "v"(lo), "v"(hi)); return r; }

struct StaticOrder {
    int nM, nN, nwg, G, c, pm0;
    const char* A; const char* B; size_t astep, bstep, apn;
    __device__ void init(int nM_, int nN_, int G_, int c_, int pm0_, const void* A_, size_t astep_, const void* B_, size_t bstep_, size_t apn_ = 0) {
        nM = nM_; nN = nN_; nwg = nM * nN; G = G_; c = c_; pm0 = pm0_; A = (const char*)A_; B = (const char*)B_; astep = astep_; bstep = bstep_; apn = apn_; }
    __device__ bool next(int i, Unit& u) const {
        const long L = (long)i * G + c; if (L >= nwg) return false;
        u.pm = pm0 + (int)(L % nM); u.pn = (int)(L / nM); return true;
    }
    __device__ __forceinline__ const char* aptr(const Unit& u) const { return A + (size_t)u.pm * astep + (size_t)u.pn * apn; }
    __device__ __forceinline__ const char* bptr(const Unit& u) const { return B + (size_t)u.pn * bstep; }
};
struct KvOrder {
    int G, c, batch; const char* A; const char* B;
    __device__ bool next(int i, Unit& u) const { const int L = i * G + c; if (L >= 16) return false; u.pm = (L >> 3) * 8 + batch; u.pn = L & 7; return true; }
    __device__ __forceinline__ const char* aptr(const Unit& u) const { return A + (size_t)u.pm * (256 * 1024 * 2); }
    __device__ __forceinline__ const char* bptr(const Unit& u) const { return B + (size_t)((u.pm >> 3) * 2048 + u.pn * 256) * (1024 * 2); }
};
struct SingleOrder {
    Unit u0; const char* A; const char* B;
    __device__ bool next(int i, Unit& u) const { if (i) return false; u = u0; return true; }
    __device__ __forceinline__ const char* aptr(const Unit&) const { return A; }
    __device__ __forceinline__ const char* bptr(const Unit&) const { return B; }
};


template <bool BASE32> struct EpiRes {
    static constexpr bool PERM = true, AFTER_DRAIN = false;
    const float* base32; bf16_t* x16; float* ssq; const float* cscale;
    __device__ __forceinline__ void operator()(const f32x4 (&acc)[2][2][4][2], const Unit& u, int wr, int wc, int fr, int fq) const {
        const int col0 = u.pn * BM + wc * 32 + 8 * fq;
        f32x4 cs[2][2];
#pragma unroll
        for (int bj = 0; bj < 2; ++bj)
#pragma unroll
            for (int n = 0; n < 2; ++n) cs[bj][n] = cscale ? *(const f32x4*)(cscale + col0 + bj * HALF + n * 4) : (f32x4){1.f, 1.f, 1.f, 1.f};
        constexpr int HSTEP = BASE32 ? 1 : 2;
#pragma unroll
        for (int a0 = 0; a0 < 2; a0 += HSTEP) {
        u32x4 bw[HSTEP][4][2]; f32x4 bf[BASE32 ? 1 : 1][4][2][2];
#pragma unroll
        for (int ah = 0; ah < HSTEP; ++ah)
#pragma unroll
            for (int m = 0; m < 4; ++m) { const int row = u.pm * BM + (a0 + ah) * HALF + wr * 64 + m * 16 + fr; const size_t off = (size_t)row * D + col0;
#pragma unroll
                for (int bj = 0; bj < 2; ++bj) {
                    if (BASE32) { bf[0][m][bj][0] = __builtin_nontemporal_load((const f32x4*)(base32 + off + bj * HALF)); bf[0][m][bj][1] = __builtin_nontemporal_load((const f32x4*)(base32 + off + bj * HALF + 4)); }
                    else bw[ah][m][bj] = *(const u32x4*)(x16 + off + bj * HALF); } }
#pragma unroll
        for (int ah = 0; ah < HSTEP; ++ah) { const int ai = a0 + ah;
#pragma unroll
            for (int m = 0; m < 4; ++m) { const int row = u.pm * BM + ai * HALF + wr * 64 + m * 16 + fr; const size_t off = (size_t)row * D + col0; float ss = 0.f;
#pragma unroll
                for (int bj = 0; bj < 2; ++bj) { f32x4 b0, b1;
                    if (BASE32) { b0 = bf[0][m][bj][0]; b1 = bf[0][m][bj][1]; }
                    else { const u32x4 w = bw[ah][m][bj];
                        b0 = (f32x4){__builtin_bit_cast(float, w.x << 16), __builtin_bit_cast(float, w.x & 0xffff0000u), __builtin_bit_cast(float, w.y << 16), __builtin_bit_cast(float, w.y & 0xffff0000u)};
                        b1 = (f32x4){__builtin_bit_cast(float, w.z << 16), __builtin_bit_cast(float, w.z & 0xffff0000u), __builtin_bit_cast(float, w.w << 16), __builtin_bit_cast(float, w.w & 0xffff0000u)}; }
                    const f32x4 v0 = b0 + acc[ai][bj][m][0] * cs[bj][0], v1 = b1 + acc[ai][bj][m][1] * cs[bj][1];
                    ss += ((v0[0] * v0[0] + v0[1] * v0[1]) + (v0[2] * v0[2] + v0[3] * v0[3])) + ((v1[0] * v1[0] + v1[1] * v1[1]) + (v1[2] * v1[2] + v1[3] * v1[3]));
                    u32x4 o; o.x = cvt_pk_bf16(v0[0], v0[1]); o.y = cvt_pk_bf16(v0[2], v0[3]); o.z = cvt_pk_bf16(v1[0], v1[1]); o.w = cvt_pk_bf16(v1[2], v1[3]);
                    *(u32x4*)(x16 + off + bj * HALF) = o; }
                ss = add_x16_x32(ss);
                if (fq == 0) ssq[(size_t)row * 16 + u.pn * 4 + wc] = ss; }
        }
        }
    }
};
__device__ __forceinline__ float rstd_from_ssq16(const float* ssq, int row) {
    const f32x4* sp = (const f32x4*)(ssq + (size_t)row * 16); const f32x4 s = (sp[0] + sp[1]) + (sp[2] + sp[3]);
    return __builtin_amdgcn_rsqf(((s[0] + s[1]) + (s[2] + s[3])) * (1.0f / D) + EPS);
}
template <int MODE> struct EpiRow {
    static constexpr bool PERM = true, AFTER_DRAIN = false;
    bf16_t* O; int ldc; const float* ssq; float scale; bf16_t* O2; float* convout; const PG8_LAS float* rsd;
    __device__ __forceinline__ void operator()(const f32x4 (&acc)[2][2][4][2], const Unit& u, int wr, int wc, int fr, int fq) const {
        const int colw = wc * 32 + 8 * fq;
        float rsv[2][4];
        if (rsd) {
#pragma unroll
          for (int ai = 0; ai < 2; ++ai)
#pragma unroll
              for (int m = 0; m < 4; ++m) rsv[ai][m] = rsd[ai * HALF + wr * 64 + m * 16 + fr];
        } else { f32x4 qv[2][4];
#pragma unroll
          for (int ai = 0; ai < 2; ++ai)
#pragma unroll
              for (int m = 0; m < 4; ++m) qv[ai][m] = *(const f32x4*)(ssq + (size_t)(u.pm * BM + ai * HALF + wr * 64 + m * 16 + fr) * 16 + 4 * fq);
#pragma unroll
          for (int ai = 0; ai < 2; ++ai)
#pragma unroll
              for (int m = 0; m < 4; ++m) { const f32x4 q = qv[ai][m]; rsv[ai][m] = __builtin_amdgcn_rsqf(add_x16_x32((q[0] + q[1]) + (q[2] + q[3])) * (1.0f / D) + EPS); } }
#pragma unroll
        for (int ai = 0; ai < 2; ++ai)
#pragma unroll
            for (int m = 0; m < 4; ++m) { const int row = u.pm * BM + ai * HALF + wr * 64 + m * 16 + fr; const float rs = rsv[ai][m];
                if (MODE == 2 && u.pn >= 4) {
                    const float r2 = rs * rs; const f32x4 v0 = acc[ai][0][m][0] * acc[ai][1][m][0] * r2, v1 = acc[ai][0][m][1] * acc[ai][1][m][1] * r2;
                    const int ch = (u.pn - 4) * 128 + colw;
                    u32x4 w; w.x = cvt_pk_bf16(v0[0], v0[1]); w.y = cvt_pk_bf16(v0[2], v0[3]); w.z = cvt_pk_bf16(v1[0], v1[1]); w.w = cvt_pk_bf16(v1[2], v1[3]);
                    *(u32x4*)(O2 + (size_t)row * D + ch) = w;
                    const int t = row & (SEQ - 1);
                    if (t >= SEQ - 2) { float* cp = convout + ((size_t)(row >> 11) * 2 + (t - (SEQ - 2))) * D + ch; *(f32x4*)cp = v0; *(f32x4*)(cp + 4) = v1; }
                } else {
                    const float sc = (MODE == 0) ? rs * scale : rs;
#pragma unroll
                    for (int bj = 0; bj < 2; ++bj) { f32x4 v0 = acc[ai][bj][m][0] * sc, v1 = acc[ai][bj][m][1] * sc;
                        if (MODE == 1) {
#pragma unroll
                            for (int j = 0; j < 4; ++j) { const float a = fmaxf(v0[j], 0.f), b = fmaxf(v1[j], 0.f); v0[j] = a * a; v1[j] = b * b; } }
                        u32x4 w; w.x = cvt_pk_bf16(v0[0], v0[1]); w.y = cvt_pk_bf16(v0[2], v0[3]); w.z = cvt_pk_bf16(v1[0], v1[1]); w.w = cvt_pk_bf16(v1[2], v1[3]);
                        *(u32x4*)(O + (size_t)row * ldc + u.pn * BM + bj * HALF + colw) = w; }
                } }
    }
};
struct EpiBf16 {
    static constexpr bool PERM = true, AFTER_DRAIN = false;
    bf16_t* O; int ldc; float scale;
    __device__ __forceinline__ void operator()(const f32x4 (&acc)[2][2][4][2], const Unit& u, int wr, int wc, int fr, int fq) const {
        const int colw = u.pn * BM + wc * 32 + 8 * fq;
#pragma unroll
        for (int ai = 0; ai < 2; ++ai)
#pragma unroll
            for (int m = 0; m < 4; ++m) { const int row = u.pm * BM + ai * HALF + wr * 64 + m * 16 + fr;
#pragma unroll
                for (int bj = 0; bj < 2; ++bj) { const f32x4 v0 = acc[ai][bj][m][0] * scale, v1 = acc[ai][bj][m][1] * scale;
                    u32x4 w; w.x = cvt_pk_bf16(v0[0], v0[1]); w.y = cvt_pk_bf16(v0[2], v0[3]); w.z = cvt_pk_bf16(v1[0], v1[1]); w.w = cvt_pk_bf16(v1[2], v1[3]);
                    *(u32x4*)(O + (size_t)row * ldc + colw + bj * HALF) = w; } }
    }
};
struct EpiKV {
    static constexpr bool PERM = false, AFTER_DRAIN = false;
    float* outk; float* outv; bf16_t* Kb; bf16_t* Vt;
    __device__ __forceinline__ void operator()(const f32x4 (&acc)[2][2][4][2], const Unit& u, int wr, int wc, int fr, int fq) const {
        const int layer = u.pm >> 3; const bool isV = u.pn >= 4; const int col0 = (u.pn & 3) * BM + wc * 32 + 4 * fq;
        float* outp = isV ? outv : outk;
#pragma unroll
        for (int ai = 0; ai < 2; ++ai)
#pragma unroll
            for (int m = 0; m < 4; ++m) { const int rowl = (u.pm & 7) * BM + ai * HALF + wr * 64 + m * 16 + fr; const size_t off = ((size_t)layer * MEMROWS + rowl) * D + col0;
#pragma unroll
                for (int bj = 0; bj < 2; ++bj)
#pragma unroll
                    for (int n = 0; n < 2; ++n) { const f32x4 v = acc[ai][bj][m][n]; *(f32x4*)(outp + off + bj * HALF + n * 16) = v;
                        if (!isV) { u32x2 p; p.x = cvt_pk_bf16(v[0], v[1]); p.y = cvt_pk_bf16(v[2], v[3]); *(u32x2*)(Kb + off + bj * HALF + n * 16) = p; }
                        else { u32x2 p; p.x = cvt_pk_bf16(v[0], v[1]); p.y = cvt_pk_bf16(v[2], v[3]); *(u32x2*)(Vt + off + bj * HALF + n * 16) = p; } } }
    }
};
struct EpiSoftmax {
    static constexpr bool PERM = true, AFTER_DRAIN = true;
    bf16_t* P; int ldp; const float* ssq;
    __device__ __forceinline__ void operator()(const f32x4 (&)[2][2][4][2], const Unit&, int, int, int, int) const {}
    __device__ __forceinline__ void fused(f32x4 (&acc)[2][2][4][2], const Unit& u, int wr, int wc, int fr, int fq, PG8_LAS unsigned char* lds, int wid, int lane) const {
        PG8_LAS float* Pm = (PG8_LAS float*)lds;
        PG8_LAS float* Ps = (PG8_LAS float*)(lds + 4096);
        float rsv[2][4];
        { f32x4 qv[2][4];
#pragma unroll
          for (int ai = 0; ai < 2; ++ai)
#pragma unroll
              for (int m = 0; m < 4; ++m) qv[ai][m] = *(const f32x4*)(ssq + (size_t)(u.pm * BM + ai * HALF + wr * 64 + m * 16 + fr) * 16 + 4 * fq);
#pragma unroll
          for (int ai = 0; ai < 2; ++ai)
#pragma unroll
              for (int m = 0; m < 4; ++m) { const f32x4 q = qv[ai][m]; rsv[ai][m] = __builtin_amdgcn_rsqf(add_x16_x32((q[0] + q[1]) + (q[2] + q[3])) * (1.0f / D) + EPS); } }
#pragma unroll
        for (int ai = 0; ai < 2; ++ai)
#pragma unroll
            for (int m = 0; m < 4; ++m) { float mx = -3.0e38f; const float rs = rsv[ai][m];
#pragma unroll
                for (int bj = 0; bj < 2; ++bj)
#pragma unroll
                    for (int n = 0; n < 2; ++n) { const f32x4 x = acc[ai][bj][m][n] * rs; acc[ai][bj][m][n] = x; mx = fmaxf(mx, fmaxf(fmaxf(x[0], x[1]), fmaxf(x[2], x[3]))); }
                mx = max_x16_x32(mx);
                if (fq == 0) Pm[(ai * HALF + wr * 64 + m * 16 + fr) * 4 + wc] = mx; }
        asm volatile("s_waitcnt lgkmcnt(0)" ::: "memory"); __builtin_amdgcn_s_barrier(); asm volatile("" ::: "memory");
#pragma unroll
        for (int ai = 0; ai < 2; ++ai)
#pragma unroll
            for (int m = 0; m < 4; ++m) { const int r = ai * HALF + wr * 64 + m * 16 + fr; const f32x4 q = *(const PG8_LAS f32x4*)(Pm + r * 4);
                const float mx = fmaxf(fmaxf(q[0], q[1]), fmaxf(q[2], q[3])); float s = 0.f;
#pragma unroll
                for (int bj = 0; bj < 2; ++bj)
#pragma unroll
                    for (int n = 0; n < 2; ++n) { f32x4 x = acc[ai][bj][m][n];
#pragma unroll
                        for (int j = 0; j < 4; ++j) { x[j] = __builtin_amdgcn_exp2f(x[j] - mx); s += x[j]; }
                        acc[ai][bj][m][n] = x; }
                s = add_x16_x32(s);
                if (fq == 0) Ps[r * 4 + wc] = s; }
        asm volatile("s_waitcnt lgkmcnt(0)" ::: "memory"); __builtin_amdgcn_s_barrier(); asm volatile("" ::: "memory");
        const int colw = u.pn * BM + wc * 32 + 8 * fq;
#pragma unroll
        for (int ai = 0; ai < 2; ++ai)
#pragma unroll
            for (int m = 0; m < 4; ++m) { const int r = ai * HALF + wr * 64 + m * 16 + fr; const f32x4 q = *(const PG8_LAS f32x4*)(Ps + r * 4);
                const float inv = __builtin_amdgcn_rcpf((q[0] + q[1]) + (q[2] + q[3]));
#pragma unroll
                for (int bj = 0; bj < 2; ++bj) { const f32x4 v0 = acc[ai][bj][m][0] * inv, v1 = acc[ai][bj][m][1] * inv;
                    u32x4 w; w.x = cvt_pk_bf16(v0[0], v0[1]); w.y = cvt_pk_bf16(v0[2], v0[3]); w.z = cvt_pk_bf16(v1[0], v1[1]); w.w = cvt_pk_bf16(v1[2], v1[3]);
                    *(u32x4*)(P + (size_t)(u.pm * BM + r) * ldp + bj * HALF + colw) = w; } }
    }
};

struct NoPre { __device__ __forceinline__ void operator()(int) const {} };
template <class Epi, class Sched, bool ALIGN_EPI, class Pre = NoPre>
__device__ __forceinline__ void gemm_phase(PG8_LAS unsigned char* lds, const Gemm g, const Sched& S, const Epi& E, int tid, const Pre& pre = Pre()) {
    asm volatile("" : "+v"(tid));
    const int wid = __builtin_amdgcn_readfirstlane(tid >> 6), lane = tid & 63, wr = wid >> 2, wc = wid & 3, fr = lane & 15, fq = lane >> 4;
    const int nt = g.K / BK;
    unsigned voffA[2], voffB[2];
#pragma unroll
    for (int i = 0; i < 2; ++i) { int R, C; stage_rc(tid * 16 + i * 8192, R, C); const int Rb = Epi::PERM ? ((R & ~31) + perm32(R & 31)) : R;
        voffA[i] = (unsigned)(R * g.lda + C) * 2u; voffB[i] = (unsigned)(Rb * g.ldb + C) * 2u; }
    const size_t kstep = (size_t)(BK * 2);
    const size_t hstepA = (size_t)HALF * g.lda * 2, hstepB = (size_t)HALF * g.ldb * 2;
    const unsigned ldsw = (unsigned)wid * 1024u;
    const int aoff = lds_byte(wr * 64 + fr, fq * 8), boff = lds_byte(wc * 32 + fr, fq * 8);
#define PG8_SA(b, h) (((b) * 2 + (h)) * HTB)
#define PG8_SB(b, h) ((4 + (b) * 2 + (h)) * HTB)
#define PG8_STAGE(bufoff, gbase, voff) do { const char* _gb = (const char*)(gbase); asm volatile("" : "+s"(_gb));   \
        _Pragma("unroll") for (int _i = 0; _i < 2; ++_i) \
        __builtin_amdgcn_global_load_lds((const unsigned*)(_gb + (voff)[_i]), (PG8_LAS unsigned*)(lds + (bufoff) + ldsw + _i * 8192), 16, 0, 0); } while (0)
#define PG8_LDA(dst, b, h) do { _Pragma("unroll") for (int m = 0; m < 4; ++m) _Pragma("unroll") for (int k = 0; k < 2; ++k) dst[m][k] = *(const PG8_LAS bf16x8*)(lds + PG8_SA(b, h) + aoff + m * 2048 + k * 1024); } while (0)
#define PG8_LDB(dst, b, h) do { _Pragma("unroll") for (int n = 0; n < 2; ++n) _Pragma("unroll") for (int k = 0; k < 2; ++k) dst[n][k] = *(const PG8_LAS bf16x8*)(lds + PG8_SB(b, h) + boff + n * 2048 + k * 1024); } while (0)
#define PG8_MMA(ai, bj, At, Bt) do { __builtin_amdgcn_s_setprio(1); _Pragma("unroll") for (int m = 0; m < 4; ++m) _Pragma("unroll") for (int n = 0; n < 2; ++n) _Pragma("unroll") for (int k = 0; k < 2; ++k) \
        acc[ai][bj][m][n] = __builtin_amdgcn_mfma_f32_16x16x32_bf16(Bt[n][k], At[m][k], acc[ai][bj][m][n], 0, 0, 0); __builtin_amdgcn_s_setprio(0); } while (0)
#define PG8_WAIT_V(n) asm volatile("s_waitcnt vmcnt(" #n ")" ::: "memory")
#define PG8_WAIT_L(n) asm volatile("s_waitcnt lgkmcnt(" #n ")" ::: "memory")
#define PG8_BAR __builtin_amdgcn_s_barrier()
#define PG8_SCHED __builtin_amdgcn_sched_barrier(0)
    Unit cur, nxt; int ui = 0;
    if (!S.next(0, cur)) return;
    f32x4 acc[2][2][4][2];
#pragma unroll
    for (int a = 0; a < 2; ++a)
#pragma unroll
        for (int b = 0; b < 2; ++b)
#pragma unroll
            for (int m = 0; m < 4; ++m)
#pragma unroll
                for (int n = 0; n < 2; ++n) acc[a][b][m][n] = (f32x4){0.f, 0.f, 0.f, 0.f};
    bf16x8 At[4][2], B0[2][2], B1[2][2];
    const char* cA = S.aptr(cur); const char* cB = S.bptr(cur);
    PG8_STAGE(PG8_SB(0, 0), cB, voffB); PG8_STAGE(PG8_SB(0, 1), cB + hstepB, voffB); PG8_STAGE(PG8_SA(0, 0), cA, voffA); PG8_STAGE(PG8_SA(0, 1), cA + hstepA, voffA);
    pre(tid);
    if (wr == 1) PG8_BAR;
    PG8_WAIT_V(2); PG8_BAR;
    PG8_STAGE(PG8_SB(1, 0), cB + kstep, voffB); PG8_STAGE(PG8_SA(1, 0), cA + kstep, voffA); PG8_STAGE(PG8_SB(1, 1), cB + hstepB + kstep, voffB);
    PG8_WAIT_V(6); PG8_BAR;
    for (;;) {
        const bool has_next = S.next(ui + 1, nxt);
        const char* nA = has_next ? S.aptr(nxt) : cA; const char* nB = has_next ? S.bptr(nxt) : cB;
        for (int t = 0; t < nt; t += 2) {
            const bool last = (t == nt - 2);
            const char* a1 = cA + (size_t)(t + 1) * kstep;
            const char* a2 = last ? nA : cA + (size_t)(t + 2) * kstep; const char* b2 = last ? nB : cB + (size_t)(t + 2) * kstep;
            const char* a3 = a2 + kstep; const char* b3 = b2 + kstep;
            PG8_LDB(B0, 0, 0); PG8_LDB(B1, 0, 1); PG8_SCHED; PG8_LDA(At, 0, 0); PG8_STAGE(PG8_SA(1, 1), a1 + hstepA, voffA);
            PG8_WAIT_V(8); PG8_WAIT_L(0); PG8_BAR; PG8_MMA(0, 0, At, B0); PG8_MMA(0, 1, At, B1); PG8_BAR; PG8_SCHED;
            PG8_LDA(At, 0, 1); PG8_STAGE(PG8_SB(0, 0), b2, voffB); PG8_STAGE(PG8_SB(0, 1), b2 + hstepB, voffB); PG8_STAGE(PG8_SA(0, 0), a2, voffA);
            PG8_WAIT_V(8); PG8_WAIT_L(0); PG8_BAR; PG8_MMA(1, 0, At, B0); PG8_MMA(1, 1, At, B1); PG8_BAR; PG8_SCHED;
            PG8_LDB(B0, 1, 0); PG8_LDB(B1, 1, 1); PG8_SCHED; PG8_LDA(At, 1, 0); PG8_STAGE(PG8_SA(0, 1), a2 + hstepA, voffA);
            PG8_WAIT_V(8); PG8_WAIT_L(0); PG8_BAR; PG8_MMA(0, 0, At, B0); PG8_MMA(0, 1, At, B1); PG8_BAR; PG8_SCHED;
            PG8_LDA(At, 1, 1); PG8_STAGE(PG8_SB(1, 0), b3, voffB); PG8_STAGE(PG8_SB(1, 1), b3 + hstepB, voffB); PG8_STAGE(PG8_SA(1, 0), a3, voffA);
            PG8_WAIT_V(8); PG8_WAIT_L(0); PG8_BAR; PG8_MMA(1, 0, At, B0); PG8_MMA(1, 1, At, B1); PG8_BAR; PG8_SCHED;
        }
        if constexpr (ALIGN_EPI) { if (wr == 0) PG8_BAR; }
        if constexpr (!Epi::AFTER_DRAIN) { const int l2 = lane_id_opaque(); E(acc, cur, wr, wc, l2 & 15, l2 >> 4); }
        if (!has_next) break;
#pragma unroll
        for (int a = 0; a < 2; ++a)
#pragma unroll
            for (int b = 0; b < 2; ++b)
#pragma unroll
                for (int m = 0; m < 4; ++m)
#pragma unroll
                    for (int n = 0; n < 2; ++n) acc[a][b][m][n] = (f32x4){0.f, 0.f, 0.f, 0.f};
        cur = nxt; cA = nA; cB = nB; ++ui;
        if constexpr (ALIGN_EPI) { if (wr == 1) PG8_BAR; }
    }
    PG8_WAIT_V(0);
    if constexpr (!ALIGN_EPI) { if (wr == 0) PG8_BAR; }
    PG8_BAR;
    if constexpr (Epi::AFTER_DRAIN) { const int l2 = lane_id_opaque(); E.fused(acc, cur, wr, wc, l2 & 15, l2 >> 4, lds, wid, l2); }
#undef PG8_SA
#undef PG8_SB
#undef PG8_STAGE
#undef PG8_LDA
#undef PG8_LDB
#undef PG8_MMA
#undef PG8_WAIT_V
#undef PG8_WAIT_L
#undef PG8_BAR
#undef PG8_SCHED
}
}

constexpr int NWAVES = 8, NTHREADS = 512;
constexpr size_t MiB = 1u << 20;
constexpr size_t WS_CTL = 0, CTL_ZERO_BYTES = 256 * 1024;
constexpr size_t WS_WPOOL = 1 * MiB;
constexpr size_t WS_WQ = 2 * MiB;
constexpr size_t WS_WO = 6 * MiB;
constexpr size_t WS_WKV = 10 * MiB;
constexpr size_t WS_WUP = 18 * MiB;
constexpr size_t WS_WDN = 34 * MiB;
constexpr size_t WS_WIN = 50 * MiB;
constexpr size_t WS_WOUT = 56 * MiB;
constexpr size_t WS_MN = 58 * MiB;
constexpr size_t WS_KB = 66 * MiB;
constexpr size_t WS_VT = 74 * MiB;
constexpr size_t WS_SSQ = 82 * MiB;
constexpr size_t WS_SMALL = 84 * MiB;
constexpr size_t WS_X = 96 * MiB;
constexpr size_t WS_XG = 160 * MiB;
constexpr size_t WS_P0 = 192 * MiB;
constexpr size_t WS_O = 224 * MiB;
constexpr size_t WS_CH = 256 * MiB;
constexpr size_t WS_PS = 288 * MiB;
constexpr size_t WS_H = 320 * MiB;
constexpr size_t WS_WQN = 448 * MiB;
constexpr size_t WS_MT = 452 * MiB;
constexpr size_t WS_VW = 484 * MiB;
constexpr size_t WS_END = 516 * MiB;
constexpr size_t SS_X = WS_SMALL;
constexpr size_t SS_XG = SS_X + 512 * 1024;
constexpr size_t SS_SSQ = SS_XG + 256 * 1024;
constexpr size_t SS_P0 = SS_SSQ + 32 * 1024;
constexpr size_t SS_O = SS_P0 + 256 * 1024;
constexpr size_t SS_CH = SS_O + 256 * 1024;
constexpr size_t SS_H = SS_CH + 512 * 1024;
constexpr size_t SS_Q = SS_H + 1024 * 1024;
static_assert(SS_Q + 512 * 1024 <= WS_X, "sample buffers");
constexpr int CW_FLAG = 0;
constexpr unsigned INIT_MAGIC = 0x5eed1357u;
constexpr int CW_BAR = 4096, CW_BAR_STRIDE = 4096;

constexpr int RING_OFF = 0, RING_BYTES = 131072;
constexpr int LDSCTL_OFF = RING_BYTES, MISC_OFF = LDSCTL_OFF + 320;
constexpr int RSD_OFF = RING_BYTES + 1024;
constexpr int LDS_BYTES = 147456;

#define GAS __attribute__((address_space(1)))
#define LAS __attribute__((address_space(3)))
typedef unsigned short bf16;
typedef unsigned v4u __attribute__((ext_vector_type(4)));
typedef unsigned v2u __attribute__((ext_vector_type(2)));
typedef float f32x4 __attribute__((ext_vector_type(4)));
typedef short bf16x8 __attribute__((ext_vector_type(8)));
#define LDS_WAIT() asm volatile("s_waitcnt lgkmcnt(0)" ::: "memory")
#define VM_WAIT() asm volatile("s_waitcnt vmcnt(0)" ::: "memory")
__device__ __forceinline__ unsigned f2bf(float f) { unsigned u = __builtin_bit_cast(unsigned, f); return (u + 0x7fffu + ((u >> 16) & 1u)) >> 16; }
__device__ __forceinline__ unsigned pk2(float lo, float hi) { return f2bf(lo) | (f2bf(hi) << 16); }
__device__ __forceinline__ float bf2f(unsigned short h) { return __builtin_bit_cast(float, (unsigned)h << 16); }
__device__ __forceinline__ float bflo(unsigned w) { return __builtin_bit_cast(float, w << 16); }
__device__ __forceinline__ float bfhi(unsigned w) { return __builtin_bit_cast(float, w & 0xffff0000u); }

#define XB_TMO      128
#define XB_XCNT(j)  (256  + 64 * (j))
#define XB_XSUB(j)  (1280 + 64 * (j))
#define XB_XGEN(j)  (2304 + 64 * (j))
#define XB_TOP      3328
#define XB_TOPGEN   3392
#define XCD_BAR_WORDS 3456
#define XB_SPIN_CAP (1u << 18)
__device__ __forceinline__ unsigned xb_ld(unsigned* p)              { return __hip_atomic_load(p, __ATOMIC_RELAXED, __HIP_MEMORY_SCOPE_AGENT); }
__device__ __forceinline__ unsigned xb_add(unsigned* p, unsigned v) { return __hip_atomic_fetch_add(p, v, __ATOMIC_RELAXED, __HIP_MEMORY_SCOPE_AGENT); }
__device__ __forceinline__ unsigned xb_xcc_id() { return (unsigned)__builtin_amdgcn_s_getreg((3 << 11) | 20) & 0xFu; }
#define XB_SPIN(cond, bar) do { unsigned _sp = 0; while (cond) { __builtin_amdgcn_s_sleep(1); \
    if ((++_sp & 255u) == 0u) { if (xb_ld(&(bar)[XB_TMO])) break; if (_sp > XB_SPIN_CAP) { atomicAdd(&(bar)[XB_TMO], 1u); break; } } } } while (0)
struct XcdBarrier { unsigned* bar; unsigned x; volatile LAS unsigned* st; unsigned gsize; };
__device__ __forceinline__ XcdBarrier xcd_barrier_post(unsigned* bar, volatile LAS unsigned* st, unsigned gsize) {
    XcdBarrier b; b.bar = bar; b.x = xb_xcc_id(); b.st = st; b.gsize = gsize;
    if (threadIdx.x == 0) (void)xb_add(&bar[XB_XCNT(b.x)], 1u);
    return b;
}
__device__ __forceinline__ void xcd_barrier_complete(unsigned* bar, unsigned x, unsigned G, unsigned& nloc, unsigned& nx) {
    unsigned sum, cnt, mine, sp = 0u;
    for (;;) {
        sum = 0u; cnt = 0u; mine = 0u;
#pragma unroll
        for (unsigned j = 0; j < 16; ++j) { const unsigned c = xb_ld(&bar[XB_XCNT(j)]); sum += c; cnt += (c > 0u) ? 1u : 0u; mine = (j == x) ? c : mine; }
        if (sum == G) break;
        __builtin_amdgcn_s_sleep(1);
        if ((++sp & 255u) == 0u) { if (xb_ld(&bar[XB_TMO])) break; if (sp > XB_SPIN_CAP) { atomicAdd(&bar[XB_TMO], 1u); break; } }
    }
    nloc = mine > 0u ? mine : 1u; nx = cnt > 0u ? cnt : 1u;
}
__device__ __forceinline__ void xcd_barrier(const XcdBarrier& b, const int tid) {
    asm volatile("s_waitcnt vmcnt(0)" ::: "memory");
    __syncthreads();
    if (tid == 0) {
        unsigned* bar = b.bar; asm volatile("" : "+s"(bar));
        __builtin_amdgcn_s_waitcnt(0);
        unsigned nloc = b.st[0], nx = b.st[1];
        if (nloc == 0u) { xcd_barrier_complete(bar, b.x, b.gsize, nloc, nx); b.st[0] = nloc; b.st[1] = nx; }
        const unsigned old = xb_add(&bar[XB_XSUB(b.x)], 1u);
        const unsigned gen = old / nloc;
        if (old + 1u == (gen + 1u) * nloc) {
            if (nx > 1u) {
                __builtin_amdgcn_fence(__ATOMIC_RELEASE, "agent");
                asm volatile("s_waitcnt vmcnt(0)" ::: "memory");
                const unsigned og = xb_add(&bar[XB_TOP], 1u);
                const unsigned tg = og / nx;
                if (og + 1u == (tg + 1u) * nx) xb_add(&bar[XB_TOPGEN], 1u);
                else XB_SPIN(xb_ld(&bar[XB_TOPGEN]) == tg, bar);
            }
            xb_add(&bar[XB_XGEN(b.x)], 1u);
            __builtin_amdgcn_fence(__ATOMIC_ACQUIRE, "agent");
            asm volatile("s_waitcnt vmcnt(0)" ::: "memory");
        } else {
            XB_SPIN(xb_ld(&bar[XB_XGEN(b.x)]) == gen, bar);
            __builtin_amdgcn_fence(__ATOMIC_ACQUIRE, "agent");
            asm volatile("s_waitcnt vmcnt(0)" ::: "memory");
        }
    }
    __syncthreads();
}

__device__ __forceinline__ int opq_v(int x) { asm volatile("" : "+v"(x)); return x; }
struct Args { const float* in[22]; float* out; unsigned char* ws; int ph_lo, ph_hi; };


__device__ __forceinline__ void p0_transpose_item(const float* W, int K, int N, bf16* WT, int k0, int n0, int drow0, LAS float* scr, int lane, const float* gk = nullptr) {
    float v[32];
#pragma unroll
    for (int i = 0; i < 32; ++i) { const int kk = 2 * i + (lane >> 5); v[i] = __builtin_nontemporal_load(W + (size_t)(k0 + kk) * N + n0 + (lane & 31)); }
    if (gk) {
#pragma unroll
        for (int i = 0; i < 32; ++i) v[i] *= gk[k0 + 2 * i + (lane >> 5)]; }
#pragma unroll
    for (int i = 0; i < 32; ++i) scr[(2 * i + (lane >> 5)) * 33 + (lane & 31)] = v[i];
    LDS_WAIT(); asm volatile("" ::: "memory");
    const int c = lane & 7;
#pragma unroll
    for (int j = 0; j < 4; ++j) { const int n = (lane >> 3) + 8 * j; const LAS float* s = scr + (8 * c) * 33 + n;
        v4u o; o.x = pg8::cvt_pk_bf16(s[0 * 33], s[1 * 33]); o.y = pg8::cvt_pk_bf16(s[2 * 33], s[3 * 33]); o.z = pg8::cvt_pk_bf16(s[4 * 33], s[5 * 33]); o.w = pg8::cvt_pk_bf16(s[6 * 33], s[7 * 33]);
        *(GAS v4u*)(WT + (size_t)(drow0 + n) * K + k0 + 8 * c) = o; }
    LDS_WAIT(); asm volatile("" ::: "memory");
}
__device__ __forceinline__ int win_dest_row(int n) {
    if (n < 1024) return n;
    if (n < 2048) { const int ch = n - 1024; return 1024 + (ch >> 7) * 256 + (ch & 127); }
    const int ch = n - 2048; return 1024 + (ch >> 7) * 256 + 128 + (ch & 127);
}

template <int W>
__device__ __forceinline__ void pool_wave(const float* xb  , const LAS float* rs, f32x4 g4, int tA, bf16* pout  , float* poolout  ) {
    f32x4 xv[15 + W];
#pragma unroll
    for (int i = 16 - W; i < 31; ++i) { const int t = tA - 15 + i; xv[i - (16 - W)] = *(const f32x4*)(xb + (size_t)(t >= 0 ? t : 0) * D); }
    f32x4 ring[16]; f32x4 S = {0.f, 0.f, 0.f, 0.f};
#pragma unroll
    for (int i = 16 - W; i < 31; ++i) {
        const int t = tA - 15 + i;
        f32x4 u = {0.f, 0.f, 0.f, 0.f};
        if (t >= 0) u = xv[i - (16 - W)] * rs[i] * g4;
        S += u; if (i - W >= 16 - W) S -= ring[(i - W) & 15];
        ring[i & 15] = u;
        if (i >= 15) {
            const int cnt = (t + 1 < W) ? (t + 1) : W; const float ic = 1.0f / (float)cnt;
            const f32x4 p = S * ic - u; v2u o; o.x = pk2(p[0], p[1]); o.y = pk2(p[2], p[3]);
            *(v2u*)(pout + (size_t)t * D) = o;
            if (t >= SEQ - 15) *(f32x4*)(poolout + (size_t)(t - (SEQ - 15)) * D) = u;
        }
    }
}

template <int RT, int CT, int GR, int KS, class F>
__device__ __forceinline__ void sgemm2(const bf16* A, int lda, int row0, const bf16* Bt, int ldb, const int (&brow)[CT], int K, LAS unsigned char* red, int wave, int lane, const F& f) {
    const int fr = lane & 15, fq = lane >> 4, kw = K >> 3;
    const bf16* ap = A + (size_t)(row0 + fr) * lda + wave * kw + fq * 8;
    const bf16* bp[CT];
#pragma unroll
    for (int ct = 0; ct < CT; ++ct) bp[ct] = Bt + (size_t)(brow[ct] + fr) * ldb + wave * kw + fq * 8;
    f32x4 acc[RT][CT];
#pragma unroll
    for (int rt = 0; rt < RT; ++rt)
#pragma unroll
        for (int ct = 0; ct < CT; ++ct) acc[rt][ct] = (f32x4){0.f, 0.f, 0.f, 0.f};
#pragma unroll 1
    for (int k0 = 0; k0 < kw; k0 += 32 * KS) {
        bf16x8 a[KS][RT], b[KS][CT];
#pragma unroll
        for (int ks = 0; ks < KS; ++ks) {
#pragma unroll
            for (int rt = 0; rt < RT; ++rt) a[ks][rt] = *(const bf16x8*)(ap + (size_t)rt * 16 * lda + k0 + 32 * ks);
#pragma unroll
            for (int ct = 0; ct < CT; ++ct) b[ks][ct] = *(const bf16x8*)(bp[ct] + k0 + 32 * ks); }
#pragma unroll
        for (int ks = 0; ks < KS; ++ks)
#pragma unroll
            for (int rt = 0; rt < RT; ++rt)
#pragma unroll
                for (int ct = 0; ct < CT; ++ct) acc[rt][ct] = __builtin_amdgcn_mfma_f32_16x16x32_bf16(b[ks][ct], a[ks][rt], acc[rt][ct], 0, 0, 0);
    }
#pragma unroll
    for (int rt = 0; rt < RT; ++rt)
#pragma unroll
        for (int ct = 0; ct < CT; ++ct) *(LAS f32x4*)(red + ((((wave * RT + rt) * CT + ct) * 64 + lane) << 4)) = acc[rt][ct];
    LDS_WAIT(); __syncthreads();
    constexpr int NCG = CT / GR, NTASK = RT * NCG;
    for (int t = wave; t < NTASK; t += 8) {
        const int rt = t / NCG, cg = t % NCG;
        f32x4 sacc[GR];
#pragma unroll
        for (int g = 0; g < GR; ++g) { f32x4 tt = {0.f, 0.f, 0.f, 0.f};
#pragma unroll
            for (int w = 0; w < 8; ++w) tt += *(const LAS f32x4*)(red + ((((w * RT + rt) * CT + cg * GR + g) * 64 + lane) << 4));
            sacc[g] = tt; }
        f(sacc, row0 + 16 * rt + fr, cg * GR, fq);
    }
    __syncthreads();
}
__device__ __forceinline__ float srstd(const float* ssq, int row, int fq) {
    const f32x4* sp = (const f32x4*)(ssq + row * 64 + fq * 16); const f32x4 s = (sp[0] + sp[1]) + (sp[2] + sp[3]); float t = (s[0] + s[1]) + (s[2] + s[3]);
    t = add_x16_x32(t);
    return __builtin_amdgcn_rsqf(t * (1.0f / D) + EPS);
}
template <int KS> __device__ __forceinline__ void s_res_unit(const bf16* A, int lda, const bf16* Bt, int ldb, int K, int cp, int row0, const float* base32, bf16* xs16, float* ssq, const float* cscale, LAS unsigned char* red, int wave, int lane) {
    const int brow[2] = {32 * cp, 32 * cp + 16};
    const int myct = wave & 1, prow = row0 + (lane & 15), pc0 = 16 * (2 * cp + myct) + 4 * (lane >> 4); const size_t poff = (size_t)prow * D + pc0;
    f32x4 cs = {1.f, 1.f, 1.f, 1.f}; if (cscale) cs = *(const f32x4*)(cscale + pc0);
    f32x4 bpre; if (base32) bpre = *(const f32x4*)(base32 + poff); else { const v2u w = *(const v2u*)(xs16 + poff); bpre = (f32x4){bflo(w.x), bfhi(w.x), bflo(w.y), bfhi(w.y)}; }
    sgemm2<1, 2, 1, KS>(A, lda, row0, Bt, ldb, brow, K, red, wave, lane, [&](f32x4 (&a)[1], int row, int ct0, int fq) {
        const int ctile = 2 * cp + ct0, c0 = 16 * ctile + 4 * fq; const size_t off = (size_t)row * D + c0;
        const f32x4 v = bpre + a[0] * cs;
        float ss = (v[0] * v[0] + v[1] * v[1]) + (v[2] * v[2] + v[3] * v[3]);
        ss = add_x16_x32(ss);
        if (fq == 0) ssq[row * 64 + ctile] = ss;
        v2u p; p.x = pk2(v[0], v[1]); p.y = pk2(v[2], v[3]); *(v2u*)(xs16 + off) = p; });
}
__device__ __forceinline__ void s_q_unit(const bf16* xs16, const bf16* wq, int cp, int row0, const float* ssq, float* qs, LAS unsigned char* red, int wave, int lane) {
    const int brow[2] = {32 * cp, 32 * cp + 16};
    const float rs = srstd(ssq, row0 + (lane & 15), lane >> 4) * QSCALE;
    sgemm2<1, 2, 1, 4>(xs16, D, row0, wq, D, brow, D, red, wave, lane, [&](f32x4 (&a)[1], int row, int ct0, int fq) {
        *(f32x4*)(qs + (size_t)row * D + 32 * cp + 16 * ct0 + 4 * fq) = a[0] * rs; });
}
__device__ __forceinline__ f32x4 relu2(f32x4 v) {
#pragma unroll
    for (int j = 0; j < 4; ++j) { const float a = fmaxf(v[j], 0.f); v[j] = a * a; }
    return v;
}

__device__ __forceinline__ void rstd_table(const float* ssq, int pm, LAS float* rsd, int tid) {
    if (tid < 256) { const f32x4* sp = (const f32x4*)(ssq + (size_t)(pm * 256 + tid) * 16); const f32x4 q = (sp[0] + sp[1]) + (sp[2] + sp[3]);
        rsd[tid] = __builtin_amdgcn_rsqf(((q[0] + q[1]) + (q[2] + q[3])) * (1.0f / D) + EPS); }
}
__device__ __forceinline__ void treduce32(float (&p)[32], int lane) {
#pragma unroll
    for (int i = 0; i < 16; ++i) { swap32(p[i], p[i + 16]); p[i] += p[i + 16]; }
    { const bool b4 = (lane & 16) != 0;
#pragma unroll
      for (int i = 0; i < 8; ++i) { const float keep = b4 ? p[i + 8] : p[i], send = b4 ? p[i] : p[i + 8]; p[i] = keep + SWZ_XOR(send, 16); } }
    { const bool b3 = (lane & 8) != 0;
#pragma unroll
      for (int i = 0; i < 4; ++i) { const float keep = b3 ? p[i + 4] : p[i], send = b3 ? p[i] : p[i + 4]; p[i] = keep + SWZ_XOR(send, 8); } }
    { const bool b2 = (lane & 4) != 0;
#pragma unroll
      for (int i = 0; i < 2; ++i) { const float keep = b2 ? p[i + 2] : p[i], send = b2 ? p[i] : p[i + 2]; p[i] = keep + SWZ_XOR(send, 4); } }
    { const bool b1 = (lane & 2) != 0; const float keep = b1 ? p[1] : p[0], send = b1 ? p[0] : p[1]; p[0] = keep + SWZ_XOR(send, 2); }
    p[0] += SWZ_XOR(p[0], 1);
}
__device__ __forceinline__ void unpack16(const v4u a, const v4u b, float (&x)[16]) {
    x[0] = bflo(a.x); x[1] = bfhi(a.x); x[2] = bflo(a.y); x[3] = bfhi(a.y); x[4] = bflo(a.z); x[5] = bfhi(a.z); x[6] = bflo(a.w); x[7] = bfhi(a.w);
    x[8] = bflo(b.x); x[9] = bfhi(b.x); x[10] = bflo(b.y); x[11] = bfhi(b.y); x[12] = bflo(b.z); x[13] = bfhi(b.z); x[14] = bflo(b.w); x[15] = bfhi(b.w);
}

constexpr int NPHASES = 15;
__global__ void __launch_bounds__(NTHREADS, 2) mk_fwd(Args args) {
    extern __shared__ __attribute__((aligned(16))) unsigned char lds[];
    LAS unsigned char* L = (LAS unsigned char*)lds;
    volatile LAS unsigned* MISC = (volatile LAS unsigned*)(L + MISC_OFF);
    const int wave0 = __builtin_amdgcn_readfirstlane((int)threadIdx.x >> 6);
    const int G = gridDim.x; const int bx = blockIdx.x; const int vcu = (G % 8 == 0) ? (bx % 8) * (G / 8) + bx / 8 : bx;
    const int grp = bx & 7, mi = bx >> 3, GS = (G - grp + 7) >> 3;
    for (int u = threadIdx.x; u < (LDS_BYTES - LDSCTL_OFF) / 4; u += NTHREADS) ((LAS unsigned*)(L + LDSCTL_OFF))[u] = 0u;
    __syncthreads();
#if MK_PER_PHASE
#define GRID_BAR() do { } while (0)
#define GROUP_BAR() do { } while (0)
#else
#if SELF_INIT
    unsigned* const ctlw = (unsigned*)(args.ws + WS_CTL);
    XcdBarrier bar, gbar;
    bar.bar = ctlw + CW_BAR; bar.x = xb_xcc_id(); bar.st = MISC + 8; bar.gsize = (unsigned)G;
    gbar.bar = ctlw + CW_BAR + (1 + grp) * CW_BAR_STRIDE; gbar.x = bar.x; gbar.st = MISC + 10; gbar.gsize = (unsigned)GS;
    if (bx == 0) {
        const int t = (int)threadIdx.x;
        if (t < 9 * 51) { const int r = t / 51, k = t % 51;
            const int w = (k == 0) ? XB_TMO : (k <= 16) ? XB_XCNT(k - 1) : (k <= 32) ? XB_XSUB(k - 17) : (k <= 48) ? XB_XGEN(k - 33) : (k == 49) ? XB_TOP : XB_TOPGEN;
            __hip_atomic_store(ctlw + CW_BAR + r * CW_BAR_STRIDE + w, 0u, __ATOMIC_RELAXED, __HIP_MEMORY_SCOPE_AGENT); }
        asm volatile("s_waitcnt vmcnt(0)" ::: "memory");
        __syncthreads();
        if (t == 0) __hip_atomic_store(ctlw + CW_FLAG, INIT_MAGIC, __ATOMIC_RELAXED, __HIP_MEMORY_SCOPE_AGENT);
    }
#else
    XcdBarrier bar = xcd_barrier_post((unsigned*)(args.ws + WS_CTL) + CW_BAR, MISC + 8, (unsigned)G);
    XcdBarrier gbar = xcd_barrier_post((unsigned*)(args.ws + WS_CTL) + CW_BAR + (1 + grp) * CW_BAR_STRIDE, MISC + 10, (unsigned)GS);
#endif
#define GRID_BAR() xcd_barrier(bar, wave0 * 64 + lane_id_opaque())
#define GROUP_BAR() xcd_barrier(gbar, wave0 * 64 + lane_id_opaque())
#endif
    const int lo = args.ph_lo, hi = args.ph_hi;
#define IN(k) (st == (k))
#define SEAM(k) do { } while (0)
    const int NGW = G * NWAVES;
#define TID_NOW (wave0 * 64 + lane_id_opaque())
#define RELANE const int tid = wave0 * 64 + lane_id_opaque(), lane = tid & 63; (void)tid; (void)lane;
#define KA_PTR(T, off) (*(T const __attribute__((address_space(4)))*)(ka + (off)))
#define PH_BEGIN const int tid = wave0 * 64 + lane_id_opaque(), lane = tid & 63, wave = wave0, gw = vcu * NWAVES + wave; (void)lane; (void)gw; \
    const __attribute__((address_space(4))) char* ka = (const __attribute__((address_space(4))) char*)__builtin_amdgcn_kernarg_segment_ptr(); asm volatile("" : "+s"(ka)); \
    unsigned char* const ws = KA_PTR(unsigned char*, 184); float* const out = KA_PTR(float*, 176); (void)ws; (void)out; \
    const float* const x_prompt = KA_PTR(const float*, 0); const float* const x_sample = KA_PTR(const float*, 8); const float* const state_pool = KA_PTR(const float*, 16); const float* const state_conv = KA_PTR(const float*, 24); \
    const float* const cache_k = KA_PTR(const float*, 32); const float* const cache_v = KA_PTR(const float*, 40); const float* const mem_prompt = KA_PTR(const float*, 48); \
    const float* const g_mix = KA_PTR(const float*, 56); const float* const g_attn = KA_PTR(const float*, 64); const float* const g_mem = KA_PTR(const float*, 72); const float* const g_ffn = KA_PTR(const float*, 80); const float* const g_final = KA_PTR(const float*, 88); \
    const float* const w_pool = KA_PTR(const float*, 96); const float* const pool_scale = KA_PTR(const float*, 104); const float* const w_conv_in = KA_PTR(const float*, 112); const float* const w_conv = KA_PTR(const float*, 120); const float* const w_conv_out = KA_PTR(const float*, 128); \
    const float* const w_q = KA_PTR(const float*, 136); const float* const w_kv = KA_PTR(const float*, 144); const float* const w_o = KA_PTR(const float*, 152); const float* const w_up = KA_PTR(const float*, 160); const float* const w_down = KA_PTR(const float*, 168); \
    (void)x_prompt; (void)x_sample; (void)state_pool; (void)state_conv; (void)cache_k; (void)cache_v; (void)mem_prompt; (void)g_mix; (void)g_attn; (void)g_mem; (void)g_ffn; (void)g_final; (void)w_pool; (void)pool_scale; (void)w_conv_in; (void)w_conv; (void)w_conv_out; (void)w_q; (void)w_kv; (void)w_o; (void)w_up; (void)w_down; \
    bf16* const WPOOL = (bf16*)(ws + WS_WPOOL); bf16* const WQ = (bf16*)(ws + WS_WQ); bf16* const WO = (bf16*)(ws + WS_WO); bf16* const WKV = (bf16*)(ws + WS_WKV); \
    bf16* const WUP = (bf16*)(ws + WS_WUP); bf16* const WDN = (bf16*)(ws + WS_WDN); bf16* const WIN = (bf16*)(ws + WS_WIN); bf16* const WOUT = (bf16*)(ws + WS_WOUT); \
    bf16* const MN = (bf16*)(ws + WS_MN); bf16* const KB = (bf16*)(ws + WS_KB); bf16* const VT = (bf16*)(ws + WS_VT); float* const SSQ = (float*)(ws + WS_SSQ); \
    bf16* const X16 = (bf16*)(ws + WS_X); bf16* const P0 = (bf16*)(ws + WS_P0); bf16* const OB = (bf16*)(ws + WS_O); bf16* const CH = (bf16*)(ws + WS_CH); \
    bf16* const WQN = (bf16*)(ws + WS_WQN); bf16* const MT = (bf16*)(ws + WS_MT); bf16* const VW = (bf16*)(ws + WS_VW); bf16* const HB = (bf16*)(ws + WS_H); \
    bf16* const XS16 = (bf16*)(ws + SS_X); float* const SSQS = (float*)(ws + SS_SSQ); bf16* const P0S = (bf16*)(ws + SS_P0); bf16* const OS = (bf16*)(ws + SS_O); \
    float* const CHS = (float*)(ws + SS_CH); bf16* const HS = (bf16*)(ws + SS_H); float* const QS = (float*)(ws + SS_Q); \
    (void)WPOOL; (void)WQ; (void)WO; (void)WKV; (void)WUP; (void)WDN; (void)WIN; (void)WOUT; (void)MN; (void)KB; (void)VT; (void)SSQ; (void)X16; (void)P0; (void)OB; (void)CH; (void)WQN; (void)MT; (void)VW; (void)HB; (void)XS16; (void)SSQS; (void)P0S; (void)OS; (void)CHS; (void)HS; (void)QS;

#if MK_PER_PHASE
    const int soff = 0; const bool sfirst = false;
#else
    const int soff = SAMPLE_SHIFT ? (grp & 1) : 0;
    const bool sfirst = false;
#endif
    const int mflip = (MEMBER_FLIP && !MK_PER_PHASE) ? (MEMBER_FLIP_SEL) : 0;
#pragma unroll 1
    for (int ph = lo; ph < hi + soff; ++ph) {
#pragma unroll 1
    for (int pp = 0; pp < 2; ++pp) {
    const int which = pp ^ mflip;
    const int st = which ? ph - soff : ph;
    const bool doP = (which == 0), doS = (which == 1) || (st == 0);
    if (st < 0 || st >= NPHASES || (which == 1 && st == 0)) continue;
    if (IN(0)) { PH_BEGIN
        LAS float* scr = (LAS float*)(L + RING_OFF + wave * 16384);
        {
            constexpr int I_POOL = 4 * 4 * 8, I_Q = 16 * 32, I_KV = 16 * 64, I_UP = 16 * 128, I_DN = 64 * 32, I_IN = 16 * 96;
            constexpr int NITEMS = I_POOL + 2 * (I_Q + I_KV + I_Q + I_UP + I_DN) + I_IN + I_Q;
            for (int it = gw; it < NITEMS; it += NGW) {
                int r = it;
                if (r < I_POOL) { const int g = r >> 5, rr = r & 31, kb = rr >> 3, nb = rr & 7; p0_transpose_item(w_pool + g * 65536, 256, 256, WPOOL + g * 65536, 64 * kb, 32 * nb, 32 * nb, scr, lane); continue; } r -= I_POOL;
                bool done = false;
#pragma unroll 1
                for (int l = 0; l < 2 && !done; ++l) {
                    if (r < I_Q) { const int kb = r >> 5, nb = r & 31; p0_transpose_item(w_q + (size_t)l * D * D, D, D, WQ + (size_t)l * D * D, 64 * kb, 32 * nb, 32 * nb, scr, lane, g_attn + l * D); done = true; break; } r -= I_Q;
                    if (r < I_KV) { const int kb = r >> 6, nb = r & 63; p0_transpose_item(w_kv + (size_t)l * D * 2048, D, 2048, WKV + (size_t)l * 2048 * D, 64 * kb, 32 * nb, 32 * nb, scr, lane); done = true; break; } r -= I_KV;
                    if (r < I_Q) { const int kb = r >> 5, nb = r & 31; p0_transpose_item(w_o + (size_t)l * D * D, D, D, WO + (size_t)l * D * D, 64 * kb, 32 * nb, 32 * nb, scr, lane); done = true; break; } r -= I_Q;
                    if (r < I_UP) { const int kb = r >> 7, nb = r & 127; p0_transpose_item(w_up + (size_t)l * D * FF, D, FF, WUP + (size_t)l * FF * D, 64 * kb, 32 * nb, 32 * nb, scr, lane, g_ffn + l * D); done = true; break; } r -= I_UP;
                    if (r < I_DN) { const int kb = r >> 5, nb = r & 31; p0_transpose_item(w_down + (size_t)l * FF * D, FF, D, WDN + (size_t)l * D * FF, 64 * kb, 32 * nb, 32 * nb, scr, lane); done = true; break; } r -= I_DN;
                }
                if (done) continue;
                if (r < I_IN) { const int kb = r / 96, nb = r % 96; p0_transpose_item(w_conv_in, D, 3072, WIN, 64 * kb, 32 * nb, win_dest_row(32 * nb), scr, lane, g_mix + D); continue; } r -= I_IN;
                { const int kb = r >> 5, nb = r & 31; p0_transpose_item(w_conv_out, D, D, WOUT, 64 * kb, 32 * nb, 32 * nb, scr, lane); }
            }
        }
        for (int m = gw; m < MEMROWS; m += NGW) {
            const f32x4* xr = (const f32x4*)(mem_prompt + (size_t)m * D) + lane; f32x4 v[4]; float s = 0.f;
#pragma unroll
            for (int j = 0; j < 4; ++j) { v[j] = __builtin_nontemporal_load(xr + 64 * j); s += (v[j][0] * v[j][0] + v[j][1] * v[j][1]) + (v[j][2] * v[j][2] + v[j][3] * v[j][3]); }
            const float rstd = __builtin_amdgcn_rsqf(wave_sum(s) * (1.f / D) + EPS);
#pragma unroll
            for (int l = 0; l < 2; ++l) { v2u* o8 = (v2u*)(MN + ((size_t)l * MEMROWS + m) * D) + lane;
#pragma unroll
                for (int j = 0; j < 4; ++j) { const f32x4 gg = *((const f32x4*)(g_mem + l * D) + lane + 64 * j); const f32x4 w = v[j] * rstd * gg; v2u o; o.x = pk2(w[0], w[1]); o.y = pk2(w[2], w[3]); o8[64 * j] = o; } }
        }
        for (int m = gw; m < 2 * D; m += NGW) {
            const float gk = g_attn[m]; const f32x4* xr = (const f32x4*)(w_q + (size_t)m * D) + lane; v2u* o8 = (v2u*)(WQN + (size_t)m * D) + lane;
            f32x4 v[4];
#pragma unroll
            for (int j = 0; j < 4; ++j) v[j] = __builtin_nontemporal_load(xr + 64 * j);
#pragma unroll
            for (int j = 0; j < 4; ++j) { const f32x4 w = v[j] * gk; v2u o; o.x = pk2(w[0], w[1]); o.y = pk2(w[2], w[3]); o8[64 * j] = o; }
        }
        for (int it = gw; it < MS * 4; it += NGW) {
            const int b = it >> 2, g = it & 3, c4 = g * 256 + lane * 4;
            const f32x4* xr = (const f32x4*)(x_sample + (size_t)b * D) + lane; float s = 0.f;
#pragma unroll
            for (int j = 0; j < 4; ++j) { const f32x4 v = xr[64 * j]; s += (v[0] * v[0] + v[1] * v[1]) + (v[2] * v[2] + v[3] * v[3]); }
            const float rstd = __builtin_amdgcn_rsqf(wave_sum(s) * (1.f / D) + EPS);
            const f32x4 u = *(const f32x4*)(x_sample + (size_t)b * D + c4) * rstd * *(const f32x4*)(g_mix + c4);
            const int W = 2 << g; f32x4 S = u;
            const float* sp = state_pool + (size_t)b * 15 * D + c4;
            float* po = out + OPS + (size_t)b * 15 * D + c4;
            f32x4 sv[15];
#pragma unroll
            for (int r = 0; r < 15; ++r) sv[r] = __builtin_nontemporal_load((const f32x4*)(sp + (size_t)r * D));
#pragma unroll
            for (int r = 0; r < 15; ++r) { if (r >= 16 - W) S += sv[r]; if (r >= 1) *(f32x4*)(po + (size_t)(r - 1) * D) = sv[r]; }
            *(f32x4*)(po + (size_t)14 * D) = u;
            const f32x4 p = S * (1.0f / (float)W) - u; v2u o; o.x = pk2(p[0], p[1]); o.y = pk2(p[2], p[3]); *(v2u*)(P0S + (size_t)b * D + c4) = o;
        }
        __syncthreads();
        {
            LAS float* rs = (LAS float*)(L + RING_OFF);
            for (int it = vcu; it < BATCH * (SEQ / 32); it += G) {
                const int b = it >> 6, t0 = (it & 63) * 32;
                { f32x4 xv[6][4];
#pragma unroll
                  for (int j = 0; j < 6; ++j) { const int r = wave + 8 * j, t = t0 - 15 + r; const bool ok = (r < 47) && (t >= 0);
                      const f32x4* xr = (const f32x4*)(x_prompt + ((size_t)b * SEQ + (ok ? t : t0)) * D) + lane;
#pragma unroll
                      for (int q = 0; q < 4; ++q) xv[j][q] = xr[64 * q]; }
#pragma unroll
                  for (int j = 0; j < 6; ++j) { const int r = wave + 8 * j, t = t0 - 15 + r; float s = 0.f;
#pragma unroll
                      for (int q = 0; q < 4; ++q) { const f32x4 v = xv[j][q]; s += (v[0] * v[0] + v[1] * v[1]) + (v[2] * v[2] + v[3] * v[3]); }
                      const float rv = (t >= 0) ? __builtin_amdgcn_rsqf(wave_sum(s) * (1.f / D) + EPS) : 0.f;
                      if (lane == 0 && r < 47) rs[r] = rv; } }
                LDS_WAIT(); __syncthreads();
                const int g = wave & 3, tA = t0 + (wave >> 2) * 16, c4 = g * 256 + lane * 4;
                const float* xb = x_prompt + (size_t)b * SEQ * D + c4; const f32x4 g4 = *(const f32x4*)(g_mix + c4);
                bf16* pout = P0 + (size_t)b * SEQ * D + c4; float* poolout = out + OPP + (size_t)b * 15 * D + c4;
                const LAS float* rsw = rs + (wave >> 2) * 16;
                if (g == 0) pool_wave<2>(xb, rsw, g4, tA, pout, poolout); else if (g == 1) pool_wave<4>(xb, rsw, g4, tA, pout, poolout);
                else if (g == 2) pool_wave<8>(xb, rsw, g4, tA, pout, poolout); else pool_wave<16>(xb, rsw, g4, tA, pout, poolout);
                __syncthreads();
            }
        }
    }
    SEAM(0);

    if (IN(1)) { PH_BEGIN
        if (doP) { pg8::Gemm g{D, D, D}; pg8::KvOrder S{GS == 32 ? 16 : GS, (GS == 32 && mi >= 16) ? (1 << 20) : mi, grp, (const char*)MN, (const char*)WKV};
          pg8::EpiKV E{out + OMK, out + OMV, KB, VT};
          pg8::gemm_phase<pg8::EpiKV, pg8::KvOrder, true>(L + RING_OFF, g, S, E, TID_NOW); }
        if (doP) { pg8::Gemm g{D, 256, 256}; pg8::StaticOrder S;
          if (GS == 32) S.init(8, 4, 16, mi >= 16 ? mi - 16 : 1 << 20, grp * 8, P0, (size_t)256 * D * 2, WPOOL, (size_t)65536 * 2, (size_t)256 * 2);
          else S.init(8, 4, GS, mi, grp * 8, P0, (size_t)256 * D * 2, WPOOL, (size_t)65536 * 2, (size_t)256 * 2);
          pg8::EpiRes<true> E{x_prompt, X16, SSQ, pool_scale};
          pg8::gemm_phase<pg8::EpiRes<true>, pg8::StaticOrder, true>(L + RING_OFF, g, S, E, TID_NOW); }
        if (doS) { RELANE for (int cp = mi; cp < 32; cp += GS) s_res_unit<1>(P0S + (cp >> 3) * 256, D, WPOOL, 256, 256, cp, 16 * grp, x_sample, XS16, SSQS, pool_scale, L + RING_OFF, wave, lane); }
    }
    SEAM(1);

    if (IN(2)) { PH_BEGIN
        if (doS) { RELANE for (int cp = mi; cp < 32; cp += GS) s_q_unit(XS16, WQ, cp, 16 * grp, SSQS, QS, L + RING_OFF, wave, lane); }
        if (doP) for (int idx = mi; idx < 64; idx += GS) {
            const int ly = idx >> 5, kind = (idx >> 4) & 1, a = (idx >> 2) & 3, q = idx & 3;
            const bf16* Ap; const bf16* Bp; bf16* Op; pg8::Unit u; float sc;
            if (kind == 0) {
                Ap = KB + ((size_t)ly * MEMROWS + grp * 256) * D + a * 256; Bp = WQN + ((size_t)ly * D + 256 * q) * D + a * 256;
                Op = MT + (size_t)((ly * BATCH + grp) * NH + a) * 256 * D; u = pg8::Unit{0, q}; sc = QSCALE;
            } else {
                Ap = WO + ((size_t)ly * D + 256 * a) * D + q * 256; Bp = VT + ((size_t)ly * MEMROWS + grp * 256) * D + q * 256;
                Op = VW + (size_t)(ly * BATCH + grp) * D * D; u = pg8::Unit{a, q}; sc = 1.f;
            }
            pg8::Gemm g{D, D, 256}; pg8::SingleOrder S{u, (const char*)Ap, (const char*)Bp};
            pg8::EpiBf16 E{Op, D, sc};
            pg8::gemm_phase<pg8::EpiBf16, pg8::SingleOrder, true>(L + RING_OFF, g, S, E, TID_NOW);
            __syncthreads();
        }
    }
    {
        const int l = (st >= 7) ? 1 : 0, pb = l ? 10 : 3;
        {
            if (IN(7)) { PH_BEGIN
                const LAS float* rsdp = nullptr;
                const bool tbl = (GS & 7) == 0; LAS float* t_ = (LAS float*)(L + RSD_OFF); if (tbl) rsdp = t_;
                if (doP) { pg8::Gemm g{D, D, D}; pg8::StaticOrder S; S.init(8, 12, GS, mi, grp * 8, X16, (size_t)256 * D * 2, WIN, (size_t)256 * D * 2);
                  pg8::EpiRow<2> E{OB, D, SSQ, 1.f, CH, out + OCP, rsdp};
                  const int pnl = grp * 8 + (mi & 7);
                  pg8::gemm_phase<pg8::EpiRow<2>, pg8::StaticOrder, true>(L + RING_OFF, g, S, E, TID_NOW, [&](int t) { if (tbl) rstd_table(SSQ, pnl, t_, t); }); }
                if (doS) { RELANE
                for (int c2 = mi; c2 < 32; c2 += GS) {
                    const int ca = 32 * c2, cb = ca + 16; const int ra = 1024 + (ca >> 7) * 256 + (ca & 127), rb = 1024 + (cb >> 7) * 256 + (cb & 127);
                    const int brow[6] = {ca, ra, ra + 128, cb, rb, rb + 128};
                    const float rs = srstd(SSQS, 16 * grp + (lane & 15), lane >> 4);
                    const int prow = 16 * grp + (lane & 15), pc = ((wave & 1) ? cb : ca) + 4 * (lane >> 4);
                    const f32x4 s0 = *(const f32x4*)(state_conv + ((size_t)prow * 2 + 0) * D + pc), s1 = *(const f32x4*)(state_conv + ((size_t)prow * 2 + 1) * D + pc);
                    const f32x4 w0 = *(const f32x4*)(w_conv + pc), w1 = *(const f32x4*)(w_conv + D + pc), w2 = *(const f32x4*)(w_conv + 2 * D + pc);
                    sgemm2<1, 6, 3, 4>(XS16, D, 16 * grp, WIN, D, brow, D, L + RING_OFF, wave, lane, [&](f32x4 (&a)[3], int row, int ct0, int fq) {
                        const int c0 = (ct0 == 0 ? ca : cb) + 4 * fq;
                        const f32x4 gb = a[0] * rs, chv = a[1] * a[2] * (rs * rs);
                        const f32x4 cv = s0 * w0 + s1 * w1 + chv * w2;
                        const unsigned g01 = pk2(gb[0], gb[1]), g23 = pk2(gb[2], gb[3]);
                        v2u o; o.x = pk2(bflo(g01) * cv[0], bfhi(g01) * cv[1]); o.y = pk2(bflo(g23) * cv[2], bfhi(g23) * cv[3]);
                        *(v2u*)(P0S + (size_t)row * D + c0) = o;
                        *(f32x4*)(out + OCS + ((size_t)row * 2 + 0) * D + c0) = s1; *(f32x4*)(out + OCS + ((size_t)row * 2 + 1) * D + c0) = chv; }); }
                }
            }
            SEAM(7);
            if (IN(8)) { PH_BEGIN
                const int gt = mi * NTHREADS + tid, NT = GS * NTHREADS;
                if (doP) for (int it0 = gt; it0 < (SEQ / 4) * 128; it0 += 2 * NT) {
                    v4u gb[2][4], cw[2][6];
#pragma unroll
                    for (int q = 0; q < 2; ++q) { const int it = it0 + q * NT; const bool ok = it < (SEQ / 4) * 128; const int t0 = ok ? (it >> 7) * 4 : 0, c8 = (it & 127) * 8; const size_t r0 = (size_t)grp * SEQ + t0;
#pragma unroll
                        for (int j = 0; j < 4; ++j) gb[q][j] = __builtin_nontemporal_load((const v4u*)(OB + (r0 + j) * D + c8));
#pragma unroll
                        for (int j = 0; j < 6; ++j) { const int dt = j - 2; cw[q][j] = *(const v4u*)(CH + (r0 + ((t0 + dt >= 0) ? dt : 0)) * D + c8); } }
#pragma unroll
                    for (int q = 0; q < 2; ++q) { const int it = it0 + q * NT; if (it >= (SEQ / 4) * 128) break; const int t0 = (it >> 7) * 4, c8 = (it & 127) * 8; const size_t r0 = (size_t)grp * SEQ + t0;
                        if (t0 == 0) { cw[q][0] = (v4u){0u, 0u, 0u, 0u}; cw[q][1] = (v4u){0u, 0u, 0u, 0u}; }
                        const f32x4 w0a = *(const f32x4*)(w_conv + c8), w0b = *(const f32x4*)(w_conv + c8 + 4), w1a = *(const f32x4*)(w_conv + D + c8), w1b = *(const f32x4*)(w_conv + D + c8 + 4),
                                    w2a = *(const f32x4*)(w_conv + 2 * D + c8), w2b = *(const f32x4*)(w_conv + 2 * D + c8 + 4);
#pragma unroll
                        for (int r = 0; r < 4; ++r) { v4u o;
#pragma unroll
                            for (int j = 0; j < 4; ++j) { const float wl0 = (j < 2) ? w0a[2 * j] : w0b[2 * j - 4], wh0 = (j < 2) ? w0a[2 * j + 1] : w0b[2 * j - 3];
                                const float wl1 = (j < 2) ? w1a[2 * j] : w1b[2 * j - 4], wh1 = (j < 2) ? w1a[2 * j + 1] : w1b[2 * j - 3];
                                const float wl2 = (j < 2) ? w2a[2 * j] : w2b[2 * j - 4], wh2 = (j < 2) ? w2a[2 * j + 1] : w2b[2 * j - 3];
                                const float lo_ = bflo(gb[q][r][j]) * (bflo(cw[q][r][j]) * wl0 + bflo(cw[q][r + 1][j]) * wl1 + bflo(cw[q][r + 2][j]) * wl2);
                                const float hi_ = bfhi(gb[q][r][j]) * (bfhi(cw[q][r][j]) * wh0 + bfhi(cw[q][r + 1][j]) * wh1 + bfhi(cw[q][r + 2][j]) * wh2);
                                o[j] = pk2(lo_, hi_); }
                            *(v4u*)(P0 + (r0 + r) * D + c8) = o; } }
                }
                if (doS) { for (int cp = mi; cp < 32; cp += GS) s_res_unit<4>(P0S, D, WOUT, D, D, cp, 16 * grp, nullptr, XS16, SSQS, nullptr, L + RING_OFF, wave, lane); }
            }
            SEAM(8);
            if (IN(9)) { PH_BEGIN
                if (doP) { pg8::Gemm g{D, D, D}; pg8::StaticOrder S; S.init(8, 4, GS, mi, grp * 8, P0, (size_t)256 * D * 2, WOUT, (size_t)256 * D * 2);
                  pg8::EpiRes<false> E{nullptr, X16, SSQ, nullptr};
                  pg8::gemm_phase<pg8::EpiRes<false>, pg8::StaticOrder, true>(L + RING_OFF, g, S, E, TID_NOW); }
                if (doS) { RELANE for (int cp = mi; cp < 32; cp += GS) s_q_unit(XS16, WQ + (size_t)D * D, cp, 16 * grp, SSQS, QS, L + RING_OFF, wave, lane); }
            }
            SEAM(9);
        }
#define LAYER_W const bf16* WQl = WQ + (size_t)l * D * D; const bf16* WOl = WO + (size_t)l * D * D; const bf16* WUPl = WUP + (size_t)l * FF * D; const bf16* WDNl = WDN + (size_t)l * D * FF; (void)WQl; (void)WOl; (void)WUPl; (void)WDNl;
        if (IN(pb)) { PH_BEGIN LAYER_W
#pragma unroll 1
            for (int half = 0; half < 2; ++half) {
            const bool sampleHalf = ((half == 0) == sfirst);
            if (doP && !sampleHalf) for (int itl = mi; itl < 32; itl += GS) {
                const int pm = grp * 8 + (itl >> 2), h = itl & 3;
                pg8::Gemm g{D, D, D}; pg8::SingleOrder S{{pm, h}, (const char*)(X16 + (size_t)pm * 256 * D), (const char*)(MT + (size_t)((l * BATCH + grp) * NH + h) * 256 * D)};
                pg8::EpiSoftmax E{OB, D, SSQ};
                pg8::gemm_phase<pg8::EpiSoftmax, pg8::SingleOrder, false>(L + RING_OFF, g, S, E, TID_NOW);
                LDS_WAIT(); __builtin_amdgcn_s_barrier(); asm volatile("" ::: "memory");
            }
            if (doS && sampleHalf) { RELANE
                LAS float* sc = (LAS float*)(L + RING_OFF);
                LAS float* po = (LAS float*)(L + RING_OFF + 1024);
                for (int it0 = mi; it0 < 64; it0 += 2 * GS) {
                    const bool pair = (it0 + GS < 64);
#pragma unroll 1
                    for (int iu = 0; iu < 2; ++iu) {
                        if (iu == 1 && !pair) break;
                        const int it = it0 + iu * GS, b = 16 * grp + (it >> 2), h = it & 3;
                        const f32x4 q4 = *(const f32x4*)(QS + (size_t)b * D + h * 256 + lane * 4);
                        const float* kp = cache_k + (((size_t)l * MS + b) * NMEM + wave * 32) * D + h * 256 + lane * 4;
                        const float* vp = cache_v + (((size_t)l * MS + b) * NMEM + wave * 32) * D + h * 256 + lane * 4;
                        f32x4 kv[32]; float p[32];
#pragma unroll
                        for (int n = 0; n < 32; ++n) kv[n] = __builtin_nontemporal_load((const f32x4*)(kp + (size_t)n * D));
#pragma unroll
                        for (int n = 0; n < 32; ++n) { p[n] = (q4[0] * kv[n][0] + q4[1] * kv[n][1]) + (q4[2] * kv[n][2] + q4[3] * kv[n][3]); kv[n] = __builtin_nontemporal_load((const f32x4*)(vp + (size_t)n * D)); }
                        treduce32(p, lane);
                        if ((lane & 1) == 0) sc[wave * 32 + (lane >> 1)] = p[0];
                        LDS_WAIT(); __builtin_amdgcn_s_barrier(); asm volatile("" ::: "memory");
                        float mx, sm = 0.f; const f32x4 sv = *(const LAS f32x4*)(sc + lane * 4);
                        mx = fmaxf(fmaxf(sv[0], sv[1]), fmaxf(sv[2], sv[3]));
                        mx = wave_max(mx);
#pragma unroll
                        for (int j = 0; j < 4; ++j) sm += __builtin_amdgcn_exp2f(sv[j] - mx);
                        sm = wave_sum(sm);
                        f32x4 acc = {0.f, 0.f, 0.f, 0.f};
#pragma unroll
                        for (int n = 0; n < 32; ++n) { const float pn_ = __builtin_amdgcn_exp2f(sc[wave * 32 + n] - mx); acc += kv[n] * pn_; }
                        *(LAS f32x4*)(po + wave * 256 + lane * 4) = acc;
                        LDS_WAIT(); __builtin_amdgcn_s_barrier(); asm volatile("" ::: "memory");
                        if (tid < 256) { float o = 0.f;
#pragma unroll
                            for (int w = 0; w < 8; ++w) o += po[w * 256 + tid];
                            OS[(size_t)b * D + h * 256 + tid] = (bf16)f2bf(o / sm); }
                        LDS_WAIT(); __builtin_amdgcn_s_barrier(); asm volatile("" ::: "memory");
                    }
                }
            }
            }
        }
        SEAM(pb);
        if (IN(pb + 1)) { PH_BEGIN LAYER_W
            if (doP) { pg8::Gemm g{D, D, D}; pg8::StaticOrder S; S.init(8, 4, GS, mi, grp * 8, OB, (size_t)256 * D * 2, VW + (size_t)(l * BATCH + grp) * D * D, (size_t)256 * D * 2);
              pg8::EpiRes<false> E{nullptr, X16, SSQ, nullptr};
              pg8::gemm_phase<pg8::EpiRes<false>, pg8::StaticOrder, true>(L + RING_OFF, g, S, E, TID_NOW); }
            if (doS) { RELANE for (int cp = mi; cp < 32; cp += GS) s_res_unit<4>(OS, D, WOl, D, D, cp, 16 * grp, nullptr, XS16, SSQS, nullptr, L + RING_OFF, wave, lane); }
        }
        SEAM(pb + 2);
        if (IN(pb + 2)) { PH_BEGIN LAYER_W
            const LAS float* rsdp = nullptr;
            const bool tbl = (GS & 7) == 0; LAS float* t_ = (LAS float*)(L + RSD_OFF); if (tbl) rsdp = t_;
            if (doP) { pg8::Gemm g{D, D, D}; pg8::StaticOrder S; S.init(8, 16, GS, mi, grp * 8, X16, (size_t)256 * D * 2, WUPl, (size_t)256 * D * 2);
              pg8::EpiRow<1> E{HB, FF, SSQ, 1.f, nullptr, nullptr, rsdp};
              const int pnl = grp * 8 + (mi & 7);
              pg8::gemm_phase<pg8::EpiRow<1>, pg8::StaticOrder, true>(L + RING_OFF, g, S, E, TID_NOW, [&](int t) { if (tbl) rstd_table(SSQ, pnl, t_, t); }); }
            if (doS) { RELANE for (int c8 = mi; c8 < 32; c8 += GS) { const int brow[8] = {128 * c8, 128 * c8 + 16, 128 * c8 + 32, 128 * c8 + 48, 128 * c8 + 64, 128 * c8 + 80, 128 * c8 + 96, 128 * c8 + 112};
                const float rs = srstd(SSQS, 16 * grp + (lane & 15), lane >> 4);
                sgemm2<1, 8, 1, 4>(XS16, D, 16 * grp, WUPl, D, brow, D, L + RING_OFF, wave, lane, [&](f32x4 (&a)[1], int row, int ct0, int fq) {
                    const f32x4 v0 = relu2(a[0] * rs);
                    v2u p0; p0.x = pk2(v0[0], v0[1]); p0.y = pk2(v0[2], v0[3]);
                    *(v2u*)(HS + (size_t)row * FF + 128 * c8 + 16 * ct0 + 4 * fq) = p0; }); } }
        }
        SEAM(pb + 3);
        if (IN(pb + 3)) { PH_BEGIN LAYER_W
            if (doP) { pg8::Gemm g{FF, FF, FF}; pg8::StaticOrder S; S.init(8, 4, GS, mi, grp * 8, HB, (size_t)256 * FF * 2, WDNl, (size_t)256 * FF * 2);
              pg8::EpiRes<false> E{nullptr, X16, SSQ, nullptr};
              pg8::gemm_phase<pg8::EpiRes<false>, pg8::StaticOrder, true>(L + RING_OFF, g, S, E, TID_NOW); }
            if (doS) { RELANE for (int cp = mi; cp < 32; cp += GS) s_res_unit<8>(HS, FF, WDNl, FF, FF, cp, 16 * grp, nullptr, XS16, SSQS, nullptr, L + RING_OFF, wave, lane); }
        }
        SEAM(pb + 4);
    }
    if (IN(14)) { PH_BEGIN
        const int mlo = doP ? 0 : SEQ, mhi = doS ? SEQ + 16 : SEQ;
        for (int ml0 = mlo + mi * NWAVES + wave; ml0 < mhi; ml0 += 4 * GS * NWAVES) {
            float sv[4]; v4u xw[4][2];
#pragma unroll
            for (int q = 0; q < 4; ++q) { const int ml = ml0 + q * GS * NWAVES; const bool ok = ml < mhi; const int mlc = ok ? ml : ml0;
                const bf16* xr;
                if (mlc < SEQ) { const int m = grp * SEQ + mlc; sv[q] = (lane < 16) ? SSQ[(size_t)m * 16 + lane] : 0.f; xr = X16 + (size_t)m * D; }
                else { const int r = 16 * grp + (mlc - SEQ); sv[q] = SSQS[r * 64 + lane]; xr = XS16 + (size_t)r * D; }
                xw[q][0] = __builtin_nontemporal_load((const v4u*)xr + lane); xw[q][1] = __builtin_nontemporal_load((const v4u*)xr + lane + 64); }
#pragma unroll
            for (int q = 0; q < 4; ++q) { const int ml = ml0 + q * GS * NWAVES; if (ml >= mhi) break;
                const float rs = __builtin_amdgcn_rsqf(wave_sum(sv[q]) * (1.f / D) + EPS);
                float* yr = (ml < SEQ) ? out + OY + (size_t)(grp * SEQ + ml) * D : out + OYS + (size_t)(16 * grp + (ml - SEQ)) * D;
#pragma unroll
                for (int j = 0; j < 2; ++j) { const v4u w = xw[q][j]; const f32x4 g0 = *((const f32x4*)g_final + 2 * (lane + 64 * j)), g1 = *((const f32x4*)g_final + 2 * (lane + 64 * j) + 1);
                    const f32x4 x0 = {bflo(w.x), bfhi(w.x), bflo(w.y), bfhi(w.y)}, x1 = {bflo(w.z), bfhi(w.z), bflo(w.w), bfhi(w.w)};
                    f32x4* yp = (f32x4*)yr + 2 * (lane + 64 * j); yp[0] = x0 * rs * g0; yp[1] = x1 * rs * g1; } }
        }
    }
    }
#if SELF_INIT && !MK_PER_PHASE
    if (ph == 0) {
        if (wave0 == 0 && lane_id_opaque() == 0) {
            unsigned sp_ = 0u;
            while (__hip_atomic_load(ctlw + CW_FLAG, __ATOMIC_RELAXED, __HIP_MEMORY_SCOPE_AGENT) != INIT_MAGIC) { __builtin_amdgcn_s_sleep(2); if (++sp_ > (1u << 22)) break; }
            (void)xb_add(&bar.bar[XB_XCNT(bar.x)], 1u); (void)xb_add(&gbar.bar[XB_XCNT(gbar.x)], 1u);
        }
    }
#endif
    if (ph + 1 < hi + soff) { if (ph == 0) { GRID_BAR();
#if STAGGER_TICKS > 0
            { const unsigned long long t0 = __builtin_amdgcn_s_memrealtime(); const unsigned long long dt = (unsigned long long)grp * STAGGER_TICKS;
              while (__builtin_amdgcn_s_memrealtime() - t0 < dt) __builtin_amdgcn_s_sleep(4); }
#endif
        } else GROUP_BAR(); }
    }
#if SELF_INIT && !MK_PER_PHASE
    if (bx == 0 && threadIdx.x == 0) __hip_atomic_store(ctlw + CW_FLAG, 0u, __ATOMIC_RELAXED, __HIP_MEMORY_SCOPE_AGENT);
#endif
#undef IN
#undef SEAM
#undef GRID_BAR
}

extern "C" void kernel_launch(void* const* d_in, const int* in_sizes, int n_in, void* d_out, int out_size, void* d_ws, size_t ws_size, hipStream_t stream) {
    static int grid = 0;
    if (grid == 0) {
        if (n_in != 22 || ws_size < WS_END) { fprintf(stderr, "kernel_launch: unexpected inputs (n_in %d, ws %zu)\n", n_in, ws_size); grid = -1; return; }
        int dev = 0, cus = 0, per_cu = 0;
        if (hipGetDevice(&dev) != hipSuccess || hipDeviceGetAttribute(&cus, hipDeviceAttributeMultiprocessorCount, dev) != hipSuccess) { grid = -1; return; }
        if (hipFuncSetAttribute((const void*)mk_fwd, hipFuncAttributeMaxDynamicSharedMemorySize, LDS_BYTES) != hipSuccess) { fprintf(stderr, "kernel_launch: hipFuncSetAttribute failed\n"); grid = -1; return; }
        if (hipOccupancyMaxActiveBlocksPerMultiprocessor(&per_cu, (const void*)mk_fwd, NTHREADS, LDS_BYTES) != hipSuccess || per_cu < 1)
            fprintf(stderr, "kernel_launch: note: occupancy query reports %d workgroups per CU\n", per_cu);
        (void)hipGetLastError();
        grid = cus;
    }
    if (grid < 0) return;
#if !SELF_INIT || MK_PER_PHASE
    (void)hipMemsetAsync((char*)d_ws + WS_CTL, 0, CTL_ZERO_BYTES, stream);
#endif
    Args a{};
    for (int i = 0; i < 22; ++i) a.in[i] = (const float*)d_in[i];
    a.out = (float*)d_out; a.ws = (unsigned char*)d_ws;
#if MK_PER_PHASE
    for (int p = 0; p < NPHASES; ++p) { a.ph_lo = p; a.ph_hi = p + 1; hipLaunchKernelGGL(mk_fwd, dim3(grid), dim3(NTHREADS), LDS_BYTES, stream, a); }
#else
    a.ph_lo = 0; a.ph_hi = NPHASES; hipLaunchKernelGGL(mk_fwd, dim3(grid), dim3(NTHREADS), LDS_BYTES, stream, a);
#endif
}
```

```cpp
#include <hip/hip_runtime.h>
#include <cstdio>
#include <cstdint>

#ifndef SAMPLE_SHIFT
#define SAMPLE_SHIFT 1
#endif
#ifndef SELF_INIT
#define SELF_INIT 1
#endif
#ifndef MEMBER_FLIP
#define MEMBER_FLIP 1
#endif
#ifndef MEMBER_FLIP_SEL
#define MEMBER_FLIP_SEL (mi & 1)
#endif
#ifndef STAGGER_TICKS
#define STAGGER_TICKS 0
#endif
#ifndef MK_PER_PHASE
#define MK_PER_PHASE 0
#endif

constexpr int D = 1024, BATCH = 8, SEQ = 2048, MP = BATCH * SEQ  , MS = 128  ;
constexpr int NMEM = 256, NH = 4, HD = 256, FF = 4096, MEMROWS = BATCH * NMEM  ;
constexpr float EPS = 1e-6f;
constexpr float QSCALE = 0.0625f * 1.4426950408889634f;

constexpr size_t OY = 0, OYS = 16777216, OPP = 16908288, OCP = 17031168, OMK = 17047552, OMV = 21241856, OPS = 25436160, OCS = 27402240;

__device__ __forceinline__ int lane_id_opaque() { int l; asm volatile("v_mbcnt_lo_u32_b32 %0, -1, 0\n\tv_mbcnt_hi_u32_b32 %0, -1, %0" : "=v"(l)); return l; }
#define SWZ_XOR(v, m) __builtin_bit_cast(float, __builtin_amdgcn_ds_swizzle(__builtin_bit_cast(int, (float)(v)), (((m) << 10) | 0x1f)))
__device__ __forceinline__ void swap32(float& a, float& b) { asm volatile("s_nop 1\n\tv_permlane32_swap_b32 %0, %1\n\ts_nop 1" : "+v"(a), "+v"(b)); }
__device__ __forceinline__ float add_x32(float v) { float a = v, b = v; swap32(a, b); return a + b; }
__device__ __forceinline__ float max_x32(float v) { float a = v, b = v; swap32(a, b); return fmaxf(a, b); }
__device__ __forceinline__ float add_x16_x32(float v) { v += SWZ_XOR(v, 16); return add_x32(v); }
__device__ __forceinline__ float max_x16_x32(float v) { v = fmaxf(v, SWZ_XOR(v, 16)); return max_x32(v); }
__device__ __forceinline__ float wave_sum(float v) { v += SWZ_XOR(v, 1); v += SWZ_XOR(v, 2); v += SWZ_XOR(v, 4); v += SWZ_XOR(v, 8); v += SWZ_XOR(v, 16); return add_x32(v); }
__device__ __forceinline__ float wave_max(float v) { v = fmaxf(v, SWZ_XOR(v, 1)); v = fmaxf(v, SWZ_XOR(v, 2)); v = fmaxf(v, SWZ_XOR(v, 4)); v = fmaxf(v, SWZ_XOR(v, 8)); v = fmaxf(v, SWZ_XOR(v, 16)); return max_x32(v); }

namespace pg8 {
#define PG8_LAS __attribute__((address_space(3)))
typedef unsigned short bf16_t;
typedef short bf16x8 __attribute__((ext_vector_type(8)));
typedef float f32x4 __attribute__((ext_vector_type(4)));
typedef float f32x2 __attribute__((ext_vector_type(2)));
typedef unsigned u32x4 __attribute__((ext_vector_type(4)));
typedef unsigned u32x2 __attribute__((ext_vector_type(2)));
constexpr int BM = 256, BK = 64, HALF = 128, HTB = HALF * BK * 2, STAGE_BYTES = 8 * HTB, NXCD = 8, WGM = 8;

__host__ __device__ __forceinline__ int lds_byte(int r, int c) { const int st = (r >> 4) * 2 + (c >> 5), rr = r & 15, cc = c & 31, ob = rr * 64 + cc * 2; return st * 1024 + (ob ^ (((ob >> 9) & 1) << 5)); }
__host__ __device__ __forceinline__ void stage_rc(int b, int& R, int& C) { const int st = b / 1024, sb = b % 1024, swz = sb ^ (((sb >> 9) & 1) << 5); R = (st >> 1) * 16 + swz / 64; C = (st & 1) * 32 + (swz % 64) / 2; }
__host__ __device__ __forceinline__ int perm32(int rho) { const int n = rho >> 4, i = rho & 15; return 8 * (i >> 2) + 4 * n + (i & 3); }

struct Unit { int pm, pn; };
struct Gemm { int lda, ldb, K; };

__device__ __forceinline__ unsigned cvt_pk_bf16(float lo, float hi) { unsigned r; asm volatile("v_cvt_pk_bf16_f32 %0, %1, %2" : "=v"(r) : "v"(lo), "v"(hi)); return r; }

struct StaticOrder {
    int nM, nN, nwg, G, c, pm0;
    const char* A; const char* B; size_t astep, bstep, apn;
    __device__ void init(int nM_, int nN_, int G_, int c_, int pm0_, const void* A_, size_t astep_, const void* B_, size_t bstep_, size_t apn_ = 0) {
        nM = nM_; nN = nN_; nwg = nM * nN; G = G_; c = c_; pm0 = pm0_; A = (const char*)A_; B = (const char*)B_; astep = astep_; bstep = bstep_; apn = apn_; }
    __device__ bool next(int i, Unit& u) const {
        const long L = (long)i * G + c; if (L >= nwg) return false;
        u.pm = pm0 + (int)(L % nM); u.pn = (int)(L / nM); return true;
    }
    __device__ __forceinline__ const char* aptr(const Unit& u) const { return A + (size_t)u.pm * astep + (size_t)u.pn * apn; }
    __device__ __forceinline__ const char* bptr(const Unit& u) const { return B + (size_t)u.pn * bstep; }
};
struct KvOrder {
    int G, c, batch; const char* A; const char* B;
    __device__ bool next(int i, Unit& u) const { const int L = i * G + c; if (L >= 16) return false; u.pm = (L >> 3) * 8 + batch; u.pn = L & 7; return true; }
    __device__ __forceinline__ const char* aptr(const Unit& u) const { return A + (size_t)u.pm * (256 * 1024 * 2); }
    __device__ __forceinline__ const char* bptr(const Unit& u) const { return B + (size_t)((u.pm >> 3) * 2048 + u.pn * 256) * (1024 * 2); }
};
struct SingleOrder {
    Unit u0; const char* A; const char* B;
    __device__ bool next(int i, Unit& u) const { if (i) return false; u = u0; return true; }
    __device__ __forceinline__ const char* aptr(const Unit&) const { return A; }
    __device__ __forceinline__ const char* bptr(const Unit&) const { return B; }
};


template <bool BASE32> struct EpiRes {
    static constexpr bool PERM = true, AFTER_DRAIN = false;
    const float* base32; bf16_t* x16; float* ssq; const float* cscale;
    __device__ __forceinline__ void operator()(const f32x4 (&acc)[2][2][4][2], const Unit& u, int wr, int wc, int fr, int fq) const {
        const int col0 = u.pn * BM + wc * 32 + 8 * fq;
        f32x4 cs[2][2];
#pragma unroll
        for (int bj = 0; bj < 2; ++bj)
#pragma unroll
            for (int n = 0; n < 2; ++n) cs[bj][n] = cscale ? *(const f32x4*)(cscale + col0 + bj * HALF + n * 4) : (f32x4){1.f, 1.f, 1.f, 1.f};
        constexpr int HSTEP = BASE32 ? 1 : 2;
#pragma unroll
        for (int a0 = 0; a0 < 2; a0 += HSTEP) {
        u32x4 bw[HSTEP][4][2]; f32x4 bf[BASE32 ? 1 : 1][4][2][2];
#pragma unroll
        for (int ah = 0; ah < HSTEP; ++ah)
#pragma unroll
            for (int m = 0; m < 4; ++m) { const int row = u.pm * BM + (a0 + ah) * HALF + wr * 64 + m * 16 + fr; const size_t off = (size_t)row * D + col0;
#pragma unroll
                for (int bj = 0; bj < 2; ++bj) {
                    if (BASE32) { bf[0][m][bj][0] = __builtin_nontemporal_load((const f32x4*)(base32 + off + bj * HALF)); bf[0][m][bj][1] = __builtin_nontemporal_load((const f32x4*)(base32 + off + bj * HALF + 4)); }
                    else bw[ah][m][bj] = *(const u32x4*)(x16 + off + bj * HALF); } }
#pragma unroll
        for (int ah = 0; ah < HSTEP; ++ah) { const int ai = a0 + ah;
#pragma unroll
            for (int m = 0; m < 4; ++m) { const int row = u.pm * BM + ai * HALF + wr * 64 + m * 16 + fr; const size_t off = (size_t)row * D + col0; float ss = 0.f;
#pragma unroll
                for (int bj = 0; bj < 2; ++bj) { f32x4 b0, b1;
                    if (BASE32) { b0 = bf[0][m][bj][0]; b1 = bf[0][m][bj][1]; }
                    else { const u32x4 w = bw[ah][m][bj];
                        b0 = (f32x4){__builtin_bit_cast(float, w.x << 16), __builtin_bit_cast(float, w.x & 0xffff0000u), __builtin_bit_cast(float, w.y << 16), __builtin_bit_cast(float, w.y & 0xffff0000u)};
                        b1 = (f32x4){__builtin_bit_cast(float, w.z << 16), __builtin_bit_cast(float, w.z & 0xffff0000u), __builtin_bit_cast(float, w.w << 16), __builtin_bit_cast(float, w.w & 0xffff0000u)}; }
                    const f32x4 v0 = b0 + acc[ai][bj][m][0] * cs[bj][0], v1 = b1 + acc[ai][bj][m][1] * cs[bj][1];
                    ss += ((v0[0] * v0[0] + v0[1] * v0[1]) + (v0[2] * v0[2] + v0[3] * v0[3])) + ((v1[0] * v1[0] + v1[1] * v1[1]) + (v1[2] * v1[2] + v1[3] * v1[3]));
                    u32x4 o; o.x = cvt_pk_bf16(v0[0], v0[1]); o.y = cvt_pk_bf16(v0[2], v0[3]); o.z = cvt_pk_bf16(v1[0], v1[1]); o.w = cvt_pk_bf16(v1[2], v1[3]);
                    *(u32x4*)(x16 + off + bj * HALF) = o; }
                ss = add_x16_x32(ss);
                if (fq == 0) ssq[(size_t)row * 16 + u.pn * 4 + wc] = ss; }
        }
        }
    }
};
__device__ __forceinline__ float rstd_from_ssq16(const float* ssq, int row) {
    const f32x4* sp = (const f32x4*)(ssq + (size_t)row * 16); const f32x4 s = (sp[0] + sp[1]) + (sp[2] + sp[3]);
    return __builtin_amdgcn_rsqf(((s[0] + s[1]) + (s[2] + s[3])) * (1.0f / D) + EPS);
}
template <int MODE> struct EpiRow {
    static constexpr bool PERM = true, AFTER_DRAIN = false;
    bf16_t* O; int ldc; const float* ssq; float scale; bf16_t* O2; float* convout; const PG8_LAS float* rsd;
    __device__ __forceinline__ void operator()(const f32x4 (&acc)[2][2][4][2], const Unit& u, int wr, int wc, int fr, int fq) const {
        const int colw = wc * 32 + 8 * fq;
        float rsv[2][4];
        if (rsd) {
#pragma unroll
          for (int ai = 0; ai < 2; ++ai)
#pragma unroll
              for (int m = 0; m < 4; ++m) rsv[ai][m] = rsd[ai * HALF + wr * 64 + m * 16 + fr];
        } else { f32x4 qv[2][4];
#pragma unroll
          for (int ai = 0; ai < 2; ++ai)
#pragma unroll
              for (int m = 0; m < 4; ++m) qv[ai][m] = *(const f32x4*)(ssq + (size_t)(u.pm * BM + ai * HALF + wr * 64 + m * 16 + fr) * 16 + 4 * fq);
#pragma unroll
          for (int ai = 0; ai < 2; ++ai)
#pragma unroll
              for (int m = 0; m < 4; ++m) { const f32x4 q = qv[ai][m]; rsv[ai][m] = __builtin_amdgcn_rsqf(add_x16_x32((q[0] + q[1]) + (q[2] + q[3])) * (1.0f / D) + EPS); } }
#pragma unroll
        for (int ai = 0; ai < 2; ++ai)
#pragma unroll
            for (int m = 0; m < 4; ++m) { const int row = u.pm * BM + ai * HALF + wr * 64 + m * 16 + fr; const float rs = rsv[ai][m];
                if (MODE == 2 && u.pn >= 4) {
                    const float r2 = rs * rs; const f32x4 v0 = acc[ai][0][m][0] * acc[ai][1][m][0] * r2, v1 = acc[ai][0][m][1] * acc[ai][1][m][1] * r2;
                    const int ch = (u.pn - 4) * 128 + colw;
                    u32x4 w; w.x = cvt_pk_bf16(v0[0], v0[1]); w.y = cvt_pk_bf16(v0[2], v0[3]); w.z = cvt_pk_bf16(v1[0], v1[1]); w.w = cvt_pk_bf16(v1[2], v1[3]);
                    *(u32x4*)(O2 + (size_t)row * D + ch) = w;
                    const int t = row & (SEQ - 1);
                    if (t >= SEQ - 2) { float* cp = convout + ((size_t)(row >> 11) * 2 + (t - (SEQ - 2))) * D + ch; *(f32x4*)cp = v0; *(f32x4*)(cp + 4) = v1; }
                } else {
                    const float sc = (MODE == 0) ? rs * scale : rs;
#pragma unroll
                    for (int bj = 0; bj < 2; ++bj) { f32x4 v0 = acc[ai][bj][m][0] * sc, v1 = acc[ai][bj][m][1] * sc;
                        if (MODE == 1) {
#pragma unroll
                            for (int j = 0; j < 4; ++j) { const float a = fmaxf(v0[j], 0.f), b = fmaxf(v1[j], 0.f); v0[j] = a * a; v1[j] = b * b; } }
                        u32x4 w; w.x = cvt_pk_bf16(v0[0], v0[1]); w.y = cvt_pk_bf16(v0[2], v0[3]); w.z = cvt_pk_bf16(v1[0], v1[1]); w.w = cvt_pk_bf16(v1[2], v1[3]);
                        *(u32x4*)(O + (size_t)row * ldc + u.pn * BM + bj * HALF + colw) = w; }
                } }
    }
};
struct EpiBf16 {
    static constexpr bool PERM = true, AFTER_DRAIN = false;
    bf16_t* O; int ldc; float scale;
    __device__ __forceinline__ void operator()(const f32x4 (&acc)[2][2][4][2], const Unit& u, int wr, int wc, int fr, int fq) const {
        const int colw = u.pn * BM + wc * 32 + 8 * fq;
#pragma unroll
        for (int ai = 0; ai < 2; ++ai)
#pragma unroll
            for (int m = 0; m < 4; ++m) { const int row = u.pm * BM + ai * HALF + wr * 64 + m * 16 + fr;
#pragma unroll
                for (int bj = 0; bj < 2; ++bj) { const f32x4 v0 = acc[ai][bj][m][0] * scale, v1 = acc[ai][bj][m][1] * scale;
                    u32x4 w; w.x = cvt_pk_bf16(v0[0], v0[1]); w.y = cvt_pk_bf16(v0[2], v0[3]); w.z = cvt_pk_bf16(v1[0], v1[1]); w.w = cvt_pk_bf16(v1[2], v1[3]);
                    *(u32x4*)(O + (size_t)row * ldc + colw + bj * HALF) = w; } }
    }
};
struct EpiKV {
    static constexpr bool PERM = false, AFTER_DRAIN = false;
    float* outk; float* outv; bf16_t* Kb; bf16_t* Vt;
    __device__ __forceinline__ void operator()(const f32x4 (&acc)[2][2][4][2], const Unit& u, int wr, int wc, int fr, int fq) const {
        const int layer = u.pm >> 3; const bool isV = u.pn >= 4; const int col0 = (u.pn & 3) * BM + wc * 32 + 4 * fq;
        float* outp = isV ? outv : outk;
#pragma unroll
        for (int ai = 0; ai < 2; ++ai)
#pragma unroll
            for (int m = 0; m < 4; ++m) { const int rowl = (u.pm & 7) * BM + ai * HALF + wr * 64 + m * 16 + fr; const size_t off = ((size_t)layer * MEMROWS + rowl) * D + col0;
#pragma unroll
                for (int bj = 0; bj < 2; ++bj)
#pragma unroll
                    for (int n = 0; n < 2; ++n) { const f32x4 v = acc[ai][bj][m][n]; *(f32x4*)(outp + off + bj * HALF + n * 16) = v;
                        if (!isV) { u32x2 p; p.x = cvt_pk_bf16(v[0], v[1]); p.y = cvt_pk_bf16(v[2], v[3]); *(u32x2*)(Kb + off + bj * HALF + n * 16) = p; }
                        else { u32x2 p; p.x = cvt_pk_bf16(v[0], v[1]); p.y = cvt_pk_bf16(v[2], v[3]); *(u32x2*)(Vt + off + bj * HALF + n * 16) = p; } } }
    }
};
struct EpiSoftmax {
    static constexpr bool PERM = true, AFTER_DRAIN = true;
    bf16_t* P; int ldp; const float* ssq; const PG8_LAS float* rsd;
    __device__ __forceinline__ void operator()(const f32x4 (&)[2][2][4][2], const Unit&, int, int, int, int) const {}
    __device__ __forceinline__ void fused(f32x4 (&acc)[2][2][4][2], const Unit& u, int wr, int wc, int fr, int fq, PG8_LAS unsigned char* lds, int wid, int lane) const {
        PG8_LAS float* Pm = (PG8_LAS float*)lds;
        PG8_LAS float* Ps = (PG8_LAS float*)(lds + 4096);
        float rsv[2][4];
        if (rsd) {
#pragma unroll
          for (int ai = 0; ai < 2; ++ai)
#pragma unroll
              for (int m = 0; m < 4; ++m) rsv[ai][m] = rsd[ai * HALF + wr * 64 + m * 16 + fr];
        } else { f32x4 qv[2][4];
#pragma unroll
          for (int ai = 0; ai < 2; ++ai)
#pragma unroll
              for (int m = 0; m < 4; ++m) qv[ai][m] = *(const f32x4*)(ssq + (size_t)(u.pm * BM + ai * HALF + wr * 64 + m * 16 + fr) * 16 + 4 * fq);
#pragma unroll
          for (int ai = 0; ai < 2; ++ai)
#pragma unroll
              for (int m = 0; m < 4; ++m) { const f32x4 q = qv[ai][m]; rsv[ai][m] = __builtin_amdgcn_rsqf(add_x16_x32((q[0] + q[1]) + (q[2] + q[3])) * (1.0f / D) + EPS); } }
#pragma unroll
        for (int ai = 0; ai < 2; ++ai)
#pragma unroll
            for (int m = 0; m < 4; ++m) { float mx = -3.0e38f; const float rs = rsv[ai][m];
#pragma unroll
                for (int bj = 0; bj < 2; ++bj)
#pragma unroll
                    for (int n = 0; n < 2; ++n) { const f32x4 x = acc[ai][bj][m][n] * rs; acc[ai][bj][m][n] = x; mx = fmaxf(mx, fmaxf(fmaxf(x[0], x[1]), fmaxf(x[2], x[3]))); }
                mx = max_x16_x32(mx);
                if (fq == 0) Pm[(ai * HALF + wr * 64 + m * 16 + fr) * 4 + wc] = mx; }
        asm volatile("s_waitcnt lgkmcnt(0)" ::: "memory"); __builtin_amdgcn_s_barrier(); asm volatile("" ::: "memory");
#pragma unroll
        for (int ai = 0; ai < 2; ++ai)
#pragma unroll
            for (int m = 0; m < 4; ++m) { const int r = ai * HALF + wr * 64 + m * 16 + fr; const f32x4 q = *(const PG8_LAS f32x4*)(Pm + r * 4);
                const float mx = fmaxf(fmaxf(q[0], q[1]), fmaxf(q[2], q[3])); float s = 0.f;
#pragma unroll
                for (int bj = 0; bj < 2; ++bj)
#pragma unroll
                    for (int n = 0; n < 2; ++n) { f32x4 x = acc[ai][bj][m][n];
#pragma unroll
                        for (int j = 0; j < 4; ++j) { x[j] = __builtin_amdgcn_exp2f(x[j] - mx); s += x[j]; }
                        acc[ai][bj][m][n] = x; }
                s = add_x16_x32(s);
                if (fq == 0) Ps[r * 4 + wc] = s; }
        asm volatile("s_waitcnt lgkmcnt(0)" ::: "memory"); __builtin_amdgcn_s_barrier(); asm volatile("" ::: "memory");
        const int colw = u.pn * BM + wc * 32 + 8 * fq;
#pragma unroll
        for (int ai = 0; ai < 2; ++ai)
#pragma unroll
            for (int m = 0; m < 4; ++m) { const int r = ai * HALF + wr * 64 + m * 16 + fr; const f32x4 q = *(const PG8_LAS f32x4*)(Ps + r * 4);
                const float inv = __builtin_amdgcn_rcpf((q[0] + q[1]) + (q[2] + q[3]));
#pragma unroll
                for (int bj = 0; bj < 2; ++bj) { const f32x4 v0 = acc[ai][bj][m][0] * inv, v1 = acc[ai][bj][m][1] * inv;
                    u32x4 w; w.x = cvt_pk_bf16(v0[0], v0[1]); w.y = cvt_pk_bf16(v0[2], v0[3]); w.z = cvt_pk_bf16(v1[0], v1[1]); w.w = cvt_pk_bf16(v1[2], v1[3]);
                    *(u32x4*)(P + (size_t)(u.pm * BM + r) * ldp + bj * HALF + colw) = w; } }
    }
};

struct NoPre { __device__ __forceinline__ void operator()(int) const {} };
template <class Epi, class Sched, bool ALIGN_EPI, class Pre = NoPre>
__device__ __forceinline__ void gemm_phase(PG8_LAS unsigned char* lds, const Gemm g, const Sched& S, const Epi& E, int tid, const Pre& pre = Pre()) {
    asm volatile("" : "+v"(tid));
    const int wid = __builtin_amdgcn_readfirstlane(tid >> 6), lane = tid & 63, wr = wid >> 2, wc = wid & 3, fr = lane & 15, fq = lane >> 4;
    const int nt = g.K / BK;
    unsigned voffA[2], voffB[2];
#pragma unroll
    for (int i = 0; i < 2; ++i) { int R, C; stage_rc(tid * 16 + i * 8192, R, C); const int Rb = Epi::PERM ? ((R & ~31) + perm32(R & 31)) : R;
        voffA[i] = (unsigned)(R * g.lda + C) * 2u; voffB[i] = (unsigned)(Rb * g.ldb + C) * 2u; }
    const size_t kstep = (size_t)(BK * 2);
    const size_t hstepA = (size_t)HALF * g.lda * 2, hstepB = (size_t)HALF * g.ldb * 2;
    const unsigned ldsw = (unsigned)wid * 1024u;
    const int aoff = lds_byte(wr * 64 + fr, fq * 8), boff = lds_byte(wc * 32 + fr, fq * 8);
#define PG8_SA(b, h) (((b) * 2 + (h)) * HTB)
#define PG8_SB(b, h) ((4 + (b) * 2 + (h)) * HTB)
#define PG8_STAGE(bufoff, gbase, voff) do { const char* _gb = (const char*)(gbase); asm volatile("" : "+s"(_gb));   \
        _Pragma("unroll") for (int _i = 0; _i < 2; ++_i) \
        __builtin_amdgcn_global_load_lds((const unsigned*)(_gb + (voff)[_i]), (PG8_LAS unsigned*)(lds + (bufoff) + ldsw + _i * 8192), 16, 0, 0); } while (0)
#define PG8_LDA(dst, b, h) do { _Pragma("unroll") for (int m = 0; m < 4; ++m) _Pragma("unroll") for (int k = 0; k < 2; ++k) dst[m][k] = *(const PG8_LAS bf16x8*)(lds + PG8_SA(b, h) + aoff + m * 2048 + k * 1024); } while (0)
#define PG8_LDB(dst, b, h) do { _Pragma("unroll") for (int n = 0; n < 2; ++n) _Pragma("unroll") for (int k = 0; k < 2; ++k) dst[n][k] = *(const PG8_LAS bf16x8*)(lds + PG8_SB(b, h) + boff + n * 2048 + k * 1024); } while (0)
#define PG8_MMA(ai, bj, At, Bt) do { __builtin_amdgcn_s_setprio(1); _Pragma("unroll") for (int m = 0; m < 4; ++m) _Pragma("unroll") for (int n = 0; n < 2; ++n) _Pragma("unroll") for (int k = 0; k < 2; ++k) \
        acc[ai][bj][m][n] = __builtin_amdgcn_mfma_f32_16x16x32_bf16(Bt[n][k], At[m][k], acc[ai][bj][m][n], 0, 0, 0); __builtin_amdgcn_s_setprio(0); } while (0)
#define PG8_WAIT_V(n) asm volatile("s_waitcnt vmcnt(" #n ")" ::: "memory")
#define PG8_WAIT_L(n) asm volatile("s_waitcnt lgkmcnt(" #n ")" ::: "memory")
#define PG8_BAR __builtin_amdgcn_s_barrier()
#define PG8_SCHED __builtin_amdgcn_sched_barrier(0)
    Unit cur, nxt; int ui = 0;
    if (!S.next(0, cur)) return;
    f32x4 acc[2][2][4][2];
#pragma unroll
    for (int a = 0; a < 2; ++a)
#pragma unroll
        for (int b = 0; b < 2; ++b)
#pragma unroll
            for (int m = 0; m < 4; ++m)
#pragma unroll
                for (int n = 0; n < 2; ++n) acc[a][b][m][n] = (f32x4){0.f, 0.f, 0.f, 0.f};
    bf16x8 At[4][2], B0[2][2], B1[2][2];
    const char* cA = S.aptr(cur); const char* cB = S.bptr(cur);
    PG8_STAGE(PG8_SB(0, 0), cB, voffB); PG8_STAGE(PG8_SB(0, 1), cB + hstepB, voffB); PG8_STAGE(PG8_SA(0, 0), cA, voffA); PG8_STAGE(PG8_SA(0, 1), cA + hstepA, voffA);
    pre(tid);
    if (wr == 1) PG8_BAR;
    PG8_WAIT_V(2); PG8_BAR;
    PG8_STAGE(PG8_SB(1, 0), cB + kstep, voffB); PG8_STAGE(PG8_SA(1, 0), cA + kstep, voffA); PG8_STAGE(PG8_SB(1, 1), cB + hstepB + kstep, voffB);
    PG8_WAIT_V(6); PG8_BAR;
    for (;;) {
        const bool has_next = S.next(ui + 1, nxt);
        const char* nA = has_next ? S.aptr(nxt) : cA; const char* nB = has_next ? S.bptr(nxt) : cB;
        for (int t = 0; t < nt; t += 2) {
            const bool last = (t == nt - 2);
            const char* a1 = cA + (size_t)(t + 1) * kstep;
            const char* a2 = last ? nA : cA + (size_t)(t + 2) * kstep; const char* b2 = last ? nB : cB + (size_t)(t + 2) * kstep;
            const char* a3 = a2 + kstep; const char* b3 = b2 + kstep;
            PG8_LDB(B0, 0, 0); PG8_LDB(B1, 0, 1); PG8_SCHED; PG8_LDA(At, 0, 0); PG8_STAGE(PG8_SA(1, 1), a1 + hstepA, voffA);
            PG8_WAIT_V(8); PG8_WAIT_L(0); PG8_BAR; PG8_MMA(0, 0, At, B0); PG8_MMA(0, 1, At, B1); PG8_BAR; PG8_SCHED;
            PG8_LDA(At, 0, 1); PG8_STAGE(PG8_SB(0, 0), b2, voffB); PG8_STAGE(PG8_SB(0, 1), b2 + hstepB, voffB); PG8_STAGE(PG8_SA(0, 0), a2, voffA);
            PG8_WAIT_V(8); PG8_WAIT_L(0); PG8_BAR; PG8_MMA(1, 0, At, B0); PG8_MMA(1, 1, At, B1); PG8_BAR; PG8_SCHED;
            PG8_LDB(B0, 1, 0); PG8_LDB(B1, 1, 1); PG8_SCHED; PG8_LDA(At, 1, 0); PG8_STAGE(PG8_SA(0, 1), a2 + hstepA, voffA);
            PG8_WAIT_V(8); PG8_WAIT_L(0); PG8_BAR; PG8_MMA(0, 0, At, B0); PG8_MMA(0, 1, At, B1); PG8_BAR; PG8_SCHED;
            PG8_LDA(At, 1, 1); PG8_STAGE(PG8_SB(1, 0), b3, voffB); PG8_STAGE(PG8_SB(1, 1), b3 + hstepB, voffB); PG8_STAGE(PG8_SA(1, 0), a3, voffA);
            PG8_WAIT_V(8); PG8_WAIT_L(0); PG8_BAR; PG8_MMA(1, 0, At, B0); PG8_MMA(1, 1, At, B1); PG8_BAR; PG8_SCHED;
        }
        if constexpr (ALIGN_EPI) { if (wr == 0) PG8_BAR; }
        if constexpr (!Epi::AFTER_DRAIN) { const int l2 = lane_id_opaque(); E(acc, cur, wr, wc, l2 & 15, l2 >> 4); }
        if (!has_next) break;
#pragma unroll
        for (int a = 0; a < 2; ++a)
#pragma unroll
            for (int b = 0; b < 2; ++b)
#pragma unroll
                for (int m = 0; m < 4; ++m)
#pragma unroll
                    for (int n = 0; n < 2; ++n) acc[a][b][m][n] = (f32x4){0.f, 0.f, 0.f, 0.f};
        cur = nxt; cA = nA; cB = nB; ++ui;
        if constexpr (ALIGN_EPI) { if (wr == 1) PG8_BAR; }
    }
    PG8_WAIT_V(0);
    if constexpr (!ALIGN_EPI) { if (wr == 0) PG8_BAR; }
    PG8_BAR;
    if constexpr (Epi::AFTER_DRAIN) { const int l2 = lane_id_opaque(); E.fused(acc, cur, wr, wc, l2 & 15, l2 >> 4, lds, wid, l2); }
#undef PG8_SA
#undef PG8_SB
#undef PG8_STAGE
#undef PG8_LDA
#undef PG8_LDB
#undef PG8_MMA
#undef PG8_WAIT_V
#undef PG8_WAIT_L
#undef PG8_BAR
#undef PG8_SCHED
}
}

constexpr int NWAVES = 8, NTHREADS = 512;
constexpr size_t MiB = 1u << 20;
constexpr size_t WS_CTL = 0, CTL_ZERO_BYTES = 256 * 1024;
constexpr size_t WS_WPOOL = 1 * MiB;
constexpr size_t WS_WQ = 2 * MiB;
constexpr size_t WS_WO = 6 * MiB;
constexpr size_t WS_WKV = 10 * MiB;
constexpr size_t WS_WUP = 18 * MiB;
constexpr size_t WS_WDN = 34 * MiB;
constexpr size_t WS_WIN = 50 * MiB;
constexpr size_t WS_WOUT = 56 * MiB;
constexpr size_t WS_MN = 58 * MiB;
constexpr size_t WS_KB = 66 * MiB;
constexpr size_t WS_VT = 74 * MiB;
constexpr size_t WS_SSQ = 82 * MiB;
constexpr size_t WS_SMALL = 84 * MiB;
constexpr size_t WS_X = 96 * MiB;
constexpr size_t WS_XG = 160 * MiB;
constexpr size_t WS_P0 = 192 * MiB;
constexpr size_t WS_O = 224 * MiB;
constexpr size_t WS_CH = 256 * MiB;
constexpr size_t WS_PS = 288 * MiB;
constexpr size_t WS_H = 320 * MiB;
constexpr size_t WS_WQN = 448 * MiB;
constexpr size_t WS_MT = 452 * MiB;
constexpr size_t WS_VW = 484 * MiB;
constexpr size_t WS_END = 516 * MiB;
constexpr size_t SS_X = WS_SMALL;
constexpr size_t SS_XG = SS_X + 512 * 1024;
constexpr size_t SS_SSQ = SS_XG + 256 * 1024;
constexpr size_t SS_P0 = SS_SSQ + 32 * 1024;
constexpr size_t SS_O = SS_P0 + 256 * 1024;
constexpr size_t SS_CH = SS_O + 256 * 1024;
constexpr size_t SS_H = SS_CH + 512 * 1024;
constexpr size_t SS_Q = SS_H + 1024 * 1024;
static_assert(SS_Q + 512 * 1024 <= WS_X, "sample buffers");
constexpr int CW_FLAG = 0;
constexpr unsigned INIT_MAGIC = 0x5eed1357u;
constexpr int CW_BAR = 4096, CW_BAR_STRIDE = 4096;

constexpr int RING_OFF = 0, RING_BYTES = 131072;
constexpr int LDSCTL_OFF = RING_BYTES, MISC_OFF = LDSCTL_OFF + 320;
constexpr int RSD_OFF = RING_BYTES + 1024;
constexpr int LDS_BYTES = 147456;

#define GAS __attribute__((address_space(1)))
#define LAS __attribute__((address_space(3)))
typedef unsigned short bf16;
typedef unsigned v4u __attribute__((ext_vector_type(4)));
typedef unsigned v2u __attribute__((ext_vector_type(2)));
typedef float f32x4 __attribute__((ext_vector_type(4)));
typedef short bf16x8 __attribute__((ext_vector_type(8)));
#define LDS_WAIT() asm volatile("s_waitcnt lgkmcnt(0)" ::: "memory")
#define VM_WAIT() asm volatile("s_waitcnt vmcnt(0)" ::: "memory")
__device__ __forceinline__ unsigned f2bf(float f) { unsigned u = __builtin_bit_cast(unsigned, f); return (u + 0x7fffu + ((u >> 16) & 1u)) >> 16; }
__device__ __forceinline__ unsigned pk2(float lo, float hi) { return f2bf(lo) | (f2bf(hi) << 16); }
__device__ __forceinline__ float bf2f(unsigned short h) { return __builtin_bit_cast(float, (unsigned)h << 16); }
__device__ __forceinline__ float bflo(unsigned w) { return __builtin_bit_cast(float, w << 16); }
__device__ __forceinline__ float bfhi(unsigned w) { return __builtin_bit_cast(float, w & 0xffff0000u); }

#define XB_TMO      128
#define XB_XCNT(j)  (256  + 64 * (j))
#define XB_XSUB(j)  (1280 + 64 * (j))
#define XB_XGEN(j)  (2304 + 64 * (j))
#define XB_TOP      3328
#define XB_TOPGEN   3392
#define XCD_BAR_WORDS 3456
#define XB_SPIN_CAP (1u << 18)
__device__ __forceinline__ unsigned xb_ld(unsigned* p)              { return __hip_atomic_load(p, __ATOMIC_RELAXED, __HIP_MEMORY_SCOPE_AGENT); }
__device__ __forceinline__ unsigned xb_add(unsigned* p, unsigned v) { return __hip_atomic_fetch_add(p, v, __ATOMIC_RELAXED, __HIP_MEMORY_SCOPE_AGENT); }
__device__ __forceinline__ unsigned xb_xcc_id() { return (unsigned)__builtin_amdgcn_s_getreg((3 << 11) | 20) & 0xFu; }
#define XB_SPIN(cond, bar) do { unsigned _sp = 0; while (cond) { __builtin_amdgcn_s_sleep(1); \
    if ((++_sp & 255u) == 0u) { if (xb_ld(&(bar)[XB_TMO])) break; if (_sp > XB_SPIN_CAP) { atomicAdd(&(bar)[XB_TMO], 1u); break; } } } } while (0)
struct XcdBarrier { unsigned* bar; unsigned x; volatile LAS unsigned* st; unsigned gsize; };
__device__ __forceinline__ XcdBarrier xcd_barrier_post(unsigned* bar, volatile LAS unsigned* st, unsigned gsize) {
    XcdBarrier b; b.bar = bar; b.x = xb_xcc_id(); b.st = st; b.gsize = gsize;
    if (threadIdx.x == 0) (void)xb_add(&bar[XB_XCNT(b.x)], 1u);
    return b;
}
__device__ __forceinline__ void xcd_barrier_complete(unsigned* bar, unsigned x, unsigned G, unsigned& nloc, unsigned& nx) {
    unsigned sum, cnt, mine, sp = 0u;
    for (;;) {
        sum = 0u; cnt = 0u; mine = 0u;
#pragma unroll
        for (unsigned j = 0; j < 16; ++j) { const unsigned c = xb_ld(&bar[XB_XCNT(j)]); sum += c; cnt += (c > 0u) ? 1u : 0u; mine = (j == x) ? c : mine; }
        if (sum == G) break;
        __builtin_amdgcn_s_sleep(1);
        if ((++sp & 255u) == 0u) { if (xb_ld(&bar[XB_TMO])) break; if (sp > XB_SPIN_CAP) { atomicAdd(&bar[XB_TMO], 1u); break; } }
    }
    nloc = mine > 0u ? mine : 1u; nx = cnt > 0u ? cnt : 1u;
}
__device__ __forceinline__ void xcd_barrier(const XcdBarrier& b, const int tid) {
    asm volatile("s_waitcnt vmcnt(0)" ::: "memory");
    __syncthreads();
    if (tid == 0) {
        unsigned* bar = b.bar; asm volatile("" : "+s"(bar));
        __builtin_amdgcn_s_waitcnt(0);
        unsigned nloc = b.st[0], nx = b.st[1];
        if (nloc == 0u) { xcd_barrier_complete(bar, b.x, b.gsize, nloc, nx); b.st[0] = nloc; b.st[1] = nx; }
        const unsigned old = xb_add(&bar[XB_XSUB(b.x)], 1u);
        const unsigned gen = old / nloc;
        if (old + 1u == (gen + 1u) * nloc) {
            if (nx > 1u) {
                __builtin_amdgcn_fence(__ATOMIC_RELEASE, "agent");
                asm volatile("s_waitcnt vmcnt(0)" ::: "memory");
                const unsigned og = xb_add(&bar[XB_TOP], 1u);
                const unsigned tg = og / nx;
                if (og + 1u == (tg + 1u) * nx) xb_add(&bar[XB_TOPGEN], 1u);
                else XB_SPIN(xb_ld(&bar[XB_TOPGEN]) == tg, bar);
            }
            xb_add(&bar[XB_XGEN(b.x)], 1u);
            __builtin_amdgcn_fence(__ATOMIC_ACQUIRE, "agent");
            asm volatile("s_waitcnt vmcnt(0)" ::: "memory");
        } else {
            XB_SPIN(xb_ld(&bar[XB_XGEN(b.x)]) == gen, bar);
            __builtin_amdgcn_fence(__ATOMIC_ACQUIRE, "agent");
            asm volatile("s_waitcnt vmcnt(0)" ::: "memory");
        }
    }
    __syncthreads();
}

__device__ __forceinline__ int opq_v(int x) { asm volatile("" : "+v"(x)); return x; }
struct Args { const float* in[22]; float* out; unsigned char* ws; int ph_lo, ph_hi; };


__device__ __forceinline__ void p0_transpose_item(const float* W, int K, int N, bf16* WT, int k0, int n0, int drow0, LAS float* scr, int lane, const float* gk = nullptr) {
    float v[32];
#pragma unroll
    for (int i = 0; i < 32; ++i) { const int kk = 2 * i + (lane >> 5); v[i] = __builtin_nontemporal_load(W + (size_t)(k0 + kk) * N + n0 + (lane & 31)); }
    if (gk) {
#pragma unroll
        for (int i = 0; i < 32; ++i) v[i] *= gk[k0 + 2 * i + (lane >> 5)]; }
#pragma unroll
    for (int i = 0; i < 32; ++i) scr[(2 * i + (lane >> 5)) * 33 + (lane & 31)] = v[i];
    LDS_WAIT(); asm volatile("" ::: "memory");
    const int c = lane & 7;
#pragma unroll
    for (int j = 0; j < 4; ++j) { const int n = (lane >> 3) + 8 * j; const LAS float* s = scr + (8 * c) * 33 + n;
        v4u o; o.x = pg8::cvt_pk_bf16(s[0 * 33], s[1 * 33]); o.y = pg8::cvt_pk_bf16(s[2 * 33], s[3 * 33]); o.z = pg8::cvt_pk_bf16(s[4 * 33], s[5 * 33]); o.w = pg8::cvt_pk_bf16(s[6 * 33], s[7 * 33]);
        *(GAS v4u*)(WT + (size_t)(drow0 + n) * K + k0 + 8 * c) = o; }
    LDS_WAIT(); asm volatile("" ::: "memory");
}
__device__ __forceinline__ int win_dest_row(int n) {
    if (n < 1024) return n;
    if (n < 2048) { const int ch = n - 1024; return 1024 + (ch >> 7) * 256 + (ch & 127); }
    const int ch = n - 2048; return 1024 + (ch >> 7) * 256 + 128 + (ch & 127);
}

template <int W>
__device__ __forceinline__ void pool_wave(const float* xb  , const LAS float* rs, f32x4 g4, int tA, bf16* pout  , float* poolout  ) {
    f32x4 xv[15 + W];
#pragma unroll
    for (int i = 16 - W; i < 31; ++i) { const int t = tA - 15 + i; xv[i - (16 - W)] = *(const f32x4*)(xb + (size_t)(t >= 0 ? t : 0) * D); }
    f32x4 ring[16]; f32x4 S = {0.f, 0.f, 0.f, 0.f};
#pragma unroll
    for (int i = 16 - W; i < 31; ++i) {
        const int t = tA - 15 + i;
        f32x4 u = {0.f, 0.f, 0.f, 0.f};
        if (t >= 0) u = xv[i - (16 - W)] * rs[i] * g4;
        S += u; if (i - W >= 16 - W) S -= ring[(i - W) & 15];
        ring[i & 15] = u;
        if (i >= 15) {
            const int cnt = (t + 1 < W) ? (t + 1) : W; const float ic = 1.0f / (float)cnt;
            const f32x4 p = S * ic - u; v2u o; o.x = pk2(p[0], p[1]); o.y = pk2(p[2], p[3]);
            *(v2u*)(pout + (size_t)t * D) = o;
            if (t >= SEQ - 15) *(f32x4*)(poolout + (size_t)(t - (SEQ - 15)) * D) = u;
        }
    }
}

template <int RT, int CT, int GR, int KS, class F>
__device__ __forceinline__ void sgemm2(const bf16* A, int lda, int row0, const bf16* Bt, int ldb, const int (&brow)[CT], int K, LAS unsigned char* red, int wave, int lane, const F& f) {
    const int fr = lane & 15, fq = lane >> 4, kw = K >> 3;
    const bf16* ap = A + (size_t)(row0 + fr) * lda + wave * kw + fq * 8;
    const bf16* bp[CT];
#pragma unroll
    for (int ct = 0; ct < CT; ++ct) bp[ct] = Bt + (size_t)(brow[ct] + fr) * ldb + wave * kw + fq * 8;
    f32x4 acc[RT][CT];
#pragma unroll
    for (int rt = 0; rt < RT; ++rt)
#pragma unroll
        for (int ct = 0; ct < CT; ++ct) acc[rt][ct] = (f32x4){0.f, 0.f, 0.f, 0.f};
#pragma unroll 1
    for (int k0 = 0; k0 < kw; k0 += 32 * KS) {
        bf16x8 a[KS][RT], b[KS][CT];
#pragma unroll
        for (int ks = 0; ks < KS; ++ks) {
#pragma unroll
            for (int rt = 0; rt < RT; ++rt) a[ks][rt] = *(const bf16x8*)(ap + (size_t)rt * 16 * lda + k0 + 32 * ks);
#pragma unroll
            for (int ct = 0; ct < CT; ++ct) b[ks][ct] = *(const bf16x8*)(bp[ct] + k0 + 32 * ks); }
#pragma unroll
        for (int ks = 0; ks < KS; ++ks)
#pragma unroll
            for (int rt = 0; rt < RT; ++rt)
#pragma unroll
                for (int ct = 0; ct < CT; ++ct) acc[rt][ct] = __builtin_amdgcn_mfma_f32_16x16x32_bf16(b[ks][ct], a[ks][rt], acc[rt][ct], 0, 0, 0);
    }
#pragma unroll
    for (int rt = 0; rt < RT; ++rt)
#pragma unroll
        for (int ct = 0; ct < CT; ++ct) *(LAS f32x4*)(red + ((((wave * RT + rt) * CT + ct) * 64 + lane) << 4)) = acc[rt][ct];
    LDS_WAIT(); __syncthreads();
    constexpr int NCG = CT / GR, NTASK = RT * NCG;
    for (int t = wave; t < NTASK; t += 8) {
        const int rt = t / NCG, cg = t % NCG;
        f32x4 sacc[GR];
#pragma unroll
        for (int g = 0; g < GR; ++g) { f32x4 tt = {0.f, 0.f, 0.f, 0.f};
#pragma unroll
            for (int w = 0; w < 8; ++w) tt += *(const LAS f32x4*)(red + ((((w * RT + rt) * CT + cg * GR + g) * 64 + lane) << 4));
            sacc[g] = tt; }
        f(sacc, row0 + 16 * rt + fr, cg * GR, fq);
    }
    __syncthreads();
}
__device__ __forceinline__ float srstd(const float* ssq, int row, int fq) {
    const f32x4* sp = (const f32x4*)(ssq + row * 64 + fq * 16); const f32x4 s = (sp[0] + sp[1]) + (sp[2] + sp[3]); float t = (s[0] + s[1]) + (s[2] + s[3]);
    t = add_x16_x32(t);
    return __builtin_amdgcn_rsqf(t * (1.0f / D) + EPS);
}
template <int KS> __device__ __forceinline__ void s_res_unit(const bf16* A, int lda, const bf16* Bt, int ldb, int K, int cp, int row0, const float* base32, bf16* xs16, float* ssq, const float* cscale, LAS unsigned char* red, int wave, int lane) {
    const int brow[2] = {32 * cp, 32 * cp + 16};
    const int myct = wave & 1, prow = row0 + (lane & 15), pc0 = 16 * (2 * cp + myct) + 4 * (lane >> 4); const size_t poff = (size_t)prow * D + pc0;
    f32x4 cs = {1.f, 1.f, 1.f, 1.f}; if (cscale) cs = *(const f32x4*)(cscale + pc0);
    f32x4 bpre; if (base32) bpre = *(const f32x4*)(base32 + poff); else { const v2u w = *(const v2u*)(xs16 + poff); bpre = (f32x4){bflo(w.x), bfhi(w.x), bflo(w.y), bfhi(w.y)}; }
    sgemm2<1, 2, 1, KS>(A, lda, row0, Bt, ldb, brow, K, red, wave, lane, [&](f32x4 (&a)[1], int row, int ct0, int fq) {
        const int ctile = 2 * cp + ct0, c0 = 16 * ctile + 4 * fq; const size_t off = (size_t)row * D + c0;
        const f32x4 v = bpre + a[0] * cs;
        float ss = (v[0] * v[0] + v[1] * v[1]) + (v[2] * v[2] + v[3] * v[3]);
        ss = add_x16_x32(ss);
        if (fq == 0) ssq[row * 64 + ctile] = ss;
        v2u p; p.x = pk2(v[0], v[1]); p.y = pk2(v[2], v[3]); *(v2u*)(xs16 + off) = p; });
}
__device__ __forceinline__ void s_q_unit(const bf16* xs16, const bf16* wq, int cp, int row0, const float* ssq, float* qs, LAS unsigned char* red, int wave, int lane) {
    const int brow[2] = {32 * cp, 32 * cp + 16};
    const float rs = srstd(ssq, row0 + (lane & 15), lane >> 4) * QSCALE;
    sgemm2<1, 2, 1, 4>(xs16, D, row0, wq, D, brow, D, red, wave, lane, [&](f32x4 (&a)[1], int row, int ct0, int fq) {
        *(f32x4*)(qs + (size_t)row * D + 32 * cp + 16 * ct0 + 4 * fq) = a[0] * rs; });
}
__device__ __forceinline__ f32x4 relu2(f32x4 v) {
#pragma unroll
    for (int j = 0; j < 4; ++j) { const float a = fmaxf(v[j], 0.f); v[j] = a * a; }
    return v;
}

__device__ __forceinline__ void rstd_table(const float* ssq, int pm, LAS float* rsd, int tid) {
    if (tid < 256) { const f32x4* sp = (const f32x4*)(ssq + (size_t)(pm * 256 + tid) * 16); const f32x4 q = (sp[0] + sp[1]) + (sp[2] + sp[3]);
        rsd[tid] = __builtin_amdgcn_rsqf(((q[0] + q[1]) + (q[2] + q[3])) * (1.0f / D) + EPS); }
}
__device__ __forceinline__ void treduce32(float (&p)[32], int lane) {
#pragma unroll
    for (int i = 0; i < 16; ++i) { swap32(p[i], p[i + 16]); p[i] += p[i + 16]; }
    { const bool b4 = (lane & 16) != 0;
#pragma unroll
      for (int i = 0; i < 8; ++i) { const float keep = b4 ? p[i + 8] : p[i], send = b4 ? p[i] : p[i + 8]; p[i] = keep + SWZ_XOR(send, 16); } }
    { const bool b3 = (lane & 8) != 0;
#pragma unroll
      for (int i = 0; i < 4; ++i) { const float keep = b3 ? p[i + 4] : p[i], send = b3 ? p[i] : p[i + 4]; p[i] = keep + SWZ_XOR(send, 8); } }
    { const bool b2 = (lane & 4) != 0;
#pragma unroll
      for (int i = 0; i < 2; ++i) { const float keep = b2 ? p[i + 2] : p[i], send = b2 ? p[i] : p[i + 2]; p[i] = keep + SWZ_XOR(send, 4); } }
    { const bool b1 = (lane & 2) != 0; const float keep = b1 ? p[1] : p[0], send = b1 ? p[0] : p[1]; p[0] = keep + SWZ_XOR(send, 2); }
    p[0] += SWZ_XOR(p[0], 1);
}
__device__ __forceinline__ void unpack16(const v4u a, const v4u b, float (&x)[16]) {
    x[0] = bflo(a.x); x[1] = bfhi(a.x); x[2] = bflo(a.y); x[3] = bfhi(a.y); x[4] = bflo(a.z); x[5] = bfhi(a.z); x[6] = bflo(a.w); x[7] = bfhi(a.w);
    x[8] = bflo(b.x); x[9] = bfhi(b.x); x[10] = bflo(b.y); x[11] = bfhi(b.y); x[12] = bflo(b.z); x[13] = bfhi(b.z); x[14] = bflo(b.w); x[15] = bfhi(b.w);
}

constexpr int NPHASES = 15;
__global__ void __launch_bounds__(NTHREADS, 2) mk_fwd(Args args) {
    extern __shared__ __attribute__((aligned(16))) unsigned char lds[];
    LAS unsigned char* L = (LAS unsigned char*)lds;
    volatile LAS unsigned* MISC = (volatile LAS unsigned*)(L + MISC_OFF);
    const int wave0 = __builtin_amdgcn_readfirstlane((int)threadIdx.x >> 6);
    const int G = gridDim.x; const int bx = blockIdx.x; const int vcu = (G % 8 == 0) ? (bx % 8) * (G / 8) + bx / 8 : bx;
    const int grp = bx & 7, mi = bx >> 3, GS = (G - grp + 7) >> 3;
    for (int u = threadIdx.x; u < (LDS_BYTES - LDSCTL_OFF) / 4; u += NTHREADS) ((LAS unsigned*)(L + LDSCTL_OFF))[u] = 0u;
    __syncthreads();
#if MK_PER_PHASE
#define GRID_BAR() do { } while (0)
#define GROUP_BAR() do { } while (0)
#else
#if SELF_INIT
    unsigned* const ctlw = (unsigned*)(args.ws + WS_CTL);
    XcdBarrier bar, gbar;
    bar.bar = ctlw + CW_BAR; bar.x = xb_xcc_id(); bar.st = MISC + 8; bar.gsize = (unsigned)G;
    gbar.bar = ctlw + CW_BAR + (1 + grp) * CW_BAR_STRIDE; gbar.x = bar.x; gbar.st = MISC + 10; gbar.gsize = (unsigned)GS;
    if (bx == 0) {
        const int t = (int)threadIdx.x;
        if (t < 9 * 51) { const int r = t / 51, k = t % 51;
            const int w = (k == 0) ? XB_TMO : (k <= 16) ? XB_XCNT(k - 1) : (k <= 32) ? XB_XSUB(k - 17) : (k <= 48) ? XB_XGEN(k - 33) : (k == 49) ? XB_TOP : XB_TOPGEN;
            __hip_atomic_store(ctlw + CW_BAR + r * CW_BAR_STRIDE + w, 0u, __ATOMIC_RELAXED, __HIP_MEMORY_SCOPE_AGENT); }
        asm volatile("s_waitcnt vmcnt(0)" ::: "memory");
        __syncthreads();
        if (t == 0) __hip_atomic_store(ctlw + CW_FLAG, INIT_MAGIC, __ATOMIC_RELAXED, __HIP_MEMORY_SCOPE_AGENT);
    }
#else
    XcdBarrier bar = xcd_barrier_post((unsigned*)(args.ws + WS_CTL) + CW_BAR, MISC + 8, (unsigned)G);
    XcdBarrier gbar = xcd_barrier_post((unsigned*)(args.ws + WS_CTL) + CW_BAR + (1 + grp) * CW_BAR_STRIDE, MISC + 10, (unsigned)GS);
#endif
#define GRID_BAR() xcd_barrier(bar, wave0 * 64 + lane_id_opaque())
#define GROUP_BAR() xcd_barrier(gbar, wave0 * 64 + lane_id_opaque())
#endif
    const int lo = args.ph_lo, hi = args.ph_hi;
#define IN(k) (st == (k))
#define SEAM(k) do { } while (0)
    const int NGW = G * NWAVES;
#define TID_NOW (wave0 * 64 + lane_id_opaque())
#define RELANE const int tid = wave0 * 64 + lane_id_opaque(), lane = tid & 63; (void)tid; (void)lane;
#define KA_PTR(T, off) (*(T const __attribute__((address_space(4)))*)(ka + (off)))
#define PH_BEGIN const int tid = wave0 * 64 + lane_id_opaque(), lane = tid & 63, wave = wave0, gw = vcu * NWAVES + wave; (void)lane; (void)gw; \
    const __attribute__((address_space(4))) char* ka = (const __attribute__((address_space(4))) char*)__builtin_amdgcn_kernarg_segment_ptr(); asm volatile("" : "+s"(ka)); \
    unsigned char* const ws = KA_PTR(unsigned char*, 184); float* const out = KA_PTR(float*, 176); (void)ws; (void)out; \
    const float* const x_prompt = KA_PTR(const float*, 0); const float* const x_sample = KA_PTR(const float*, 8); const float* const state_pool = KA_PTR(const float*, 16); const float* const state_conv = KA_PTR(const float*, 24); \
    const float* const cache_k = KA_PTR(const float*, 32); const float* const cache_v = KA_PTR(const float*, 40); const float* const mem_prompt = KA_PTR(const float*, 48); \
    const float* const g_mix = KA_PTR(const float*, 56); const float* const g_attn = KA_PTR(const float*, 64); const float* const g_mem = KA_PTR(const float*, 72); const float* const g_ffn = KA_PTR(const float*, 80); const float* const g_final = KA_PTR(const float*, 88); \
    const float* const w_pool = KA_PTR(const float*, 96); const float* const pool_scale = KA_PTR(const float*, 104); const float* const w_conv_in = KA_PTR(const float*, 112); const float* const w_conv = KA_PTR(const float*, 120); const float* const w_conv_out = KA_PTR(const float*, 128); \
    const float* const w_q = KA_PTR(const float*, 136); const float* const w_kv = KA_PTR(const float*, 144); const float* const w_o = KA_PTR(const float*, 152); const float* const w_up = KA_PTR(const float*, 160); const float* const w_down = KA_PTR(const float*, 168); \
    (void)x_prompt; (void)x_sample; (void)state_pool; (void)state_conv; (void)cache_k; (void)cache_v; (void)mem_prompt; (void)g_mix; (void)g_attn; (void)g_mem; (void)g_ffn; (void)g_final; (void)w_pool; (void)pool_scale; (void)w_conv_in; (void)w_conv; (void)w_conv_out; (void)w_q; (void)w_kv; (void)w_o; (void)w_up; (void)w_down; \
    bf16* const WPOOL = (bf16*)(ws + WS_WPOOL); bf16* const WQ = (bf16*)(ws + WS_WQ); bf16* const WO = (bf16*)(ws + WS_WO); bf16* const WKV = (bf16*)(ws + WS_WKV); \
    bf16* const WUP = (bf16*)(ws + WS_WUP); bf16* const WDN = (bf16*)(ws + WS_WDN); bf16* const WIN = (bf16*)(ws + WS_WIN); bf16* const WOUT = (bf16*)(ws + WS_WOUT); \
    bf16* const MN = (bf16*)(ws + WS_MN); bf16* const KB = (bf16*)(ws + WS_KB); bf16* const VT = (bf16*)(ws + WS_VT); float* const SSQ = (float*)(ws + WS_SSQ); \
    bf16* const X16 = (bf16*)(ws + WS_X); bf16* const P0 = (bf16*)(ws + WS_P0); bf16* const OB = (bf16*)(ws + WS_O); bf16* const CH = (bf16*)(ws + WS_CH); \
    bf16* const WQN = (bf16*)(ws + WS_WQN); bf16* const MT = (bf16*)(ws + WS_MT); bf16* const VW = (bf16*)(ws + WS_VW); bf16* const HB = (bf16*)(ws + WS_H); \
    bf16* const XS16 = (bf16*)(ws + SS_X); float* const SSQS = (float*)(ws + SS_SSQ); bf16* const P0S = (bf16*)(ws + SS_P0); bf16* const OS = (bf16*)(ws + SS_O); \
    float* const CHS = (float*)(ws + SS_CH); bf16* const HS = (bf16*)(ws + SS_H); float* const QS = (float*)(ws + SS_Q); \
    (void)WPOOL; (void)WQ; (void)WO; (void)WKV; (void)WUP; (void)WDN; (void)WIN; (void)WOUT; (void)MN; (void)KB; (void)VT; (void)SSQ; (void)X16; (void)P0; (void)OB; (void)CH; (void)WQN; (void)MT; (void)VW; (void)HB; (void)XS16; (void)SSQS; (void)P0S; (void)OS; (void)CHS; (void)HS; (void)QS;

#if MK_PER_PHASE
    const int soff = 0; const bool sfirst = false;
#else
    const int soff = SAMPLE_SHIFT ? (grp & 1) : 0;
    const bool sfirst = false;
#endif
    const int mflip = (MEMBER_FLIP && !MK_PER_PHASE) ? (MEMBER_FLIP_SEL) : 0;
#pragma unroll 1
    for (int ph = lo; ph < hi + soff; ++ph) {
#pragma unroll 1
    for (int pp = 0; pp < 2; ++pp) {
    const int which = pp ^ mflip;
    const int st = which ? ph - soff : ph;
    const bool doP = (which == 0), doS = (which == 1) || (st == 0);
    if (st < 0 || st >= NPHASES || (which == 1 && st == 0)) continue;
    if (IN(0)) { PH_BEGIN
        LAS float* scr = (LAS float*)(L + RING_OFF + wave * 16384);
        {
            constexpr int I_POOL = 4 * 4 * 8, I_Q = 16 * 32, I_KV = 16 * 64, I_UP = 16 * 128, I_DN = 64 * 32, I_IN = 16 * 96;
            constexpr int NITEMS = I_POOL + 2 * (I_Q + I_KV + I_Q + I_UP + I_DN) + I_IN + I_Q;
            for (int it = gw; it < NITEMS; it += NGW) {
                int r = it;
                if (r < I_POOL) { const int g = r >> 5, rr = r & 31, kb = rr >> 3, nb = rr & 7; p0_transpose_item(w_pool + g * 65536, 256, 256, WPOOL + g * 65536, 64 * kb, 32 * nb, 32 * nb, scr, lane); continue; } r -= I_POOL;
                bool done = false;
#pragma unroll 1
                for (int l = 0; l < 2 && !done; ++l) {
                    if (r < I_Q) { const int kb = r >> 5, nb = r & 31; p0_transpose_item(w_q + (size_t)l * D * D, D, D, WQ + (size_t)l * D * D, 64 * kb, 32 * nb, 32 * nb, scr, lane, g_attn + l * D); done = true; break; } r -= I_Q;
                    if (r < I_KV) { const int kb = r >> 6, nb = r & 63; p0_transpose_item(w_kv + (size_t)l * D * 2048, D, 2048, WKV + (size_t)l * 2048 * D, 64 * kb, 32 * nb, 32 * nb, scr, lane); done = true; break; } r -= I_KV;
                    if (r < I_Q) { const int kb = r >> 5, nb = r & 31; p0_transpose_item(w_o + (size_t)l * D * D, D, D, WO + (size_t)l * D * D, 64 * kb, 32 * nb, 32 * nb, scr, lane); done = true; break; } r -= I_Q;
                    if (r < I_UP) { const int kb = r >> 7, nb = r & 127; p0_transpose_item(w_up + (size_t)l * D * FF, D, FF, WUP + (size_t)l * FF * D, 64 * kb, 32 * nb, 32 * nb, scr, lane, g_ffn + l * D); done = true; break; } r -= I_UP;
                    if (r < I_DN) { const int kb = r >> 5, nb = r & 31; p0_transpose_item(w_down + (size_t)l * FF * D, FF, D, WDN + (size_t)l * D * FF, 64 * kb, 32 * nb, 32 * nb, scr, lane); done = true; break; } r -= I_DN;
                }
                if (done) continue;
                if (r < I_IN) { const int kb = r / 96, nb = r % 96; p0_transpose_item(w_conv_in, D, 3072, WIN, 64 * kb, 32 * nb, win_dest_row(32 * nb), scr, lane, g_mix + D); continue; } r -= I_IN;
                { const int kb = r >> 5, nb = r & 31; p0_transpose_item(w_conv_out, D, D, WOUT, 64 * kb, 32 * nb, 32 * nb, scr, lane); }
            }
        }
        for (int m = gw; m < MEMROWS; m += NGW) {
            const f32x4* xr = (const f32x4*)(mem_prompt + (size_t)m * D) + lane; f32x4 v[4]; float s = 0.f;
#pragma unroll
            for (int j = 0; j < 4; ++j) { v[j] = __builtin_nontemporal_load(xr + 64 * j); s += (v[j][0] * v[j][0] + v[j][1] * v[j][1]) + (v[j][2] * v[j][2] + v[j][3] * v[j][3]); }
            const float rstd = __builtin_amdgcn_rsqf(wave_sum(s) * (1.f / D) + EPS);
#pragma unroll
            for (int l = 0; l < 2; ++l) { v2u* o8 = (v2u*)(MN + ((size_t)l * MEMROWS + m) * D) + lane;
#pragma unroll
                for (int j = 0; j < 4; ++j) { const f32x4 gg = *((const f32x4*)(g_mem + l * D) + lane + 64 * j); const f32x4 w = v[j] * rstd * gg; v2u o; o.x = pk2(w[0], w[1]); o.y = pk2(w[2], w[3]); o8[64 * j] = o; } }
        }
        for (int m = gw; m < 2 * D; m += NGW) {
            const float gk = g_attn[m]; const f32x4* xr = (const f32x4*)(w_q + (size_t)m * D) + lane; v2u* o8 = (v2u*)(WQN + (size_t)m * D) + lane;
            f32x4 v[4];
#pragma unroll
            for (int j = 0; j < 4; ++j) v[j] = __builtin_nontemporal_load(xr + 64 * j);
#pragma unroll
            for (int j = 0; j < 4; ++j) { const f32x4 w = v[j] * gk; v2u o; o.x = pk2(w[0], w[1]); o.y = pk2(w[2], w[3]); o8[64 * j] = o; }
        }
        for (int it = gw; it < MS * 4; it += NGW) {
            const int b = it >> 2, g = it & 3, c4 = g * 256 + lane * 4;
            const f32x4* xr = (const f32x4*)(x_sample + (size_t)b * D) + lane; float s = 0.f;
#pragma unroll
            for (int j = 0; j < 4; ++j) { const f32x4 v = xr[64 * j]; s += (v[0] * v[0] + v[1] * v[1]) + (v[2] * v[2] + v[3] * v[3]); }
            const float rstd = __builtin_amdgcn_rsqf(wave_sum(s) * (1.f / D) + EPS);
            const f32x4 u = *(const f32x4*)(x_sample + (size_t)b * D + c4) * rstd * *(const f32x4*)(g_mix + c4);
            const int W = 2 << g; f32x4 S = u;
            const float* sp = state_pool + (size_t)b * 15 * D + c4;
            float* po = out + OPS + (size_t)b * 15 * D + c4;
            f32x4 sv[15];
#pragma unroll
            for (int r = 0; r < 15; ++r) sv[r] = __builtin_nontemporal_load((const f32x4*)(sp + (size_t)r * D));
#pragma unroll
            for (int r = 0; r < 15; ++r) { if (r >= 16 - W) S += sv[r]; if (r >= 1) *(f32x4*)(po + (size_t)(r - 1) * D) = sv[r]; }
            *(f32x4*)(po + (size_t)14 * D) = u;
            const f32x4 p = S * (1.0f / (float)W) - u; v2u o; o.x = pk2(p[0], p[1]); o.y = pk2(p[2], p[3]); *(v2u*)(P0S + (size_t)b * D + c4) = o;
        }
        __syncthreads();
        {
            LAS float* rs = (LAS float*)(L + RING_OFF);
            for (int it = vcu; it < BATCH * (SEQ / 32); it += G) {
                const int b = it >> 6, t0 = (it & 63) * 32;
                { f32x4 xv[6][4];
#pragma unroll
                  for (int j = 0; j < 6; ++j) { const int r = wave + 8 * j, t = t0 - 15 + r; const bool ok = (r < 47) && (t >= 0);
                      const f32x4* xr = (const f32x4*)(x_prompt + ((size_t)b * SEQ + (ok ? t : t0)) * D) + lane;
#pragma unroll
                      for (int q = 0; q < 4; ++q) xv[j][q] = xr[64 * q]; }
#pragma unroll
                  for (int j = 0; j < 6; ++j) { const int r = wave + 8 * j, t = t0 - 15 + r; float s = 0.f;
#pragma unroll
                      for (int q = 0; q < 4; ++q) { const f32x4 v = xv[j][q]; s += (v[0] * v[0] + v[1] * v[1]) + (v[2] * v[2] + v[3] * v[3]); }
                      const float rv = (t >= 0) ? __builtin_amdgcn_rsqf(wave_sum(s) * (1.f / D) + EPS) : 0.f;
                      if (lane == 0 && r < 47) rs[r] = rv; } }
                LDS_WAIT(); __syncthreads();
                const int g = wave & 3, tA = t0 + (wave >> 2) * 16, c4 = g * 256 + lane * 4;
                const float* xb = x_prompt + (size_t)b * SEQ * D + c4; const f32x4 g4 = *(const f32x4*)(g_mix + c4);
                bf16* pout = P0 + (size_t)b * SEQ * D + c4; float* poolout = out + OPP + (size_t)b * 15 * D + c4;
                const LAS float* rsw = rs + (wave >> 2) * 16;
                if (g == 0) pool_wave<2>(xb, rsw, g4, tA, pout, poolout); else if (g == 1) pool_wave<4>(xb, rsw, g4, tA, pout, poolout);
                else if (g == 2) pool_wave<8>(xb, rsw, g4, tA, pout, poolout); else pool_wave<16>(xb, rsw, g4, tA, pout, poolout);
                __syncthreads();
            }
        }
    }
    SEAM(0);

    if (IN(1)) { PH_BEGIN
        if (doP) { pg8::Gemm g{D, D, D}; pg8::KvOrder S{GS == 32 ? 16 : GS, (GS == 32 && mi >= 16) ? (1 << 20) : mi, grp, (const char*)MN, (const char*)WKV};
          pg8::EpiKV E{out + OMK, out + OMV, KB, VT};
          pg8::gemm_phase<pg8::EpiKV, pg8::KvOrder, true>(L + RING_OFF, g, S, E, TID_NOW); }
        if (doP) { pg8::Gemm g{D, 256, 256}; pg8::StaticOrder S;
          if (GS == 32) S.init(8, 4, 16, mi >= 16 ? mi - 16 : 1 << 20, grp * 8, P0, (size_t)256 * D * 2, WPOOL, (size_t)65536 * 2, (size_t)256 * 2);
          else S.init(8, 4, GS, mi, grp * 8, P0, (size_t)256 * D * 2, WPOOL, (size_t)65536 * 2, (size_t)256 * 2);
          pg8::EpiRes<true> E{x_prompt, X16, SSQ, pool_scale};
          pg8::gemm_phase<pg8::EpiRes<true>, pg8::StaticOrder, true>(L + RING_OFF, g, S, E, TID_NOW); }
        if (doS) { RELANE for (int cp = mi; cp < 32; cp += GS) s_res_unit<1>(P0S + (cp >> 3) * 256, D, WPOOL, 256, 256, cp, 16 * grp, x_sample, XS16, SSQS, pool_scale, L + RING_OFF, wave, lane); }
    }
    SEAM(1);

    if (IN(2)) { PH_BEGIN
        if (doS) { RELANE for (int cp = mi; cp < 32; cp += GS) s_q_unit(XS16, WQ, cp, 16 * grp, SSQS, QS, L + RING_OFF, wave, lane); }
        if (doP) for (int idx = mi; idx < 64; idx += GS) {
            const int ly = idx >> 5, kind = (idx >> 4) & 1, a = (idx >> 2) & 3, q = idx & 3;
            const bf16* Ap; const bf16* Bp; bf16* Op; pg8::Unit u; float sc;
            if (kind == 0) {
                Ap = KB + ((size_t)ly * MEMROWS + grp * 256) * D + a * 256; Bp = WQN + ((size_t)ly * D + 256 * q) * D + a * 256;
                Op = MT + (size_t)((ly * BATCH + grp) * NH + a) * 256 * D; u = pg8::Unit{0, q}; sc = QSCALE;
            } else {
                Ap = WO + ((size_t)ly * D + 256 * a) * D + q * 256; Bp = VT + ((size_t)ly * MEMROWS + grp * 256) * D + q * 256;
                Op = VW + (size_t)(ly * BATCH + grp) * D * D; u = pg8::Unit{a, q}; sc = 1.f;
            }
            pg8::Gemm g{D, D, 256}; pg8::SingleOrder S{u, (const char*)Ap, (const char*)Bp};
            pg8::EpiBf16 E{Op, D, sc};
            pg8::gemm_phase<pg8::EpiBf16, pg8::SingleOrder, true>(L + RING_OFF, g, S, E, TID_NOW);
            __syncthreads();
        }
    }
    {
        const int l = (st >= 7) ? 1 : 0, pb = l ? 10 : 3;
        {
            if (IN(7)) { PH_BEGIN
                const LAS float* rsdp = nullptr;
                const bool tbl = (GS & 7) == 0; LAS float* t_ = (LAS float*)(L + RSD_OFF); if (tbl) rsdp = t_;
                if (doP) { pg8::Gemm g{D, D, D}; pg8::StaticOrder S; S.init(8, 12, GS, mi, grp * 8, X16, (size_t)256 * D * 2, WIN, (size_t)256 * D * 2);
                  pg8::EpiRow<2> E{OB, D, SSQ, 1.f, CH, out + OCP, rsdp};
                  const int pnl = grp * 8 + (mi & 7);
                  pg8::gemm_phase<pg8::EpiRow<2>, pg8::StaticOrder, true>(L + RING_OFF, g, S, E, TID_NOW, [&](int t) { if (tbl) rstd_table(SSQ, pnl, t_, t); }); }
                if (doS) { RELANE
                for (int c2 = mi; c2 < 32; c2 += GS) {
                    const int ca = 32 * c2, cb = ca + 16; const int ra = 1024 + (ca >> 7) * 256 + (ca & 127), rb = 1024 + (cb >> 7) * 256 + (cb & 127);
                    const int brow[6] = {ca, ra, ra + 128, cb, rb, rb + 128};
                    const float rs = srstd(SSQS, 16 * grp + (lane & 15), lane >> 4);
                    const int prow = 16 * grp + (lane & 15), pc = ((wave & 1) ? cb : ca) + 4 * (lane >> 4);
                    const f32x4 s0 = *(const f32x4*)(state_conv + ((size_t)prow * 2 + 0) * D + pc), s1 = *(const f32x4*)(state_conv + ((size_t)prow * 2 + 1) * D + pc);
                    const f32x4 w0 = *(const f32x4*)(w_conv + pc), w1 = *(const f32x4*)(w_conv + D + pc), w2 = *(const f32x4*)(w_conv + 2 * D + pc);
                    sgemm2<1, 6, 3, 4>(XS16, D, 16 * grp, WIN, D, brow, D, L + RING_OFF, wave, lane, [&](f32x4 (&a)[3], int row, int ct0, int fq) {
                        const int c0 = (ct0 == 0 ? ca : cb) + 4 * fq;
                        const f32x4 gb = a[0] * rs, chv = a[1] * a[2] * (rs * rs);
                        const f32x4 cv = s0 * w0 + s1 * w1 + chv * w2;
                        const unsigned g01 = pk2(gb[0], gb[1]), g23 = pk2(gb[2], gb[3]);
                        v2u o; o.x = pk2(bflo(g01) * cv[0], bfhi(g01) * cv[1]); o.y = pk2(bflo(g23) * cv[2], bfhi(g23) * cv[3]);
                        *(v2u*)(P0S + (size_t)row * D + c0) = o;
                        *(f32x4*)(out + OCS + ((size_t)row * 2 + 0) * D + c0) = s1; *(f32x4*)(out + OCS + ((size_t)row * 2 + 1) * D + c0) = chv; }); }
                }
            }
            SEAM(7);
            if (IN(8)) { PH_BEGIN
                const int gt = mi * NTHREADS + tid, NT = GS * NTHREADS;
                if (doP) for (int it0 = gt; it0 < (SEQ / 4) * 128; it0 += 2 * NT) {
                    v4u gb[2][4], cw[2][6];
#pragma unroll
                    for (int q = 0; q < 2; ++q) { const int it = it0 + q * NT; const bool ok = it < (SEQ / 4) * 128; const int t0 = ok ? (it >> 7) * 4 : 0, c8 = (it & 127) * 8; const size_t r0 = (size_t)grp * SEQ + t0;
#pragma unroll
                        for (int j = 0; j < 4; ++j) gb[q][j] = __builtin_nontemporal_load((const v4u*)(OB + (r0 + j) * D + c8));
#pragma unroll
                        for (int j = 0; j < 6; ++j) { const int dt = j - 2; cw[q][j] = *(const v4u*)(CH + (r0 + ((t0 + dt >= 0) ? dt : 0)) * D + c8); } }
#pragma unroll
                    for (int q = 0; q < 2; ++q) { const int it = it0 + q * NT; if (it >= (SEQ / 4) * 128) break; const int t0 = (it >> 7) * 4, c8 = (it & 127) * 8; const size_t r0 = (size_t)grp * SEQ + t0;
                        if (t0 == 0) { cw[q][0] = (v4u){0u, 0u, 0u, 0u}; cw[q][1] = (v4u){0u, 0u, 0u, 0u}; }
                        const f32x4 w0a = *(const f32x4*)(w_conv + c8), w0b = *(const f32x4*)(w_conv + c8 + 4), w1a = *(const f32x4*)(w_conv + D + c8), w1b = *(const f32x4*)(w_conv + D + c8 + 4),
                                    w2a = *(const f32x4*)(w_conv + 2 * D + c8), w2b = *(const f32x4*)(w_conv + 2 * D + c8 + 4);
#pragma unroll
                        for (int r = 0; r < 4; ++r) { v4u o;
#pragma unroll
                            for (int j = 0; j < 4; ++j) { const float wl0 = (j < 2) ? w0a[2 * j] : w0b[2 * j - 4], wh0 = (j < 2) ? w0a[2 * j + 1] : w0b[2 * j - 3];
                                const float wl1 = (j < 2) ? w1a[2 * j] : w1b[2 * j - 4], wh1 = (j < 2) ? w1a[2 * j + 1] : w1b[2 * j - 3];
                                const float wl2 = (j < 2) ? w2a[2 * j] : w2b[2 * j - 4], wh2 = (j < 2) ? w2a[2 * j + 1] : w2b[2 * j - 3];
                                const float lo_ = bflo(gb[q][r][j]) * (bflo(cw[q][r][j]) * wl0 + bflo(cw[q][r + 1][j]) * wl1 + bflo(cw[q][r + 2][j]) * wl2);
                                const float hi_ = bfhi(gb[q][r][j]) * (bfhi(cw[q][r][j]) * wh0 + bfhi(cw[q][r + 1][j]) * wh1 + bfhi(cw[q][r + 2][j]) * wh2);
                                o[j] = pk2(lo_, hi_); }
                            *(v4u*)(P0 + (r0 + r) * D + c8) = o; } }
                }
                if (doS) { for (int cp = mi; cp < 32; cp += GS) s_res_unit<4>(P0S, D, WOUT, D, D, cp, 16 * grp, nullptr, XS16, SSQS, nullptr, L + RING_OFF, wave, lane); }
            }
            SEAM(8);
            if (IN(9)) { PH_BEGIN
                if (doP) { pg8::Gemm g{D, D, D}; pg8::StaticOrder S; S.init(8, 4, GS, mi, grp * 8, P0, (size_t)256 * D * 2, WOUT, (size_t)256 * D * 2);
                  pg8::EpiRes<false> E{nullptr, X16, SSQ, nullptr};
                  pg8::gemm_phase<pg8::EpiRes<false>, pg8::StaticOrder, true>(L + RING_OFF, g, S, E, TID_NOW); }
                if (doS) { RELANE for (int cp = mi; cp < 32; cp += GS) s_q_unit(XS16, WQ + (size_t)D * D, cp, 16 * grp, SSQS, QS, L + RING_OFF, wave, lane); }
            }
            SEAM(9);
        }
#define LAYER_W const bf16* WQl = WQ + (size_t)l * D * D; const bf16* WOl = WO + (size_t)l * D * D; const bf16* WUPl = WUP + (size_t)l * FF * D; const bf16* WDNl = WDN + (size_t)l * D * FF; (void)WQl; (void)WOl; (void)WUPl; (void)WDNl;
        if (IN(pb)) { PH_BEGIN LAYER_W
#pragma unroll 1
            for (int half = 0; half < 2; ++half) {
            const bool sampleHalf = ((half == 0) == sfirst);
            if (doP && !sampleHalf) for (int itl = mi; itl < 32; itl += GS) {
                const int pm = grp * 8 + (itl >> 2), h = itl & 3;
                pg8::Gemm g{D, D, D}; pg8::SingleOrder S{{pm, h}, (const char*)(X16 + (size_t)pm * 256 * D), (const char*)(MT + (size_t)((l * BATCH + grp) * NH + h) * 256 * D)};
                LAS float* t_ = (LAS float*)(L + RSD_OFF);
                pg8::EpiSoftmax E{OB, D, SSQ, t_};
                pg8::gemm_phase<pg8::EpiSoftmax, pg8::SingleOrder, false>(L + RING_OFF, g, S, E, TID_NOW, [&](int t) { rstd_table(SSQ, pm, t_, t); });
                LDS_WAIT(); __builtin_amdgcn_s_barrier(); asm volatile("" ::: "memory");
            }
            if (doS && sampleHalf) { RELANE
                LAS float* sc = (LAS float*)(L + RING_OFF);
                LAS float* po = (LAS float*)(L + RING_OFF + 1024);
                for (int it0 = mi; it0 < 64; it0 += 2 * GS) {
                    const bool pair = (it0 + GS < 64);
#pragma unroll 1
                    for (int iu = 0; iu < 2; ++iu) {
                        if (iu == 1 && !pair) break;
                        const int it = it0 + iu * GS, b = 16 * grp + (it >> 2), h = it & 3;
                        const f32x4 q4 = *(const f32x4*)(QS + (size_t)b * D + h * 256 + lane * 4);
                        const float* kp = cache_k + (((size_t)l * MS + b) * NMEM + wave * 32) * D + h * 256 + lane * 4;
                        const float* vp = cache_v + (((size_t)l * MS + b) * NMEM + wave * 32) * D + h * 256 + lane * 4;
                        f32x4 kv[32]; float p[32];
#pragma unroll
                        for (int n = 0; n < 32; ++n) kv[n] = __builtin_nontemporal_load((const f32x4*)(kp + (size_t)n * D));
#pragma unroll
                        for (int n = 0; n < 32; ++n) { p[n] = (q4[0] * kv[n][0] + q4[1] * kv[n][1]) + (q4[2] * kv[n][2] + q4[3] * kv[n][3]); kv[n] = __builtin_nontemporal_load((const f32x4*)(vp + (size_t)n * D)); }
                        treduce32(p, lane);
                        if ((lane & 1) == 0) sc[wave * 32 + (lane >> 1)] = p[0];
                        LDS_WAIT(); __builtin_amdgcn_s_barrier(); asm volatile("" ::: "memory");
                        float mx, sm = 0.f; const f32x4 sv = *(const LAS f32x4*)(sc + lane * 4);
                        mx = fmaxf(fmaxf(sv[0], sv[1]), fmaxf(sv[2], sv[3]));
                        mx = wave_max(mx);
#pragma unroll
                        for (int j = 0; j < 4; ++j) sm += __builtin_amdgcn_exp2f(sv[j] - mx);
                        sm = wave_sum(sm);
                        f32x4 acc = {0.f, 0.f, 0.f, 0.f};
#pragma unroll
                        for (int n = 0; n < 32; ++n) { const float pn_ = __builtin_amdgcn_exp2f(sc[wave * 32 + n] - mx); acc += kv[n] * pn_; }
                        *(LAS f32x4*)(po + wave * 256 + lane * 4) = acc;
                        LDS_WAIT(); __builtin_amdgcn_s_barrier(); asm volatile("" ::: "memory");
                        if (tid < 256) { float o = 0.f;
#pragma unroll
                            for (int w = 0; w < 8; ++w) o += po[w * 256 + tid];
                            OS[(size_t)b * D + h * 256 + tid] = (bf16)f2bf(o / sm); }
                        LDS_WAIT(); __builtin_amdgcn_s_barrier(); asm volatile("" ::: "memory");
                    }
                }
            }
            }
        }
        SEAM(pb);
        if (IN(pb + 1)) { PH_BEGIN LAYER_W
            if (doP) { pg8::Gemm g{D, D, D}; pg8::StaticOrder S; S.init(8, 4, GS, mi, grp * 8, OB, (size_t)256 * D * 2, VW + (size_t)(l * BATCH + grp) * D * D, (size_t)256 * D * 2);
              pg8::EpiRes<false> E{nullptr, X16, SSQ, nullptr};
              pg8::gemm_phase<pg8::EpiRes<false>, pg8::StaticOrder, true>(L + RING_OFF, g, S, E, TID_NOW); }
            if (doS) { RELANE for (int cp = mi; cp < 32; cp += GS) s_res_unit<4>(OS, D, WOl, D, D, cp, 16 * grp, nullptr, XS16, SSQS, nullptr, L + RING_OFF, wave, lane); }
        }
        SEAM(pb + 2);
        if (IN(pb + 2)) { PH_BEGIN LAYER_W
            const LAS float* rsdp = nullptr;
            const bool tbl = (GS & 7) == 0; LAS float* t_ = (LAS float*)(L + RSD_OFF); if (tbl) rsdp = t_;
            if (doP) { pg8::Gemm g{D, D, D}; pg8::StaticOrder S; S.init(8, 16, GS, mi, grp * 8, X16, (size_t)256 * D * 2, WUPl, (size_t)256 * D * 2);
              pg8::EpiRow<1> E{HB, FF, SSQ, 1.f, nullptr, nullptr, rsdp};
              const int pnl = grp * 8 + (mi & 7);
              pg8::gemm_phase<pg8::EpiRow<1>, pg8::StaticOrder, true>(L + RING_OFF, g, S, E, TID_NOW, [&](int t) { if (tbl) rstd_table(SSQ, pnl, t_, t); }); }
            if (doS) { RELANE for (int c8 = mi; c8 < 32; c8 += GS) { const int brow[8] = {128 * c8, 128 * c8 + 16, 128 * c8 + 32, 128 * c8 + 48, 128 * c8 + 64, 128 * c8 + 80, 128 * c8 + 96, 128 * c8 + 112};
                const float rs = srstd(SSQS, 16 * grp + (lane & 15), lane >> 4);
                sgemm2<1, 8, 1, 4>(XS16, D, 16 * grp, WUPl, D, brow, D, L + RING_OFF, wave, lane, [&](f32x4 (&a)[1], int row, int ct0, int fq) {
                    const f32x4 v0 = relu2(a[0] * rs);
                    v2u p0; p0.x = pk2(v0[0], v0[1]); p0.y = pk2(v0[2], v0[3]);
                    *(v2u*)(HS + (size_t)row * FF + 128 * c8 + 16 * ct0 + 4 * fq) = p0; }); } }
        }
        SEAM(pb + 3);
        if (IN(pb + 3)) { PH_BEGIN LAYER_W
            if (doP) { pg8::Gemm g{FF, FF, FF}; pg8::StaticOrder S; S.init(8, 4, GS, mi, grp * 8, HB, (size_t)256 * FF * 2, WDNl, (size_t)256 * FF * 2);
              pg8::EpiRes<false> E{nullptr, X16, SSQ, nullptr};
              pg8::gemm_phase<pg8::EpiRes<false>, pg8::StaticOrder, true>(L + RING_OFF, g, S, E, TID_NOW); }
            if (doS) { RELANE for (int cp = mi; cp < 32; cp += GS) s_res_unit<8>(HS, FF, WDNl, FF, FF, cp, 16 * grp, nullptr, XS16, SSQS, nullptr, L + RING_OFF, wave, lane); }
        }
        SEAM(pb + 4);
    }
    if (IN(14)) { PH_BEGIN
        const int mlo = doP ? 0 : SEQ, mhi = doS ? SEQ + 16 : SEQ;
        for (int ml0 = mlo + mi * NWAVES + wave; ml0 < mhi; ml0 += 4 * GS * NWAVES) {
            float sv[4]; v4u xw[4][2];
#pragma unroll
            for (int q = 0; q < 4; ++q) { const int ml = ml0 + q * GS * NWAVES; const bool ok = ml < mhi; const int mlc = ok ? ml : ml0;
                const bf16* xr;
                if (mlc < SEQ) { const int m = grp * SEQ + mlc; sv[q] = (lane < 16) ? SSQ[(size_t)m * 16 + lane] : 0.f; xr = X16 + (size_t)m * D; }
                else { const int r = 16 * grp + (mlc - SEQ); sv[q] = SSQS[r * 64 + lane]; xr = XS16 + (size_t)r * D; }
                xw[q][0] = __builtin_nontemporal_load((const v4u*)xr + lane); xw[q][1] = __builtin_nontemporal_load((const v4u*)xr + lane + 64); }
#pragma unroll
            for (int q = 0; q < 4; ++q) { const int ml = ml0 + q * GS * NWAVES; if (ml >= mhi) break;
                const float rs = __builtin_amdgcn_rsqf(wave_sum(sv[q]) * (1.f / D) + EPS);
                float* yr = (ml < SEQ) ? out + OY + (size_t)(grp * SEQ + ml) * D : out + OYS + (size_t)(16 * grp + (ml - SEQ)) * D;
#pragma unroll
                for (int j = 0; j < 2; ++j) { const v4u w = xw[q][j]; const f32x4 g0 = *((const f32x4*)g_final + 2 * (lane + 64 * j)), g1 = *((const f32x4*)g_final + 2 * (lane + 64 * j) + 1);
                    const f32x4 x0 = {bflo(w.x), bfhi(w.x), bflo(w.y), bfhi(w.y)}, x1 = {bflo(w.z), bfhi(w.z), bflo(w.w), bfhi(w.w)};
                    f32x4* yp = (f32x4*)yr + 2 * (lane + 64 * j); yp[0] = x0 * rs * g0; yp[1] = x1 * rs * g1; } }
        }
    }
    }
#if SELF_INIT && !MK_PER_PHASE
    if (ph == 0) {
        if (wave0 == 0 && lane_id_opaque() == 0) {
            unsigned sp_ = 0u;
            while (__hip_atomic_load(ctlw + CW_FLAG, __ATOMIC_RELAXED, __HIP_MEMORY_SCOPE_AGENT) != INIT_MAGIC) { __builtin_amdgcn_s_sleep(2); if (++sp_ > (1u << 22)) break; }
            (void)xb_add(&bar.bar[XB_XCNT(bar.x)], 1u); (void)xb_add(&gbar.bar[XB_XCNT(gbar.x)], 1u);
        }
    }
#endif
    if (ph + 1 < hi + soff) { if (ph == 0) { GRID_BAR();
#if STAGGER_TICKS > 0
            { const unsigned long long t0 = __builtin_amdgcn_s_memrealtime(); const unsigned long long dt = (unsigned long long)grp * STAGGER_TICKS;
              while (__builtin_amdgcn_s_memrealtime() - t0 < dt) __builtin_amdgcn_s_sleep(4); }
#endif
        } else GROUP_BAR(); }
    }
#if SELF_INIT && !MK_PER_PHASE
    if (bx == 0 && threadIdx.x == 0) __hip_atomic_store(ctlw + CW_FLAG, 0u, __ATOMIC_RELAXED, __HIP_MEMORY_SCOPE_AGENT);
#endif
#undef IN
#undef SEAM
#undef GRID_BAR
}

extern "C" void kernel_launch(void* const* d_in, const int* in_sizes, int n_in, void* d_out, int out_size, void* d_ws, size_t ws_size, hipStream_t stream) {
    static int grid = 0;
    if (grid == 0) {
        if (n_in != 22 || ws_size < WS_END) { fprintf(stderr, "kernel_launch: unexpected inputs (n_in %d, ws %zu)\n", n_in, ws_size); grid = -1; return; }
        int dev = 0, cus = 0, per_cu = 0;
        if (hipGetDevice(&dev) != hipSuccess || hipDeviceGetAttribute(&cus, hipDeviceAttributeMultiprocessorCount, dev) != hipSuccess) { grid = -1; return; }
        if (hipFuncSetAttribute((const void*)mk_fwd, hipFuncAttributeMaxDynamicSharedMemorySize, LDS_BYTES) != hipSuccess) { fprintf(stderr, "kernel_launch: hipFuncSetAttribute failed\n"); grid = -1; return; }
        if (hipOccupancyMaxActiveBlocksPerMultiprocessor(&per_cu, (const void*)mk_fwd, NTHREADS, LDS_BYTES) != hipSuccess || per_cu < 1)
            fprintf(stderr, "kernel_launch: note: occupancy query reports %d workgroups per CU\n", per_cu);
        (void)hipGetLastError();
        grid = cus;
    }
    if (grid < 0) return;
#if !SELF_INIT || MK_PER_PHASE
    (void)hipMemsetAsync((char*)d_ws + WS_CTL, 0, CTL_ZERO_BYTES, stream);
#endif
    Args a{};
    for (int i = 0; i < 22; ++i) a.in[i] = (const float*)d_in[i];
    a.out = (float*)d_out; a.ws = (unsigned char*)d_ws;
#if MK_PER_PHASE
    for (int p = 0; p < NPHASES; ++p) { a.ph_lo = p; a.ph_hi = p + 1; hipLaunchKernelGGL(mk_fwd, dim3(grid), dim3(NTHREADS), LDS_BYTES, stream, a); }
#else
    a.ph_lo = 0; a.ph_hi = NPHASES; hipLaunchKernelGGL(mk_fwd, dim3(grid), dim3(NTHREADS), LDS_BYTES, stream, a);
#endif
}
```

```cpp
#include <hip/hip_runtime.h>
#include <cstdio>
#include <cstdint>

#ifndef SAMPLE_SHIFT
#define SAMPLE_SHIFT 1
#endif
#ifndef SELF_INIT
#define SELF_INIT 1
#endif
#ifndef EARLY_INV
#define EARLY_INV 1
#endif
#ifndef MEMBER_FLIP
#define MEMBER_FLIP 1
#endif
#ifndef MEMBER_FLIP_SEL
#define MEMBER_FLIP_SEL (mi & 1)
#endif
#ifndef STAGGER_TICKS
#define STAGGER_TICKS 0
#endif
#ifndef MK_PER_PHASE
#define MK_PER_PHASE 0
#endif

constexpr int D = 1024, BATCH = 8, SEQ = 2048, MP = BATCH * SEQ  , MS = 128  ;
constexpr int NMEM = 256, NH = 4, HD = 256, FF = 4096, MEMROWS = BATCH * NMEM  ;
constexpr float EPS = 1e-6f;
constexpr float QSCALE = 0.0625f * 1.4426950408889634f;

constexpr size_t OY = 0, OYS = 16777216, OPP = 16908288, OCP = 17031168, OMK = 17047552, OMV = 21241856, OPS = 25436160, OCS = 27402240;

__device__ __forceinline__ int lane_id_opaque() { int l; asm volatile("v_mbcnt_lo_u32_b32 %0, -1, 0\n\tv_mbcnt_hi_u32_b32 %0, -1, %0" : "=v"(l)); return l; }
#define SWZ_XOR(v, m) __builtin_bit_cast(float, __builtin_amdgcn_ds_swizzle(__builtin_bit_cast(int, (float)(v)), (((m) << 10) | 0x1f)))
__device__ __forceinline__ void swap32(float& a, float& b) { asm volatile("s_nop 1\n\tv_permlane32_swap_b32 %0, %1\n\ts_nop 1" : "+v"(a), "+v"(b)); }
__device__ __forceinline__ float add_x32(float v) { float a = v, b = v; swap32(a, b); return a + b; }
__device__ __forceinline__ float max_x32(float v) { float a = v, b = v; swap32(a, b); return fmaxf(a, b); }
__device__ __forceinline__ float add_x16_x32(float v) { v += SWZ_XOR(v, 16); return add_x32(v); }
__device__ __forceinline__ float max_x16_x32(float v) { v = fmaxf(v, SWZ_XOR(v, 16)); return max_x32(v); }
__device__ __forceinline__ float wave_sum(float v) { v += SWZ_XOR(v, 1); v += SWZ_XOR(v, 2); v += SWZ_XOR(v, 4); v += SWZ_XOR(v, 8); v += SWZ_XOR(v, 16); return add_x32(v); }
__device__ __forceinline__ float wave_max(float v) { v = fmaxf(v, SWZ_XOR(v, 1)); v = fmaxf(v, SWZ_XOR(v, 2)); v = fmaxf(v, SWZ_XOR(v, 4)); v = fmaxf(v, SWZ_XOR(v, 8)); v = fmaxf(v, SWZ_XOR(v, 16)); return max_x32(v); }

namespace pg8 {
#define PG8_LAS __attribute__((address_space(3)))
typedef unsigned short bf16_t;
typedef short bf16x8 __attribute__((ext_vector_type(8)));
typedef float f32x4 __attribute__((ext_vector_type(4)));
typedef float f32x2 __attribute__((ext_vector_type(2)));
typedef unsigned u32x4 __attribute__((ext_vector_type(4)));
typedef unsigned u32x2 __attribute__((ext_vector_type(2)));
constexpr int BM = 256, BK = 64, HALF = 128, HTB = HALF * BK * 2, STAGE_BYTES = 8 * HTB, NXCD = 8, WGM = 8;

__host__ __device__ __forceinline__ int lds_byte(int r, int c) { const int st = (r >> 4) * 2 + (c >> 5), rr = r & 15, cc = c & 31, ob = rr * 64 + cc * 2; return st * 1024 + (ob ^ (((ob >> 9) & 1) << 5)); }
__host__ __device__ __forceinline__ void stage_rc(int b, int& R, int& C) { const int st = b / 1024, sb = b % 1024, swz = sb ^ (((sb >> 9) & 1) << 5); R = (st >> 1) * 16 + swz / 64; C = (st & 1) * 32 + (swz % 64) / 2; }
__host__ __device__ __forceinline__ int perm32(int rho) { const int n = rho >> 4, i = rho & 15; return 8 * (i >> 2) + 4 * n + (i & 3); }

struct Unit { int pm, pn; };
struct Gemm { int lda, ldb, K; };

__device__ __forceinline__ unsigned cvt_pk_bf16(float lo, float hi) { unsigned r; asm volatile("v_cvt_pk_bf16_f32 %0, %1, %2" : "=v"(r) : "v"(lo), "v"(hi)); return r; }

struct StaticOrder {
    int nM, nN, nwg, G, c, pm0;
    const char* A; const char* B; size_t astep, bstep, apn;
    __device__ void init(int nM_, int nN_, int G_, int c_, int pm0_, const void* A_, size_t astep_, const void* B_, size_t bstep_, size_t apn_ = 0) {
        nM = nM_; nN = nN_; nwg = nM * nN; G = G_; c = c_; pm0 = pm0_; A = (const char*)A_; B = (const char*)B_; astep = astep_; bstep = bstep_; apn = apn_; }
    __device__ bool next(int i, Unit& u) const {
        const long L = (long)i * G + c; if (L >= nwg) return false;
        u.pm = pm0 + (int)(L % nM); u.pn = (int)(L / nM); return true;
    }
    __device__ __forceinline__ const char* aptr(const Unit& u) const { return A + (size_t)u.pm * astep + (size_t)u.pn * apn; }
    __device__ __forceinline__ const char* bptr(const Unit& u) const { return B + (size_t)u.pn * bstep; }
};
struct KvOrder {
    int G, c, batch; const char* A; const char* B;
    __device__ bool next(int i, Unit& u) const { const int L = i * G + c; if (L >= 16) return false; u.pm = (L >> 3) * 8 + batch; u.pn = L & 7; return true; }
    __device__ __forceinline__ const char* aptr(const Unit& u) const { return A + (size_t)u.pm * (256 * 1024 * 2); }
    __device__ __forceinline__ const char* bptr(const Unit& u) const { return B + (size_t)((u.pm >> 3) * 2048 + u.pn * 256) * (1024 * 2); }
};
struct SingleOrder {
    Unit u0; const char* A; const char* B;
    __device__ bool next(int i, Unit& u) const { if (i) return false; u = u0; return true; }
    __device__ __forceinline__ const char* aptr(const Unit&) const { return A; }
    __device__ __forceinline__ const char* bptr(const Unit&) const { return B; }
};


template <bool BASE32> struct EpiRes {
    static constexpr bool PERM = true, AFTER_DRAIN = false;
    const float* base32; bf16_t* x16; float* ssq; const float* cscale;
    __device__ __forceinline__ void operator()(const f32x4 (&acc)[2][2][4][2], const Unit& u, int wr, int wc, int fr, int fq) const {
        const int col0 = u.pn * BM + wc * 32 + 8 * fq;
        f32x4 cs[2][2];
#pragma unroll
        for (int bj = 0; bj < 2; ++bj)
#pragma unroll
            for (int n = 0; n < 2; ++n) cs[bj][n] = cscale ? *(const f32x4*)(cscale + col0 + bj * HALF + n * 4) : (f32x4){1.f, 1.f, 1.f, 1.f};
        constexpr int HSTEP = BASE32 ? 1 : 2;
#pragma unroll
        for (int a0 = 0; a0 < 2; a0 += HSTEP) {
        u32x4 bw[HSTEP][4][2]; f32x4 bf[BASE32 ? 1 : 1][4][2][2];
#pragma unroll
        for (int ah = 0; ah < HSTEP; ++ah)
#pragma unroll
            for (int m = 0; m < 4; ++m) { const int row = u.pm * BM + (a0 + ah) * HALF + wr * 64 + m * 16 + fr; const size_t off = (size_t)row * D + col0;
#pragma unroll
                for (int bj = 0; bj < 2; ++bj) {
                    if (BASE32) { bf[0][m][bj][0] = __builtin_nontemporal_load((const f32x4*)(base32 + off + bj * HALF)); bf[0][m][bj][1] = __builtin_nontemporal_load((const f32x4*)(base32 + off + bj * HALF + 4)); }
                    else bw[ah][m][bj] = *(const u32x4*)(x16 + off + bj * HALF); } }
#pragma unroll
        for (int ah = 0; ah < HSTEP; ++ah) { const int ai = a0 + ah;
#pragma unroll
            for (int m = 0; m < 4; ++m) { const int row = u.pm * BM + ai * HALF + wr * 64 + m * 16 + fr; const size_t off = (size_t)row * D + col0; float ss = 0.f;
#pragma unroll
                for (int bj = 0; bj < 2; ++bj) { f32x4 b0, b1;
                    if (BASE32) { b0 = bf[0][m][bj][0]; b1 = bf[0][m][bj][1]; }
                    else { const u32x4 w = bw[ah][m][bj];
                        b0 = (f32x4){__builtin_bit_cast(float, w.x << 16), __builtin_bit_cast(float, w.x & 0xffff0000u), __builtin_bit_cast(float, w.y << 16), __builtin_bit_cast(float, w.y & 0xffff0000u)};
                        b1 = (f32x4){__builtin_bit_cast(float, w.z << 16), __builtin_bit_cast(float, w.z & 0xffff0000u), __builtin_bit_cast(float, w.w << 16), __builtin_bit_cast(float, w.w & 0xffff0000u)}; }
                    const f32x4 v0 = b0 + acc[ai][bj][m][0] * cs[bj][0], v1 = b1 + acc[ai][bj][m][1] * cs[bj][1];
                    ss += ((v0[0] * v0[0] + v0[1] * v0[1]) + (v0[2] * v0[2] + v0[3] * v0[3])) + ((v1[0] * v1[0] + v1[1] * v1[1]) + (v1[2] * v1[2] + v1[3] * v1[3]));
                    u32x4 o; o.x = cvt_pk_bf16(v0[0], v0[1]); o.y = cvt_pk_bf16(v0[2], v0[3]); o.z = cvt_pk_bf16(v1[0], v1[1]); o.w = cvt_pk_bf16(v1[2], v1[3]);
                    *(u32x4*)(x16 + off + bj * HALF) = o; }
                ss = add_x16_x32(ss);
                if (fq == 0) ssq[(size_t)row * 16 + u.pn * 4 + wc] = ss; }
        }
        }
    }
};
__device__ __forceinline__ float rstd_from_ssq16(const float* ssq, int row) {
    const f32x4* sp = (const f32x4*)(ssq + (size_t)row * 16); const f32x4 s = (sp[0] + sp[1]) + (sp[2] + sp[3]);
    return __builtin_amdgcn_rsqf(((s[0] + s[1]) + (s[2] + s[3])) * (1.0f / D) + EPS);
}
template <int MODE> struct EpiRow {
    static constexpr bool PERM = true, AFTER_DRAIN = false;
    bf16_t* O; int ldc; const float* ssq; float scale; bf16_t* O2; float* convout; const PG8_LAS float* rsd;
    __device__ __forceinline__ void operator()(const f32x4 (&acc)[2][2][4][2], const Unit& u, int wr, int wc, int fr, int fq) const {
        const int colw = wc * 32 + 8 * fq;
        float rsv[2][4];
        if (rsd) {
#pragma unroll
          for (int ai = 0; ai < 2; ++ai)
#pragma unroll
              for (int m = 0; m < 4; ++m) rsv[ai][m] = rsd[ai * HALF + wr * 64 + m * 16 + fr];
        } else { f32x4 qv[2][4];
#pragma unroll
          for (int ai = 0; ai < 2; ++ai)
#pragma unroll
              for (int m = 0; m < 4; ++m) qv[ai][m] = *(const f32x4*)(ssq + (size_t)(u.pm * BM + ai * HALF + wr * 64 + m * 16 + fr) * 16 + 4 * fq);
#pragma unroll
          for (int ai = 0; ai < 2; ++ai)
#pragma unroll
              for (int m = 0; m < 4; ++m) { const f32x4 q = qv[ai][m]; rsv[ai][m] = __builtin_amdgcn_rsqf(add_x16_x32((q[0] + q[1]) + (q[2] + q[3])) * (1.0f / D) + EPS); } }
#pragma unroll
        for (int ai = 0; ai < 2; ++ai)
#pragma unroll
            for (int m = 0; m < 4; ++m) { const int row = u.pm * BM + ai * HALF + wr * 64 + m * 16 + fr; const float rs = rsv[ai][m];
                if (MODE == 2 && u.pn >= 4) {
                    const float r2 = rs * rs; const f32x4 v0 = acc[ai][0][m][0] * acc[ai][1][m][0] * r2, v1 = acc[ai][0][m][1] * acc[ai][1][m][1] * r2;
                    const int ch = (u.pn - 4) * 128 + colw;
                    u32x4 w; w.x = cvt_pk_bf16(v0[0], v0[1]); w.y = cvt_pk_bf16(v0[2], v0[3]); w.z = cvt_pk_bf16(v1[0], v1[1]); w.w = cvt_pk_bf16(v1[2], v1[3]);
                    *(u32x4*)(O2 + (size_t)row * D + ch) = w;
                    const int t = row & (SEQ - 1);
                    if (t >= SEQ - 2) { float* cp = convout + ((size_t)(row >> 11) * 2 + (t - (SEQ - 2))) * D + ch; *(f32x4*)cp = v0; *(f32x4*)(cp + 4) = v1; }
                } else {
                    const float sc = (MODE == 0) ? rs * scale : rs;
#pragma unroll
                    for (int bj = 0; bj < 2; ++bj) { f32x4 v0 = acc[ai][bj][m][0] * sc, v1 = acc[ai][bj][m][1] * sc;
                        if (MODE == 1) {
#pragma unroll
                            for (int j = 0; j < 4; ++j) { const float a = fmaxf(v0[j], 0.f), b = fmaxf(v1[j], 0.f); v0[j] = a * a; v1[j] = b * b; } }
                        u32x4 w; w.x = cvt_pk_bf16(v0[0], v0[1]); w.y = cvt_pk_bf16(v0[2], v0[3]); w.z = cvt_pk_bf16(v1[0], v1[1]); w.w = cvt_pk_bf16(v1[2], v1[3]);
                        *(u32x4*)(O + (size_t)row * ldc + u.pn * BM + bj * HALF + colw) = w; }
                } }
    }
};
struct EpiBf16 {
    static constexpr bool PERM = true, AFTER_DRAIN = false;
    bf16_t* O; int ldc; float scale;
    __device__ __forceinline__ void operator()(const f32x4 (&acc)[2][2][4][2], const Unit& u, int wr, int wc, int fr, int fq) const {
        const int colw = u.pn * BM + wc * 32 + 8 * fq;
#pragma unroll
        for (int ai = 0; ai < 2; ++ai)
#pragma unroll
            for (int m = 0; m < 4; ++m) { const int row = u.pm * BM + ai * HALF + wr * 64 + m * 16 + fr;
#pragma unroll
                for (int bj = 0; bj < 2; ++bj) { const f32x4 v0 = acc[ai][bj][m][0] * scale, v1 = acc[ai][bj][m][1] * scale;
                    u32x4 w; w.x = cvt_pk_bf16(v0[0], v0[1]); w.y = cvt_pk_bf16(v0[2], v0[3]); w.z = cvt_pk_bf16(v1[0], v1[1]); w.w = cvt_pk_bf16(v1[2], v1[3]);
                    *(u32x4*)(O + (size_t)row * ldc + colw + bj * HALF) = w; } }
    }
};
struct EpiKV {
    static constexpr bool PERM = false, AFTER_DRAIN = false;
    float* outk; float* outv; bf16_t* Kb; bf16_t* Vt;
    __device__ __forceinline__ void operator()(const f32x4 (&acc)[2][2][4][2], const Unit& u, int wr, int wc, int fr, int fq) const {
        const int layer = u.pm >> 3; const bool isV = u.pn >= 4; const int col0 = (u.pn & 3) * BM + wc * 32 + 4 * fq;
        float* outp = isV ? outv : outk;
#pragma unroll
        for (int ai = 0; ai < 2; ++ai)
#pragma unroll
            for (int m = 0; m < 4; ++m) { const int rowl = (u.pm & 7) * BM + ai * HALF + wr * 64 + m * 16 + fr; const size_t off = ((size_t)layer * MEMROWS + rowl) * D + col0;
#pragma unroll
                for (int bj = 0; bj < 2; ++bj)
#pragma unroll
                    for (int n = 0; n < 2; ++n) { const f32x4 v = acc[ai][bj][m][n]; *(f32x4*)(outp + off + bj * HALF + n * 16) = v;
                        if (!isV) { u32x2 p; p.x = cvt_pk_bf16(v[0], v[1]); p.y = cvt_pk_bf16(v[2], v[3]); *(u32x2*)(Kb + off + bj * HALF + n * 16) = p; }
                        else { u32x2 p; p.x = cvt_pk_bf16(v[0], v[1]); p.y = cvt_pk_bf16(v[2], v[3]); *(u32x2*)(Vt + off + bj * HALF + n * 16) = p; } } }
    }
};
struct EpiSoftmax {
    static constexpr bool PERM = true, AFTER_DRAIN = true;
    bf16_t* P; int ldp; const float* ssq; const PG8_LAS float* rsd;
    __device__ __forceinline__ void operator()(const f32x4 (&)[2][2][4][2], const Unit&, int, int, int, int) const {}
    __device__ __forceinline__ void fused(f32x4 (&acc)[2][2][4][2], const Unit& u, int wr, int wc, int fr, int fq, PG8_LAS unsigned char* lds, int wid, int lane) const {
        PG8_LAS float* Pm = (PG8_LAS float*)lds;
        PG8_LAS float* Ps = (PG8_LAS float*)(lds + 4096);
        float rsv[2][4];
        if (rsd) {
#pragma unroll
          for (int ai = 0; ai < 2; ++ai)
#pragma unroll
              for (int m = 0; m < 4; ++m) rsv[ai][m] = rsd[ai * HALF + wr * 64 + m * 16 + fr];
        } else { f32x4 qv[2][4];
#pragma unroll
          for (int ai = 0; ai < 2; ++ai)
#pragma unroll
              for (int m = 0; m < 4; ++m) qv[ai][m] = *(const f32x4*)(ssq + (size_t)(u.pm * BM + ai * HALF + wr * 64 + m * 16 + fr) * 16 + 4 * fq);
#pragma unroll
          for (int ai = 0; ai < 2; ++ai)
#pragma unroll
              for (int m = 0; m < 4; ++m) { const f32x4 q = qv[ai][m]; rsv[ai][m] = __builtin_amdgcn_rsqf(add_x16_x32((q[0] + q[1]) + (q[2] + q[3])) * (1.0f / D) + EPS); } }
#pragma unroll
        for (int ai = 0; ai < 2; ++ai)
#pragma unroll
            for (int m = 0; m < 4; ++m) { float mx = -3.0e38f; const float rs = rsv[ai][m];
#pragma unroll
                for (int bj = 0; bj < 2; ++bj)
#pragma unroll
                    for (int n = 0; n < 2; ++n) { const f32x4 x = acc[ai][bj][m][n] * rs; acc[ai][bj][m][n] = x; mx = fmaxf(mx, fmaxf(fmaxf(x[0], x[1]), fmaxf(x[2], x[3]))); }
                mx = max_x16_x32(mx);
                if (fq == 0) Pm[(ai * HALF + wr * 64 + m * 16 + fr) * 4 + wc] = mx; }
        asm volatile("s_waitcnt lgkmcnt(0)" ::: "memory"); __builtin_amdgcn_s_barrier(); asm volatile("" ::: "memory");
#pragma unroll
        for (int ai = 0; ai < 2; ++ai)
#pragma unroll
            for (int m = 0; m < 4; ++m) { const int r = ai * HALF + wr * 64 + m * 16 + fr; const f32x4 q = *(const PG8_LAS f32x4*)(Pm + r * 4);
                const float mx = fmaxf(fmaxf(q[0], q[1]), fmaxf(q[2], q[3])); float s = 0.f;
#pragma unroll
                for (int bj = 0; bj < 2; ++bj)
#pragma unroll
                    for (int n = 0; n < 2; ++n) { f32x4 x = acc[ai][bj][m][n];
#pragma unroll
                        for (int j = 0; j < 4; ++j) { x[j] = __builtin_amdgcn_exp2f(x[j] - mx); s += x[j]; }
                        acc[ai][bj][m][n] = x; }
                s = add_x16_x32(s);
                if (fq == 0) Ps[r * 4 + wc] = s; }
        asm volatile("s_waitcnt lgkmcnt(0)" ::: "memory"); __builtin_amdgcn_s_barrier(); asm volatile("" ::: "memory");
        const int colw = u.pn * BM + wc * 32 + 8 * fq;
#pragma unroll
        for (int ai = 0; ai < 2; ++ai)
#pragma unroll
            for (int m = 0; m < 4; ++m) { const int r = ai * HALF + wr * 64 + m * 16 + fr; const f32x4 q = *(const PG8_LAS f32x4*)(Ps + r * 4);
                const float inv = __builtin_amdgcn_rcpf((q[0] + q[1]) + (q[2] + q[3]));
#pragma unroll
                for (int bj = 0; bj < 2; ++bj) { const f32x4 v0 = acc[ai][bj][m][0] * inv, v1 = acc[ai][bj][m][1] * inv;
                    u32x4 w; w.x = cvt_pk_bf16(v0[0], v0[1]); w.y = cvt_pk_bf16(v0[2], v0[3]); w.z = cvt_pk_bf16(v1[0], v1[1]); w.w = cvt_pk_bf16(v1[2], v1[3]);
                    *(u32x4*)(P + (size_t)(u.pm * BM + r) * ldp + bj * HALF + colw) = w; } }
    }
};

struct NoPre { __device__ __forceinline__ void operator()(int) const {} };
template <class Epi, class Sched, bool ALIGN_EPI, class Pre = NoPre>
__device__ __forceinline__ void gemm_phase(PG8_LAS unsigned char* lds, const Gemm g, const Sched& S, const Epi& E, int tid, const Pre& pre = Pre()) {
    asm volatile("" : "+v"(tid));
    const int wid = __builtin_amdgcn_readfirstlane(tid >> 6), lane = tid & 63, wr = wid >> 2, wc = wid & 3, fr = lane & 15, fq = lane >> 4;
    const int nt = g.K / BK;
    unsigned voffA[2], voffB[2];
#pragma unroll
    for (int i = 0; i < 2; ++i) { int R, C; stage_rc(tid * 16 + i * 8192, R, C); const int Rb = Epi::PERM ? ((R & ~31) + perm32(R & 31)) : R;
        voffA[i] = (unsigned)(R * g.lda + C) * 2u; voffB[i] = (unsigned)(Rb * g.ldb + C) * 2u; }
    const size_t kstep = (size_t)(BK * 2);
    const size_t hstepA = (size_t)HALF * g.lda * 2, hstepB = (size_t)HALF * g.ldb * 2;
    const unsigned ldsw = (unsigned)wid * 1024u;
    const int aoff = lds_byte(wr * 64 + fr, fq * 8), boff = lds_byte(wc * 32 + fr, fq * 8);
#define PG8_SA(b, h) (((b) * 2 + (h)) * HTB)
#define PG8_SB(b, h) ((4 + (b) * 2 + (h)) * HTB)
#define PG8_STAGE(bufoff, gbase, voff) do { const char* _gb = (const char*)(gbase); asm volatile("" : "+s"(_gb));   \
        _Pragma("unroll") for (int _i = 0; _i < 2; ++_i) \
        __builtin_amdgcn_global_load_lds((const unsigned*)(_gb + (voff)[_i]), (PG8_LAS unsigned*)(lds + (bufoff) + ldsw + _i * 8192), 16, 0, 0); } while (0)
#define PG8_LDA(dst, b, h) do { _Pragma("unroll") for (int m = 0; m < 4; ++m) _Pragma("unroll") for (int k = 0; k < 2; ++k) dst[m][k] = *(const PG8_LAS bf16x8*)(lds + PG8_SA(b, h) + aoff + m * 2048 + k * 1024); } while (0)
#define PG8_LDB(dst, b, h) do { _Pragma("unroll") for (int n = 0; n < 2; ++n) _Pragma("unroll") for (int k = 0; k < 2; ++k) dst[n][k] = *(const PG8_LAS bf16x8*)(lds + PG8_SB(b, h) + boff + n * 2048 + k * 1024); } while (0)
#define PG8_MMA(ai, bj, At, Bt) do { __builtin_amdgcn_s_setprio(1); _Pragma("unroll") for (int m = 0; m < 4; ++m) _Pragma("unroll") for (int n = 0; n < 2; ++n) _Pragma("unroll") for (int k = 0; k < 2; ++k) \
        acc[ai][bj][m][n] = __builtin_amdgcn_mfma_f32_16x16x32_bf16(Bt[n][k], At[m][k], acc[ai][bj][m][n], 0, 0, 0); __builtin_amdgcn_s_setprio(0); } while (0)
#define PG8_WAIT_V(n) asm volatile("s_waitcnt vmcnt(" #n ")" ::: "memory")
#define PG8_WAIT_L(n) asm volatile("s_waitcnt lgkmcnt(" #n ")" ::: "memory")
#define PG8_BAR __builtin_amdgcn_s_barrier()
#define PG8_SCHED __builtin_amdgcn_sched_barrier(0)
    Unit cur, nxt; int ui = 0;
    if (!S.next(0, cur)) return;
    f32x4 acc[2][2][4][2];
#pragma unroll
    for (int a = 0; a < 2; ++a)
#pragma unroll
        for (int b = 0; b < 2; ++b)
#pragma unroll
            for (int m = 0; m < 4; ++m)
#pragma unroll
                for (int n = 0; n < 2; ++n) acc[a][b][m][n] = (f32x4){0.f, 0.f, 0.f, 0.f};
    bf16x8 At[4][2], B0[2][2], B1[2][2];
    const char* cA = S.aptr(cur); const char* cB = S.bptr(cur);
    PG8_STAGE(PG8_SB(0, 0), cB, voffB); PG8_STAGE(PG8_SB(0, 1), cB + hstepB, voffB); PG8_STAGE(PG8_SA(0, 0), cA, voffA); PG8_STAGE(PG8_SA(0, 1), cA + hstepA, voffA);
    pre(tid);
    if (wr == 1) PG8_BAR;
    PG8_WAIT_V(2); PG8_BAR;
    PG8_STAGE(PG8_SB(1, 0), cB + kstep, voffB); PG8_STAGE(PG8_SA(1, 0), cA + kstep, voffA); PG8_STAGE(PG8_SB(1, 1), cB + hstepB + kstep, voffB);
    PG8_WAIT_V(6); PG8_BAR;
    for (;;) {
        const bool has_next = S.next(ui + 1, nxt);
        const char* nA = has_next ? S.aptr(nxt) : cA; const char* nB = has_next ? S.bptr(nxt) : cB;
        for (int t = 0; t < nt; t += 2) {
            const bool last = (t == nt - 2);
            const char* a1 = cA + (size_t)(t + 1) * kstep;
            const char* a2 = last ? nA : cA + (size_t)(t + 2) * kstep; const char* b2 = last ? nB : cB + (size_t)(t + 2) * kstep;
            const char* a3 = a2 + kstep; const char* b3 = b2 + kstep;
            PG8_LDB(B0, 0, 0); PG8_LDB(B1, 0, 1); PG8_SCHED; PG8_LDA(At, 0, 0); PG8_STAGE(PG8_SA(1, 1), a1 + hstepA, voffA);
            PG8_WAIT_V(8); PG8_WAIT_L(0); PG8_BAR; PG8_MMA(0, 0, At, B0); PG8_MMA(0, 1, At, B1); PG8_BAR; PG8_SCHED;
            PG8_LDA(At, 0, 1); PG8_STAGE(PG8_SB(0, 0), b2, voffB); PG8_STAGE(PG8_SB(0, 1), b2 + hstepB, voffB); PG8_STAGE(PG8_SA(0, 0), a2, voffA);
            PG8_WAIT_V(8); PG8_WAIT_L(0); PG8_BAR; PG8_MMA(1, 0, At, B0); PG8_MMA(1, 1, At, B1); PG8_BAR; PG8_SCHED;
            PG8_LDB(B0, 1, 0); PG8_LDB(B1, 1, 1); PG8_SCHED; PG8_LDA(At, 1, 0); PG8_STAGE(PG8_SA(0, 1), a2 + hstepA, voffA);
            PG8_WAIT_V(8); PG8_WAIT_L(0); PG8_BAR; PG8_MMA(0, 0, At, B0); PG8_MMA(0, 1, At, B1); PG8_BAR; PG8_SCHED;
            PG8_LDA(At, 1, 1); PG8_STAGE(PG8_SB(1, 0), b3, voffB); PG8_STAGE(PG8_SB(1, 1), b3 + hstepB, voffB); PG8_STAGE(PG8_SA(1, 0), a3, voffA);
            PG8_WAIT_V(8); PG8_WAIT_L(0); PG8_BAR; PG8_MMA(1, 0, At, B0); PG8_MMA(1, 1, At, B1); PG8_BAR; PG8_SCHED;
        }
        if constexpr (ALIGN_EPI) { if (wr == 0) PG8_BAR; }
        if constexpr (!Epi::AFTER_DRAIN) { const int l2 = lane_id_opaque(); E(acc, cur, wr, wc, l2 & 15, l2 >> 4); }
        if (!has_next) break;
#pragma unroll
        for (int a = 0; a < 2; ++a)
#pragma unroll
            for (int b = 0; b < 2; ++b)
#pragma unroll
                for (int m = 0; m < 4; ++m)
#pragma unroll
                    for (int n = 0; n < 2; ++n) acc[a][b][m][n] = (f32x4){0.f, 0.f, 0.f, 0.f};
        cur = nxt; cA = nA; cB = nB; ++ui;
        if constexpr (ALIGN_EPI) { if (wr == 1) PG8_BAR; }
    }
    PG8_WAIT_V(0);
    if constexpr (!ALIGN_EPI) { if (wr == 0) PG8_BAR; }
    PG8_BAR;
    if constexpr (Epi::AFTER_DRAIN) { const int l2 = lane_id_opaque(); E.fused(acc, cur, wr, wc, l2 & 15, l2 >> 4, lds, wid, l2); }
#undef PG8_SA
#undef PG8_SB
#undef PG8_STAGE
#undef PG8_LDA
#undef PG8_LDB
#undef PG8_MMA
#undef PG8_WAIT_V
#undef PG8_WAIT_L
#undef PG8_BAR
#undef PG8_SCHED
}
}

constexpr int NWAVES = 8, NTHREADS = 512;
constexpr size_t MiB = 1u << 20;
constexpr size_t WS_CTL = 0, CTL_ZERO_BYTES = 256 * 1024;
constexpr size_t WS_WPOOL = 1 * MiB;
constexpr size_t WS_WQ = 2 * MiB;
constexpr size_t WS_WO = 6 * MiB;
constexpr size_t WS_WKV = 10 * MiB;
constexpr size_t WS_WUP = 18 * MiB;
constexpr size_t WS_WDN = 34 * MiB;
constexpr size_t WS_WIN = 50 * MiB;
constexpr size_t WS_WOUT = 56 * MiB;
constexpr size_t WS_MN = 58 * MiB;
constexpr size_t WS_KB = 66 * MiB;
constexpr size_t WS_VT = 74 * MiB;
constexpr size_t WS_SSQ = 82 * MiB;
constexpr size_t WS_SMALL = 84 * MiB;
constexpr size_t WS_X = 96 * MiB;
constexpr size_t WS_XG = 160 * MiB;
constexpr size_t WS_P0 = 192 * MiB;
constexpr size_t WS_O = 224 * MiB;
constexpr size_t WS_CH = 256 * MiB;
constexpr size_t WS_PS = 288 * MiB;
constexpr size_t WS_H = 320 * MiB;
constexpr size_t WS_WQN = 448 * MiB;
constexpr size_t WS_MT = 452 * MiB;
constexpr size_t WS_VW = 484 * MiB;
constexpr size_t WS_END = 516 * MiB;
constexpr size_t SS_X = WS_SMALL;
constexpr size_t SS_XG = SS_X + 512 * 1024;
constexpr size_t SS_SSQ = SS_XG + 256 * 1024;
constexpr size_t SS_P0 = SS_SSQ + 32 * 1024;
constexpr size_t SS_O = SS_P0 + 256 * 1024;
constexpr size_t SS_CH = SS_O + 256 * 1024;
constexpr size_t SS_H = SS_CH + 512 * 1024;
constexpr size_t SS_Q = SS_H + 1024 * 1024;
static_assert(SS_Q + 512 * 1024 <= WS_X, "sample buffers");
constexpr int CW_FLAG = 0;
constexpr unsigned INIT_MAGIC = 0x5eed1357u;
constexpr int CW_BAR = 4096, CW_BAR_STRIDE = 4096;

constexpr int RING_OFF = 0, RING_BYTES = 131072;
constexpr int LDSCTL_OFF = RING_BYTES, MISC_OFF = LDSCTL_OFF + 320;
constexpr int RSD_OFF = RING_BYTES + 1024;
constexpr int LDS_BYTES = 147456;

#define GAS __attribute__((address_space(1)))
#define LAS __attribute__((address_space(3)))
typedef unsigned short bf16;
typedef unsigned v4u __attribute__((ext_vector_type(4)));
typedef unsigned v2u __attribute__((ext_vector_type(2)));
typedef float f32x4 __attribute__((ext_vector_type(4)));
typedef short bf16x8 __attribute__((ext_vector_type(8)));
#define LDS_WAIT() asm volatile("s_waitcnt lgkmcnt(0)" ::: "memory")
#define VM_WAIT() asm volatile("s_waitcnt vmcnt(0)" ::: "memory")
__device__ __forceinline__ unsigned f2bf(float f) { unsigned u = __builtin_bit_cast(unsigned, f); return (u + 0x7fffu + ((u >> 16) & 1u)) >> 16; }
__device__ __forceinline__ unsigned pk2(float lo, float hi) { return f2bf(lo) | (f2bf(hi) << 16); }
__device__ __forceinline__ float bf2f(unsigned short h) { return __builtin_bit_cast(float, (unsigned)h << 16); }
__device__ __forceinline__ float bflo(unsigned w) { return __builtin_bit_cast(float, w << 16); }
__device__ __forceinline__ float bfhi(unsigned w) { return __builtin_bit_cast(float, w & 0xffff0000u); }

#define XB_TMO      128
#define XB_XCNT(j)  (256  + 64 * (j))
#define XB_XSUB(j)  (1280 + 64 * (j))
#define XB_XGEN(j)  (2304 + 64 * (j))
#define XB_TOP      3328
#define XB_TOPGEN   3392
#define XCD_BAR_WORDS 3456
#define XB_SPIN_CAP (1u << 18)
__device__ __forceinline__ unsigned xb_ld(unsigned* p)              { return __hip_atomic_load(p, __ATOMIC_RELAXED, __HIP_MEMORY_SCOPE_AGENT); }
__device__ __forceinline__ unsigned xb_add(unsigned* p, unsigned v) { return __hip_atomic_fetch_add(p, v, __ATOMIC_RELAXED, __HIP_MEMORY_SCOPE_AGENT); }
__device__ __forceinline__ unsigned xb_xcc_id() { return (unsigned)__builtin_amdgcn_s_getreg((3 << 11) | 20) & 0xFu; }
#define XB_SPIN(cond, bar) do { unsigned _sp = 0; while (cond) { __builtin_amdgcn_s_sleep(1); \
    if ((++_sp & 255u) == 0u) { if (xb_ld(&(bar)[XB_TMO])) break; if (_sp > XB_SPIN_CAP) { atomicAdd(&(bar)[XB_TMO], 1u); break; } } } } while (0)
struct XcdBarrier { unsigned* bar; unsigned x; volatile LAS unsigned* st; unsigned gsize; };
__device__ __forceinline__ XcdBarrier xcd_barrier_post(unsigned* bar, volatile LAS unsigned* st, unsigned gsize) {
    XcdBarrier b; b.bar = bar; b.x = xb_xcc_id(); b.st = st; b.gsize = gsize;
    if (threadIdx.x == 0) (void)xb_add(&bar[XB_XCNT(b.x)], 1u);
    return b;
}
__device__ __forceinline__ void xcd_barrier_complete(unsigned* bar, unsigned x, unsigned G, unsigned& nloc, unsigned& nx) {
    unsigned sum, cnt, mine, sp = 0u;
    for (;;) {
        sum = 0u; cnt = 0u; mine = 0u;
#pragma unroll
        for (unsigned j = 0; j < 16; ++j) { const unsigned c = xb_ld(&bar[XB_XCNT(j)]); sum += c; cnt += (c > 0u) ? 1u : 0u; mine = (j == x) ? c : mine; }
        if (sum == G) break;
        __builtin_amdgcn_s_sleep(1);
        if ((++sp & 255u) == 0u) { if (xb_ld(&bar[XB_TMO])) break; if (sp > XB_SPIN_CAP) { atomicAdd(&bar[XB_TMO], 1u); break; } }
    }
    nloc = mine > 0u ? mine : 1u; nx = cnt > 0u ? cnt : 1u;
}
__device__ __forceinline__ void xcd_barrier(const XcdBarrier& b, const int tid) {
    asm volatile("s_waitcnt vmcnt(0)" ::: "memory");
    __syncthreads();
    if (tid == 0) {
        unsigned* bar = b.bar; asm volatile("" : "+s"(bar));
        __builtin_amdgcn_s_waitcnt(0);
        unsigned nloc = b.st[0], nx = b.st[1];
        if (nloc == 0u) { xcd_barrier_complete(bar, b.x, b.gsize, nloc, nx); b.st[0] = nloc; b.st[1] = nx; }
        if (EARLY_INV && nx == 1u) {
            unsigned old_; unsigned* ap = &bar[XB_XSUB(b.x)]; const unsigned one = 1u;
            asm volatile("global_atomic_add %0, %1, %2, off sc0\n\tbuffer_inv sc1\n\ts_waitcnt vmcnt(1)" : "=&v"(old_) : "v"(ap), "v"(one) : "memory");
            const unsigned gen_ = old_ / nloc;
            if (old_ + 1u == (gen_ + 1u) * nloc) xb_add(&bar[XB_XGEN(b.x)], 1u);
            else XB_SPIN(xb_ld(&bar[XB_XGEN(b.x)]) == gen_, bar);
            asm volatile("s_waitcnt vmcnt(0)" ::: "memory");
        } else {
        const unsigned old = xb_add(&bar[XB_XSUB(b.x)], 1u);
        const unsigned gen = old / nloc;
        if (old + 1u == (gen + 1u) * nloc) {
            if (nx > 1u) {
                __builtin_amdgcn_fence(__ATOMIC_RELEASE, "agent");
                asm volatile("s_waitcnt vmcnt(0)" ::: "memory");
                const unsigned og = xb_add(&bar[XB_TOP], 1u);
                const unsigned tg = og / nx;
                if (og + 1u == (tg + 1u) * nx) xb_add(&bar[XB_TOPGEN], 1u);
                else XB_SPIN(xb_ld(&bar[XB_TOPGEN]) == tg, bar);
            }
            xb_add(&bar[XB_XGEN(b.x)], 1u);
            __builtin_amdgcn_fence(__ATOMIC_ACQUIRE, "agent");
            asm volatile("s_waitcnt vmcnt(0)" ::: "memory");
        } else {
            XB_SPIN(xb_ld(&bar[XB_XGEN(b.x)]) == gen, bar);
            __builtin_amdgcn_fence(__ATOMIC_ACQUIRE, "agent");
            asm volatile("s_waitcnt vmcnt(0)" ::: "memory");
        }
        }
    }
    __syncthreads();
}

__device__ __forceinline__ int opq_v(int x) { asm volatile("" : "+v"(x)); return x; }
struct Args { const float* in[22]; float* out; unsigned char* ws; int ph_lo, ph_hi; };


__device__ __forceinline__ void p0_transpose_item(const float* W, int K, int N, bf16* WT, int k0, int n0, int drow0, LAS float* scr, int lane, const float* gk = nullptr) {
    float v[32];
#pragma unroll
    for (int i = 0; i < 32; ++i) { const int kk = 2 * i + (lane >> 5); v[i] = __builtin_nontemporal_load(W + (size_t)(k0 + kk) * N + n0 + (lane & 31)); }
    if (gk) {
#pragma unroll
        for (int i = 0; i < 32; ++i) v[i] *= gk[k0 + 2 * i + (lane >> 5)]; }
#pragma unroll
    for (int i = 0; i < 32; ++i) scr[(2 * i + (lane >> 5)) * 33 + (lane & 31)] = v[i];
    LDS_WAIT(); asm volatile("" ::: "memory");
    const int c = lane & 7;
#pragma unroll
    for (int j = 0; j < 4; ++j) { const int n = (lane >> 3) + 8 * j; const LAS float* s = scr + (8 * c) * 33 + n;
        v4u o; o.x = pg8::cvt_pk_bf16(s[0 * 33], s[1 * 33]); o.y = pg8::cvt_pk_bf16(s[2 * 33], s[3 * 33]); o.z = pg8::cvt_pk_bf16(s[4 * 33], s[5 * 33]); o.w = pg8::cvt_pk_bf16(s[6 * 33], s[7 * 33]);
        *(GAS v4u*)(WT + (size_t)(drow0 + n) * K + k0 + 8 * c) = o; }
    LDS_WAIT(); asm volatile("" ::: "memory");
}
__device__ __forceinline__ int win_dest_row(int n) {
    if (n < 1024) return n;
    if (n < 2048) { const int ch = n - 1024; return 1024 + (ch >> 7) * 256 + (ch & 127); }
    const int ch = n - 2048; return 1024 + (ch >> 7) * 256 + 128 + (ch & 127);
}

template <int W>
__device__ __forceinline__ void pool_wave(const float* xb  , const LAS float* rs, f32x4 g4, int tA, bf16* pout  , float* poolout  ) {
    f32x4 xv[15 + W];
#pragma unroll
    for (int i = 16 - W; i < 31; ++i) { const int t = tA - 15 + i; xv[i - (16 - W)] = *(const f32x4*)(xb + (size_t)(t >= 0 ? t : 0) * D); }
    f32x4 ring[16]; f32x4 S = {0.f, 0.f, 0.f, 0.f};
#pragma unroll
    for (int i = 16 - W; i < 31; ++i) {
        const int t = tA - 15 + i;
        f32x4 u = {0.f, 0.f, 0.f, 0.f};
        if (t >= 0) u = xv[i - (16 - W)] * rs[i] * g4;
        S += u; if (i - W >= 16 - W) S -= ring[(i - W) & 15];
        ring[i & 15] = u;
        if (i >= 15) {
            const int cnt = (t + 1 < W) ? (t + 1) : W; const float ic = 1.0f / (float)cnt;
            const f32x4 p = S * ic - u; v2u o; o.x = pk2(p[0], p[1]); o.y = pk2(p[2], p[3]);
            *(v2u*)(pout + (size_t)t * D) = o;
            if (t >= SEQ - 15) *(f32x4*)(poolout + (size_t)(t - (SEQ - 15)) * D) = u;
        }
    }
}

template <int RT, int CT, int GR, int KS, class F>
__device__ __forceinline__ void sgemm2(const bf16* A, int lda, int row0, const bf16* Bt, int ldb, const int (&brow)[CT], int K, LAS unsigned char* red, int wave, int lane, const F& f) {
    const int fr = lane & 15, fq = lane >> 4, kw = K >> 3;
    const bf16* ap = A + (size_t)(row0 + fr) * lda + wave * kw + fq * 8;
    const bf16* bp[CT];
#pragma unroll
    for (int ct = 0; ct < CT; ++ct) bp[ct] = Bt + (size_t)(brow[ct] + fr) * ldb + wave * kw + fq * 8;
    f32x4 acc[RT][CT];
#pragma unroll
    for (int rt = 0; rt < RT; ++rt)
#pragma unroll
        for (int ct = 0; ct < CT; ++ct) acc[rt][ct] = (f32x4){0.f, 0.f, 0.f, 0.f};
#pragma unroll 1
    for (int k0 = 0; k0 < kw; k0 += 32 * KS) {
        bf16x8 a[KS][RT], b[KS][CT];
#pragma unroll
        for (int ks = 0; ks < KS; ++ks) {
#pragma unroll
            for (int rt = 0; rt < RT; ++rt) a[ks][rt] = *(const bf16x8*)(ap + (size_t)rt * 16 * lda + k0 + 32 * ks);
#pragma unroll
            for (int ct = 0; ct < CT; ++ct) b[ks][ct] = *(const bf16x8*)(bp[ct] + k0 + 32 * ks); }
#pragma unroll
        for (int ks = 0; ks < KS; ++ks)
#pragma unroll
            for (int rt = 0; rt < RT; ++rt)
#pragma unroll
                for (int ct = 0; ct < CT; ++ct) acc[rt][ct] = __builtin_amdgcn_mfma_f32_16x16x32_bf16(b[ks][ct], a[ks][rt], acc[rt][ct], 0, 0, 0);
    }
#pragma unroll
    for (int rt = 0; rt < RT; ++rt)
#pragma unroll
        for (int ct = 0; ct < CT; ++ct) *(LAS f32x4*)(red + ((((wave * RT + rt) * CT + ct) * 64 + lane) << 4)) = acc[rt][ct];
    LDS_WAIT(); __syncthreads();
    constexpr int NCG = CT / GR, NTASK = RT * NCG;
    for (int t = wave; t < NTASK; t += 8) {
        const int rt = t / NCG, cg = t % NCG;
        f32x4 sacc[GR];
#pragma unroll
        for (int g = 0; g < GR; ++g) { f32x4 tt = {0.f, 0.f, 0.f, 0.f};
#pragma unroll
            for (int w = 0; w < 8; ++w) tt += *(const LAS f32x4*)(red + ((((w * RT + rt) * CT + cg * GR + g) * 64 + lane) << 4));
            sacc[g] = tt; }
        f(sacc, row0 + 16 * rt + fr, cg * GR, fq);
    }
    __syncthreads();
}
__device__ __forceinline__ float srstd(const float* ssq, int row, int fq) {
    const f32x4* sp = (const f32x4*)(ssq + row * 64 + fq * 16); const f32x4 s = (sp[0] + sp[1]) + (sp[2] + sp[3]); float t = (s[0] + s[1]) + (s[2] + s[3]);
    t = add_x16_x32(t);
    return __builtin_amdgcn_rsqf(t * (1.0f / D) + EPS);
}
template <int KS> __device__ __forceinline__ void s_res_unit(const bf16* A, int lda, const bf16* Bt, int ldb, int K, int cp, int row0, const float* base32, bf16* xs16, float* ssq, const float* cscale, LAS unsigned char* red, int wave, int lane) {
    const int brow[2] = {32 * cp, 32 * cp + 16};
    const int myct = wave & 1, prow = row0 + (lane & 15), pc0 = 16 * (2 * cp + myct) + 4 * (lane >> 4); const size_t poff = (size_t)prow * D + pc0;
    f32x4 cs = {1.f, 1.f, 1.f, 1.f}; if (cscale) cs = *(const f32x4*)(cscale + pc0);
    f32x4 bpre; if (base32) bpre = *(const f32x4*)(base32 + poff); else { const v2u w = *(const v2u*)(xs16 + poff); bpre = (f32x4){bflo(w.x), bfhi(w.x), bflo(w.y), bfhi(w.y)}; }
    sgemm2<1, 2, 1, KS>(A, lda, row0, Bt, ldb, brow, K, red, wave, lane, [&](f32x4 (&a)[1], int row, int ct0, int fq) {
        const int ctile = 2 * cp + ct0, c0 = 16 * ctile + 4 * fq; const size_t off = (size_t)row * D + c0;
        const f32x4 v = bpre + a[0] * cs;
        float ss = (v[0] * v[0] + v[1] * v[1]) + (v[2] * v[2] + v[3] * v[3]);
        ss = add_x16_x32(ss);
        if (fq == 0) ssq[row * 64 + ctile] = ss;
        v2u p; p.x = pk2(v[0], v[1]); p.y = pk2(v[2], v[3]); *(v2u*)(xs16 + off) = p; });
}
__device__ __forceinline__ void s_q_unit(const bf16* xs16, const bf16* wq, int cp, int row0, const float* ssq, float* qs, LAS unsigned char* red, int wave, int lane) {
    const int brow[2] = {32 * cp, 32 * cp + 16};
    const float rs = srstd(ssq, row0 + (lane & 15), lane >> 4) * QSCALE;
    sgemm2<1, 2, 1, 4>(xs16, D, row0, wq, D, brow, D, red, wave, lane, [&](f32x4 (&a)[1], int row, int ct0, int fq) {
        *(f32x4*)(qs + (size_t)row * D + 32 * cp + 16 * ct0 + 4 * fq) = a[0] * rs; });
}
__device__ __forceinline__ f32x4 relu2(f32x4 v) {
#pragma unroll
    for (int j = 0; j < 4; ++j) { const float a = fmaxf(v[j], 0.f); v[j] = a * a; }
    return v;
}

__device__ __forceinline__ void rstd_table(const float* ssq, int pm, LAS float* rsd, int tid) {
    if (tid < 256) { const f32x4* sp = (const f32x4*)(ssq + (size_t)(pm * 256 + tid) * 16); const f32x4 q = (sp[0] + sp[1]) + (sp[2] + sp[3]);
        rsd[tid] = __builtin_amdgcn_rsqf(((q[0] + q[1]) + (q[2] + q[3])) * (1.0f / D) + EPS); }
}
__device__ __forceinline__ void treduce32(float (&p)[32], int lane) {
#pragma unroll
    for (int i = 0; i < 16; ++i) { swap32(p[i], p[i + 16]); p[i] += p[i + 16]; }
    { const bool b4 = (lane & 16) != 0;
#pragma unroll
      for (int i = 0; i < 8; ++i) { const float keep = b4 ? p[i + 8] : p[i], send = b4 ? p[i] : p[i + 8]; p[i] = keep + SWZ_XOR(send, 16); } }
    { const bool b3 = (lane & 8) != 0;
#pragma unroll
      for (int i = 0; i < 4; ++i) { const float keep = b3 ? p[i + 4] : p[i], send = b3 ? p[i] : p[i + 4]; p[i] = keep + SWZ_XOR(send, 8); } }
    { const bool b2 = (lane & 4) != 0;
#pragma unroll
      for (int i = 0; i < 2; ++i) { const float keep = b2 ? p[i + 2] : p[i], send = b2 ? p[i] : p[i + 2]; p[i] = keep + SWZ_XOR(send, 4); } }
    { const bool b1 = (lane & 2) != 0; const float keep = b1 ? p[1] : p[0], send = b1 ? p[0] : p[1]; p[0] = keep + SWZ_XOR(send, 2); }
    p[0] += SWZ_XOR(p[0], 1);
}
__device__ __forceinline__ void unpack16(const v4u a, const v4u b, float (&x)[16]) {
    x[0] = bflo(a.x); x[1] = bfhi(a.x); x[2] = bflo(a.y); x[3] = bfhi(a.y); x[4] = bflo(a.z); x[5] = bfhi(a.z); x[6] = bflo(a.w); x[7] = bfhi(a.w);
    x[8] = bflo(b.x); x[9] = bfhi(b.x); x[10] = bflo(b.y); x[11] = bfhi(b.y); x[12] = bflo(b.z); x[13] = bfhi(b.z); x[14] = bflo(b.w); x[15] = bfhi(b.w);
}

constexpr int NPHASES = 15;
__global__ void __launch_bounds__(NTHREADS, 2) mk_fwd(Args args) {
    extern __shared__ __attribute__((aligned(16))) unsigned char lds[];
    LAS unsigned char* L = (LAS unsigned char*)lds;
    volatile LAS unsigned* MISC = (volatile LAS unsigned*)(L + MISC_OFF);
    const int wave0 = __builtin_amdgcn_readfirstlane((int)threadIdx.x >> 6);
    const int G = gridDim.x; const int bx = blockIdx.x; const int vcu = (G % 8 == 0) ? (bx % 8) * (G / 8) + bx / 8 : bx;
    const int grp = bx & 7, mi = bx >> 3, GS = (G - grp + 7) >> 3;
    for (int u = threadIdx.x; u < (LDS_BYTES - LDSCTL_OFF) / 4; u += NTHREADS) ((LAS unsigned*)(L + LDSCTL_OFF))[u] = 0u;
    __syncthreads();
#if MK_PER_PHASE
#define GRID_BAR() do { } while (0)
#define GROUP_BAR() do { } while (0)
#else
#if SELF_INIT
    unsigned* const ctlw = (unsigned*)(args.ws + WS_CTL);
    XcdBarrier bar, gbar;
    bar.bar = ctlw + CW_BAR; bar.x = xb_xcc_id(); bar.st = MISC + 8; bar.gsize = (unsigned)G;
    gbar.bar = ctlw + CW_BAR + (1 + grp) * CW_BAR_STRIDE; gbar.x = bar.x; gbar.st = MISC + 10; gbar.gsize = (unsigned)GS;
    if (bx == 0) {
        const int t = (int)threadIdx.x;
        if (t < 9 * 51) { const int r = t / 51, k = t % 51;
            const int w = (k == 0) ? XB_TMO : (k <= 16) ? XB_XCNT(k - 1) : (k <= 32) ? XB_XSUB(k - 17) : (k <= 48) ? XB_XGEN(k - 33) : (k == 49) ? XB_TOP : XB_TOPGEN;
            __hip_atomic_store(ctlw + CW_BAR + r * CW_BAR_STRIDE + w, 0u, __ATOMIC_RELAXED, __HIP_MEMORY_SCOPE_AGENT); }
        asm volatile("s_waitcnt vmcnt(0)" ::: "memory");
        __syncthreads();
        if (t == 0) __hip_atomic_store(ctlw + CW_FLAG, INIT_MAGIC, __ATOMIC_RELAXED, __HIP_MEMORY_SCOPE_AGENT);
    }
#else
    XcdBarrier bar = xcd_barrier_post((unsigned*)(args.ws + WS_CTL) + CW_BAR, MISC + 8, (unsigned)G);
    XcdBarrier gbar = xcd_barrier_post((unsigned*)(args.ws + WS_CTL) + CW_BAR + (1 + grp) * CW_BAR_STRIDE, MISC + 10, (unsigned)GS);
#endif
#define GRID_BAR() xcd_barrier(bar, wave0 * 64 + lane_id_opaque())
#define GROUP_BAR() xcd_barrier(gbar, wave0 * 64 + lane_id_opaque())
#endif
    const int lo = args.ph_lo, hi = args.ph_hi;
#define IN(k) (st == (k))
#define SEAM(k) do { } while (0)
    const int NGW = G * NWAVES;
#define TID_NOW (wave0 * 64 + lane_id_opaque())
#define RELANE const int tid = wave0 * 64 + lane_id_opaque(), lane = tid & 63; (void)tid; (void)lane;
#define KA_PTR(T, off) (*(T const __attribute__((address_space(4)))*)(ka + (off)))
#define PH_BEGIN const int tid = wave0 * 64 + lane_id_opaque(), lane = tid & 63, wave = wave0, gw = vcu * NWAVES + wave; (void)lane; (void)gw; \
    const __attribute__((address_space(4))) char* ka = (const __attribute__((address_space(4))) char*)__builtin_amdgcn_kernarg_segment_ptr(); asm volatile("" : "+s"(ka)); \
    unsigned char* const ws = KA_PTR(unsigned char*, 184); float* const out = KA_PTR(float*, 176); (void)ws; (void)out; \
    const float* const x_prompt = KA_PTR(const float*, 0); const float* const x_sample = KA_PTR(const float*, 8); const float* const state_pool = KA_PTR(const float*, 16); const float* const state_conv = KA_PTR(const float*, 24); \
    const float* const cache_k = KA_PTR(const float*, 32); const float* const cache_v = KA_PTR(const float*, 40); const float* const mem_prompt = KA_PTR(const float*, 48); \
    const float* const g_mix = KA_PTR(const float*, 56); const float* const g_attn = KA_PTR(const float*, 64); const float* const g_mem = KA_PTR(const float*, 72); const float* const g_ffn = KA_PTR(const float*, 80); const float* const g_final = KA_PTR(const float*, 88); \
    const float* const w_pool = KA_PTR(const float*, 96); const float* const pool_scale = KA_PTR(const float*, 104); const float* const w_conv_in = KA_PTR(const float*, 112); const float* const w_conv = KA_PTR(const float*, 120); const float* const w_conv_out = KA_PTR(const float*, 128); \
    const float* const w_q = KA_PTR(const float*, 136); const float* const w_kv = KA_PTR(const float*, 144); const float* const w_o = KA_PTR(const float*, 152); const float* const w_up = KA_PTR(const float*, 160); const float* const w_down = KA_PTR(const float*, 168); \
    (void)x_prompt; (void)x_sample; (void)state_pool; (void)state_conv; (void)cache_k; (void)cache_v; (void)mem_prompt; (void)g_mix; (void)g_attn; (void)g_mem; (void)g_ffn; (void)g_final; (void)w_pool; (void)pool_scale; (void)w_conv_in; (void)w_conv; (void)w_conv_out; (void)w_q; (void)w_kv; (void)w_o; (void)w_up; (void)w_down; \
    bf16* const WPOOL = (bf16*)(ws + WS_WPOOL); bf16* const WQ = (bf16*)(ws + WS_WQ); bf16* const WO = (bf16*)(ws + WS_WO); bf16* const WKV = (bf16*)(ws + WS_WKV); \
    bf16* const WUP = (bf16*)(ws + WS_WUP); bf16* const WDN = (bf16*)(ws + WS_WDN); bf16* const WIN = (bf16*)(ws + WS_WIN); bf16* const WOUT = (bf16*)(ws + WS_WOUT); \
    bf16* const MN = (bf16*)(ws + WS_MN); bf16* const KB = (bf16*)(ws + WS_KB); bf16* const VT = (bf16*)(ws + WS_VT); float* const SSQ = (float*)(ws + WS_SSQ); \
    bf16* const X16 = (bf16*)(ws + WS_X); bf16* const P0 = (bf16*)(ws + WS_P0); bf16* const OB = (bf16*)(ws + WS_O); bf16* const CH = (bf16*)(ws + WS_CH); \
    bf16* const WQN = (bf16*)(ws + WS_WQN); bf16* const MT = (bf16*)(ws + WS_MT); bf16* const VW = (bf16*)(ws + WS_VW); bf16* const HB = (bf16*)(ws + WS_H); \
    bf16* const XS16 = (bf16*)(ws + SS_X); float* const SSQS = (float*)(ws + SS_SSQ); bf16* const P0S = (bf16*)(ws + SS_P0); bf16* const OS = (bf16*)(ws + SS_O); \
    float* const CHS = (float*)(ws + SS_CH); bf16* const HS = (bf16*)(ws + SS_H); float* const QS = (float*)(ws + SS_Q); \
    (void)WPOOL; (void)WQ; (void)WO; (void)WKV; (void)WUP; (void)WDN; (void)WIN; (void)WOUT; (void)MN; (void)KB; (void)VT; (void)SSQ; (void)X16; (void)P0; (void)OB; (void)CH; (void)WQN; (void)MT; (void)VW; (void)HB; (void)XS16; (void)SSQS; (void)P0S; (void)OS; (void)CHS; (void)HS; (void)QS;

#if MK_PER_PHASE
    const int soff = 0; const bool sfirst = false;
#else
    const int soff = SAMPLE_SHIFT ? (grp & 1) : 0;
    const bool sfirst = false;
#endif
    const int mflip = (MEMBER_FLIP && !MK_PER_PHASE) ? (MEMBER_FLIP_SEL) : 0;
#pragma unroll 1
    for (int ph = lo; ph < hi + soff; ++ph) {
#pragma unroll 1
    for (int pp = 0; pp < 2; ++pp) {
    const int which = pp ^ mflip;
    const int st = which ? ph - soff : ph;
    const bool doP = (which == 0), doS = (which == 1) || (st == 0);
    if (st < 0 || st >= NPHASES || (which == 1 && st == 0)) continue;
    if (IN(0)) { PH_BEGIN
        LAS float* scr = (LAS float*)(L + RING_OFF + wave * 16384);
        {
            constexpr int I_POOL = 4 * 4 * 8, I_Q = 16 * 32, I_KV = 16 * 64, I_UP = 16 * 128, I_DN = 64 * 32, I_IN = 16 * 96;
            constexpr int NITEMS = I_POOL + 2 * (I_Q + I_KV + I_Q + I_UP + I_DN) + I_IN + I_Q;
            for (int it = gw; it < NITEMS; it += NGW) {
                int r = it;
                if (r < I_POOL) { const int g = r >> 5, rr = r & 31, kb = rr >> 3, nb = rr & 7; p0_transpose_item(w_pool + g * 65536, 256, 256, WPOOL + g * 65536, 64 * kb, 32 * nb, 32 * nb, scr, lane); continue; } r -= I_POOL;
                bool done = false;
#pragma unroll 1
                for (int l = 0; l < 2 && !done; ++l) {
                    if (r < I_Q) { const int kb = r >> 5, nb = r & 31; p0_transpose_item(w_q + (size_t)l * D * D, D, D, WQ + (size_t)l * D * D, 64 * kb, 32 * nb, 32 * nb, scr, lane, g_attn + l * D); done = true; break; } r -= I_Q;
                    if (r < I_KV) { const int kb = r >> 6, nb = r & 63; p0_transpose_item(w_kv + (size_t)l * D * 2048, D, 2048, WKV + (size_t)l * 2048 * D, 64 * kb, 32 * nb, 32 * nb, scr, lane); done = true; break; } r -= I_KV;
                    if (r < I_Q) { const int kb = r >> 5, nb = r & 31; p0_transpose_item(w_o + (size_t)l * D * D, D, D, WO + (size_t)l * D * D, 64 * kb, 32 * nb, 32 * nb, scr, lane); done = true; break; } r -= I_Q;
                    if (r < I_UP) { const int kb = r >> 7, nb = r & 127; p0_transpose_item(w_up + (size_t)l * D * FF, D, FF, WUP + (size_t)l * FF * D, 64 * kb, 32 * nb, 32 * nb, scr, lane, g_ffn + l * D); done = true; break; } r -= I_UP;
                    if (r < I_DN) { const int kb = r >> 5, nb = r & 31; p0_transpose_item(w_down + (size_t)l * FF * D, FF, D, WDN + (size_t)l * D * FF, 64 * kb, 32 * nb, 32 * nb, scr, lane); done = true; break; } r -= I_DN;
                }
                if (done) continue;
                if (r < I_IN) { const int kb = r / 96, nb = r % 96; p0_transpose_item(w_conv_in, D, 3072, WIN, 64 * kb, 32 * nb, win_dest_row(32 * nb), scr, lane, g_mix + D); continue; } r -= I_IN;
                { const int kb = r >> 5, nb = r & 31; p0_transpose_item(w_conv_out, D, D, WOUT, 64 * kb, 32 * nb, 32 * nb, scr, lane); }
            }
        }
        for (int m = gw; m < MEMROWS; m += NGW) {
            const f32x4* xr = (const f32x4*)(mem_prompt + (size_t)m * D) + lane; f32x4 v[4]; float s = 0.f;
#pragma unroll
            for (int j = 0; j < 4; ++j) { v[j] = __builtin_nontemporal_load(xr + 64 * j); s += (v[j][0] * v[j][0] + v[j][1] * v[j][1]) + (v[j][2] * v[j][2] + v[j][3] * v[j][3]); }
            const float rstd = __builtin_amdgcn_rsqf(wave_sum(s) * (1.f / D) + EPS);
#pragma unroll
            for (int l = 0; l < 2; ++l) { v2u* o8 = (v2u*)(MN + ((size_t)l * MEMROWS + m) * D) + lane;
#pragma unroll
                for (int j = 0; j < 4; ++j) { const f32x4 gg = *((const f32x4*)(g_mem + l * D) + lane + 64 * j); const f32x4 w = v[j] * rstd * gg; v2u o; o.x = pk2(w[0], w[1]); o.y = pk2(w[2], w[3]); o8[64 * j] = o; } }
        }
        for (int m = gw; m < 2 * D; m += NGW) {
            const float gk = g_attn[m]; const f32x4* xr = (const f32x4*)(w_q + (size_t)m * D) + lane; v2u* o8 = (v2u*)(WQN + (size_t)m * D) + lane;
            f32x4 v[4];
#pragma unroll
            for (int j = 0; j < 4; ++j) v[j] = __builtin_nontemporal_load(xr + 64 * j);
#pragma unroll
            for (int j = 0; j < 4; ++j) { const f32x4 w = v[j] * gk; v2u o; o.x = pk2(w[0], w[1]); o.y = pk2(w[2], w[3]); o8[64 * j] = o; }
        }
        for (int it = gw; it < MS * 4; it += NGW) {
            const int b = it >> 2, g = it & 3, c4 = g * 256 + lane * 4;
            const f32x4* xr = (const f32x4*)(x_sample + (size_t)b * D) + lane; float s = 0.f;
#pragma unroll
            for (int j = 0; j < 4; ++j) { const f32x4 v = xr[64 * j]; s += (v[0] * v[0] + v[1] * v[1]) + (v[2] * v[2] + v[3] * v[3]); }
            const float rstd = __builtin_amdgcn_rsqf(wave_sum(s) * (1.f / D) + EPS);
            const f32x4 u = *(const f32x4*)(x_sample + (size_t)b * D + c4) * rstd * *(const f32x4*)(g_mix + c4);
            const int W = 2 << g; f32x4 S = u;
            const float* sp = state_pool + (size_t)b * 15 * D + c4;
            float* po = out + OPS + (size_t)b * 15 * D + c4;
            f32x4 sv[15];
#pragma unroll
            for (int r = 0; r < 15; ++r) sv[r] = __builtin_nontemporal_load((const f32x4*)(sp + (size_t)r * D));
#pragma unroll
            for (int r = 0; r < 15; ++r) { if (r >= 16 - W) S += sv[r]; if (r >= 1) *(f32x4*)(po + (size_t)(r - 1) * D) = sv[r]; }
            *(f32x4*)(po + (size_t)14 * D) = u;
            const f32x4 p = S * (1.0f / (float)W) - u; v2u o; o.x = pk2(p[0], p[1]); o.y = pk2(p[2], p[3]); *(v2u*)(P0S + (size_t)b * D + c4) = o;
        }
        __syncthreads();
        {
            LAS float* rs = (LAS float*)(L + RING_OFF);
            for (int it = vcu; it < BATCH * (SEQ / 32); it += G) {
                const int b = it >> 6, t0 = (it & 63) * 32;
                { f32x4 xv[6][4];
#pragma unroll
                  for (int j = 0; j < 6; ++j) { const int r = wave + 8 * j, t = t0 - 15 + r; const bool ok = (r < 47) && (t >= 0);
                      const f32x4* xr = (const f32x4*)(x_prompt + ((size_t)b * SEQ + (ok ? t : t0)) * D) + lane;
#pragma unroll
                      for (int q = 0; q < 4; ++q) xv[j][q] = xr[64 * q]; }
#pragma unroll
                  for (int j = 0; j < 6; ++j) { const int r = wave + 8 * j, t = t0 - 15 + r; float s = 0.f;
#pragma unroll
                      for (int q = 0; q < 4; ++q) { const f32x4 v = xv[j][q]; s += (v[0] * v[0] + v[1] * v[1]) + (v[2] * v[2] + v[3] * v[3]); }
                      const float rv = (t >= 0) ? __builtin_amdgcn_rsqf(wave_sum(s) * (1.f / D) + EPS) : 0.f;
                      if (lane == 0 && r < 47) rs[r] = rv; } }
                LDS_WAIT(); __syncthreads();
                const int g = wave & 3, tA = t0 + (wave >> 2) * 16, c4 = g * 256 + lane * 4;
                const float* xb = x_prompt + (size_t)b * SEQ * D + c4; const f32x4 g4 = *(const f32x4*)(g_mix + c4);
                bf16* pout = P0 + (size_t)b * SEQ * D + c4; float* poolout = out + OPP + (size_t)b * 15 * D + c4;
                const LAS float* rsw = rs + (wave >> 2) * 16;
                if (g == 0) pool_wave<2>(xb, rsw, g4, tA, pout, poolout); else if (g == 1) pool_wave<4>(xb, rsw, g4, tA, pout, poolout);
                else if (g == 2) pool_wave<8>(xb, rsw, g4, tA, pout, poolout); else pool_wave<16>(xb, rsw, g4, tA, pout, poolout);
                __syncthreads();
            }
        }
    }
    SEAM(0);

    if (IN(1)) { PH_BEGIN
        if (doP) { pg8::Gemm g{D, D, D}; pg8::KvOrder S{GS == 32 ? 16 : GS, (GS == 32 && mi >= 16) ? (1 << 20) : mi, grp, (const char*)MN, (const char*)WKV};
          pg8::EpiKV E{out + OMK, out + OMV, KB, VT};
          pg8::gemm_phase<pg8::EpiKV, pg8::KvOrder, true>(L + RING_OFF, g, S, E, TID_NOW); }
        if (doP) { pg8::Gemm g{D, 256, 256}; pg8::StaticOrder S;
          if (GS == 32) S.init(8, 4, 16, mi >= 16 ? mi - 16 : 1 << 20, grp * 8, P0, (size_t)256 * D * 2, WPOOL, (size_t)65536 * 2, (size_t)256 * 2);
          else S.init(8, 4, GS, mi, grp * 8, P0, (size_t)256 * D * 2, WPOOL, (size_t)65536 * 2, (size_t)256 * 2);
          pg8::EpiRes<true> E{x_prompt, X16, SSQ, pool_scale};
          pg8::gemm_phase<pg8::EpiRes<true>, pg8::StaticOrder, true>(L + RING_OFF, g, S, E, TID_NOW); }
        if (doS) { RELANE for (int cp = mi; cp < 32; cp += GS) s_res_unit<1>(P0S + (cp >> 3) * 256, D, WPOOL, 256, 256, cp, 16 * grp, x_sample, XS16, SSQS, pool_scale, L + RING_OFF, wave, lane); }
    }
    SEAM(1);

    if (IN(2)) { PH_BEGIN
        if (doS) { RELANE for (int cp = mi; cp < 32; cp += GS) s_q_unit(XS16, WQ, cp, 16 * grp, SSQS, QS, L + RING_OFF, wave, lane); }
        if (doP) for (int idx = mi; idx < 64; idx += GS) {
            const int ly = idx >> 5, kind = (idx >> 4) & 1, a = (idx >> 2) & 3, q = idx & 3;
            const bf16* Ap; const bf16* Bp; bf16* Op; pg8::Unit u; float sc;
            if (kind == 0) {
                Ap = KB + ((size_t)ly * MEMROWS + grp * 256) * D + a * 256; Bp = WQN + ((size_t)ly * D + 256 * q) * D + a * 256;
                Op = MT + (size_t)((ly * BATCH + grp) * NH + a) * 256 * D; u = pg8::Unit{0, q}; sc = QSCALE;
            } else {
                Ap = WO + ((size_t)ly * D + 256 * a) * D + q * 256; Bp = VT + ((size_t)ly * MEMROWS + grp * 256) * D + q * 256;
                Op = VW + (size_t)(ly * BATCH + grp) * D * D; u = pg8::Unit{a, q}; sc = 1.f;
            }
            pg8::Gemm g{D, D, 256}; pg8::SingleOrder S{u, (const char*)Ap, (const char*)Bp};
            pg8::EpiBf16 E{Op, D, sc};
            pg8::gemm_phase<pg8::EpiBf16, pg8::SingleOrder, true>(L + RING_OFF, g, S, E, TID_NOW);
            __syncthreads();
        }
    }
    {
        const int l = (st >= 7) ? 1 : 0, pb = l ? 10 : 3;
        {
            if (IN(7)) { PH_BEGIN
                const LAS float* rsdp = nullptr;
                const bool tbl = (GS & 7) == 0; LAS float* t_ = (LAS float*)(L + RSD_OFF); if (tbl) rsdp = t_;
                if (doP) { pg8::Gemm g{D, D, D}; pg8::StaticOrder S; S.init(8, 12, GS, mi, grp * 8, X16, (size_t)256 * D * 2, WIN, (size_t)256 * D * 2);
                  pg8::EpiRow<2> E{OB, D, SSQ, 1.f, CH, out + OCP, rsdp};
                  const int pnl = grp * 8 + (mi & 7);
                  pg8::gemm_phase<pg8::EpiRow<2>, pg8::StaticOrder, true>(L + RING_OFF, g, S, E, TID_NOW, [&](int t) { if (tbl) rstd_table(SSQ, pnl, t_, t); }); }
                if (doS) { RELANE
                for (int c2 = mi; c2 < 32; c2 += GS) {
                    const int ca = 32 * c2, cb = ca + 16; const int ra = 1024 + (ca >> 7) * 256 + (ca & 127), rb = 1024 + (cb >> 7) * 256 + (cb & 127);
                    const int brow[6] = {ca, ra, ra + 128, cb, rb, rb + 128};
                    const float rs = srstd(SSQS, 16 * grp + (lane & 15), lane >> 4);
                    const int prow = 16 * grp + (lane & 15), pc = ((wave & 1) ? cb : ca) + 4 * (lane >> 4);
                    const f32x4 s0 = *(const f32x4*)(state_conv + ((size_t)prow * 2 + 0) * D + pc), s1 = *(const f32x4*)(state_conv + ((size_t)prow * 2 + 1) * D + pc);
                    const f32x4 w0 = *(const f32x4*)(w_conv + pc), w1 = *(const f32x4*)(w_conv + D + pc), w2 = *(const f32x4*)(w_conv + 2 * D + pc);
                    sgemm2<1, 6, 3, 4>(XS16, D, 16 * grp, WIN, D, brow, D, L + RING_OFF, wave, lane, [&](f32x4 (&a)[3], int row, int ct0, int fq) {
                        const int c0 = (ct0 == 0 ? ca : cb) + 4 * fq;
                        const f32x4 gb = a[0] * rs, chv = a[1] * a[2] * (rs * rs);
                        const f32x4 cv = s0 * w0 + s1 * w1 + chv * w2;
                        const unsigned g01 = pk2(gb[0], gb[1]), g23 = pk2(gb[2], gb[3]);
                        v2u o; o.x = pk2(bflo(g01) * cv[0], bfhi(g01) * cv[1]); o.y = pk2(bflo(g23) * cv[2], bfhi(g23) * cv[3]);
                        *(v2u*)(P0S + (size_t)row * D + c0) = o;
                        *(f32x4*)(out + OCS + ((size_t)row * 2 + 0) * D + c0) = s1; *(f32x4*)(out + OCS + ((size_t)row * 2 + 1) * D + c0) = chv; }); }
                }
            }
            SEAM(7);
            if (IN(8)) { PH_BEGIN
                const int gt = mi * NTHREADS + tid, NT = GS * NTHREADS;
                if (doP) for (int it0 = gt; it0 < (SEQ / 4) * 128; it0 += 2 * NT) {
                    v4u gb[2][4], cw[2][6];
#pragma unroll
                    for (int q = 0; q < 2; ++q) { const int it = it0 + q * NT; const bool ok = it < (SEQ / 4) * 128; const int t0 = ok ? (it >> 7) * 4 : 0, c8 = (it & 127) * 8; const size_t r0 = (size_t)grp * SEQ + t0;
#pragma unroll
                        for (int j = 0; j < 4; ++j) gb[q][j] = __builtin_nontemporal_load((const v4u*)(OB + (r0 + j) * D + c8));
#pragma unroll
                        for (int j = 0; j < 6; ++j) { const int dt = j - 2; cw[q][j] = *(const v4u*)(CH + (r0 + ((t0 + dt >= 0) ? dt : 0)) * D + c8); } }
#pragma unroll
                    for (int q = 0; q < 2; ++q) { const int it = it0 + q * NT; if (it >= (SEQ / 4) * 128) break; const int t0 = (it >> 7) * 4, c8 = (it & 127) * 8; const size_t r0 = (size_t)grp * SEQ + t0;
                        if (t0 == 0) { cw[q][0] = (v4u){0u, 0u, 0u, 0u}; cw[q][1] = (v4u){0u, 0u, 0u, 0u}; }
                        const f32x4 w0a = *(const f32x4*)(w_conv + c8), w0b = *(const f32x4*)(w_conv + c8 + 4), w1a = *(const f32x4*)(w_conv + D + c8), w1b = *(const f32x4*)(w_conv + D + c8 + 4),
                                    w2a = *(const f32x4*)(w_conv + 2 * D + c8), w2b = *(const f32x4*)(w_conv + 2 * D + c8 + 4);
#pragma unroll
                        for (int r = 0; r < 4; ++r) { v4u o;
#pragma unroll
                            for (int j = 0; j < 4; ++j) { const float wl0 = (j < 2) ? w0a[2 * j] : w0b[2 * j - 4], wh0 = (j < 2) ? w0a[2 * j + 1] : w0b[2 * j - 3];
                                const float wl1 = (j < 2) ? w1a[2 * j] : w1b[2 * j - 4], wh1 = (j < 2) ? w1a[2 * j + 1] : w1b[2 * j - 3];
                                const float wl2 = (j < 2) ? w2a[2 * j] : w2b[2 * j - 4], wh2 = (j < 2) ? w2a[2 * j + 1] : w2b[2 * j - 3];
                                const float lo_ = bflo(gb[q][r][j]) * (bflo(cw[q][r][j]) * wl0 + bflo(cw[q][r + 1][j]) * wl1 + bflo(cw[q][r + 2][j]) * wl2);
                                const float hi_ = bfhi(gb[q][r][j]) * (bfhi(cw[q][r][j]) * wh0 + bfhi(cw[q][r + 1][j]) * wh1 + bfhi(cw[q][r + 2][j]) * wh2);
                                o[j] = pk2(lo_, hi_); }
                            *(v4u*)(P0 + (r0 + r) * D + c8) = o; } }
                }
                if (doS) { for (int cp = mi; cp < 32; cp += GS) s_res_unit<4>(P0S, D, WOUT, D, D, cp, 16 * grp, nullptr, XS16, SSQS, nullptr, L + RING_OFF, wave, lane); }
            }
            SEAM(8);
            if (IN(9)) { PH_BEGIN
                if (doP) { pg8::Gemm g{D, D, D}; pg8::StaticOrder S; S.init(8, 4, GS, mi, grp * 8, P0, (size_t)256 * D * 2, WOUT, (size_t)256 * D * 2);
                  pg8::EpiRes<false> E{nullptr, X16, SSQ, nullptr};
                  pg8::gemm_phase<pg8::EpiRes<false>, pg8::StaticOrder, true>(L + RING_OFF, g, S, E, TID_NOW); }
                if (doS) { RELANE for (int cp = mi; cp < 32; cp += GS) s_q_unit(XS16, WQ + (size_t)D * D, cp, 16 * grp, SSQS, QS, L + RING_OFF, wave, lane); }
            }
            SEAM(9);
        }
#define LAYER_W const bf16* WQl = WQ + (size_t)l * D * D; const bf16* WOl = WO + (size_t)l * D * D; const bf16* WUPl = WUP + (size_t)l * FF * D; const bf16* WDNl = WDN + (size_t)l * D * FF; (void)WQl; (void)WOl; (void)WUPl; (void)WDNl;
        if (IN(pb)) { PH_BEGIN LAYER_W
#pragma unroll 1
            for (int half = 0; half < 2; ++half) {
            const bool sampleHalf = ((half == 0) == sfirst);
            if (doP && !sampleHalf) for (int itl = mi; itl < 32; itl += GS) {
                const int pm = grp * 8 + (itl >> 2), h = itl & 3;
                pg8::Gemm g{D, D, D}; pg8::SingleOrder S{{pm, h}, (const char*)(X16 + (size_t)pm * 256 * D), (const char*)(MT + (size_t)((l * BATCH + grp) * NH + h) * 256 * D)};
                LAS float* t_ = (LAS float*)(L + RSD_OFF);
                pg8::EpiSoftmax E{OB, D, SSQ, t_};
                pg8::gemm_phase<pg8::EpiSoftmax, pg8::SingleOrder, false>(L + RING_OFF, g, S, E, TID_NOW, [&](int t) { rstd_table(SSQ, pm, t_, t); });
                LDS_WAIT(); __builtin_amdgcn_s_barrier(); asm volatile("" ::: "memory");
            }
            if (doS && sampleHalf) { RELANE
                LAS float* sc = (LAS float*)(L + RING_OFF);
                LAS float* po = (LAS float*)(L + RING_OFF + 1024);
                for (int it0 = mi; it0 < 64; it0 += 2 * GS) {
                    const bool pair = (it0 + GS < 64);
#pragma unroll 1
                    for (int iu = 0; iu < 2; ++iu) {
                        if (iu == 1 && !pair) break;
                        const int it = it0 + iu * GS, b = 16 * grp + (it >> 2), h = it & 3;
                        const f32x4 q4 = *(const f32x4*)(QS + (size_t)b * D + h * 256 + lane * 4);
                        const float* kp = cache_k + (((size_t)l * MS + b) * NMEM + wave * 32) * D + h * 256 + lane * 4;
                        const float* vp = cache_v + (((size_t)l * MS + b) * NMEM + wave * 32) * D + h * 256 + lane * 4;
                        f32x4 kv[32]; float p[32];
#pragma unroll
                        for (int n = 0; n < 32; ++n) kv[n] = __builtin_nontemporal_load((const f32x4*)(kp + (size_t)n * D));
#pragma unroll
                        for (int n = 0; n < 32; ++n) { p[n] = (q4[0] * kv[n][0] + q4[1] * kv[n][1]) + (q4[2] * kv[n][2] + q4[3] * kv[n][3]); kv[n] = __builtin_nontemporal_load((const f32x4*)(vp + (size_t)n * D)); }
                        treduce32(p, lane);
                        if ((lane & 1) == 0) sc[wave * 32 + (lane >> 1)] = p[0];
                        LDS_WAIT(); __builtin_amdgcn_s_barrier(); asm volatile("" ::: "memory");
                        float mx, sm = 0.f; const f32x4 sv = *(const LAS f32x4*)(sc + lane * 4);
                        mx = fmaxf(fmaxf(sv[0], sv[1]), fmaxf(sv[2], sv[3]));
                        mx = wave_max(mx);
#pragma unroll
                        for (int j = 0; j < 4; ++j) sm += __builtin_amdgcn_exp2f(sv[j] - mx);
                        sm = wave_sum(sm);
                        f32x4 acc = {0.f, 0.f, 0.f, 0.f};
#pragma unroll
                        for (int n = 0; n < 32; ++n) { const float pn_ = __builtin_amdgcn_exp2f(sc[wave * 32 + n] - mx); acc += kv[n] * pn_; }
                        *(LAS f32x4*)(po + wave * 256 + lane * 4) = acc;
                        LDS_WAIT(); __builtin_amdgcn_s_barrier(); asm volatile("" ::: "memory");
                        if (tid < 256) { float o = 0.f;
#pragma unroll
                            for (int w = 0; w < 8; ++w) o += po[w * 256 + tid];
                            OS[(size_t)b * D + h * 256 + tid] = (bf16)f2bf(o / sm); }
                        LDS_WAIT(); __builtin_amdgcn_s_barrier(); asm volatile("" ::: "memory");
                    }
                }
            }
            }
        }
        SEAM(pb);
        if (IN(pb + 1)) { PH_BEGIN LAYER_W
            if (doP) { pg8::Gemm g{D, D, D}; pg8::StaticOrder S; S.init(8, 4, GS, mi, grp * 8, OB, (size_t)256 * D * 2, VW + (size_t)(l * BATCH + grp) * D * D, (size_t)256 * D * 2);
              pg8::EpiRes<false> E{nullptr, X16, SSQ, nullptr};
              pg8::gemm_phase<pg8::EpiRes<false>, pg8::StaticOrder, true>(L + RING_OFF, g, S, E, TID_NOW); }
            if (doS) { RELANE for (int cp = mi; cp < 32; cp += GS) s_res_unit<4>(OS, D, WOl, D, D, cp, 16 * grp, nullptr, XS16, SSQS, nullptr, L + RING_OFF, wave, lane); }
        }
        SEAM(pb + 2);
        if (IN(pb + 2)) { PH_BEGIN LAYER_W
            const LAS float* rsdp = nullptr;
            const bool tbl = (GS & 7) == 0; LAS float* t_ = (LAS float*)(L + RSD_OFF); if (tbl) rsdp = t_;
            if (doP) { pg8::Gemm g{D, D, D}; pg8::StaticOrder S; S.init(8, 16, GS, mi, grp * 8, X16, (size_t)256 * D * 2, WUPl, (size_t)256 * D * 2);
              pg8::EpiRow<1> E{HB, FF, SSQ, 1.f, nullptr, nullptr, rsdp};
              const int pnl = grp * 8 + (mi & 7);
              pg8::gemm_phase<pg8::EpiRow<1>, pg8::StaticOrder, true>(L + RING_OFF, g, S, E, TID_NOW, [&](int t) { if (tbl) rstd_table(SSQ, pnl, t_, t); }); }
            if (doS) { RELANE for (int c8 = mi; c8 < 32; c8 += GS) { const int brow[8] = {128 * c8, 128 * c8 + 16, 128 * c8 + 32, 128 * c8 + 48, 128 * c8 + 64, 128 * c8 + 80, 128 * c8 + 96, 128 * c8 + 112};
                const float rs = srstd(SSQS, 16 * grp + (lane & 15), lane >> 4);
                sgemm2<1, 8, 1, 4>(XS16, D, 16 * grp, WUPl, D, brow, D, L + RING_OFF, wave, lane, [&](f32x4 (&a)[1], int row, int ct0, int fq) {
                    const f32x4 v0 = relu2(a[0] * rs);
                    v2u p0; p0.x = pk2(v0[0], v0[1]); p0.y = pk2(v0[2], v0[3]);
                    *(v2u*)(HS + (size_t)row * FF + 128 * c8 + 16 * ct0 + 4 * fq) = p0; }); } }
        }
        SEAM(pb + 3);
        if (IN(pb + 3)) { PH_BEGIN LAYER_W
            if (doP) { pg8::Gemm g{FF, FF, FF}; pg8::StaticOrder S; S.init(8, 4, GS, mi, grp * 8, HB, (size_t)256 * FF * 2, WDNl, (size_t)256 * FF * 2);
              pg8::EpiRes<false> E{nullptr, X16, SSQ, nullptr};
              pg8::gemm_phase<pg8::EpiRes<false>, pg8::StaticOrder, true>(L + RING_OFF, g, S, E, TID_NOW); }
            if (doS) { RELANE for (int cp = mi; cp < 32; cp += GS) s_res_unit<8>(HS, FF, WDNl, FF, FF, cp, 16 * grp, nullptr, XS16, SSQS, nullptr, L + RING_OFF, wave, lane); }
        }
        SEAM(pb + 4);
    }
    if (IN(14)) { PH_BEGIN
        const int mlo = doP ? 0 : SEQ, mhi = doS ? SEQ + 16 : SEQ;
        for (int ml0 = mlo + mi * NWAVES + wave; ml0 < mhi; ml0 += 4 * GS * NWAVES) {
            float sv[4]; v4u xw[4][2];
#pragma unroll
            for (int q = 0; q < 4; ++q) { const int ml = ml0 + q * GS * NWAVES; const bool ok = ml < mhi; const int mlc = ok ? ml : ml0;
                const bf16* xr;
                if (mlc < SEQ) { const int m = grp * SEQ + mlc; sv[q] = (lane < 16) ? SSQ[(size_t)m * 16 + lane] : 0.f; xr = X16 + (size_t)m * D; }
                else { const int r = 16 * grp + (mlc - SEQ); sv[q] = SSQS[r * 64 + lane]; xr = XS16 + (size_t)r * D; }
                xw[q][0] = __builtin_nontemporal_load((const v4u*)xr + lane); xw[q][1] = __builtin_nontemporal_load((const v4u*)xr + lane + 64); }
#pragma unroll
            for (int q = 0; q < 4; ++q) { const int ml = ml0 + q * GS * NWAVES; if (ml >= mhi) break;
                const float rs = __builtin_amdgcn_rsqf(wave_sum(sv[q]) * (1.f / D) + EPS);
                float* yr = (ml < SEQ) ? out + OY + (size_t)(grp * SEQ + ml) * D : out + OYS + (size_t)(16 * grp + (ml - SEQ)) * D;
#pragma unroll
                for (int j = 0; j < 2; ++j) { const v4u w = xw[q][j]; const f32x4 g0 = *((const f32x4*)g_final + 2 * (lane + 64 * j)), g1 = *((const f32x4*)g_final + 2 * (lane + 64 * j) + 1);
                    const f32x4 x0 = {bflo(w.x), bfhi(w.x), bflo(w.y), bfhi(w.y)}, x1 = {bflo(w.z), bfhi(w.z), bflo(w.w), bfhi(w.w)};
                    f32x4* yp = (f32x4*)yr + 2 * (lane + 64 * j); yp[0] = x0 * rs * g0; yp[1] = x1 * rs * g1; } }
        }
    }
    }
#if SELF_INIT && !MK_PER_PHASE
    if (ph == 0) {
        if (wave0 == 0 && lane_id_opaque() == 0) {
            unsigned sp_ = 0u;
            while (__hip_atomic_load(ctlw + CW_FLAG, __ATOMIC_RELAXED, __HIP_MEMORY_SCOPE_AGENT) != INIT_MAGIC) { __builtin_amdgcn_s_sleep(2); if (++sp_ > (1u << 22)) break; }
            (void)xb_add(&bar.bar[XB_XCNT(bar.x)], 1u); (void)xb_add(&gbar.bar[XB_XCNT(gbar.x)], 1u);
        }
    }
#endif
    if (ph + 1 < hi + soff) { if (ph == 0) { GRID_BAR();
#if STAGGER_TICKS > 0
            { const unsigned long long t0 = __builtin_amdgcn_s_memrealtime(); const unsigned long long dt = (unsigned long long)grp * STAGGER_TICKS;
              while (__builtin_amdgcn_s_memrealtime() - t0 < dt) __builtin_amdgcn_s_sleep(4); }
#endif
        } else GROUP_BAR(); }
    }
#if SELF_INIT && !MK_PER_PHASE
    if (bx == 0 && threadIdx.x == 0) __hip_atomic_store(ctlw + CW_FLAG, 0u, __ATOMIC_RELAXED, __HIP_MEMORY_SCOPE_AGENT);
#endif
#undef IN
#undef SEAM
#undef GRID_BAR
}

extern "C" void kernel_launch(void* const* d_in, const int* in_sizes, int n_in, void* d_out, int out_size, void* d_ws, size_t ws_size, hipStream_t stream) {
    static int grid = 0;
    if (grid == 0) {
        if (n_in != 22 || ws_size < WS_END) { fprintf(stderr, "kernel_launch: unexpected inputs (n_in %d, ws %zu)\n", n_in, ws_size); grid = -1; return; }
        int dev = 0, cus = 0, per_cu = 0;
        if (hipGetDevice(&dev) != hipSuccess || hipDeviceGetAttribute(&cus, hipDeviceAttributeMultiprocessorCount, dev) != hipSuccess) { grid = -1; return; }
        if (hipFuncSetAttribute((const void*)mk_fwd, hipFuncAttributeMaxDynamicSharedMemorySize, LDS_BYTES) != hipSuccess) { fprintf(stderr, "kernel_launch: hipFuncSetAttribute failed\n"); grid = -1; return; }
        if (hipOccupancyMaxActiveBlocksPerMultiprocessor(&per_cu, (const void*)mk_fwd, NTHREADS, LDS_BYTES) != hipSuccess || per_cu < 1)
            fprintf(stderr, "kernel_launch: note: occupancy query reports %d workgroups per CU\n", per_cu);
        (void)hipGetLastError();
        grid = cus;
    }
    if (grid < 0) return;
#if !SELF_INIT || MK_PER_PHASE
    (void)hipMemsetAsync((char*)d_ws + WS_CTL, 0, CTL_ZERO_BYTES, stream);
#endif
    Args a{};
    for (int i = 0; i < 22; ++i) a.in[i] = (const float*)d_in[i];
    a.out = (float*)d_out; a.ws = (unsigned char*)d_ws;
#if MK_PER_PHASE
    for (int p = 0; p < NPHASES; ++p) { a.ph_lo = p; a.ph_hi = p + 1; hipLaunchKernelGGL(mk_fwd, dim3(grid), dim3(NTHREADS), LDS_BYTES, stream, a); }
#else
    a.ph_lo = 0; a.ph_hi = NPHASES; hipLaunchKernelGGL(mk_fwd, dim3(grid), dim3(NTHREADS), LDS_BYTES, stream, a);
#endif
}
```
